# Optimizing an MI355X kernel written in HIP

```python
import numpy as np
import jax
import jax.numpy as jnp
from jax import lax

D_MODEL = 1024
BATCH = 8
SEQ = 2048
DEPTH = 2

CTX_LEN = 256
GRID_W = 64
MIX_DIM = D_MODEL
HEAD_DIM = 64
NA_DIM = MIX_DIM // 2
NA_HEADS = NA_DIM // HEAD_DIM
NA_WIN_ROWS = 8
NA_WIN_COLS = 16
POOL_DIM = MIX_DIM // 4
POOL_WINDOWS = (2, 4, 8, 16)
POOL_GROUPS = len(POOL_WINDOWS)
POOL_GROUP_DIM = POOL_DIM // POOL_GROUPS
ML_DIM = MIX_DIM // 4
ML_HEADS = ML_DIM // HEAD_DIM
ML_CHUNK = 64
ML_CONV_W = 5
ML_N_GATES = 4 * ML_HEADS
IN_COLS = 3 * NA_DIM + POOL_DIM + 4 * ML_DIM + ML_N_GATES
PEER_KEYS = 128
PEER_EXPERTS = PEER_KEYS * PEER_KEYS
PEER_HEADS = 8
PEER_TOPK = 16
PEER_DKEY = 256
PEER_BLOCK = 128
ROPE_BASE = 10000.0
EPS = 1e-6

kernel_name = 'hybrid_na_pool_mlstm_peer_dit'


def _rms(x, g):
    xf = x.astype(jnp.float32)
    y = xf * lax.rsqrt(jnp.mean(xf * xf, axis=-1, keepdims=True) + EPS)
    return (y * g.astype(jnp.float32)).astype(x.dtype)


def _heads(u, n_heads):
    return u.reshape(u.shape[:-1] + (n_heads, HEAD_DIM))


def _split_cols(p):
    sizes = (NA_DIM, NA_DIM, NA_DIM, POOL_DIM, ML_DIM, ML_DIM, ML_DIM, ML_DIM, ML_N_GATES)
    offs = np.cumsum(sizes)[:-1].tolist()
    return jnp.split(p, offs, axis=-1)


def _na_latent(q, k, v, k_ctx, v_ctx, rpb):
    B, S, H, d = q.shape
    R = S // GRID_W
    KR = min(NA_WIN_ROWS, R)
    qg = q.reshape(B, R, GRID_W, H, d)
    kg = k.reshape(B, R, GRID_W, H, d)
    vg = v.reshape(B, R, GRID_W, H, d)
    r = jnp.arange(R)
    r0 = jnp.clip(r - KR // 2, 0, R - KR)
    rows = r0[:, None] + jnp.arange(KR)[None, :]
    k_strip = kg[:, rows]
    v_strip = vg[:, rows]
    cq = jnp.arange(GRID_W)
    c0 = jnp.clip(cq - NA_WIN_COLS // 2, 0, GRID_W - NA_WIN_COLS)
    in_win = (cq[None, :] >= c0[:, None]) & (cq[None, :] < c0[:, None] + NA_WIN_COLS)
    br = rows - r[:, None] + (NA_WIN_ROWS - 1)
    bc = jnp.clip(cq[None, :] - cq[:, None] + (NA_WIN_COLS - 1), 0, 2 * NA_WIN_COLS - 2)
    bias = rpb[:, br[:, None, :, None], bc[None, :, None, :]]
    bias = jnp.transpose(bias, (1, 0, 2, 3, 4)).astype(jnp.float32)
    scale = HEAD_DIM ** -0.5
    s_win = jnp.einsum('brwhd,brkxhd->brhwkx', qg, k_strip).astype(jnp.float32) * scale + bias
    s_win = jnp.where(in_win[:, None, :], s_win, -jnp.inf).reshape(B, R, H, GRID_W, KR * GRID_W)
    s_ctx = jnp.einsum('brwhd,bchd->brhwc', qg, k_ctx).astype(jnp.float32) * scale
    p = jax.nn.softmax(jnp.concatenate([s_win, s_ctx], axis=-1), axis=-1).astype(v.dtype)
    p_win = p[..., :KR * GRID_W].reshape(B, R, H, GRID_W, KR, GRID_W)
    p_ctx = p[..., KR * GRID_W:]
    o = jnp.einsum('brhwkx,brkxhd->brwhd', p_win, v_strip) + jnp.einsum('brhwc,bchd->brwhd', p_ctx, v_ctx)
    return o.reshape(B, S, H * d)


def _na_context(q, k, v):
    s = jnp.einsum('bqhd,bkhd->bhqk', q, k).astype(jnp.float32) * HEAD_DIM ** -0.5
    p = jax.nn.softmax(s, axis=-1).astype(v.dtype)
    o = jnp.einsum('bhqk,bkhd->bqhd', p, v)
    return o.reshape(o.shape[:2] + (NA_DIM,))


def _pool_mix(u, pool_w, pool_scale):
    B, T, _ = u.shape
    ug = u.reshape(B, T, POOL_GROUPS, POOL_GROUP_DIM)
    csum = jnp.concatenate([jnp.zeros((B, 1, POOL_GROUPS, POOL_GROUP_DIM), jnp.float32),
                            jnp.cumsum(ug.astype(jnp.float32), axis=1)], axis=1)
    t = jnp.arange(T)
    outs = []
    for gi, w in enumerate(POOL_WINDOWS):
        lo = jnp.clip(t - w // 2, 0, T - 1)
        hi = jnp.clip(t + (w - w // 2 - 1), 0, T - 1)
        total = csum[:, hi + 1, gi] - csum[:, lo, gi]
        cnt = (hi - lo + 1).astype(jnp.float32)[None, :, None]
        outs.append(total / cnt)
    pooled = jnp.stack(outs, axis=2).astype(u.dtype) - ug
    mixed = jnp.einsum('btgc,gcd->btgd', pooled, pool_w)
    return mixed.reshape(B, T, POOL_DIM) * pool_scale


def _dwconv(u, w):
    C = u.shape[-1]
    return lax.conv_general_dilated(u, w[:, None, :].astype(u.dtype), window_strides=(1,), padding='SAME',
                                    dimension_numbers=('NWC', 'WIO', 'NWC'), feature_group_count=C)


def _axial_rope(T):
    t = jnp.arange(T)
    row = (t // GRID_W).astype(jnp.float32)
    col = (t % GRID_W).astype(jnp.float32)
    nf = HEAD_DIM // 4
    inv = ROPE_BASE ** (-jnp.arange(nf, dtype=jnp.float32) / nf)
    ang = jnp.stack([row[:, None] * inv, col[:, None] * inv], axis=1)
    return jnp.cos(ang), jnp.sin(ang)


def _apply_rope(x, cos, sin):
    xs = x.reshape(x.shape[:-1] + (2, 2, HEAD_DIM // 4))
    a, b = xs[..., 0, :], xs[..., 1, :]
    out = jnp.stack([a * cos - b * sin, a * sin + b * cos], axis=-2)
    return out.reshape(x.shape)


def _mlstm_inputs(uq, uk, uv, ug, conv_w, gate_b, rope):
    qk = jax.nn.silu(_dwconv(jnp.concatenate([uq, uk], axis=-1), conv_w))
    q, k = jnp.split(qk, 2, axis=-1)
    to_h = lambda u: jnp.moveaxis(_heads(u, ML_HEADS).astype(jnp.float32), 2, 1)
    q, k, v = to_h(q), to_h(k), to_h(uv)
    if rope is not None:
        q = _apply_rope(q, *rope)
        k = _apply_rope(k, *rope)
    k = k * HEAD_DIM ** -0.5
    g = ug.astype(jnp.float32) + gate_b.astype(jnp.float32)
    g = jnp.moveaxis(g.reshape(g.shape[:2] + (4, ML_HEADS)), (2, 3), (0, 2))
    gates = (g[0], jax.nn.log_sigmoid(g[1]), g[2], jax.nn.log_sigmoid(g[3]))
    return q, k, v, gates


def _mlstm_chunked(q, k, v, log_i, log_f, state):
    B, H, T, d = q.shape
    L = min(ML_CHUNK, T)
    nc = T // L

    def chunks(a):
        return jnp.moveaxis(a.reshape(a.shape[:2] + (nc, L) + a.shape[3:]), 2, 0)

    lower = jnp.tril(jnp.ones((L, L), dtype=bool))

    def step(carry, inp):
        C, n, m = carry
        qc, kc, vc, ic, fc = inp
        b = jnp.cumsum(fc, axis=-1)
        log_d = jnp.where(lower, b[..., :, None] - b[..., None, :] + ic[..., None, :], -jnp.inf)
        inter = b + m[..., None]
        m_t = jnp.maximum(inter, jnp.max(log_d, axis=-1))
        w_intra = jnp.einsum('bhtd,bhsd->bhts', qc, kc) * jnp.exp(log_d - m_t[..., None])
        w_inter = jnp.exp(inter - m_t)
        num = jnp.einsum('bhts,bhsd->bhtd', w_intra, vc) + w_inter[..., None] * jnp.einsum('bhtd,bhde->bhte', qc, C)
        den = jnp.sum(w_intra, axis=-1) + w_inter * jnp.einsum('bhtd,bhd->bht', qc, n)
        h = num / jnp.maximum(jnp.abs(den), jnp.exp(-m_t))[..., None]
        b_last = b[..., -1]
        log_w = b_last[..., None] - b + ic
        m_new = jnp.maximum(b_last + m, jnp.max(log_w, axis=-1))
        w_s = jnp.exp(log_w - m_new[..., None])
        decay = jnp.exp(b_last + m - m_new)
        C_new = decay[..., None, None] * C + jnp.einsum('bhs,bhsd,bhse->bhde', w_s, kc, vc)
        n_new = decay[..., None] * n + jnp.einsum('bhs,bhsd->bhd', w_s, kc)
        return (C_new, n_new, m_new), h

    state, h = lax.scan(step, state, (chunks(q), chunks(k), chunks(v), chunks(log_i), chunks(log_f)))
    return jnp.moveaxis(h, 0, 2).reshape(B, H, T, d), state


def _mlstm_out(h, uo, norm_g):
    hf = h * lax.rsqrt(jnp.mean(h * h, axis=-1, keepdims=True) + EPS)
    hf = jnp.moveaxis(hf, 1, 2).reshape(h.shape[0], h.shape[2], ML_DIM)
    return (hf * norm_g.astype(jnp.float32)).astype(uo.dtype) * jax.nn.sigmoid(uo)


def _token_mix(xn, hn, w_in, ml_gate_b, na_q_g, na_k_g, na_rpb, pool_w, pool_scale, ml_conv, ml_norm_g,
               need_ctx_out):
    lq, lk, lv, lpool, lmq, lmk, lmv, lmo, lmg = _split_cols(xn @ w_in)
    cq, ck, cv, cpool, cmq, cmk, cmv, cmo, cmg = _split_cols(hn @ w_in)
    qn = lambda u: _rms(_heads(u, NA_HEADS), na_q_g)
    kn = lambda u: _rms(_heads(u, NA_HEADS), na_k_g)
    k_ctx, v_ctx = kn(ck), _heads(cv, NA_HEADS)
    na_lat = _na_latent(qn(lq), kn(lk), _heads(lv, NA_HEADS), k_ctx, v_ctx, na_rpb)
    pool_lat = _pool_mix(lpool, pool_w, pool_scale)
    T = xn.shape[1]
    ql, kl, vl, gl = _mlstm_inputs(lmq, lmk, lmv, lmg, ml_conv, ml_gate_b, _axial_rope(T))
    qc, kc, vc, gc = _mlstm_inputs(cmq, cmk, cmv, cmg, ml_conv, ml_gate_b, None)
    B = xn.shape[0]
    zero = (jnp.zeros((B, ML_HEADS, HEAD_DIM, HEAD_DIM), jnp.float32),
            jnp.zeros((B, ML_HEADS, HEAD_DIM), jnp.float32),
            jnp.zeros((B, ML_HEADS), jnp.float32))
    fl = lambda a: jnp.flip(a, axis=2)
    h_cf, st_f = _mlstm_chunked(qc, kc, vc, gc[0], gc[1], zero)
    h_cb, st_b = _mlstm_chunked(fl(qc), fl(kc), fl(vc), fl(gc[2]), fl(gc[3]), zero)
    h_lf, _ = _mlstm_chunked(ql, kl, vl, gl[0], gl[1], st_f)
    h_lb, _ = _mlstm_chunked(fl(ql), fl(kl), fl(vl), fl(gl[2]), fl(gl[3]), st_b)
    ml_lat = _mlstm_out(h_lf + fl(h_lb), lmo, ml_norm_g)
    y_lat = jnp.concatenate([na_lat, pool_lat, ml_lat], axis=-1)
    if not need_ctx_out:
        return y_lat, None
    na_ctx = _na_context(qn(cq), k_ctx, v_ctx)
    pool_ctx = _pool_mix(cpool, pool_w, pool_scale)
    ml_ctx = _mlstm_out(h_cf + fl(h_cb), cmo, ml_norm_g)
    y_ctx = jnp.concatenate([na_ctx, pool_ctx, ml_ctx], axis=-1)
    return y_lat, y_ctx


def _peer(xn, wq, sub_keys, u_tab, v_tab):
    B, T, D = xn.shape
    n = B * T
    tok = xn.reshape(n, D)
    q = (tok @ wq).reshape(n, PEER_HEADS, 2, PEER_DKEY // 2).astype(jnp.float32)
    s = jnp.einsum('nhpd,hpkd->nhpk', q, sub_keys.astype(jnp.float32))
    s1, i1 = lax.top_k(s[:, :, 0], PEER_TOPK)
    s2, i2 = lax.top_k(s[:, :, 1], PEER_TOPK)
    cand_s = (s1[..., :, None] + s2[..., None, :]).reshape(n, PEER_HEADS, PEER_TOPK * PEER_TOPK)
    cand_i = (i1[..., :, None] * PEER_KEYS + i2[..., None, :]).reshape(n, PEER_HEADS, PEER_TOPK * PEER_TOPK)
    top_s, pos = lax.top_k(cand_s, PEER_TOPK)
    idx = jnp.take_along_axis(cand_i, pos, axis=-1)
    gate = jax.nn.softmax(top_s, axis=-1).astype(xn.dtype)
    nb = n // PEER_BLOCK

    def block(args):
        xb, ib, gb = args
        u_e = u_tab[ib]
        v_e = v_tab[ib]
        a = jax.nn.gelu(jnp.einsum('nd,nhkd->nhk', xb, u_e)) * gb
        return jnp.einsum('nhk,nhkd->nd', a, v_e)

    out = lax.map(block, (tok.reshape(nb, PEER_BLOCK, D),
                          idx.reshape(nb, PEER_BLOCK, PEER_HEADS, PEER_TOPK),
                          gate.reshape(nb, PEER_BLOCK, PEER_HEADS, PEER_TOPK)))
    return out.reshape(B, T, D)


def setup_inputs(seed: int = 0) -> dict:
    key = jax.random.key(seed)
    ks = jax.random.split(key, 24)
    D = D_MODEL

    def nrm(k, shape, s):
        return jax.random.normal(k, shape, jnp.float32) * s

    f_init = jnp.linspace(3.0, 6.0, ML_HEADS, dtype=jnp.float32)
    z = jnp.zeros((ML_HEADS,), jnp.float32)
    gate_base = jnp.concatenate([z, f_init, z, f_init])
    return {
        'x': nrm(ks[0], (BATCH, SEQ, D), 1.0),
        'c': nrm(ks[1], (BATCH, D), 1.0),
        'ctx': nrm(ks[2], (BATCH, CTX_LEN, D), 1.0),
        'c_ctx': nrm(ks[3], (D,), 1.0),
        'w_ada': nrm(ks[4], (DEPTH, D, 6 * D), 0.5 * D ** -0.5),
        'b_ada': nrm(ks[5], (DEPTH, 6 * D), 0.02),
        'norm1_g': 1.0 + nrm(ks[6], (DEPTH, D), 0.02),
        'w_in': nrm(ks[7], (DEPTH, D, IN_COLS), D ** -0.5),
        'ml_gate_b': gate_base[None, :] + nrm(ks[8], (DEPTH, ML_N_GATES), 0.1),
        'na_q_g': 1.0 + nrm(ks[9], (DEPTH, HEAD_DIM), 0.02),
        'na_k_g': 1.0 + nrm(ks[10], (DEPTH, HEAD_DIM), 0.02),
        'na_rpb': nrm(ks[11], (DEPTH, NA_HEADS, 2 * NA_WIN_ROWS - 1, 2 * NA_WIN_COLS - 1), 0.1),
        'pool_w': nrm(ks[12], (DEPTH, POOL_GROUPS, POOL_GROUP_DIM, POOL_GROUP_DIM), POOL_GROUP_DIM ** -0.5),
        'pool_scale': 1.0 + nrm(ks[13], (DEPTH, POOL_DIM), 0.02),
        'ml_conv': nrm(ks[14], (DEPTH, ML_CONV_W, 2 * ML_DIM), ML_CONV_W ** -0.5),
        'ml_norm_g': 1.0 + nrm(ks[15], (DEPTH, ML_DIM), 0.02),
        'w_out': nrm(ks[16], (DEPTH, MIX_DIM, D), MIX_DIM ** -0.5),
        'norm2_g': 1.0 + nrm(ks[17], (DEPTH, D), 0.02),
        'peer_wq': nrm(ks[18], (DEPTH, D, PEER_HEADS * PEER_DKEY), D ** -0.5),
        'peer_keys': nrm(ks[19], (DEPTH, PEER_HEADS, 2, PEER_KEYS, PEER_DKEY // 2), (PEER_DKEY // 2) ** -0.5),
        'peer_u': nrm(ks[20], (DEPTH, PEER_EXPERTS, D), D ** -0.5),
        'peer_v': nrm(ks[21], (DEPTH, PEER_EXPERTS, D), 0.25),
    }


def reference(x, c, ctx, c_ctx, w_ada, b_ada, norm1_g, w_in, ml_gate_b, na_q_g, na_k_g, na_rpb, pool_w,
              pool_scale, ml_conv, ml_norm_g, w_out, norm2_g, peer_wq, peer_keys, peer_u, peer_v):
    hc = ctx
    for l in range(DEPTH):
        need_ctx = l < DEPTH - 1
        mod_lat = jax.nn.silu(c) @ w_ada[l] + b_ada[l]
        mod_ctx = jax.nn.silu(c_ctx) @ w_ada[l] + b_ada[l]
        sh1, sc1, g1, sh2, sc2, g2 = jnp.split(mod_lat[:, None, :], 6, axis=-1)
        csh1, csc1, cg1, csh2, csc2, cg2 = jnp.split(mod_ctx[None, None, :], 6, axis=-1)
        xn = _rms(x, norm1_g[l]) * (1.0 + sc1) + sh1
        hn = _rms(hc, norm1_g[l]) * (1.0 + csc1) + csh1
        y_lat, y_ctx = _token_mix(xn, hn, w_in[l], ml_gate_b[l], na_q_g[l], na_k_g[l], na_rpb[l], pool_w[l],
                                  pool_scale[l], ml_conv[l], ml_norm_g[l], need_ctx)
        x = x + g1 * (y_lat @ w_out[l])
        x = x + g2 * _peer(_rms(x, norm2_g[l]) * (1.0 + sc2) + sh2, peer_wq[l], peer_keys[l], peer_u[l], peer_v[l])
        if need_ctx:
            hc = hc + cg1 * (y_ctx @ w_out[l])
            hc = hc + cg2 * _peer(_rms(hc, norm2_g[l]) * (1.0 + csc2) + csh2, peer_wq[l], peer_keys[l],
                                  peer_u[l], peer_v[l])
    return x
```

```cpp
#include <hip/hip_runtime.h>
#include <hip/hip_cooperative_groups.h>
#include <cstdio>
namespace cg = cooperative_groups;

#ifndef MEGA
#define MEGA 1
#endif

typedef unsigned short u16;
typedef __attribute__((ext_vector_type(8))) short bf16x8;
typedef __attribute__((ext_vector_type(4))) float f32x4;

#define ML_ROWS 16384
#define MC_ROWS 2048
#define MT_ROWS 18432
#define INC 2832
#define INC_PAD 2944
#define SLOT 4224
#define SMEM_BYTES 69632
#define NPHASES 23

struct P {
  const float *x, *c, *ctx, *c_ctx, *w_ada, *b_ada, *norm1_g, *w_in, *ml_gate_b, *na_q_g, *na_k_g, *na_rpb,
      *pool_w, *pool_scale, *ml_conv, *ml_norm_g, *w_out, *norm2_g, *peer_wq, *peer_keys, *peer_u, *peer_v;
  float* out;
  u16 *WinT, *WoutT, *WsT, *Ub, *Vb;
  float* mod;
  u16* xn;
  u16* U;
  float* MQK;
  u16* Y;
  float* S;
  float* G;
  float* mst;
  float* hc;
  int* eidx;
  float* egate;
  long long ph_lo, ph_hi;
};

__device__ __forceinline__ u16 f2bf(float f) {
  unsigned u = __float_as_uint(f);
  u += 0x7fffu + ((u >> 16) & 1u);
  return (u16)(u >> 16);
}
__device__ __forceinline__ float bf2f(u16 h) { return __uint_as_float(((unsigned)h) << 16); }
__device__ __forceinline__ float bflo(unsigned u) { return __uint_as_float(u << 16); }
__device__ __forceinline__ float bfhi(unsigned u) { return __uint_as_float(u & 0xffff0000u); }
__device__ __forceinline__ unsigned pack2(float a, float b) { return (unsigned)f2bf(a) | ((unsigned)f2bf(b) << 16); }
__device__ __forceinline__ float wave_sum(float v) {
#pragma unroll
  for (int o = 32; o; o >>= 1) v += __shfl_xor(v, o);
  return v;
}
__device__ __forceinline__ void wave_argmax(float& v, int& i) {
#pragma unroll
  for (int o = 32; o; o >>= 1) {
    float ov = __shfl_xor(v, o);
    int oi = __shfl_xor(i, o);
    if (ov > v || (ov == v && oi < i)) { v = ov; i = oi; }
  }
}
__device__ __forceinline__ float sigmoidf_(float x) { return 1.f / (1.f + __expf(-x)); }
__device__ __forceinline__ float siluf_(float x) { return x / (1.f + __expf(-x)); }

__device__ __forceinline__ void transpose_item(const float* __restrict__ src, int N, u16* __restrict__ dst, int kt, int nt, float* tl) {
  const int tid = threadIdx.x;
#pragma unroll 4
  for (int i = 0; i < 16; i++) {
    int idx = tid + 256 * i;
    int kk = idx >> 6, nn = idx & 63;
    int n = nt * 64 + nn;
    float v = (n < N) ? src[(size_t)(kt * 64 + kk) * N + n] : 0.f;
    tl[kk * 65 + nn] = v;
  }
  __syncthreads();
#pragma unroll 4
  for (int i = 0; i < 16; i++) {
    int idx = tid + 256 * i;
    int nn = idx >> 6, kk = idx & 63;
    dst[(size_t)(nt * 64 + nn) * 1024 + kt * 64 + kk] = f2bf(tl[kk * 65 + nn]);
  }
  __syncthreads();
}

__device__ __forceinline__ void wst_item(const P& p, int it, float* sm) {
  const int tid = threadIdx.x;
  int l = it >> 8, hp = (it >> 4) & 15, dt = it & 15;
  float* As = sm;
  float* Ks = sm + 64 * 33;
  const float* wq = p.peer_wq + (size_t)l * 1024 * 2048;
  const float* keys = p.peer_keys + ((size_t)l * 16 + hp) * 128 * 128;
  int d = tid & 63, cg_ = tid >> 6;
  float acc[32];
#pragma unroll
  for (int c = 0; c < 32; c++) acc[c] = 0.f;
  for (int jc = 0; jc < 4; jc++) {
    __syncthreads();
#pragma unroll
    for (int i = 0; i < 8; i++) {
      int idx = tid + 256 * i;
      int dd = idx >> 5, j = idx & 31;
      As[dd * 33 + j] = wq[(size_t)(dt * 64 + dd) * 2048 + hp * 128 + jc * 32 + j];
    }
#pragma unroll
    for (int i = 0; i < 16; i++) {
      int idx = tid + 256 * i;
      int k = idx >> 5, j = idx & 31;
      Ks[k * 33 + j] = keys[k * 128 + jc * 32 + j];
    }
    __syncthreads();
    for (int j = 0; j < 32; j++) {
      float a = As[d * 33 + j];
#pragma unroll
      for (int c = 0; c < 32; c++) acc[c] += a * Ks[(cg_ * 32 + c) * 33 + j];
    }
  }
  u16* dst = p.WsT + (size_t)l * 2048 * 1024;
#pragma unroll
  for (int c = 0; c < 32; c++) dst[(size_t)(hp * 128 + cg_ * 32 + c) * 1024 + dt * 64 + d] = f2bf(acc[c]);
  __syncthreads();
}

__device__ __forceinline__ void mod_item(const P& p, int it, float* sm) {
  const int tid = threadIdx.x;
  int l = it / 96, cc = it % 96;
  float* sc = sm;
  float* red = sm + 9216;
  for (int idx = tid; idx < 9216; idx += 256) {
    int r = idx >> 10, k = idx & 1023;
    float v = (r < 8) ? p.c[r * 1024 + k] : p.c_ctx[k];
    sc[idx] = siluf_(v);
  }
  __syncthreads();
  int cl = tid & 63, kg = tid >> 6;
  int col = cc * 64 + cl;
  float acc[9];
#pragma unroll
  for (int r = 0; r < 9; r++) acc[r] = 0.f;
  const float* wa = p.w_ada + (size_t)l * 1024 * 6144;
#pragma unroll 4
  for (int k = kg * 256; k < kg * 256 + 256; k++) {
    float w = wa[(size_t)k * 6144 + col];
#pragma unroll
    for (int r = 0; r < 9; r++) acc[r] += sc[r * 1024 + k] * w;
  }
#pragma unroll
  for (int r = 0; r < 9; r++) red[(kg * 9 + r) * 64 + cl] = acc[r];
  __syncthreads();
  if (kg == 0) {
    float bb = p.b_ada[l * 6144 + col];
#pragma unroll
    for (int r = 0; r < 9; r++) {
      float s = red[(0 * 9 + r) * 64 + cl] + red[(1 * 9 + r) * 64 + cl] + red[(2 * 9 + r) * 64 + cl] + red[(3 * 9 + r) * 64 + cl];
      p.mod[(size_t)(l * 9 + r) * 6144 + col] = s + bb;
    }
  }
  __syncthreads();
}

__device__ __forceinline__ void phase_prologue(const P& p, char* smem) {
  float* sm = (float*)smem;
  const int tid = threadIdx.x;
  const int N_A = 2 * 16 * 46, N_B = 2 * 16 * 16, N_C = 512, N_D = 192, N_E = 4096;
  const int total = N_A + N_B + N_C + N_D + N_E;
  for (int item = blockIdx.x; item < total; item += gridDim.x) {
    int it = item;
    if (it < N_A) {
      int l = it / (16 * 46), r = it % (16 * 46);
      transpose_item(p.w_in + (size_t)l * 1024 * INC, INC, p.WinT + (size_t)l * INC_PAD * 1024, r / 46, r % 46, sm);
      continue;
    }
    it -= N_A;
    if (it < N_B) {
      int l = it >> 8, r = it & 255;
      transpose_item(p.w_out + (size_t)l * 1024 * 1024, 1024, p.WoutT + (size_t)l * 1024 * 1024, r >> 4, r & 15, sm);
      continue;
    }
    it -= N_B;
    if (it < N_C) { wst_item(p, it, sm); continue; }
    it -= N_C;
    if (it < N_D) { mod_item(p, it, sm); continue; }
    it -= N_D;
    {
      int tab = it >> 11;
      int chunk = it & 2047;
      const float4* src = (const float4*)(tab ? p.peer_v : p.peer_u) + (size_t)chunk * 4096;
      uint2* dst = (uint2*)(tab ? p.Vb : p.Ub) + (size_t)chunk * 4096;
#pragma unroll 4
      for (int i = 0; i < 16; i++) {
        float4 v = src[i * 256 + tid];
        uint2 o;
        o.x = pack2(v.x, v.y);
        o.y = pack2(v.z, v.w);
        dst[i * 256 + tid] = o;
      }
    }
  }
}

__device__ __forceinline__ void phase_norm(const P& p, int l, int which) {
  const int tid = threadIdx.x, lane = tid & 63, w = tid >> 6;
  const int nrows = (which == 2 && l == 1) ? ML_ROWS : MT_ROWS;
  const float* g = (which == 1 ? p.norm1_g : p.norm2_g) + l * 1024;
  for (int item = blockIdx.x; item * 4 < nrows; item += gridDim.x) {
    int row = item * 4 + w;
    const float* src;
    if (l == 0 && which == 1) src = row < ML_ROWS ? p.x + (size_t)row * 1024 : p.ctx + (size_t)(row - ML_ROWS) * 1024;
    else src = row < ML_ROWS ? p.out + (size_t)row * 1024 : p.hc + (size_t)(row - ML_ROWS) * 1024;
    int mr = row < ML_ROWS ? (row >> 11) : 8;
    const float* modp = p.mod + (size_t)(l * 9 + mr) * 6144;
    const float* sh = modp + (which == 1 ? 0 : 3072);
    const float* sc = modp + (which == 1 ? 1024 : 4096);
    float4 v[4];
    float ss = 0.f;
#pragma unroll
    for (int i = 0; i < 4; i++) {
      v[i] = ((const float4*)src)[i * 64 + lane];
      ss += v[i].x * v[i].x + v[i].y * v[i].y + v[i].z * v[i].z + v[i].w * v[i].w;
    }
    ss = wave_sum(ss);
    float rs = rsqrtf(ss * (1.f / 1024.f) + 1e-6f);
#pragma unroll
    for (int i = 0; i < 4; i++) {
      int d = (i * 64 + lane) * 4;
      float4 gg = *(const float4*)(g + d);
      float4 s4 = *(const float4*)(sc + d);
      float4 h4 = *(const float4*)(sh + d);
      float o0 = v[i].x * rs * gg.x * (1.f + s4.x) + h4.x;
      float o1 = v[i].y * rs * gg.y * (1.f + s4.y) + h4.y;
      float o2 = v[i].z * rs * gg.z * (1.f + s4.z) + h4.z;
      float o3 = v[i].w * rs * gg.w * (1.f + s4.w) + h4.w;
      uint2 o;
      o.x = pack2(o0, o1);
      o.y = pack2(o2, o3);
      ((uint2*)(p.xn + (size_t)row * 1024))[i * 64 + lane] = o;
    }
  }
}

template <int EPI>
__device__ __forceinline__ void phase_gemm(const P& p, int l, const u16* __restrict__ A, const u16* __restrict__ Bt, int mtiles, int ntiles,
                           char* smem) {
  u16* As = (u16*)smem;
  u16* Bs = As + 128 * 40;
  const int tid = threadIdx.x, lane = tid & 63, w = tid >> 6, wm = w >> 1, wn = w & 1;
  const int lr = lane & 15, quad = lane >> 4;
  const int nitems = mtiles * ntiles;
  for (int item = blockIdx.x; item < nitems; item += gridDim.x) {
    int mt = item / ntiles, nt = item - mt * ntiles;
    int m0 = mt * 128, n0 = nt * 128;
    f32x4 acc[4][4];
#pragma unroll
    for (int i = 0; i < 4; i++)
#pragma unroll
      for (int j = 0; j < 4; j++) acc[i][j] = (f32x4){0.f, 0.f, 0.f, 0.f};
    const int r0_ = tid >> 2, ch_ = tid & 3;
    const u16* Ap0 = A + (size_t)(m0 + r0_) * 1024 + ch_ * 8;
    const u16* Ap1 = Ap0 + (size_t)64 * 1024;
    const u16* Bp0 = Bt + (size_t)(n0 + r0_) * 1024 + ch_ * 8;
    const u16* Bp1 = Bp0 + (size_t)64 * 1024;
    uint4 ra0 = *(const uint4*)Ap0, ra1 = *(const uint4*)Ap1, rb0 = *(const uint4*)Bp0, rb1 = *(const uint4*)Bp1;
    for (int kt = 0; kt < 32; kt++) {
      __syncthreads();
      *(uint4*)(As + r0_ * 40 + ch_ * 8) = ra0;
      *(uint4*)(As + (r0_ + 64) * 40 + ch_ * 8) = ra1;
      *(uint4*)(Bs + r0_ * 40 + ch_ * 8) = rb0;
      *(uint4*)(Bs + (r0_ + 64) * 40 + ch_ * 8) = rb1;
      __syncthreads();
      if (kt < 31) {
        ra0 = *(const uint4*)(Ap0 + (kt + 1) * 32);
        ra1 = *(const uint4*)(Ap1 + (kt + 1) * 32);
        rb0 = *(const uint4*)(Bp0 + (kt + 1) * 32);
        rb1 = *(const uint4*)(Bp1 + (kt + 1) * 32);
      }
      bf16x8 a[4], b[4];
#pragma unroll
      for (int i = 0; i < 4; i++) {
        a[i] = *(const bf16x8*)(As + (wm * 64 + i * 16 + lr) * 40 + quad * 8);
        b[i] = *(const bf16x8*)(Bs + (wn * 64 + i * 16 + lr) * 40 + quad * 8);
      }
#pragma unroll
      for (int i = 0; i < 4; i++)
#pragma unroll
        for (int j = 0; j < 4; j++) acc[i][j] = __builtin_amdgcn_mfma_f32_16x16x32_bf16(a[i], b[j], acc[i][j], 0, 0, 0);
    }
#pragma unroll
    for (int i = 0; i < 4; i++)
#pragma unroll
      for (int j = 0; j < 4; j++)
#pragma unroll
        for (int r = 0; r < 4; r++) {
          int row = m0 + wm * 64 + i * 16 + quad * 4 + r;
          int col = n0 + wn * 64 + j * 16 + lr;
          float v = acc[i][j][r];
          if (EPI == 0) {
            if (col < INC) {
              p.U[(size_t)row * INC + col] = f2bf(v);
              if (col >= 2816) p.G[row * 16 + (col - 2816)] = v;
            }
          } else if (EPI == 1) {
            int mr = row < ML_ROWS ? (row >> 11) : 8;
            float g1 = p.mod[(size_t)(l * 9 + mr) * 6144 + 2048 + col];
            float sv;
            if (l == 0) sv = row < ML_ROWS ? p.x[(size_t)row * 1024 + col] : p.ctx[(size_t)(row - ML_ROWS) * 1024 + col];
            else sv = p.out[(size_t)row * 1024 + col];
            float* dst = row < ML_ROWS ? p.out + (size_t)row * 1024 + col : p.hc + (size_t)(row - ML_ROWS) * 1024 + col;
            *dst = sv + g1 * v;
          } else {
            p.S[(size_t)row * 2048 + col] = v;
          }
        }
  }
}

__device__ __forceinline__ void phase_mixprep(const P& p, int l, char* smem) {
  const int tid = threadIdx.x;
  float* pl = (float*)smem;
  const int N_QK = MT_ROWS * 16 / 256;
  const int N_POOL = (l == 0 ? MT_ROWS : ML_ROWS) / 16;
  const int N_PREP = MT_ROWS;
  const int total = N_QK + N_POOL + N_PREP;
  for (int item = blockIdx.x; item < total; item += gridDim.x) {
    int it = item;
    if (it < N_QK) {
      int gi = it * 256 + tid;
      int row = gi >> 4, sub = gi & 15;
      int qk = sub >> 3, h = sub & 7;
      u16* ptr = p.U + (size_t)row * INC + qk * 512 + h * 64;
      const float* g = (qk ? p.na_k_g : p.na_q_g) + l * 64;
      uint4 v[8];
      float ss = 0.f;
#pragma unroll
      for (int c = 0; c < 8; c++) {
        v[c] = ((const uint4*)ptr)[c];
        float a;
        a = bflo(v[c].x); ss += a * a; a = bfhi(v[c].x); ss += a * a;
        a = bflo(v[c].y); ss += a * a; a = bfhi(v[c].y); ss += a * a;
        a = bflo(v[c].z); ss += a * a; a = bfhi(v[c].z); ss += a * a;
        a = bflo(v[c].w); ss += a * a; a = bfhi(v[c].w); ss += a * a;
      }
      float rs = rsqrtf(ss * (1.f / 64.f) + 1e-6f);
#pragma unroll
      for (int c = 0; c < 8; c++) {
        uint4 o;
        o.x = pack2(bflo(v[c].x) * rs * g[c * 8 + 0], bfhi(v[c].x) * rs * g[c * 8 + 1]);
        o.y = pack2(bflo(v[c].y) * rs * g[c * 8 + 2], bfhi(v[c].y) * rs * g[c * 8 + 3]);
        o.z = pack2(bflo(v[c].z) * rs * g[c * 8 + 4], bfhi(v[c].z) * rs * g[c * 8 + 5]);
        o.w = pack2(bflo(v[c].w) * rs * g[c * 8 + 6], bfhi(v[c].w) * rs * g[c * 8 + 7]);
        ((uint4*)ptr)[c] = o;
      }
      continue;
    }
    it -= N_QK;
    if (it < N_POOL) {
      int row0 = it * 16;
      int base, T;
      if (row0 < ML_ROWS) { base = (row0 >> 11) << 11; T = 2048; }
      else { base = ML_ROWS + (((row0 - ML_ROWS) >> 8) << 8); T = 256; }
      int t0 = row0 - base;
      int ch = tid, g = ch >> 6;
      int wdw = 2 << g;
      __syncthreads();
      for (int tt = 0; tt < 16; tt++) {
        int t = t0 + tt;
        int lo = max(t - wdw / 2, 0), hi = min(t + (wdw - wdw / 2 - 1), T - 1);
        float s = 0.f;
        for (int tau = lo; tau <= hi; tau++) s += bf2f(p.U[(size_t)(base + tau) * INC + 1536 + ch]);
        float self = bf2f(p.U[(size_t)(base + t) * INC + 1536 + ch]);
        pl[tt * 256 + ch] = s / (float)(hi - lo + 1) - self;
      }
      __syncthreads();
      float acc[16];
#pragma unroll
      for (int tt = 0; tt < 16; tt++) acc[tt] = 0.f;
      int d = ch & 63;
      const float* pw = p.pool_w + ((size_t)(l * 4 + g) * 64) * 64 + d;
      for (int c = 0; c < 64; c++) {
        float wv = pw[c * 64];
#pragma unroll
        for (int tt = 0; tt < 16; tt++) acc[tt] += pl[tt * 256 + g * 64 + c] * wv;
      }
      float ps = p.pool_scale[l * 256 + ch];
#pragma unroll
      for (int tt = 0; tt < 16; tt++) p.Y[(size_t)(row0 + tt) * 1024 + 512 + ch] = f2bf(acc[tt] * ps);
      continue;
    }
    it -= N_POOL;
    {
      int row = it;
      int base, T;
      if (row < ML_ROWS) { base = (row >> 11) << 11; T = 2048; }
      else { base = ML_ROWS + (((row - ML_ROWS) >> 8) << 8); T = 256; }
      int t = row - base;
      int qk = tid >> 7, hh = (tid >> 5) & 3, ax = (tid >> 4) & 1, f = tid & 15;
      int ca = qk * 256 + hh * 64 + ax * 32 + f, cb = ca + 16;
      float a = 0.f, b = 0.f;
#pragma unroll
      for (int j = 0; j < 5; j++) {
        int tt = t + j - 2;
        if (tt >= 0 && tt < T) {
          const u16* ur = p.U + (size_t)(base + tt) * INC + 1792;
          a += p.ml_conv[(l * 5 + j) * 512 + ca] * bf2f(ur[ca]);
          b += p.ml_conv[(l * 5 + j) * 512 + cb] * bf2f(ur[cb]);
        }
      }
      a = siluf_(a);
      b = siluf_(b);
      if (row < ML_ROWS) {
        float pos = (float)(ax == 0 ? (t >> 6) : (t & 63));
        float inv = __expf(-(float)f * (9.210340371976184f / 16.f));
        float ang = pos * inv;
        float cs = __cosf(ang), sn = __sinf(ang);
        float oa = a * cs - b * sn, ob = a * sn + b * cs;
        a = oa; b = ob;
      }
      if (qk) { a *= 0.125f; b *= 0.125f; }
      p.MQK[(size_t)row * 512 + ca] = a;
      p.MQK[(size_t)row * 512 + cb] = b;
      if (tid < 16) {
        float gv = p.G[row * 16 + tid] + p.ml_gate_b[l * 16 + tid];
        if ((tid >> 2) & 1) gv = fminf(gv, 0.f) - log1pf(__expf(-fabsf(gv)));
        p.G[row * 16 + tid] = gv;
      }
    }
  }
}

__device__ __forceinline__ float dot32(const float* q, const u16* krow) {
  const uint4* kp = (const uint4*)krow;
  float s = 0.f;
#pragma unroll
  for (int c = 0; c < 4; c++) {
    uint4 kv = kp[c];
    s += q[c * 8 + 0] * bflo(kv.x) + q[c * 8 + 1] * bfhi(kv.x) + q[c * 8 + 2] * bflo(kv.y) + q[c * 8 + 3] * bfhi(kv.y) +
         q[c * 8 + 4] * bflo(kv.z) + q[c * 8 + 5] * bfhi(kv.z) + q[c * 8 + 6] * bflo(kv.w) + q[c * 8 + 7] * bfhi(kv.w);
  }
  return s + __shfl_xor(s, 1);
}
__device__ __forceinline__ void axpy32(float* o, float pw, const u16* vrow) {
  const uint4* vp = (const uint4*)vrow;
#pragma unroll
  for (int c = 0; c < 4; c++) {
    uint4 vv = vp[c];
    o[c * 8 + 0] += pw * bflo(vv.x); o[c * 8 + 1] += pw * bfhi(vv.x);
    o[c * 8 + 2] += pw * bflo(vv.y); o[c * 8 + 3] += pw * bfhi(vv.y);
    o[c * 8 + 4] += pw * bflo(vv.z); o[c * 8 + 5] += pw * bfhi(vv.z);
    o[c * 8 + 6] += pw * bflo(vv.w); o[c * 8 + 7] += pw * bfhi(vv.w);
  }
}

__device__ __forceinline__ void attn_wave(const P& p, int l, int wi) {
  const int lane = threadIdx.x & 63;
  const int ql = lane >> 1, hf = lane & 1;
  bool latent = wi < 4096;
  int b, r = 0, h, qrow, qc = 0;
  if (latent) { b = wi >> 9; r = (wi >> 4) & 31; h = (wi >> 1) & 7; qc = (wi & 1) * 32 + ql; qrow = b * 2048 + r * 64 + qc; }
  else { int ci = wi - 4096; b = ci >> 6; int qb = (ci >> 3) & 7; h = ci & 7; qrow = ML_ROWS + b * 256 + qb * 32 + ql; }
  const int co = h * 64 + hf * 32;
  float q[32], o[32];
  {
    const uint4* qp = (const uint4*)(p.U + (size_t)qrow * INC + co);
#pragma unroll
    for (int c = 0; c < 4; c++) {
      uint4 v = qp[c];
      q[c * 8 + 0] = bflo(v.x) * 0.125f; q[c * 8 + 1] = bfhi(v.x) * 0.125f;
      q[c * 8 + 2] = bflo(v.y) * 0.125f; q[c * 8 + 3] = bfhi(v.y) * 0.125f;
      q[c * 8 + 4] = bflo(v.z) * 0.125f; q[c * 8 + 5] = bfhi(v.z) * 0.125f;
      q[c * 8 + 6] = bflo(v.w) * 0.125f; q[c * 8 + 7] = bfhi(v.w) * 0.125f;
    }
  }
#pragma unroll
  for (int d = 0; d < 32; d++) o[d] = 0.f;
  float m = -INFINITY, lsum = 0.f;
  if (latent) {
    int r0 = min(max(r - 4, 0), 24);
    int c0 = min(max(qc - 8, 0), 48);
    const float* rp = p.na_rpb + (size_t)((l * 8 + h) * 15) * 31;
    for (int g = 0; g < 32; g++) {
      int kr = g >> 2, kc0 = (g & 3) * 4;
      int krow0 = b * 2048 + (r0 + kr) * 64 + c0 + kc0;
      const float* bp = rp + (r0 + kr - r + 7) * 31 + (c0 + kc0 - qc + 15);
      float s[4];
#pragma unroll
      for (int j = 0; j < 4; j++) s[j] = dot32(q, p.U + (size_t)(krow0 + j) * INC + 512 + co) + bp[j];
      float mx = fmaxf(fmaxf(s[0], s[1]), fmaxf(s[2], s[3]));
      float mn = fmaxf(m, mx);
      float sc = __expf(m - mn);
      lsum *= sc;
#pragma unroll
      for (int d = 0; d < 32; d++) o[d] *= sc;
#pragma unroll
      for (int j = 0; j < 4; j++) {
        float pw = __expf(s[j] - mn);
        lsum += pw;
        axpy32(o, pw, p.U + (size_t)(krow0 + j) * INC + 1024 + co);
      }
      m = mn;
    }
  }
  for (int g = 0; g < 64; g++) {
    int krow0 = ML_ROWS + b * 256 + g * 4;
    float s[4];
#pragma unroll
    for (int j = 0; j < 4; j++) s[j] = dot32(q, p.U + (size_t)(krow0 + j) * INC + 512 + co);
    float mx = fmaxf(fmaxf(s[0], s[1]), fmaxf(s[2], s[3]));
    float mn = fmaxf(m, mx);
    float sc = __expf(m - mn);
    lsum *= sc;
#pragma unroll
    for (int d = 0; d < 32; d++) o[d] *= sc;
#pragma unroll
    for (int j = 0; j < 4; j++) {
      float pw = __expf(s[j] - mn);
      lsum += pw;
      axpy32(o, pw, p.U + (size_t)(krow0 + j) * INC + 1024 + co);
    }
    m = mn;
  }
  float il = 1.f / lsum;
  uint4* yp = (uint4*)(p.Y + (size_t)qrow * 1024 + co);
#pragma unroll
  for (int c = 0; c < 4; c++) {
    uint4 ov;
    ov.x = pack2(o[c * 8 + 0] * il, o[c * 8 + 1] * il);
    ov.y = pack2(o[c * 8 + 2] * il, o[c * 8 + 3] * il);
    ov.z = pack2(o[c * 8 + 4] * il, o[c * 8 + 5] * il);
    ov.w = pack2(o[c * 8 + 6] * il, o[c * 8 + 7] * il);
    yp[c] = ov;
  }
}

__device__ __forceinline__ int ml_row(int b, int dir, int j, int pp) {
  if (j < 4) {
    int pos = j * 64 + pp;
    int t = dir ? 255 - pos : pos;
    return ML_ROWS + b * 256 + t;
  } else {
    int pos = (j - 4) * 64 + pp;
    int t = dir ? 2047 - pos : pos;
    return b * 2048 + t;
  }
}

__device__ __forceinline__ void mlstmA_item(const P& p, int it, float* sm) {
  const int tid = threadIdx.x;
  int seq = it / 36, j = it % 36;
  int b = seq >> 3, h = (seq >> 1) & 3, dir = seq & 1;
  float* ks = sm;
  float* vs = sm + 64 * 65;
  float* ic = sm + 2 * 64 * 65;
  float* fc = ic + 64;
  float* bb = fc + 64;
  float* wsm = bb + 64;
  float* scal = wsm + 64;
  __syncthreads();
  for (int idx = tid; idx < 4096; idx += 256) {
    int pp = idx >> 6, d = idx & 63;
    int row = ml_row(b, dir, j, pp);
    ks[pp * 65 + d] = p.MQK[(size_t)row * 512 + 256 + h * 64 + d];
    vs[pp * 65 + d] = bf2f(p.U[(size_t)row * INC + 2304 + h * 64 + d]);
  }
  if (tid < 64) {
    int row = ml_row(b, dir, j, tid);
    ic[tid] = p.G[row * 16 + (dir * 2) * 4 + h];
    fc[tid] = p.G[row * 16 + (dir * 2 + 1) * 4 + h];
  }
  __syncthreads();
  if (tid == 0) {
    float acc = 0.f;
    for (int pp = 0; pp < 64; pp++) { acc += fc[pp]; bb[pp] = acc; }
    float bl = acc, ml = -INFINITY;
    for (int pp = 0; pp < 64; pp++) ml = fmaxf(ml, bl - bb[pp] + ic[pp]);
    scal[0] = bl; scal[1] = ml;
  }
  __syncthreads();
  if (tid < 64) wsm[tid] = __expf(scal[0] - bb[tid] + ic[tid] - scal[1]);
  __syncthreads();
  float* slot = p.mst + (size_t)it * SLOT;
  {
    int e = tid & 63, dg = tid >> 6;
    float acc[16];
#pragma unroll
    for (int dd = 0; dd < 16; dd++) acc[dd] = 0.f;
    for (int pp = 0; pp < 64; pp++) {
      float wv = wsm[pp] * vs[pp * 65 + e];
#pragma unroll
      for (int dd = 0; dd < 16; dd++) acc[dd] += ks[pp * 65 + dg * 16 + dd] * wv;
    }
#pragma unroll
    for (int dd = 0; dd < 16; dd++) slot[(dg * 16 + dd) * 64 + e] = acc[dd];
  }
  if (tid < 64) {
    float a = 0.f;
    for (int pp = 0; pp < 64; pp++) a += wsm[pp] * ks[pp * 65 + tid];
    slot[4096 + tid] = a;
  }
  if (tid == 0) { slot[4160] = scal[0]; slot[4161] = scal[1]; }
}

__device__ __forceinline__ void phase_attn_mlA(const P& p, int l, char* smem) {
  const int w = threadIdx.x >> 6;
  const int N_ATT = (l == 0 ? 4608 : 4096) / 4;
  const int N_MLA = 64 * 36;
  const int total = N_ATT + N_MLA;
  for (int item = blockIdx.x; item < total; item += gridDim.x) {
    if (item < N_MLA) mlstmA_item(p, item, (float*)smem);
    else attn_wave(p, l, (item - N_MLA) * 4 + w);
  }
}

__device__ __forceinline__ void phase_mlB(const P& p) {
  const int tid = threadIdx.x;
  const int total = 64 * 4160 / 256;
  for (int item = blockIdx.x; item < total; item += gridDim.x) {
    int idx = item * 256 + tid;
    int seq = idx / 4160, el = idx - seq * 4160;
    float m = 0.f, val = 0.f;
    for (int j = 0; j < 36; j++) {
      float* slot = p.mst + (size_t)(seq * 36 + j) * SLOT;
      float bl = slot[4160], ml = slot[4161];
      float loc = slot[el];
      slot[el] = val;
      if (el == 0) slot[4162] = m;
      float mn = fmaxf(bl + m, ml);
      val = __expf(bl + m - mn) * val + __expf(ml - mn) * loc;
      m = mn;
    }
  }
}

__device__ __forceinline__ void phase_mlC(const P& p, int l, char* smem) {
  const int tid = threadIdx.x;
  float* qs = (float*)smem;
  float* kb = qs + 64 * 65;
  float* Ss = kb + 64 * 65;
  float* hs = Ss + 64 * 65;
  float* ic = hs + 64 * 65;
  float* fc = ic + 64;
  float* bb = fc + 64;
  float* mt = bb + 64;
  float* rsn = mt + 64;
  const int nch = (l == 0) ? 36 : 32;
  const int total = 32 * nch;
  for (int item = blockIdx.x; item < total; item += gridDim.x) {
    int bh = item / nch, c = item % nch + (l == 0 ? 0 : 4);
    int b = bh >> 2, h = bh & 3;
    for (int dir = 0; dir < 2; dir++) {
      int j = dir ? (c < 4 ? 3 - c : 4 + 31 - (c - 4)) : c;
      const float* slot = p.mst + (size_t)(((b * 4 + h) * 2 + dir) * 36 + j) * SLOT;
      float m0 = slot[4162];
      __syncthreads();
      for (int idx = tid; idx < 4096; idx += 256) {
        int pp = idx >> 6, d = idx & 63;
        int row = ml_row(b, dir, j, pp);
        qs[pp * 65 + d] = p.MQK[(size_t)row * 512 + h * 64 + d];
        kb[pp * 65 + d] = p.MQK[(size_t)row * 512 + 256 + h * 64 + d];
      }
      if (tid < 64) {
        int row = ml_row(b, dir, j, tid);
        ic[tid] = p.G[row * 16 + (dir * 2) * 4 + h];
        fc[tid] = p.G[row * 16 + (dir * 2 + 1) * 4 + h];
      }
      __syncthreads();
      if (tid == 0) {
        float acc = 0.f, pm = -INFINITY;
        for (int pp = 0; pp < 64; pp++) {
          acc += fc[pp];
          bb[pp] = acc;
          pm = fmaxf(pm, ic[pp] - acc);
          mt[pp] = fmaxf(acc + m0, acc + pm);
        }
      }
      __syncthreads();
      {
        int s = tid & 63, tg = tid >> 6;
        float acc[16];
#pragma unroll
        for (int tt = 0; tt < 16; tt++) acc[tt] = 0.f;
        for (int d = 0; d < 64; d++) {
          float kv = kb[s * 65 + d];
#pragma unroll
          for (int tt = 0; tt < 16; tt++) acc[tt] += qs[(tg * 16 + tt) * 65 + d] * kv;
        }
        float cs = ic[s] - bb[s];
#pragma unroll
        for (int tt = 0; tt < 16; tt++) {
          int t = tg * 16 + tt;
          float wv = (s <= t) ? acc[tt] * __expf(bb[t] + cs - mt[t]) : 0.f;
          Ss[t * 65 + s] = wv;
        }
      }
      __syncthreads();
      for (int idx = tid; idx < 4096; idx += 256) {
        int pp = idx >> 6, d = idx & 63;
        int row = ml_row(b, dir, j, pp);
        kb[pp * 65 + d] = bf2f(p.U[(size_t)row * INC + 2304 + h * 64 + d]);
      }
      __syncthreads();
      {
        int e = tid & 63, tg = tid >> 6;
        float a1[16], a2[16], ds[16], dq[16];
#pragma unroll
        for (int tt = 0; tt < 16; tt++) { a1[tt] = 0.f; a2[tt] = 0.f; ds[tt] = 0.f; dq[tt] = 0.f; }
        for (int s = 0; s < 64; s++) {
          float vv = kb[s * 65 + e];
#pragma unroll
          for (int tt = 0; tt < 16; tt++) {
            float wv = Ss[(tg * 16 + tt) * 65 + s];
            a1[tt] += wv * vv;
            ds[tt] += wv;
          }
        }
        for (int d = 0; d < 64; d++) {
          float cv = slot[d * 64 + e];
          float nv = slot[4096 + d];
#pragma unroll
          for (int tt = 0; tt < 16; tt++) {
            float qv = qs[(tg * 16 + tt) * 65 + d];
            a2[tt] += qv * cv;
            dq[tt] += qv * nv;
          }
        }
#pragma unroll
        for (int tt = 0; tt < 16; tt++) {
          int t = tg * 16 + tt;
          float wi = __expf(bb[t] + m0 - mt[t]);
          float num = a1[tt] + wi * a2[tt];
          float den = ds[tt] + wi * dq[tt];
          float hv = num / fmaxf(fabsf(den), __expf(-mt[t]));
          int to = dir ? 63 - t : t;
          if (dir == 0) hs[to * 65 + e] = hv;
          else hs[to * 65 + e] += hv;
        }
      }
    }
    __syncthreads();
    {
      int t = tid >> 2, part = tid & 3;
      float ss = 0.f;
#pragma unroll
      for (int i = 0; i < 16; i++) { float v = hs[t * 65 + part * 16 + i]; ss += v * v; }
      ss += __shfl_xor(ss, 1);
      ss += __shfl_xor(ss, 2);
      if (part == 0) rsn[t] = rsqrtf(ss * (1.f / 64.f) + 1e-6f);
    }
    __syncthreads();
    {
      int e = tid & 63, tg = tid >> 6;
      float ng = p.ml_norm_g[l * 256 + h * 64 + e];
#pragma unroll 4
      for (int tt = 0; tt < 16; tt++) {
        int t = tg * 16 + tt;
        int row = (c < 4) ? (ML_ROWS + b * 256 + c * 64 + t) : (b * 2048 + (c - 4) * 64 + t);
        float uo = bf2f(p.U[(size_t)row * INC + 2560 + h * 64 + e]);
        float v = hs[t * 65 + e] * rsn[t] * ng * sigmoidf_(uo);
        p.Y[(size_t)row * 1024 + 768 + h * 64 + e] = f2bf(v);
      }
    }
    __syncthreads();
  }
}

__device__ __forceinline__ void phase_topk(const P& p, int l) {
  const int lane = threadIdx.x & 63, w = threadIdx.x >> 6;
  const int nrows = (l == 1) ? ML_ROWS : MT_ROWS;
  const int total = nrows * 8 / 4;
  for (int item = blockIdx.x; item < total; item += gridDim.x) {
    int wi = item * 4 + w;
    int row = wi >> 3, h = wi & 7;
    const float* sp = p.S + (size_t)row * 2048 + h * 256;
    float tv[2];
    int ti[2];
#pragma unroll
    for (int half = 0; half < 2; half++) {
      float a0 = sp[half * 128 + lane], a1 = sp[half * 128 + 64 + lane];
      float rv = 0.f;
      int ri = 0;
      for (int r = 0; r < 16; r++) {
        float bv;
        int bi;
        if (a0 >= a1) { bv = a0; bi = lane; } else { bv = a1; bi = lane + 64; }
        wave_argmax(bv, bi);
        if (lane == r) { rv = bv; ri = bi; }
        if ((bi & 63) == lane) { if (bi < 64) a0 = -INFINITY; else a1 = -INFINITY; }
      }
      tv[half] = rv;
      ti[half] = ri;
    }
    float s1 = __shfl(tv[0], lane >> 2);
    int jb = (lane & 3) * 4;
    float c0 = s1 + __shfl(tv[1], jb + 0);
    float c1 = s1 + __shfl(tv[1], jb + 1);
    float c2 = s1 + __shfl(tv[1], jb + 2);
    float c3 = s1 + __shfl(tv[1], jb + 3);
    float fv = 0.f;
    int fci = 0;
    for (int r = 0; r < 16; r++) {
      float bv = c0;
      int bi = lane * 4;
      if (c1 > bv) { bv = c1; bi = lane * 4 + 1; }
      if (c2 > bv) { bv = c2; bi = lane * 4 + 2; }
      if (c3 > bv) { bv = c3; bi = lane * 4 + 3; }
      wave_argmax(bv, bi);
      if (lane == r) { fv = bv; fci = bi; }
      if ((bi >> 2) == lane) {
        int q = bi & 3;
        if (q == 0) c0 = -INFINITY; else if (q == 1) c1 = -INFINITY; else if (q == 2) c2 = -INFINITY; else c3 = -INFINITY;
      }
    }
    float mx = __shfl(fv, 0);
    float ev = (lane < 16) ? __expf(fv - mx) : 0.f;
    float sum = wave_sum(ev);
    int e1 = __shfl(ti[0], (fci >> 4) & 15);
    int e2 = __shfl(ti[1], fci & 15);
    if (lane < 16) {
      p.eidx[(size_t)row * 128 + h * 16 + lane] = e1 * 128 + e2;
      p.egate[(size_t)row * 128 + h * 16 + lane] = ev / sum;
    }
  }
}

__device__ __forceinline__ float gelu_tanh(float x) {
  float u = 0.7978845608028654f * (x + 0.044715f * x * x * x);
  float th = 1.f - 2.f / (1.f + __expf(2.f * u));
  return 0.5f * x * (1.f + th);
}

__device__ __forceinline__ void phase_expert(const P& p, int l, char* smem) {
  const int tid = threadIdx.x, lane = tid & 63, w = tid >> 6;
  float* as = (float*)smem;
  float* part = as + 128;
  const int nrows = (l == 1) ? ML_ROWS : MT_ROWS;
  const u16* Ub = p.Ub + (size_t)l * 16384 * 1024;
  const u16* Vb = p.Vb + (size_t)l * 16384 * 1024;
  for (int row = blockIdx.x; row < nrows; row += gridDim.x) {
    float xr[16];
    {
      const uint4* xp = (const uint4*)(p.xn + (size_t)row * 1024 + lane * 16);
#pragma unroll
      for (int c = 0; c < 2; c++) {
        uint4 v = xp[c];
        xr[c * 8 + 0] = bflo(v.x); xr[c * 8 + 1] = bfhi(v.x); xr[c * 8 + 2] = bflo(v.y); xr[c * 8 + 3] = bfhi(v.y);
        xr[c * 8 + 4] = bflo(v.z); xr[c * 8 + 5] = bfhi(v.z); xr[c * 8 + 6] = bflo(v.w); xr[c * 8 + 7] = bfhi(v.w);
      }
    }
    const int* ip = p.eidx + (size_t)row * 128 + w * 32;
    const float* gp = p.egate + (size_t)row * 128 + w * 32;
    __syncthreads();
    for (int e = 0; e < 32; e += 4) {
      float dsum[4];
#pragma unroll
      for (int k = 0; k < 4; k++) {
        int id = ip[e + k];
        const uint4* up = (const uint4*)(Ub + (size_t)id * 1024 + lane * 16);
        uint4 v0 = up[0], v1 = up[1];
        float s = xr[0] * bflo(v0.x) + xr[1] * bfhi(v0.x) + xr[2] * bflo(v0.y) + xr[3] * bfhi(v0.y) + xr[4] * bflo(v0.z) +
                  xr[5] * bfhi(v0.z) + xr[6] * bflo(v0.w) + xr[7] * bfhi(v0.w) + xr[8] * bflo(v1.x) + xr[9] * bfhi(v1.x) +
                  xr[10] * bflo(v1.y) + xr[11] * bfhi(v1.y) + xr[12] * bflo(v1.z) + xr[13] * bfhi(v1.z) +
                  xr[14] * bflo(v1.w) + xr[15] * bfhi(v1.w);
        dsum[k] = s;
      }
#pragma unroll
      for (int k = 0; k < 4; k++) {
        float s = wave_sum(dsum[k]);
        float a = gelu_tanh(s) * gp[e + k];
        if (lane == 0) as[w * 32 + e + k] = a;
      }
    }
    __syncthreads();
    float acc[16];
#pragma unroll
    for (int i = 0; i < 16; i++) acc[i] = 0.f;
    for (int e = 0; e < 32; e += 4) {
#pragma unroll
      for (int k = 0; k < 4; k++) {
        int id = ip[e + k];
        float a = as[w * 32 + e + k];
        const uint4* vp = (const uint4*)(Vb + (size_t)id * 1024 + lane * 16);
        uint4 v0 = vp[0], v1 = vp[1];
        acc[0] += a * bflo(v0.x); acc[1] += a * bfhi(v0.x); acc[2] += a * bflo(v0.y); acc[3] += a * bfhi(v0.y);
        acc[4] += a * bflo(v0.z); acc[5] += a * bfhi(v0.z); acc[6] += a * bflo(v0.w); acc[7] += a * bfhi(v0.w);
        acc[8] += a * bflo(v1.x); acc[9] += a * bfhi(v1.x); acc[10] += a * bflo(v1.y); acc[11] += a * bfhi(v1.y);
        acc[12] += a * bflo(v1.z); acc[13] += a * bfhi(v1.z); acc[14] += a * bflo(v1.w); acc[15] += a * bfhi(v1.w);
      }
    }
#pragma unroll
    for (int i = 0; i < 4; i++)
      *(float4*)(part + w * 1024 + lane * 16 + i * 4) = make_float4(acc[i * 4], acc[i * 4 + 1], acc[i * 4 + 2], acc[i * 4 + 3]);
    __syncthreads();
    {
      int d = tid * 4;
      float4 s0 = *(const float4*)(part + d), s1 = *(const float4*)(part + 1024 + d), s2 = *(const float4*)(part + 2048 + d),
             s3 = *(const float4*)(part + 3072 + d);
      int mr = row < ML_ROWS ? (row >> 11) : 8;
      float4 g2 = *(const float4*)(p.mod + (size_t)(l * 9 + mr) * 6144 + 5120 + d);
      float* dst = row < ML_ROWS ? p.out + (size_t)row * 1024 + d : p.hc + (size_t)(row - ML_ROWS) * 1024 + d;
      float4 cur = *(const float4*)dst;
      cur.x += g2.x * (s0.x + s1.x + s2.x + s3.x);
      cur.y += g2.y * (s0.y + s1.y + s2.y + s3.y);
      cur.z += g2.z * (s0.z + s1.z + s2.z + s3.z);
      cur.w += g2.w * (s0.w + s1.w + s2.w + s3.w);
      *(float4*)dst = cur;
    }
  }
}

#define RUN(k, call)                         \
  if (lo <= (k) && (k) < hi) {               \
    call;                                    \
    if ((k) + 1 < hi) grid.sync();           \
  }
#define LAYER(l, base)                                                                                                    \
  RUN(base + 0, phase_norm(p, l, 1))                                                                                     \
  RUN(base + 1, phase_gemm<0>(p, l, p.xn, p.WinT + (size_t)l * INC_PAD * 1024, MT_ROWS / 128, INC_PAD / 128, smem))     \
  RUN(base + 2, phase_mixprep(p, l, smem))                                                                               \
  RUN(base + 3, phase_attn_mlA(p, l, smem))                                                                              \
  RUN(base + 4, phase_mlB(p))                                                                                            \
  RUN(base + 5, phase_mlC(p, l, smem))                                                                                   \
  RUN(base + 6, phase_gemm<1>(p, l, p.Y, p.WoutT + (size_t)l * 1024 * 1024, (l == 0 ? MT_ROWS : ML_ROWS) / 128, 8, smem)) \
  RUN(base + 7, phase_norm(p, l, 2))                                                                                     \
  RUN(base + 8, phase_gemm<2>(p, l, p.xn, p.WsT + (size_t)l * 2048 * 1024, (l == 0 ? MT_ROWS : ML_ROWS) / 128, 16, smem)) \
  RUN(base + 9, phase_topk(p, l))                                                                                        \
  RUN(base + 10, phase_expert(p, l, smem))

__global__ void __launch_bounds__(256) fwd_kernel(P p) {
  __shared__ __attribute__((aligned(16))) char smem[SMEM_BYTES];
  cg::grid_group grid = cg::this_grid();
  const int lo = (int)p.ph_lo, hi = (int)p.ph_hi;
  RUN(0, phase_prologue(p, smem))
  LAYER(0, 1)
  LAYER(1, 12)
}

extern "C" void kernel_launch(void* const* d_in, const int* in_sizes, int n_in, void* d_out, int out_size, void* d_ws,
                              size_t ws_size, hipStream_t stream) {
  static int grid_blocks = 0;
  if (!grid_blocks) {
    int dev = 0, cus = 0, per_cu = 0;
    hipGetDevice(&dev);
    hipDeviceGetAttribute(&cus, hipDeviceAttributeMultiprocessorCount, dev);
    hipOccupancyMaxActiveBlocksPerMultiprocessor(&per_cu, fwd_kernel, 256, 0);
    if (per_cu < 1) per_cu = 1;
    if (per_cu > 2) per_cu = 2;
    grid_blocks = cus * per_cu;
  }
  P p{};
  const float** ins = (const float**)&p;
  for (int i = 0; i < 22; i++) ins[i] = (const float*)d_in[i];
  p.out = (float*)d_out;
  char* ws = (char*)d_ws;
  size_t off = 0;
  auto take = [&](size_t bytes) { char* r = ws + off; off += (bytes + 255) & ~(size_t)255; return r; };
  p.WinT = (u16*)take((size_t)2 * INC_PAD * 1024 * 2);
  p.WoutT = (u16*)take((size_t)2 * 1024 * 1024 * 2);
  p.WsT = (u16*)take((size_t)2 * 2048 * 1024 * 2);
  p.Ub = (u16*)take((size_t)2 * 16384 * 1024 * 2);
  p.Vb = (u16*)take((size_t)2 * 16384 * 1024 * 2);
  p.mod = (float*)take((size_t)2 * 9 * 6144 * 4);
  p.xn = (u16*)take((size_t)MT_ROWS * 1024 * 2);
  p.U = (u16*)take((size_t)MT_ROWS * INC * 2);
  p.MQK = (float*)take((size_t)MT_ROWS * 512 * 4);
  p.Y = (u16*)take((size_t)MT_ROWS * 1024 * 2);
  p.S = (float*)p.U;
  p.G = (float*)take((size_t)MT_ROWS * 16 * 4);
  p.mst = (float*)take((size_t)2304 * SLOT * 4);
  p.hc = (float*)take((size_t)MC_ROWS * 1024 * 4);
  p.eidx = (int*)take((size_t)MT_ROWS * 128 * 4);
  p.egate = (float*)take((size_t)MT_ROWS * 128 * 4);
  if (off > ws_size) { fprintf(stderr, "workspace too small: need %zu have %zu\n", off, ws_size); return; }
#if MEGA
  p.ph_lo = 0; p.ph_hi = NPHASES;
  void* args[] = {&p};
  hipError_t e = hipLaunchCooperativeKernel((void*)fwd_kernel, dim3(grid_blocks), dim3(256), args, 0, stream);
  if (e != hipSuccess) fprintf(stderr, "cooperative launch failed: %s (grid %d)\n", hipGetErrorString(e), grid_blocks);
#else
  for (int ph = 0; ph < NPHASES; ph++) {
    p.ph_lo = ph; p.ph_hi = ph + 1;
    void* args[] = {&p};
    hipError_t e = hipLaunchCooperativeKernel((void*)fwd_kernel, dim3(grid_blocks), dim3(256), args, 0, stream);
    if (e != hipSuccess) fprintf(stderr, "cooperative launch failed: %s (grid %d)\n", hipGetErrorString(e), grid_blocks);
  }
#endif
}
```

```cpp
#include <hip/hip_runtime.h>
#include <hip/hip_cooperative_groups.h>
#include <cstdio>
namespace cg = cooperative_groups;

#ifndef MEGA
#define MEGA 1
#endif

typedef unsigned short u16;
typedef __attribute__((ext_vector_type(8))) short bf16x8;
typedef __attribute__((ext_vector_type(4))) float f32x4;

#define ML_ROWS 16384
#define MC_ROWS 2048
#define MT_ROWS 18432
#define INC 2832
#define INC_PAD 2944
#define SLOT 4224
#define SMEM_BYTES 69632
#define NPHASES 21

struct P {
  const float *x, *c, *ctx, *c_ctx, *w_ada, *b_ada, *norm1_g, *w_in, *ml_gate_b, *na_q_g, *na_k_g, *na_rpb,
      *pool_w, *pool_scale, *ml_conv, *ml_norm_g, *w_out, *norm2_g, *peer_wq, *peer_keys, *peer_u, *peer_v;
  float* out;
  u16 *WinT, *WoutT, *WsT, *Ub, *Vb;
  float* mod;
  u16* xn;
  u16* U;
  float* MQK;
  u16* Y;
  float* S;
  float* G;
  float* mst;
  float* hc;
  u16* VT;
  long long ph_lo, ph_hi;
};

__device__ __forceinline__ u16 f2bf(float f) {
  unsigned u = __float_as_uint(f);
  u += 0x7fffu + ((u >> 16) & 1u);
  return (u16)(u >> 16);
}
__device__ __forceinline__ float bf2f(u16 h) { return __uint_as_float(((unsigned)h) << 16); }
__device__ __forceinline__ float bflo(unsigned u) { return __uint_as_float(u << 16); }
__device__ __forceinline__ float bfhi(unsigned u) { return __uint_as_float(u & 0xffff0000u); }
__device__ __forceinline__ unsigned pack2(float a, float b) { return (unsigned)f2bf(a) | ((unsigned)f2bf(b) << 16); }
__device__ __forceinline__ float wave_sum(float v) {
#pragma unroll
  for (int o = 32; o; o >>= 1) v += __shfl_xor(v, o);
  return v;
}
__device__ __forceinline__ void wave_argmax(float& v, int& i) {
#pragma unroll
  for (int o = 32; o; o >>= 1) {
    float ov = __shfl_xor(v, o);
    int oi = __shfl_xor(i, o);
    if (ov > v || (ov == v && oi < i)) { v = ov; i = oi; }
  }
}
__device__ __forceinline__ float sigmoidf_(float x) { return 1.f / (1.f + __expf(-x)); }
__device__ __forceinline__ float siluf_(float x) { return x / (1.f + __expf(-x)); }

__device__ __forceinline__ void transpose_item(const float* __restrict__ src, int N, u16* __restrict__ dst, int kt, int nt, float* tl) {
  const int tid = threadIdx.x;
#pragma unroll 4
  for (int i = 0; i < 16; i++) {
    int idx = tid + 256 * i;
    int kk = idx >> 6, nn = idx & 63;
    int n = nt * 64 + nn;
    float v = (n < N) ? src[(size_t)(kt * 64 + kk) * N + n] : 0.f;
    tl[kk * 65 + nn] = v;
  }
  __syncthreads();
#pragma unroll 4
  for (int i = 0; i < 16; i++) {
    int idx = tid + 256 * i;
    int nn = idx >> 6, kk = idx & 63;
    dst[(size_t)(nt * 64 + nn) * 1024 + kt * 64 + kk] = f2bf(tl[kk * 65 + nn]);
  }
  __syncthreads();
}

__device__ __forceinline__ void wst_item(const P& p, int it, float* sm) {
  const int tid = threadIdx.x;
  int l = it >> 8, hp = (it >> 4) & 15, dt = it & 15;
  float* As = sm;
  float* Ks = sm + 64 * 33;
  const float* wq = p.peer_wq + (size_t)l * 1024 * 2048;
  const float* keys = p.peer_keys + ((size_t)l * 16 + hp) * 128 * 128;
  int d = tid & 63, cg_ = tid >> 6;
  float acc[32];
#pragma unroll
  for (int c = 0; c < 32; c++) acc[c] = 0.f;
  for (int jc = 0; jc < 4; jc++) {
    __syncthreads();
#pragma unroll
    for (int i = 0; i < 8; i++) {
      int idx = tid + 256 * i;
      int dd = idx >> 5, j = idx & 31;
      As[dd * 33 + j] = wq[(size_t)(dt * 64 + dd) * 2048 + hp * 128 + jc * 32 + j];
    }
#pragma unroll
    for (int i = 0; i < 16; i++) {
      int idx = tid + 256 * i;
      int k = idx >> 5, j = idx & 31;
      Ks[k * 33 + j] = keys[k * 128 + jc * 32 + j];
    }
    __syncthreads();
    for (int j = 0; j < 32; j++) {
      float a = As[d * 33 + j];
#pragma unroll
      for (int c = 0; c < 32; c++) acc[c] += a * Ks[(cg_ * 32 + c) * 33 + j];
    }
  }
  u16* dst = p.WsT + (size_t)l * 2048 * 1024;
#pragma unroll
  for (int c = 0; c < 32; c++) dst[(size_t)(hp * 128 + cg_ * 32 + c) * 1024 + dt * 64 + d] = f2bf(acc[c]);
  __syncthreads();
}

__device__ __forceinline__ void mod_item(const P& p, int it, float* sm) {
  const int tid = threadIdx.x;
  int l = it / 96, cc = it % 96;
  float* sc = sm;
  float* red = sm + 9216;
  for (int idx = tid; idx < 9216; idx += 256) {
    int r = idx >> 10, k = idx & 1023;
    float v = (r < 8) ? p.c[r * 1024 + k] : p.c_ctx[k];
    sc[idx] = siluf_(v);
  }
  __syncthreads();
  int cl = tid & 63, kg = tid >> 6;
  int col = cc * 64 + cl;
  float acc[9];
#pragma unroll
  for (int r = 0; r < 9; r++) acc[r] = 0.f;
  const float* wa = p.w_ada + (size_t)l * 1024 * 6144;
#pragma unroll 4
  for (int k = kg * 256; k < kg * 256 + 256; k++) {
    float w = wa[(size_t)k * 6144 + col];
#pragma unroll
    for (int r = 0; r < 9; r++) acc[r] += sc[r * 1024 + k] * w;
  }
#pragma unroll
  for (int r = 0; r < 9; r++) red[(kg * 9 + r) * 64 + cl] = acc[r];
  __syncthreads();
  if (kg == 0) {
    float bb = p.b_ada[l * 6144 + col];
#pragma unroll
    for (int r = 0; r < 9; r++) {
      float s = red[(0 * 9 + r) * 64 + cl] + red[(1 * 9 + r) * 64 + cl] + red[(2 * 9 + r) * 64 + cl] + red[(3 * 9 + r) * 64 + cl];
      p.mod[(size_t)(l * 9 + r) * 6144 + col] = s + bb;
    }
  }
  __syncthreads();
}

__device__ __forceinline__ void phase_prologue(const P& p, char* smem) {
  float* sm = (float*)smem;
  const int tid = threadIdx.x;
  const int N_A = 2 * 16 * 46, N_B = 2 * 16 * 16, N_C = 512, N_D = 192, N_E = 4096;
  const int total = N_A + N_B + N_C + N_D + N_E;
  for (int item = blockIdx.x; item < total; item += gridDim.x) {
    int it = item;
    if (it < N_A) {
      int l = it / (16 * 46), r = it % (16 * 46);
      transpose_item(p.w_in + (size_t)l * 1024 * INC, INC, p.WinT + (size_t)l * INC_PAD * 1024, r / 46, r % 46, sm);
      continue;
    }
    it -= N_A;
    if (it < N_B) {
      int l = it >> 8, r = it & 255;
      transpose_item(p.w_out + (size_t)l * 1024 * 1024, 1024, p.WoutT + (size_t)l * 1024 * 1024, r >> 4, r & 15, sm);
      continue;
    }
    it -= N_B;
    if (it < N_C) { wst_item(p, it, sm); continue; }
    it -= N_C;
    if (it < N_D) { mod_item(p, it, sm); continue; }
    it -= N_D;
    {
      int tab = it >> 11;
      int chunk = it & 2047;
      const float scl = tab ? 8.f : 64.f;
      const float4* src = (const float4*)(tab ? p.peer_v : p.peer_u) + (size_t)chunk * 4096;
      uint4* dst = (uint4*)(tab ? p.Vb : p.Ub) + (size_t)chunk * 1024;
#pragma unroll
      for (int i = 0; i < 4; i++) {
        int q = i * 256 + tid;
        float4 v0 = src[q * 4 + 0], v1 = src[q * 4 + 1], v2 = src[q * 4 + 2], v3 = src[q * 4 + 3];
        uint4 o;
        int w_;
        w_ = __builtin_amdgcn_cvt_pk_fp8_f32(v0.x * scl, v0.y * scl, 0, false);
        w_ = __builtin_amdgcn_cvt_pk_fp8_f32(v0.z * scl, v0.w * scl, w_, true);
        o.x = (unsigned)w_;
        w_ = __builtin_amdgcn_cvt_pk_fp8_f32(v1.x * scl, v1.y * scl, 0, false);
        w_ = __builtin_amdgcn_cvt_pk_fp8_f32(v1.z * scl, v1.w * scl, w_, true);
        o.y = (unsigned)w_;
        w_ = __builtin_amdgcn_cvt_pk_fp8_f32(v2.x * scl, v2.y * scl, 0, false);
        w_ = __builtin_amdgcn_cvt_pk_fp8_f32(v2.z * scl, v2.w * scl, w_, true);
        o.z = (unsigned)w_;
        w_ = __builtin_amdgcn_cvt_pk_fp8_f32(v3.x * scl, v3.y * scl, 0, false);
        w_ = __builtin_amdgcn_cvt_pk_fp8_f32(v3.z * scl, v3.w * scl, w_, true);
        o.w = (unsigned)w_;
        dst[q] = o;
      }
    }
  }
}

__device__ __forceinline__ void phase_norm(const P& p, int l, int which) {
  const int tid = threadIdx.x, lane = tid & 63, w = tid >> 6;
  const int nrows = (which == 2 && l == 1) ? ML_ROWS : MT_ROWS;
  const float* g = (which == 1 ? p.norm1_g : p.norm2_g) + l * 1024;
  for (int item = blockIdx.x; item * 4 < nrows; item += gridDim.x) {
    int row = item * 4 + w;
    const float* src;
    if (l == 0 && which == 1) src = row < ML_ROWS ? p.x + (size_t)row * 1024 : p.ctx + (size_t)(row - ML_ROWS) * 1024;
    else src = row < ML_ROWS ? p.out + (size_t)row * 1024 : p.hc + (size_t)(row - ML_ROWS) * 1024;
    int mr = row < ML_ROWS ? (row >> 11) : 8;
    const float* modp = p.mod + (size_t)(l * 9 + mr) * 6144;
    const float* sh = modp + (which == 1 ? 0 : 3072);
    const float* sc = modp + (which == 1 ? 1024 : 4096);
    float4 v[4];
    float ss = 0.f;
#pragma unroll
    for (int i = 0; i < 4; i++) {
      v[i] = ((const float4*)src)[i * 64 + lane];
      ss += v[i].x * v[i].x + v[i].y * v[i].y + v[i].z * v[i].z + v[i].w * v[i].w;
    }
    ss = wave_sum(ss);
    float rs = rsqrtf(ss * (1.f / 1024.f) + 1e-6f);
#pragma unroll
    for (int i = 0; i < 4; i++) {
      int d = (i * 64 + lane) * 4;
      float4 gg = *(const float4*)(g + d);
      float4 s4 = *(const float4*)(sc + d);
      float4 h4 = *(const float4*)(sh + d);
      float o0 = v[i].x * rs * gg.x * (1.f + s4.x) + h4.x;
      float o1 = v[i].y * rs * gg.y * (1.f + s4.y) + h4.y;
      float o2 = v[i].z * rs * gg.z * (1.f + s4.z) + h4.z;
      float o3 = v[i].w * rs * gg.w * (1.f + s4.w) + h4.w;
      uint2 o;
      o.x = pack2(o0, o1);
      o.y = pack2(o2, o3);
      ((uint2*)(p.xn + (size_t)row * 1024))[i * 64 + lane] = o;
    }
  }
}

template <int EPI>
__device__ __forceinline__ void phase_gemm(const P& p, int l, const u16* __restrict__ A, const u16* __restrict__ Bt, int mtiles, int ntiles,
                           char* smem) {
  u16* As = (u16*)smem;
  u16* Bs = As + 128 * 40;
  const int tid = threadIdx.x, lane = tid & 63, w = tid >> 6, wm = w >> 1, wn = w & 1;
  const int lr = lane & 15, quad = lane >> 4;
  const int nitems = mtiles * ntiles;
  for (int item = blockIdx.x; item < nitems; item += gridDim.x) {
    int mt = item / ntiles, nt = item - mt * ntiles;
    int m0 = mt * 128, n0 = nt * 128;
    f32x4 acc[4][4];
#pragma unroll
    for (int i = 0; i < 4; i++)
#pragma unroll
      for (int j = 0; j < 4; j++) acc[i][j] = (f32x4){0.f, 0.f, 0.f, 0.f};
    const int r0_ = tid >> 2, ch_ = tid & 3;
    const u16* Ap0 = A + (size_t)(m0 + r0_) * 1024 + ch_ * 8;
    const u16* Ap1 = Ap0 + (size_t)64 * 1024;
    const u16* Bp0 = Bt + (size_t)(n0 + r0_) * 1024 + ch_ * 8;
    const u16* Bp1 = Bp0 + (size_t)64 * 1024;
    uint4 ra0 = *(const uint4*)Ap0, ra1 = *(const uint4*)Ap1, rb0 = *(const uint4*)Bp0, rb1 = *(const uint4*)Bp1;
    for (int kt = 0; kt < 32; kt++) {
      __syncthreads();
      *(uint4*)(As + r0_ * 40 + ch_ * 8) = ra0;
      *(uint4*)(As + (r0_ + 64) * 40 + ch_ * 8) = ra1;
      *(uint4*)(Bs + r0_ * 40 + ch_ * 8) = rb0;
      *(uint4*)(Bs + (r0_ + 64) * 40 + ch_ * 8) = rb1;
      __syncthreads();
      if (kt < 31) {
        ra0 = *(const uint4*)(Ap0 + (kt + 1) * 32);
        ra1 = *(const uint4*)(Ap1 + (kt + 1) * 32);
        rb0 = *(const uint4*)(Bp0 + (kt + 1) * 32);
        rb1 = *(const uint4*)(Bp1 + (kt + 1) * 32);
      }
      bf16x8 a[4], b[4];
#pragma unroll
      for (int i = 0; i < 4; i++) {
        a[i] = *(const bf16x8*)(As + (wm * 64 + i * 16 + lr) * 40 + quad * 8);
        b[i] = *(const bf16x8*)(Bs + (wn * 64 + i * 16 + lr) * 40 + quad * 8);
      }
#pragma unroll
      for (int i = 0; i < 4; i++)
#pragma unroll
        for (int j = 0; j < 4; j++) acc[i][j] = __builtin_amdgcn_mfma_f32_16x16x32_bf16(a[i], b[j], acc[i][j], 0, 0, 0);
    }
#pragma unroll
    for (int i = 0; i < 4; i++)
#pragma unroll
      for (int j = 0; j < 4; j++)
#pragma unroll
        for (int r = 0; r < 4; r++) {
          int row = m0 + wm * 64 + i * 16 + quad * 4 + r;
          int col = n0 + wn * 64 + j * 16 + lr;
          float v = acc[i][j][r];
          if (EPI == 0) {
            if (col < INC) {
              p.U[(size_t)row * INC + col] = f2bf(v);
              if (col >= 2816) p.G[row * 16 + (col - 2816)] = v;
            }
          } else if (EPI == 1) {
            int mr = row < ML_ROWS ? (row >> 11) : 8;
            float g1 = p.mod[(size_t)(l * 9 + mr) * 6144 + 2048 + col];
            float sv;
            if (l == 0) sv = row < ML_ROWS ? p.x[(size_t)row * 1024 + col] : p.ctx[(size_t)(row - ML_ROWS) * 1024 + col];
            else sv = p.out[(size_t)row * 1024 + col];
            float* dst = row < ML_ROWS ? p.out + (size_t)row * 1024 + col : p.hc + (size_t)(row - ML_ROWS) * 1024 + col;
            *dst = sv + g1 * v;
          } else {
            p.S[(size_t)row * 2048 + col] = v;
          }
        }
  }
}

__device__ __forceinline__ void vt_item(const P& p, int it, u16* tl);
__device__ __forceinline__ void phase_mixprep(const P& p, int l, char* smem) {
  const int tid = threadIdx.x;
  float* pl = (float*)smem;
  const int N_QK = MT_ROWS * 16 / 256;
  const int N_POOL = (l == 0 ? MT_ROWS : ML_ROWS) / 16;
  const int N_PREP = MT_ROWS;
  const int N_VT = 2304;
  const int total = N_QK + N_POOL + N_PREP + N_VT;
  for (int item = blockIdx.x; item < total; item += gridDim.x) {
    int it = item;
    if (it >= N_QK + N_POOL + N_PREP) { vt_item(p, it - (N_QK + N_POOL + N_PREP), (u16*)smem); continue; }
    if (it < N_QK) {
      int gi = it * 256 + tid;
      int row = gi >> 4, sub = gi & 15;
      int qk = sub >> 3, h = sub & 7;
      u16* ptr = p.U + (size_t)row * INC + qk * 512 + h * 64;
      const float* g = (qk ? p.na_k_g : p.na_q_g) + l * 64;
      uint4 v[8];
      float ss = 0.f;
#pragma unroll
      for (int c = 0; c < 8; c++) {
        v[c] = ((const uint4*)ptr)[c];
        float a;
        a = bflo(v[c].x); ss += a * a; a = bfhi(v[c].x); ss += a * a;
        a = bflo(v[c].y); ss += a * a; a = bfhi(v[c].y); ss += a * a;
        a = bflo(v[c].z); ss += a * a; a = bfhi(v[c].z); ss += a * a;
        a = bflo(v[c].w); ss += a * a; a = bfhi(v[c].w); ss += a * a;
      }
      float rs = rsqrtf(ss * (1.f / 64.f) + 1e-6f);
#pragma unroll
      for (int c = 0; c < 8; c++) {
        uint4 o;
        o.x = pack2(bflo(v[c].x) * rs * g[c * 8 + 0], bfhi(v[c].x) * rs * g[c * 8 + 1]);
        o.y = pack2(bflo(v[c].y) * rs * g[c * 8 + 2], bfhi(v[c].y) * rs * g[c * 8 + 3]);
        o.z = pack2(bflo(v[c].z) * rs * g[c * 8 + 4], bfhi(v[c].z) * rs * g[c * 8 + 5]);
        o.w = pack2(bflo(v[c].w) * rs * g[c * 8 + 6], bfhi(v[c].w) * rs * g[c * 8 + 7]);
        ((uint4*)ptr)[c] = o;
      }
      continue;
    }
    it -= N_QK;
    if (it < N_POOL) {
      int row0 = it * 16;
      int base, T;
      if (row0 < ML_ROWS) { base = (row0 >> 11) << 11; T = 2048; }
      else { base = ML_ROWS + (((row0 - ML_ROWS) >> 8) << 8); T = 256; }
      int t0 = row0 - base;
      int ch = tid, g = ch >> 6;
      int wdw = 2 << g;
      __syncthreads();
      for (int tt = 0; tt < 16; tt++) {
        int t = t0 + tt;
        int lo = max(t - wdw / 2, 0), hi = min(t + (wdw - wdw / 2 - 1), T - 1);
        float s = 0.f;
        for (int tau = lo; tau <= hi; tau++) s += bf2f(p.U[(size_t)(base + tau) * INC + 1536 + ch]);
        float self = bf2f(p.U[(size_t)(base + t) * INC + 1536 + ch]);
        pl[tt * 256 + ch] = s / (float)(hi - lo + 1) - self;
      }
      __syncthreads();
      float acc[16];
#pragma unroll
      for (int tt = 0; tt < 16; tt++) acc[tt] = 0.f;
      int d = ch & 63;
      const float* pw = p.pool_w + ((size_t)(l * 4 + g) * 64) * 64 + d;
      for (int c = 0; c < 64; c++) {
        float wv = pw[c * 64];
#pragma unroll
        for (int tt = 0; tt < 16; tt++) acc[tt] += pl[tt * 256 + g * 64 + c] * wv;
      }
      float ps = p.pool_scale[l * 256 + ch];
#pragma unroll
      for (int tt = 0; tt < 16; tt++) p.Y[(size_t)(row0 + tt) * 1024 + 512 + ch] = f2bf(acc[tt] * ps);
      continue;
    }
    it -= N_POOL;
    {
      int row = it;
      int base, T;
      if (row < ML_ROWS) { base = (row >> 11) << 11; T = 2048; }
      else { base = ML_ROWS + (((row - ML_ROWS) >> 8) << 8); T = 256; }
      int t = row - base;
      int qk = tid >> 7, hh = (tid >> 5) & 3, ax = (tid >> 4) & 1, f = tid & 15;
      int ca = qk * 256 + hh * 64 + ax * 32 + f, cb = ca + 16;
      float a = 0.f, b = 0.f;
#pragma unroll
      for (int j = 0; j < 5; j++) {
        int tt = t + j - 2;
        if (tt >= 0 && tt < T) {
          const u16* ur = p.U + (size_t)(base + tt) * INC + 1792;
          a += p.ml_conv[(l * 5 + j) * 512 + ca] * bf2f(ur[ca]);
          b += p.ml_conv[(l * 5 + j) * 512 + cb] * bf2f(ur[cb]);
        }
      }
      a = siluf_(a);
      b = siluf_(b);
      if (row < ML_ROWS) {
        float pos = (float)(ax == 0 ? (t >> 6) : (t & 63));
        float inv = __expf(-(float)f * (9.210340371976184f / 16.f));
        float ang = pos * inv;
        float cs = __cosf(ang), sn = __sinf(ang);
        float oa = a * cs - b * sn, ob = a * sn + b * cs;
        a = oa; b = ob;
      }
      if (qk) { a *= 0.125f; b *= 0.125f; }
      p.MQK[(size_t)row * 512 + ca] = a;
      p.MQK[(size_t)row * 512 + cb] = b;
      if (tid < 16) {
        float gv = p.G[row * 16 + tid] + p.ml_gate_b[l * 16 + tid];
        if ((tid >> 2) & 1) gv = fminf(gv, 0.f) - log1pf(__expf(-fabsf(gv)));
        p.G[row * 16 + tid] = gv;
      }
    }
  }
}

#define VT_CTX_OFF ((size_t)8 * 8 * 64 * 2048)
__device__ __forceinline__ void vt_item(const P& p, int it, u16* tl) {
  const int tid = threadIdx.x;
  int b, h, tt, row0, TK;
  u16* dst;
  if (it < 2048) { b = it >> 8; h = (it >> 5) & 7; tt = it & 31; row0 = b * 2048 + tt * 64; TK = 2048; dst = p.VT + (size_t)((b * 8 + h) * 64) * 2048 + tt * 64; }
  else { int ci = it - 2048; b = ci >> 5; h = (ci >> 2) & 7; tt = ci & 3; row0 = ML_ROWS + b * 256 + tt * 64; TK = 256; dst = p.VT + VT_CTX_OFF + (size_t)((b * 8 + h) * 64) * 256 + tt * 64; }
  __syncthreads();
  {
    int i = tid >> 2, part = tid & 3;
    const uint4* src = (const uint4*)(p.U + (size_t)(row0 + i) * INC + 1024 + h * 64 + part * 16);
    uint4 v0 = src[0], v1 = src[1];
    unsigned* t32 = (unsigned*)(tl + i * 66 + part * 16);
    t32[0] = v0.x; t32[1] = v0.y; t32[2] = v0.z; t32[3] = v0.w;
    t32[4] = v1.x; t32[5] = v1.y; t32[6] = v1.z; t32[7] = v1.w;
  }
  __syncthreads();
  {
    int d = tid >> 2, part = tid & 3;
    unsigned o[8];
#pragma unroll
    for (int k = 0; k < 8; k++) {
      unsigned lo = tl[(part * 16 + 2 * k) * 66 + d], hi = tl[(part * 16 + 2 * k + 1) * 66 + d];
      o[k] = lo | (hi << 16);
    }
    uint4* dp = (uint4*)(dst + (size_t)d * TK + part * 16);
    dp[0] = make_uint4(o[0], o[1], o[2], o[3]);
    dp[1] = make_uint4(o[4], o[5], o[6], o[7]);
  }
}

__device__ __forceinline__ void attn_item(const P& p, int l, int item, float* sb) {
  const int tid = threadIdx.x, lane = tid & 63, w = tid >> 6, q = lane & 15, quad = lane >> 4;
  const bool latent = item < 2048;
  int b, r = 0, h, qb = 0;
  if (latent) { b = item >> 8; r = (item >> 3) & 31; h = item & 7; }
  else { int ci = item - 2048; b = ci >> 5; qb = (ci >> 3) & 3; h = ci & 7; }
  const int r0 = min(max(r - 4, 0), 24);
  __syncthreads();
  if (latent) {
    int kr = tid >> 5, j = tid & 31;
    if (j < 31) sb[tid] = p.na_rpb[(size_t)((l * 8 + h) * 15 + (r0 + kr - r + 7)) * 31 + j];
  }
  __syncthreads();
  const int qc = w * 16 + q;
  const int qrow = latent ? (b * 2048 + r * 64 + qc) : (ML_ROWS + b * 256 + qb * 64 + qc);
  const int cs = (w == 0) ? 0 : (w == 1) ? 8 : (w == 2) ? 24 : 32;
  const int c0 = min(max(qc - 8, 0), 48);
  const bf16x8 bq0 = *(const bf16x8*)(p.U + (size_t)qrow * INC + h * 64 + quad * 8);
  const bf16x8 bq1 = *(const bf16x8*)(p.U + (size_t)qrow * INC + h * 64 + 32 + quad * 8);
  const int mrow = (q >> 2) * 8 + (q & 3);
  const u16* vt_lat = p.VT + (size_t)((b * 8 + h) * 64 + q) * 2048 + quad * 8;
  const u16* vt_ctx = p.VT + VT_CTX_OFF + (size_t)((b * 8 + h) * 64 + q) * 256 + quad * 8;
  float m = -INFINITY, lsum = 0.f;
  f32x4 o[4];
#pragma unroll
  for (int dt = 0; dt < 4; dt++) o[dt] = (f32x4){0.f, 0.f, 0.f, 0.f};
#pragma unroll 1
  for (int chunk = (latent ? 0 : 2); chunk < 4; chunk++) {
    f32x4 s[4][2];
#pragma unroll
    for (int blk = 0; blk < 4; blk++) {
      int rowbase = (chunk < 2) ? (b * 2048 + (r0 + chunk * 4 + blk) * 64 + cs) : (ML_ROWS + b * 256 + (chunk - 2) * 128 + blk * 32);
#pragma unroll
      for (int T = 0; T < 2; T++) {
        const u16* kp = p.U + (size_t)(rowbase + mrow + T * 4) * INC + 512 + h * 64 + quad * 8;
        bf16x8 a0 = *(const bf16x8*)kp;
        bf16x8 a1 = *(const bf16x8*)(kp + 32);
        f32x4 acc = (f32x4){0.f, 0.f, 0.f, 0.f};
        acc = __builtin_amdgcn_mfma_f32_16x16x32_bf16(a0, bq0, acc, 0, 0, 0);
        acc = __builtin_amdgcn_mfma_f32_16x16x32_bf16(a1, bq1, acc, 0, 0, 0);
        s[blk][T] = acc;
      }
    }
    float mx = -INFINITY;
    if (chunk < 2) {
#pragma unroll
      for (int blk = 0; blk < 4; blk++)
#pragma unroll
        for (int T = 0; T < 2; T++)
#pragma unroll
          for (int rr = 0; rr < 4; rr++) {
            int kc = cs + quad * 8 + T * 4 + rr;
            bool valid = (kc >= c0) && (kc < c0 + 16);
            int bi = (chunk * 4 + blk) * 32 + min(max(kc - qc + 15, 0), 30);
            float v = valid ? (s[blk][T][rr] * 0.125f + sb[bi]) : -INFINITY;
            s[blk][T][rr] = v;
            mx = fmaxf(mx, v);
          }
    } else {
#pragma unroll
      for (int blk = 0; blk < 4; blk++)
#pragma unroll
        for (int T = 0; T < 2; T++)
#pragma unroll
          for (int rr = 0; rr < 4; rr++) {
            float v = s[blk][T][rr] * 0.125f;
            s[blk][T][rr] = v;
            mx = fmaxf(mx, v);
          }
    }
    mx = fmaxf(mx, __shfl_xor(mx, 16));
    mx = fmaxf(mx, __shfl_xor(mx, 32));
    float mn = fmaxf(m, mx);
    float sc = __expf(m - mn);
    lsum *= sc;
#pragma unroll
    for (int dt = 0; dt < 4; dt++) o[dt] *= sc;
    m = mn;
#pragma unroll
    for (int blk = 0; blk < 4; blk++) {
      float pv[8];
#pragma unroll
      for (int T = 0; T < 2; T++)
#pragma unroll
        for (int rr = 0; rr < 4; rr++) {
          float e = __expf(s[blk][T][rr] - mn);
          pv[T * 4 + rr] = e;
          lsum += e;
        }
      union { bf16x8 v; unsigned u[4]; } pk;
      pk.u[0] = pack2(pv[0], pv[1]); pk.u[1] = pack2(pv[2], pv[3]); pk.u[2] = pack2(pv[4], pv[5]); pk.u[3] = pack2(pv[6], pv[7]);
      const u16* vb = (chunk < 2) ? (vt_lat + (r0 + chunk * 4 + blk) * 64 + cs) : (vt_ctx + (chunk - 2) * 128 + blk * 32);
      const size_t dstr = (chunk < 2) ? (size_t)16 * 2048 : (size_t)16 * 256;
#pragma unroll
      for (int dt = 0; dt < 4; dt++) {
        bf16x8 av = *(const bf16x8*)(vb + dt * dstr);
        o[dt] = __builtin_amdgcn_mfma_f32_16x16x32_bf16(av, pk.v, o[dt], 0, 0, 0);
      }
    }
  }
  lsum += __shfl_xor(lsum, 16);
  lsum += __shfl_xor(lsum, 32);
  float il = 1.f / lsum;
#pragma unroll
  for (int dt = 0; dt < 4; dt++) {
    uint2 ov;
    ov.x = pack2(o[dt][0] * il, o[dt][1] * il);
    ov.y = pack2(o[dt][2] * il, o[dt][3] * il);
    *(uint2*)(p.Y + (size_t)qrow * 1024 + h * 64 + dt * 16 + quad * 4) = ov;
  }
}

__device__ __forceinline__ int ml_row(int b, int dir, int j, int pp) {
  if (j < 4) {
    int pos = j * 64 + pp;
    int t = dir ? 255 - pos : pos;
    return ML_ROWS + b * 256 + t;
  } else {
    int pos = (j - 4) * 64 + pp;
    int t = dir ? 2047 - pos : pos;
    return b * 2048 + t;
  }
}

__device__ __forceinline__ void mlstmA_item(const P& p, int it, float* sm) {
  const int tid = threadIdx.x;
  int seq = it / 36, j = it % 36;
  int b = seq >> 3, h = (seq >> 1) & 3, dir = seq & 1;
  float* ks = sm;
  float* vs = sm + 64 * 65;
  float* ic = sm + 2 * 64 * 65;
  float* fc = ic + 64;
  float* bb = fc + 64;
  float* wsm = bb + 64;
  float* scal = wsm + 64;
  __syncthreads();
  for (int idx = tid; idx < 4096; idx += 256) {
    int pp = idx >> 6, d = idx & 63;
    int row = ml_row(b, dir, j, pp);
    ks[pp * 65 + d] = p.MQK[(size_t)row * 512 + 256 + h * 64 + d];
    vs[pp * 65 + d] = bf2f(p.U[(size_t)row * INC + 2304 + h * 64 + d]);
  }
  if (tid < 64) {
    int row = ml_row(b, dir, j, tid);
    ic[tid] = p.G[row * 16 + (dir * 2) * 4 + h];
    fc[tid] = p.G[row * 16 + (dir * 2 + 1) * 4 + h];
  }
  __syncthreads();
  if (tid == 0) {
    float acc = 0.f;
    for (int pp = 0; pp < 64; pp++) { acc += fc[pp]; bb[pp] = acc; }
    float bl = acc, ml = -INFINITY;
    for (int pp = 0; pp < 64; pp++) ml = fmaxf(ml, bl - bb[pp] + ic[pp]);
    scal[0] = bl; scal[1] = ml;
  }
  __syncthreads();
  if (tid < 64) wsm[tid] = __expf(scal[0] - bb[tid] + ic[tid] - scal[1]);
  __syncthreads();
  float* slot = p.mst + (size_t)it * SLOT;
  {
    int e = tid & 63, dg = tid >> 6;
    float acc[16];
#pragma unroll
    for (int dd = 0; dd < 16; dd++) acc[dd] = 0.f;
    for (int pp = 0; pp < 64; pp++) {
      float wv = wsm[pp] * vs[pp * 65 + e];
#pragma unroll
      for (int dd = 0; dd < 16; dd++) acc[dd] += ks[pp * 65 + dg * 16 + dd] * wv;
    }
#pragma unroll
    for (int dd = 0; dd < 16; dd++) slot[(dg * 16 + dd) * 64 + e] = acc[dd];
  }
  if (tid < 64) {
    float a = 0.f;
    for (int pp = 0; pp < 64; pp++) a += wsm[pp] * ks[pp * 65 + tid];
    slot[4096 + tid] = a;
  }
  if (tid == 0) { slot[4160] = scal[0]; slot[4161] = scal[1]; }
}

__device__ __forceinline__ void phase_attn_mlA(const P& p, int l, char* smem) {
  const int N_ATT = (l == 0 ? 2304 : 2048);
  const int N_MLA = 64 * 36;
  const int total = N_ATT + N_MLA;
  for (int item = blockIdx.x; item < total; item += gridDim.x) {
    if (item < N_MLA) mlstmA_item(p, item, (float*)smem);
    else attn_item(p, l, item - N_MLA, (float*)smem);
  }
}

__device__ __forceinline__ void phase_mlB(const P& p) {
  const int tid = threadIdx.x;
  const int total = 64 * 4160 / 256;
  for (int item = blockIdx.x; item < total; item += gridDim.x) {
    int idx = item * 256 + tid;
    int seq = idx / 4160, el = idx - seq * 4160;
    float m = 0.f, val = 0.f;
    for (int j = 0; j < 36; j++) {
      float* slot = p.mst + (size_t)(seq * 36 + j) * SLOT;
      float bl = slot[4160], ml = slot[4161];
      float loc = slot[el];
      slot[el] = val;
      if (el == 0) slot[4162] = m;
      float mn = fmaxf(bl + m, ml);
      val = __expf(bl + m - mn) * val + __expf(ml - mn) * loc;
      m = mn;
    }
  }
}

__device__ __forceinline__ void phase_mlC(const P& p, int l, char* smem) {
  const int tid = threadIdx.x;
  float* qs = (float*)smem;
  float* kb = qs + 64 * 65;
  float* Ss = kb + 64 * 65;
  float* hs = Ss + 64 * 65;
  float* ic = hs + 64 * 65;
  float* fc = ic + 64;
  float* bb = fc + 64;
  float* mt = bb + 64;
  float* rsn = mt + 64;
  const int nch = (l == 0) ? 36 : 32;
  const int total = 32 * nch;
  for (int item = blockIdx.x; item < total; item += gridDim.x) {
    int bh = item / nch, c = item % nch + (l == 0 ? 0 : 4);
    int b = bh >> 2, h = bh & 3;
    for (int dir = 0; dir < 2; dir++) {
      int j = dir ? (c < 4 ? 3 - c : 4 + 31 - (c - 4)) : c;
      const float* slot = p.mst + (size_t)(((b * 4 + h) * 2 + dir) * 36 + j) * SLOT;
      float m0 = slot[4162];
      __syncthreads();
      for (int idx = tid; idx < 4096; idx += 256) {
        int pp = idx >> 6, d = idx & 63;
        int row = ml_row(b, dir, j, pp);
        qs[pp * 65 + d] = p.MQK[(size_t)row * 512 + h * 64 + d];
        kb[pp * 65 + d] = p.MQK[(size_t)row * 512 + 256 + h * 64 + d];
      }
      if (tid < 64) {
        int row = ml_row(b, dir, j, tid);
        ic[tid] = p.G[row * 16 + (dir * 2) * 4 + h];
        fc[tid] = p.G[row * 16 + (dir * 2 + 1) * 4 + h];
      }
      __syncthreads();
      if (tid == 0) {
        float acc = 0.f, pm = -INFINITY;
        for (int pp = 0; pp < 64; pp++) {
          acc += fc[pp];
          bb[pp] = acc;
          pm = fmaxf(pm, ic[pp] - acc);
          mt[pp] = fmaxf(acc + m0, acc + pm);
        }
      }
      __syncthreads();
      {
        int s = tid & 63, tg = tid >> 6;
        float acc[16];
#pragma unroll
        for (int tt = 0; tt < 16; tt++) acc[tt] = 0.f;
        for (int d = 0; d < 64; d++) {
          float kv = kb[s * 65 + d];
#pragma unroll
          for (int tt = 0; tt < 16; tt++) acc[tt] += qs[(tg * 16 + tt) * 65 + d] * kv;
        }
        float cs = ic[s] - bb[s];
#pragma unroll
        for (int tt = 0; tt < 16; tt++) {
          int t = tg * 16 + tt;
          float wv = (s <= t) ? acc[tt] * __expf(bb[t] + cs - mt[t]) : 0.f;
          Ss[t * 65 + s] = wv;
        }
      }
      __syncthreads();
      for (int idx = tid; idx < 4096; idx += 256) {
        int pp = idx >> 6, d = idx & 63;
        int row = ml_row(b, dir, j, pp);
        kb[pp * 65 + d] = bf2f(p.U[(size_t)row * INC + 2304 + h * 64 + d]);
      }
      __syncthreads();
      {
        int e = tid & 63, tg = tid >> 6;
        float a1[16], a2[16], ds[16], dq[16];
#pragma unroll
        for (int tt = 0; tt < 16; tt++) { a1[tt] = 0.f; a2[tt] = 0.f; ds[tt] = 0.f; dq[tt] = 0.f; }
        for (int s = 0; s < 64; s++) {
          float vv = kb[s * 65 + e];
#pragma unroll
          for (int tt = 0; tt < 16; tt++) {
            float wv = Ss[(tg * 16 + tt) * 65 + s];
            a1[tt] += wv * vv;
            ds[tt] += wv;
          }
        }
        for (int d = 0; d < 64; d++) {
          float cv = slot[d * 64 + e];
          float nv = slot[4096 + d];
#pragma unroll
          for (int tt = 0; tt < 16; tt++) {
            float qv = qs[(tg * 16 + tt) * 65 + d];
            a2[tt] += qv * cv;
            dq[tt] += qv * nv;
          }
        }
#pragma unroll
        for (int tt = 0; tt < 16; tt++) {
          int t = tg * 16 + tt;
          float wi = __expf(bb[t] + m0 - mt[t]);
          float num = a1[tt] + wi * a2[tt];
          float den = ds[tt] + wi * dq[tt];
          float hv = num / fmaxf(fabsf(den), __expf(-mt[t]));
          int to = dir ? 63 - t : t;
          if (dir == 0) hs[to * 65 + e] = hv;
          else hs[to * 65 + e] += hv;
        }
      }
    }
    __syncthreads();
    {
      int t = tid >> 2, part = tid & 3;
      float ss = 0.f;
#pragma unroll
      for (int i = 0; i < 16; i++) { float v = hs[t * 65 + part * 16 + i]; ss += v * v; }
      ss += __shfl_xor(ss, 1);
      ss += __shfl_xor(ss, 2);
      if (part == 0) rsn[t] = rsqrtf(ss * (1.f / 64.f) + 1e-6f);
    }
    __syncthreads();
    {
      int e = tid & 63, tg = tid >> 6;
      float ng = p.ml_norm_g[l * 256 + h * 64 + e];
#pragma unroll 4
      for (int tt = 0; tt < 16; tt++) {
        int t = tg * 16 + tt;
        int row = (c < 4) ? (ML_ROWS + b * 256 + c * 64 + t) : (b * 2048 + (c - 4) * 64 + t);
        float uo = bf2f(p.U[(size_t)row * INC + 2560 + h * 64 + e]);
        float v = hs[t * 65 + e] * rsn[t] * ng * sigmoidf_(uo);
        p.Y[(size_t)row * 1024 + 768 + h * 64 + e] = f2bf(v);
      }
    }
    __syncthreads();
  }
}

typedef __attribute__((ext_vector_type(2))) float f32x2;
__device__ __forceinline__ float gelu_tanh(float x) {
  float u = 0.7978845608028654f * (x + 0.044715f * x * x * x);
  float th = 1.f - 2.f / (1.f + __expf(2.f * u));
  return 0.5f * x * (1.f + th);
}
__device__ __forceinline__ float dot16_fp8(const float* xr, uint4 v) {
  f32x2 t;
  float s = 0.f;
  t = __builtin_amdgcn_cvt_pk_f32_fp8((int)v.x, false); s += xr[0] * t.x + xr[1] * t.y;
  t = __builtin_amdgcn_cvt_pk_f32_fp8((int)v.x, true);  s += xr[2] * t.x + xr[3] * t.y;
  t = __builtin_amdgcn_cvt_pk_f32_fp8((int)v.y, false); s += xr[4] * t.x + xr[5] * t.y;
  t = __builtin_amdgcn_cvt_pk_f32_fp8((int)v.y, true);  s += xr[6] * t.x + xr[7] * t.y;
  t = __builtin_amdgcn_cvt_pk_f32_fp8((int)v.z, false); s += xr[8] * t.x + xr[9] * t.y;
  t = __builtin_amdgcn_cvt_pk_f32_fp8((int)v.z, true);  s += xr[10] * t.x + xr[11] * t.y;
  t = __builtin_amdgcn_cvt_pk_f32_fp8((int)v.w, false); s += xr[12] * t.x + xr[13] * t.y;
  t = __builtin_amdgcn_cvt_pk_f32_fp8((int)v.w, true);  s += xr[14] * t.x + xr[15] * t.y;
  return s;
}
__device__ __forceinline__ void axpy16_fp8(float* acc, float a, uint4 v) {
  f32x2 t;
  t = __builtin_amdgcn_cvt_pk_f32_fp8((int)v.x, false); acc[0] += a * t.x; acc[1] += a * t.y;
  t = __builtin_amdgcn_cvt_pk_f32_fp8((int)v.x, true);  acc[2] += a * t.x; acc[3] += a * t.y;
  t = __builtin_amdgcn_cvt_pk_f32_fp8((int)v.y, false); acc[4] += a * t.x; acc[5] += a * t.y;
  t = __builtin_amdgcn_cvt_pk_f32_fp8((int)v.y, true);  acc[6] += a * t.x; acc[7] += a * t.y;
  t = __builtin_amdgcn_cvt_pk_f32_fp8((int)v.z, false); acc[8] += a * t.x; acc[9] += a * t.y;
  t = __builtin_amdgcn_cvt_pk_f32_fp8((int)v.z, true);  acc[10] += a * t.x; acc[11] += a * t.y;
  t = __builtin_amdgcn_cvt_pk_f32_fp8((int)v.w, false); acc[12] += a * t.x; acc[13] += a * t.y;
  t = __builtin_amdgcn_cvt_pk_f32_fp8((int)v.w, true);  acc[14] += a * t.x; acc[15] += a * t.y;
}

__device__ __forceinline__ unsigned fkey(float f) {
  unsigned u = __float_as_uint(f);
  return (u & 0x80000000u) ? ~u : (u | 0x80000000u);
}
__device__ __forceinline__ int mbcnt64(unsigned long long m) {
  return __builtin_amdgcn_mbcnt_hi((unsigned)(m >> 32), __builtin_amdgcn_mbcnt_lo((unsigned)m, 0));
}
#define WAVE_LDS_FENCE() do { __builtin_amdgcn_fence(__ATOMIC_RELEASE, "wavefront"); __builtin_amdgcn_wave_barrier(); __builtin_amdgcn_fence(__ATOMIC_ACQUIRE, "wavefront"); } while (0)

__device__ __forceinline__ void phase_peer(const P& p, int l, char* smem) {
  const int tid = threadIdx.x, lane = tid & 63, w = tid >> 6;
  float* wl = (float*)smem + w * 512;
  float* cs = wl;
  int* ci = (int*)(wl + 32);
  int* el = (int*)(wl + 64);
  float* sl = wl + 192;
  float* as = wl + 320;
  const int nrows = (l == 1) ? ML_ROWS : MT_ROWS;
  const unsigned char* Ub = (const unsigned char*)p.Ub + (size_t)l * 16384 * 1024;
  const unsigned char* Vb = (const unsigned char*)p.Vb + (size_t)l * 16384 * 1024;
  const bool hi5 = (lane & 32) != 0, hi4 = (lane & 16) != 0, hi3 = (lane & 8) != 0, hi2 = (lane & 4) != 0;
  const int nw = gridDim.x * 4;
  for (int row = blockIdx.x * 4 + w; row < nrows; row += nw) {
#pragma unroll 1
    for (int h = 0; h < 8; h++) {
      const float* sp = p.S + (size_t)row * 2048 + h * 256;
      float a0 = sp[lane], a1 = sp[64 + lane], b0 = sp[128 + lane], b1 = sp[192 + lane];
      unsigned kA0 = fkey(a0), kA1 = fkey(a1), kB0 = fkey(b0), kB1 = fkey(b1);
      unsigned pA = 0, pB = 0;
      bool dA = false, dB = false;
#pragma unroll 1
      for (int bit = 31; bit >= 0; --bit) {
        unsigned cA = pA | (1u << bit), cB = pB | (1u << bit);
        int nA = __popcll(__ballot(kA0 >= cA)) + __popcll(__ballot(kA1 >= cA));
        int nB = __popcll(__ballot(kB0 >= cB)) + __popcll(__ballot(kB1 >= cB));
        if (!dA && nA >= 16) { pA = cA; dA = (nA == 16); }
        if (!dB && nB >= 16) { pB = cB; dB = (nB == 16); }
        if (dA && dB) break;
      }
      {
        unsigned long long m0 = __ballot(kA0 >= pA), m1 = __ballot(kA1 >= pA);
        int p0 = mbcnt64(m0), p1 = __popcll(m0) + mbcnt64(m1);
        if (kA0 >= pA && p0 < 16) { cs[p0] = a0; ci[p0] = lane; }
        if (kA1 >= pA && p1 < 16) { cs[p1] = a1; ci[p1] = lane + 64; }
        m0 = __ballot(kB0 >= pB); m1 = __ballot(kB1 >= pB);
        p0 = mbcnt64(m0); p1 = __popcll(m0) + mbcnt64(m1);
        if (kB0 >= pB && p0 < 16) { cs[16 + p0] = b0; ci[16 + p0] = lane; }
        if (kB1 >= pB && p1 < 16) { cs[16 + p1] = b1; ci[16 + p1] = lane + 64; }
      }
      WAVE_LDS_FENCE();
      const int ii = lane >> 2, jb = (lane & 3) * 4;
      float s1 = cs[ii];
      float c0 = s1 + cs[16 + jb + 0], c1 = s1 + cs[16 + jb + 1], c2 = s1 + cs[16 + jb + 2], c3 = s1 + cs[16 + jb + 3];
      int e1 = ci[ii] * 128;
      int f0 = e1 + ci[16 + jb + 0], f1 = e1 + ci[16 + jb + 1], f2 = e1 + ci[16 + jb + 2], f3 = e1 + ci[16 + jb + 3];
      unsigned k0 = fkey(c0), k1 = fkey(c1), k2 = fkey(c2), k3 = fkey(c3);
      unsigned pC = 0;
#pragma unroll 1
      for (int bit = 31; bit >= 0; --bit) {
        unsigned cC = pC | (1u << bit);
        int n = __popcll(__ballot(k0 >= cC)) + __popcll(__ballot(k1 >= cC)) + __popcll(__ballot(k2 >= cC)) + __popcll(__ballot(k3 >= cC));
        if (n >= 16) { pC = cC; if (n == 16) break; }
      }
      {
        unsigned long long m0 = __ballot(k0 >= pC), m1 = __ballot(k1 >= pC), m2 = __ballot(k2 >= pC), m3 = __ballot(k3 >= pC);
        int q0 = mbcnt64(m0);
        int q1 = __popcll(m0) + mbcnt64(m1);
        int q2 = __popcll(m0) + __popcll(m1) + mbcnt64(m2);
        int q3 = __popcll(m0) + __popcll(m1) + __popcll(m2) + mbcnt64(m3);
        if (k0 >= pC && q0 < 16) { el[h * 16 + q0] = f0; sl[h * 16 + q0] = c0; }
        if (k1 >= pC && q1 < 16) { el[h * 16 + q1] = f1; sl[h * 16 + q1] = c1; }
        if (k2 >= pC && q2 < 16) { el[h * 16 + q2] = f2; sl[h * 16 + q2] = c2; }
        if (k3 >= pC && q3 < 16) { el[h * 16 + q3] = f3; sl[h * 16 + q3] = c3; }
      }
      WAVE_LDS_FENCE();
    }
    {
      float v0 = sl[lane], v1 = sl[64 + lane];
      float m0 = v0, m1 = v1;
#pragma unroll
      for (int o = 1; o < 16; o <<= 1) { m0 = fmaxf(m0, __shfl_xor(m0, o)); m1 = fmaxf(m1, __shfl_xor(m1, o)); }
      float e0 = __expf(v0 - m0), e1 = __expf(v1 - m1);
      float s0 = e0, s1 = e1;
#pragma unroll
      for (int o = 1; o < 16; o <<= 1) { s0 += __shfl_xor(s0, o); s1 += __shfl_xor(s1, o); }
      sl[lane] = e0 / s0;
      sl[64 + lane] = e1 / s1;
    }
    float xr[16];
    {
      const uint4* xp = (const uint4*)(p.xn + (size_t)row * 1024 + lane * 16);
#pragma unroll
      for (int c = 0; c < 2; c++) {
        uint4 v = xp[c];
        xr[c * 8 + 0] = bflo(v.x); xr[c * 8 + 1] = bfhi(v.x); xr[c * 8 + 2] = bflo(v.y); xr[c * 8 + 3] = bfhi(v.y);
        xr[c * 8 + 4] = bflo(v.z); xr[c * 8 + 5] = bfhi(v.z); xr[c * 8 + 6] = bflo(v.w); xr[c * 8 + 7] = bfhi(v.w);
      }
    }
    WAVE_LDS_FENCE();
#pragma unroll 1
    for (int e0 = 0; e0 < 128; e0 += 16) {
      uint4 rr[16];
#pragma unroll
      for (int i = 0; i < 16; i++) rr[i] = *(const uint4*)(Ub + (size_t)el[e0 + i] * 1024 + lane * 16);
      float d[16];
#pragma unroll
      for (int i = 0; i < 16; i++) d[i] = dot16_fp8(xr, rr[i]);
      float k8[8], k4[4], k2[2];
#pragma unroll
      for (int i = 0; i < 8; i++) k8[i] = (hi5 ? d[i + 8] : d[i]) + __shfl_xor(hi5 ? d[i] : d[i + 8], 32);
#pragma unroll
      for (int i = 0; i < 4; i++) k4[i] = (hi4 ? k8[i + 4] : k8[i]) + __shfl_xor(hi4 ? k8[i] : k8[i + 4], 16);
#pragma unroll
      for (int i = 0; i < 2; i++) k2[i] = (hi3 ? k4[i + 2] : k4[i]) + __shfl_xor(hi3 ? k4[i] : k4[i + 2], 8);
      float k1 = (hi2 ? k2[1] : k2[0]) + __shfl_xor(hi2 ? k2[0] : k2[1], 4);
      k1 += __shfl_xor(k1, 2);
      k1 += __shfl_xor(k1, 1);
      if ((lane & 3) == 0) {
        int k = e0 + (lane >> 2);
        as[k] = gelu_tanh(k1 * (1.f / 64.f)) * sl[k];
      }
    }
    WAVE_LDS_FENCE();
    float acc[16];
#pragma unroll
    for (int i = 0; i < 16; i++) acc[i] = 0.f;
#pragma unroll 1
    for (int e0 = 0; e0 < 128; e0 += 16) {
      uint4 rr[16];
#pragma unroll
      for (int i = 0; i < 16; i++) rr[i] = *(const uint4*)(Vb + (size_t)el[e0 + i] * 1024 + lane * 16);
#pragma unroll
      for (int i = 0; i < 16; i++) axpy16_fp8(acc, as[e0 + i], rr[i]);
    }
    {
      int mr = row < ML_ROWS ? (row >> 11) : 8;
      const float4* g2p = (const float4*)(p.mod + (size_t)(l * 9 + mr) * 6144 + 5120 + lane * 16);
      float4* dst = (float4*)(row < ML_ROWS ? p.out + (size_t)row * 1024 + lane * 16 : p.hc + (size_t)(row - ML_ROWS) * 1024 + lane * 16);
#pragma unroll
      for (int i = 0; i < 4; i++) {
        float4 g2 = g2p[i];
        float4 cur = dst[i];
        cur.x += g2.x * 0.125f * acc[i * 4 + 0];
        cur.y += g2.y * 0.125f * acc[i * 4 + 1];
        cur.z += g2.z * 0.125f * acc[i * 4 + 2];
        cur.w += g2.w * 0.125f * acc[i * 4 + 3];
        dst[i] = cur;
      }
    }
    WAVE_LDS_FENCE();
  }
}

#define RUN(k, call)                         \
  if (lo <= (k) && (k) < hi) {               \
    call;                                    \
    if ((k) + 1 < hi) grid.sync();           \
  }
#define LAYER(l, base)                                                                                                    \
  RUN(base + 0, phase_norm(p, l, 1))                                                                                     \
  RUN(base + 1, phase_gemm<0>(p, l, p.xn, p.WinT + (size_t)l * INC_PAD * 1024, MT_ROWS / 128, INC_PAD / 128, smem))     \
  RUN(base + 2, phase_mixprep(p, l, smem))                                                                               \
  RUN(base + 3, phase_attn_mlA(p, l, smem))                                                                              \
  RUN(base + 4, phase_mlB(p))                                                                                            \
  RUN(base + 5, phase_mlC(p, l, smem))                                                                                   \
  RUN(base + 6, phase_gemm<1>(p, l, p.Y, p.WoutT + (size_t)l * 1024 * 1024, (l == 0 ? MT_ROWS : ML_ROWS) / 128, 8, smem)) \
  RUN(base + 7, phase_norm(p, l, 2))                                                                                     \
  RUN(base + 8, phase_gemm<2>(p, l, p.xn, p.WsT + (size_t)l * 2048 * 1024, (l == 0 ? MT_ROWS : ML_ROWS) / 128, 16, smem)) \
  RUN(base + 9, phase_peer(p, l, smem))

__global__ void __launch_bounds__(256, 2) fwd_kernel(P p) {
  __shared__ __attribute__((aligned(16))) char smem[SMEM_BYTES];
  cg::grid_group grid = cg::this_grid();
  const int lo = (int)p.ph_lo, hi = (int)p.ph_hi;
  RUN(0, phase_prologue(p, smem))
  LAYER(0, 1)
  LAYER(1, 11)
}

extern "C" void kernel_launch(void* const* d_in, const int* in_sizes, int n_in, void* d_out, int out_size, void* d_ws,
                              size_t ws_size, hipStream_t stream) {
  static int grid_blocks = 0;
  if (!grid_blocks) {
    int dev = 0, cus = 0, per_cu = 0;
    hipGetDevice(&dev);
    hipDeviceGetAttribute(&cus, hipDeviceAttributeMultiprocessorCount, dev);
    hipOccupancyMaxActiveBlocksPerMultiprocessor(&per_cu, fwd_kernel, 256, 0);
    if (per_cu < 1) per_cu = 1;
    if (per_cu > 2) per_cu = 2;
    grid_blocks = cus * per_cu;
  }
  P p{};
  const float** ins = (const float**)&p;
  for (int i = 0; i < 22; i++) ins[i] = (const float*)d_in[i];
  p.out = (float*)d_out;
  char* ws = (char*)d_ws;
  size_t off = 0;
  auto take = [&](size_t bytes) { char* r = ws + off; off += (bytes + 255) & ~(size_t)255; return r; };
  p.WinT = (u16*)take((size_t)2 * INC_PAD * 1024 * 2);
  p.WoutT = (u16*)take((size_t)2 * 1024 * 1024 * 2);
  p.WsT = (u16*)take((size_t)2 * 2048 * 1024 * 2);
  p.Ub = (u16*)take((size_t)2 * 16384 * 1024 * 2);
  p.Vb = (u16*)take((size_t)2 * 16384 * 1024 * 2);
  p.mod = (float*)take((size_t)2 * 9 * 6144 * 4);
  p.xn = (u16*)take((size_t)MT_ROWS * 1024 * 2);
  p.U = (u16*)take((size_t)MT_ROWS * INC * 2);
  p.MQK = (float*)take((size_t)MT_ROWS * 512 * 4);
  p.Y = (u16*)take((size_t)MT_ROWS * 1024 * 2);
  p.S = (float*)p.U;
  p.G = (float*)take((size_t)MT_ROWS * 16 * 4);
  p.mst = (float*)take((size_t)2304 * SLOT * 4);
  p.hc = (float*)take((size_t)MC_ROWS * 1024 * 4);
  p.VT = (u16*)take((size_t)(8 * 8 * 64) * (2048 + 256) * 2);
  if (off > ws_size) { fprintf(stderr, "workspace too small: need %zu have %zu\n", off, ws_size); return; }
#if MEGA
  p.ph_lo = 0; p.ph_hi = NPHASES;
  void* args[] = {&p};
  hipError_t e = hipLaunchCooperativeKernel((void*)fwd_kernel, dim3(grid_blocks), dim3(256), args, 0, stream);
  if (e != hipSuccess) fprintf(stderr, "cooperative launch failed: %s (grid %d)\n", hipGetErrorString(e), grid_blocks);
#else
  for (int ph = 0; ph < NPHASES; ph++) {
    p.ph_lo = ph; p.ph_hi = ph + 1;
    void* args[] = {&p};
    hipError_t e = hipLaunchCooperativeKernel((void*)fwd_kernel, dim3(grid_blocks), dim3(256), args, 0, stream);
    if (e != hipSuccess) fprintf(stderr, "cooperative launch failed: %s (grid %d)\n", hipGetErrorString(e), grid_blocks);
  }
#endif
}
```

```cpp
#include <hip/hip_runtime.h>
#include <hip/hip_cooperative_groups.h>
#include <cstdio>
namespace cg = cooperative_groups;

#ifndef MEGA
#define MEGA 1
#endif

typedef unsigned short u16;
typedef __attribute__((ext_vector_type(8))) short bf16x8;
typedef __attribute__((ext_vector_type(4))) float f32x4;

#define ML_ROWS 16384
#define MC_ROWS 2048
#define MT_ROWS 18432
#define INC 2832
#define INC_PAD 2944
#define SLOT 4224
#define SMEM_BYTES 69632
#define NPHASES 21

struct P {
  const float *x, *c, *ctx, *c_ctx, *w_ada, *b_ada, *norm1_g, *w_in, *ml_gate_b, *na_q_g, *na_k_g, *na_rpb,
      *pool_w, *pool_scale, *ml_conv, *ml_norm_g, *w_out, *norm2_g, *peer_wq, *peer_keys, *peer_u, *peer_v;
  float* out;
  u16 *WinT, *WoutT, *WsT, *Ub, *Vb;
  float* mod;
  u16* xn;
  u16* U;
  float* MQK;
  u16* Y;
  float* S;
  float* G;
  float* mst;
  float* hc;
  u16* VT;
  unsigned* bar;
  long long ph_lo, ph_hi;
};

__device__ __forceinline__ u16 f2bf(float f) {
  unsigned u = __float_as_uint(f);
  u += 0x7fffu + ((u >> 16) & 1u);
  return (u16)(u >> 16);
}
__device__ __forceinline__ float bf2f(u16 h) { return __uint_as_float(((unsigned)h) << 16); }
__device__ __forceinline__ float bflo(unsigned u) { return __uint_as_float(u << 16); }
__device__ __forceinline__ float bfhi(unsigned u) { return __uint_as_float(u & 0xffff0000u); }
__device__ __forceinline__ unsigned pack2(float a, float b) { return (unsigned)f2bf(a) | ((unsigned)f2bf(b) << 16); }
__device__ __forceinline__ float wave_sum(float v) {
#pragma unroll
  for (int o = 32; o; o >>= 1) v += __shfl_xor(v, o);
  return v;
}
__device__ __forceinline__ void wave_argmax(float& v, int& i) {
#pragma unroll
  for (int o = 32; o; o >>= 1) {
    float ov = __shfl_xor(v, o);
    int oi = __shfl_xor(i, o);
    if (ov > v || (ov == v && oi < i)) { v = ov; i = oi; }
  }
}
__device__ __forceinline__ float sigmoidf_(float x) { return 1.f / (1.f + __expf(-x)); }
__device__ __forceinline__ float siluf_(float x) { return x / (1.f + __expf(-x)); }

#define XB_TMO      128
#define XB_XCNT(j)  (256  + 64 * (j))
#define XB_XSUB(j)  (1280 + 64 * (j))
#define XB_XGEN(j)  (2304 + 64 * (j))
#define XB_TOP      3328
#define XB_TOPGEN   3392
#define XCD_BAR_WORDS 3456
#define XB_SPIN_CAP (1u << 18)
#define LAS __attribute__((address_space(3)))
__device__ __forceinline__ unsigned xb_ld(unsigned* p)              { return __hip_atomic_load(p, __ATOMIC_RELAXED, __HIP_MEMORY_SCOPE_AGENT); }
__device__ __forceinline__ unsigned xb_add(unsigned* p, unsigned v) { return __hip_atomic_fetch_add(p, v, __ATOMIC_RELAXED, __HIP_MEMORY_SCOPE_AGENT); }
__device__ __forceinline__ unsigned xb_xcc_id() { return (unsigned)__builtin_amdgcn_s_getreg((3 << 11) | 20) & 0xFu; }
#define XB_SPIN(cond, bar) do { unsigned _sp = 0; while (cond) { __builtin_amdgcn_s_sleep(1); \
    if ((++_sp & 255u) == 0u) { if (xb_ld(&(bar)[XB_TMO])) break; if (_sp > XB_SPIN_CAP) { atomicAdd(&(bar)[XB_TMO], 1u); break; } } } } while (0)
struct XcdBarrier { unsigned* bar; unsigned x; volatile LAS unsigned* st; };
__device__ __forceinline__ XcdBarrier xcd_barrier_post(unsigned* bar, volatile LAS unsigned* st) {
    XcdBarrier b; b.bar = bar; b.x = xb_xcc_id(); b.st = st;
    if (threadIdx.x == 0) (void)xb_add(&bar[XB_XCNT(b.x)], 1u);
    return b;
}
__device__ __forceinline__ void xcd_barrier_complete(unsigned* bar, unsigned x, unsigned& nloc, unsigned& nx) {
    const unsigned G = gridDim.x * gridDim.y * gridDim.z;
    unsigned sum, cnt, mine, sp = 0u;
    for (;;) {
        sum = 0u; cnt = 0u; mine = 0u;
#pragma unroll
        for (unsigned j = 0; j < 16; ++j) { const unsigned c = xb_ld(&bar[XB_XCNT(j)]); sum += c; cnt += (c > 0u) ? 1u : 0u; mine = (j == x) ? c : mine; }
        if (sum == G) break;
        __builtin_amdgcn_s_sleep(1);
        if ((++sp & 255u) == 0u) { if (xb_ld(&bar[XB_TMO])) break; if (sp > XB_SPIN_CAP) { atomicAdd(&bar[XB_TMO], 1u); break; } }
    }
    nloc = mine > 0u ? mine : 1u; nx = cnt > 0u ? cnt : 1u;
}
__device__ __forceinline__ void xcd_barrier(const XcdBarrier& b) {
    asm volatile("s_waitcnt vmcnt(0)" ::: "memory");
    __syncthreads();
    if (threadIdx.x == 0) {
        unsigned* bar = b.bar;
        __builtin_amdgcn_s_waitcnt(0);
        unsigned nloc = b.st[0], nx = b.st[1];
        if (nloc == 0u) { xcd_barrier_complete(bar, b.x, nloc, nx); b.st[0] = nloc; b.st[1] = nx; }
        const unsigned old = xb_add(&bar[XB_XSUB(b.x)], 1u);
        const unsigned gen = old / nloc;
        if (old + 1u == (gen + 1u) * nloc) {
            __builtin_amdgcn_fence(__ATOMIC_RELEASE, "agent");
            asm volatile("s_waitcnt vmcnt(0)" ::: "memory");
            const unsigned og = xb_add(&bar[XB_TOP], 1u);
            const unsigned tg = og / nx;
            if (og + 1u == (tg + 1u) * nx) xb_add(&bar[XB_TOPGEN], 1u);
            else XB_SPIN(xb_ld(&bar[XB_TOPGEN]) == tg, bar);
            __builtin_amdgcn_fence(__ATOMIC_ACQUIRE, "agent");
            xb_add(&bar[XB_XGEN(b.x)], 1u);
            asm volatile("s_waitcnt vmcnt(0)" ::: "memory");
        } else {
            XB_SPIN(xb_ld(&bar[XB_XGEN(b.x)]) == gen, bar);
            __builtin_amdgcn_fence(__ATOMIC_ACQUIRE, "agent");
            asm volatile("s_waitcnt vmcnt(0)" ::: "memory");
        }
    }
    __syncthreads();
}

__device__ __forceinline__ void transpose_item(const float* __restrict__ src, int N, u16* __restrict__ dst, int kt, int nt, float* tl) {
  const int tid = threadIdx.x;
#pragma unroll 4
  for (int i = 0; i < 16; i++) {
    int idx = tid + 256 * i;
    int kk = idx >> 6, nn = idx & 63;
    int n = nt * 64 + nn;
    float v = (n < N) ? src[(size_t)(kt * 64 + kk) * N + n] : 0.f;
    tl[kk * 65 + nn] = v;
  }
  __syncthreads();
#pragma unroll 4
  for (int i = 0; i < 16; i++) {
    int idx = tid + 256 * i;
    int nn = idx >> 6, kk = idx & 63;
    dst[(size_t)(nt * 64 + nn) * 1024 + kt * 64 + kk] = f2bf(tl[kk * 65 + nn]);
  }
  __syncthreads();
}

__device__ __forceinline__ void wst_item(const P& p, int it, float* sm) {
  const int tid = threadIdx.x;
  int l = it >> 8, hp = (it >> 4) & 15, dt = it & 15;
  float* As = sm;
  float* Ks = sm + 64 * 33;
  const float* wq = p.peer_wq + (size_t)l * 1024 * 2048;
  const float* keys = p.peer_keys + ((size_t)l * 16 + hp) * 128 * 128;
  int d = tid & 63, cg_ = tid >> 6;
  float acc[32];
#pragma unroll
  for (int c = 0; c < 32; c++) acc[c] = 0.f;
  for (int jc = 0; jc < 4; jc++) {
    __syncthreads();
#pragma unroll
    for (int i = 0; i < 8; i++) {
      int idx = tid + 256 * i;
      int dd = idx >> 5, j = idx & 31;
      As[dd * 33 + j] = wq[(size_t)(dt * 64 + dd) * 2048 + hp * 128 + jc * 32 + j];
    }
#pragma unroll
    for (int i = 0; i < 16; i++) {
      int idx = tid + 256 * i;
      int k = idx >> 5, j = idx & 31;
      Ks[k * 33 + j] = keys[k * 128 + jc * 32 + j];
    }
    __syncthreads();
    for (int j = 0; j < 32; j++) {
      float a = As[d * 33 + j];
#pragma unroll
      for (int c = 0; c < 32; c++) acc[c] += a * Ks[(cg_ * 32 + c) * 33 + j];
    }
  }
  u16* dst = p.WsT + (size_t)l * 2048 * 1024;
#pragma unroll
  for (int c = 0; c < 32; c++) dst[(size_t)(hp * 128 + cg_ * 32 + c) * 1024 + dt * 64 + d] = f2bf(acc[c]);
  __syncthreads();
}

__device__ __forceinline__ void mod_item(const P& p, int it, float* sm) {
  const int tid = threadIdx.x;
  int l = it / 96, cc = it % 96;
  float* sc = sm;
  float* red = sm + 9216;
  for (int idx = tid; idx < 9216; idx += 256) {
    int r = idx >> 10, k = idx & 1023;
    float v = (r < 8) ? p.c[r * 1024 + k] : p.c_ctx[k];
    sc[idx] = siluf_(v);
  }
  __syncthreads();
  int cl = tid & 63, kg = tid >> 6;
  int col = cc * 64 + cl;
  float acc[9];
#pragma unroll
  for (int r = 0; r < 9; r++) acc[r] = 0.f;
  const float* wa = p.w_ada + (size_t)l * 1024 * 6144;
#pragma unroll 4
  for (int k = kg * 256; k < kg * 256 + 256; k++) {
    float w = wa[(size_t)k * 6144 + col];
#pragma unroll
    for (int r = 0; r < 9; r++) acc[r] += sc[r * 1024 + k] * w;
  }
#pragma unroll
  for (int r = 0; r < 9; r++) red[(kg * 9 + r) * 64 + cl] = acc[r];
  __syncthreads();
  if (kg == 0) {
    float bb = p.b_ada[l * 6144 + col];
#pragma unroll
    for (int r = 0; r < 9; r++) {
      float s = red[(0 * 9 + r) * 64 + cl] + red[(1 * 9 + r) * 64 + cl] + red[(2 * 9 + r) * 64 + cl] + red[(3 * 9 + r) * 64 + cl];
      p.mod[(size_t)(l * 9 + r) * 6144 + col] = s + bb;
    }
  }
  __syncthreads();
}

__device__ __forceinline__ void phase_prologue(const P& p, char* smem) {
  float* sm = (float*)smem;
  const int tid = threadIdx.x;
  const int N_A = 2 * 16 * 46, N_B = 2 * 16 * 16, N_C = 512, N_D = 192, N_E = 4096;
  const int total = N_A + N_B + N_C + N_D + N_E;
  for (int item = blockIdx.x; item < total; item += gridDim.x) {
    int it = item;
    if (it < N_A) {
      int l = it / (16 * 46), r = it % (16 * 46);
      transpose_item(p.w_in + (size_t)l * 1024 * INC, INC, p.WinT + (size_t)l * INC_PAD * 1024, r / 46, r % 46, sm);
      continue;
    }
    it -= N_A;
    if (it < N_B) {
      int l = it >> 8, r = it & 255;
      transpose_item(p.w_out + (size_t)l * 1024 * 1024, 1024, p.WoutT + (size_t)l * 1024 * 1024, r >> 4, r & 15, sm);
      continue;
    }
    it -= N_B;
    if (it < N_C) { wst_item(p, it, sm); continue; }
    it -= N_C;
    if (it < N_D) { mod_item(p, it, sm); continue; }
    it -= N_D;
    {
      int tab = it >> 11;
      int chunk = it & 2047;
      const float scl = tab ? 8.f : 64.f;
      const float4* src = (const float4*)(tab ? p.peer_v : p.peer_u) + (size_t)chunk * 4096;
      uint4* dst = (uint4*)(tab ? p.Vb : p.Ub) + (size_t)chunk * 1024;
#pragma unroll
      for (int i = 0; i < 4; i++) {
        int q = i * 256 + tid;
        float4 v0 = src[q * 4 + 0], v1 = src[q * 4 + 1], v2 = src[q * 4 + 2], v3 = src[q * 4 + 3];
        uint4 o;
        int w_;
        w_ = __builtin_amdgcn_cvt_pk_fp8_f32(v0.x * scl, v0.y * scl, 0, false);
        w_ = __builtin_amdgcn_cvt_pk_fp8_f32(v0.z * scl, v0.w * scl, w_, true);
        o.x = (unsigned)w_;
        w_ = __builtin_amdgcn_cvt_pk_fp8_f32(v1.x * scl, v1.y * scl, 0, false);
        w_ = __builtin_amdgcn_cvt_pk_fp8_f32(v1.z * scl, v1.w * scl, w_, true);
        o.y = (unsigned)w_;
        w_ = __builtin_amdgcn_cvt_pk_fp8_f32(v2.x * scl, v2.y * scl, 0, false);
        w_ = __builtin_amdgcn_cvt_pk_fp8_f32(v2.z * scl, v2.w * scl, w_, true);
        o.z = (unsigned)w_;
        w_ = __builtin_amdgcn_cvt_pk_fp8_f32(v3.x * scl, v3.y * scl, 0, false);
        w_ = __builtin_amdgcn_cvt_pk_fp8_f32(v3.z * scl, v3.w * scl, w_, true);
        o.w = (unsigned)w_;
        dst[q] = o;
      }
    }
  }
}

__device__ __forceinline__ void phase_norm(const P& p, int l, int which) {
  const int tid = threadIdx.x, lane = tid & 63, w = tid >> 6;
  const int nrows = (which == 2 && l == 1) ? ML_ROWS : MT_ROWS;
  const float* g = (which == 1 ? p.norm1_g : p.norm2_g) + l * 1024;
  for (int item = blockIdx.x; item * 4 < nrows; item += gridDim.x) {
    int row = item * 4 + w;
    const float* src;
    if (l == 0 && which == 1) src = row < ML_ROWS ? p.x + (size_t)row * 1024 : p.ctx + (size_t)(row - ML_ROWS) * 1024;
    else src = row < ML_ROWS ? p.out + (size_t)row * 1024 : p.hc + (size_t)(row - ML_ROWS) * 1024;
    int mr = row < ML_ROWS ? (row >> 11) : 8;
    const float* modp = p.mod + (size_t)(l * 9 + mr) * 6144;
    const float* sh = modp + (which == 1 ? 0 : 3072);
    const float* sc = modp + (which == 1 ? 1024 : 4096);
    float4 v[4];
    float ss = 0.f;
#pragma unroll
    for (int i = 0; i < 4; i++) {
      v[i] = ((const float4*)src)[i * 64 + lane];
      ss += v[i].x * v[i].x + v[i].y * v[i].y + v[i].z * v[i].z + v[i].w * v[i].w;
    }
    ss = wave_sum(ss);
    float rs = rsqrtf(ss * (1.f / 1024.f) + 1e-6f);
#pragma unroll
    for (int i = 0; i < 4; i++) {
      int d = (i * 64 + lane) * 4;
      float4 gg = *(const float4*)(g + d);
      float4 s4 = *(const float4*)(sc + d);
      float4 h4 = *(const float4*)(sh + d);
      float o0 = v[i].x * rs * gg.x * (1.f + s4.x) + h4.x;
      float o1 = v[i].y * rs * gg.y * (1.f + s4.y) + h4.y;
      float o2 = v[i].z * rs * gg.z * (1.f + s4.z) + h4.z;
      float o3 = v[i].w * rs * gg.w * (1.f + s4.w) + h4.w;
      uint2 o;
      o.x = pack2(o0, o1);
      o.y = pack2(o2, o3);
      ((uint2*)(p.xn + (size_t)row * 1024))[i * 64 + lane] = o;
    }
  }
}

template <int EPI>
__device__ __forceinline__ void phase_gemm(const P& p, int l, const u16* __restrict__ A, const u16* __restrict__ Bt, int mtiles, int ntiles,
                           char* smem) {
  u16* As = (u16*)smem;
  u16* Bs = As + 128 * 40;
  const int tid = threadIdx.x, lane = tid & 63, w = tid >> 6, wm = w >> 1, wn = w & 1;
  const int lr = lane & 15, quad = lane >> 4;
  const int nitems = mtiles * ntiles;
  for (int item = blockIdx.x; item < nitems; item += gridDim.x) {
    int mt = item / ntiles, nt = item - mt * ntiles;
    int m0 = mt * 128, n0 = nt * 128;
    f32x4 acc[4][4];
#pragma unroll
    for (int i = 0; i < 4; i++)
#pragma unroll
      for (int j = 0; j < 4; j++) acc[i][j] = (f32x4){0.f, 0.f, 0.f, 0.f};
    const int r0_ = tid >> 2, ch_ = tid & 3;
    const u16* Ap0 = A + (size_t)(m0 + r0_) * 1024 + ch_ * 8;
    const u16* Ap1 = Ap0 + (size_t)64 * 1024;
    const u16* Bp0 = Bt + (size_t)(n0 + r0_) * 1024 + ch_ * 8;
    const u16* Bp1 = Bp0 + (size_t)64 * 1024;
    uint4 ra0 = *(const uint4*)Ap0, ra1 = *(const uint4*)Ap1, rb0 = *(const uint4*)Bp0, rb1 = *(const uint4*)Bp1;
    for (int kt = 0; kt < 32; kt++) {
      __syncthreads();
      *(uint4*)(As + r0_ * 40 + ch_ * 8) = ra0;
      *(uint4*)(As + (r0_ + 64) * 40 + ch_ * 8) = ra1;
      *(uint4*)(Bs + r0_ * 40 + ch_ * 8) = rb0;
      *(uint4*)(Bs + (r0_ + 64) * 40 + ch_ * 8) = rb1;
      __syncthreads();
      if (kt < 31) {
        ra0 = *(const uint4*)(Ap0 + (kt + 1) * 32);
        ra1 = *(const uint4*)(Ap1 + (kt + 1) * 32);
        rb0 = *(const uint4*)(Bp0 + (kt + 1) * 32);
        rb1 = *(const uint4*)(Bp1 + (kt + 1) * 32);
      }
      bf16x8 a[4], b[4];
#pragma unroll
      for (int i = 0; i < 4; i++) {
        a[i] = *(const bf16x8*)(As + (wm * 64 + i * 16 + lr) * 40 + quad * 8);
        b[i] = *(const bf16x8*)(Bs + (wn * 64 + i * 16 + lr) * 40 + quad * 8);
      }
#pragma unroll
      for (int i = 0; i < 4; i++)
#pragma unroll
        for (int j = 0; j < 4; j++) acc[i][j] = __builtin_amdgcn_mfma_f32_16x16x32_bf16(a[i], b[j], acc[i][j], 0, 0, 0);
    }
#pragma unroll
    for (int i = 0; i < 4; i++)
#pragma unroll
      for (int j = 0; j < 4; j++)
#pragma unroll
        for (int r = 0; r < 4; r++) {
          int row = m0 + wm * 64 + i * 16 + quad * 4 + r;
          int col = n0 + wn * 64 + j * 16 + lr;
          float v = acc[i][j][r];
          if (EPI == 0) {
            if (col < INC) {
              p.U[(size_t)row * INC + col] = f2bf(v);
              if (col >= 2816) p.G[row * 16 + (col - 2816)] = v;
            }
          } else if (EPI == 1) {
            int mr = row < ML_ROWS ? (row >> 11) : 8;
            float g1 = p.mod[(size_t)(l * 9 + mr) * 6144 + 2048 + col];
            float sv;
            if (l == 0) sv = row < ML_ROWS ? p.x[(size_t)row * 1024 + col] : p.ctx[(size_t)(row - ML_ROWS) * 1024 + col];
            else sv = p.out[(size_t)row * 1024 + col];
            float* dst = row < ML_ROWS ? p.out + (size_t)row * 1024 + col : p.hc + (size_t)(row - ML_ROWS) * 1024 + col;
            *dst = sv + g1 * v;
          } else {
            p.S[(size_t)row * 2048 + col] = v;
          }
        }
  }
}

__device__ __forceinline__ void vt_item(const P& p, int it, u16* tl);
__device__ __forceinline__ void phase_mixprep(const P& p, int l, char* smem) {
  const int tid = threadIdx.x;
  float* pl = (float*)smem;
  const int N_QK = MT_ROWS * 16 / 256;
  const int N_POOL = (l == 0 ? MT_ROWS : ML_ROWS) / 16;
  const int N_PREP = MT_ROWS / 8;
  const int N_VT = 2304;
  const int total = N_QK + N_POOL + N_PREP + N_VT;
  for (int item = blockIdx.x; item < total; item += gridDim.x) {
    int it = item;
    if (it >= N_QK + N_POOL + N_PREP) { vt_item(p, it - (N_QK + N_POOL + N_PREP), (u16*)smem); continue; }
    if (it < N_QK) {
      int gi = it * 256 + tid;
      int row = gi >> 4, sub = gi & 15;
      int qk = sub >> 3, h = sub & 7;
      u16* ptr = p.U + (size_t)row * INC + qk * 512 + h * 64;
      const float* g = (qk ? p.na_k_g : p.na_q_g) + l * 64;
      uint4 v[8];
      float ss = 0.f;
#pragma unroll
      for (int c = 0; c < 8; c++) {
        v[c] = ((const uint4*)ptr)[c];
        float a;
        a = bflo(v[c].x); ss += a * a; a = bfhi(v[c].x); ss += a * a;
        a = bflo(v[c].y); ss += a * a; a = bfhi(v[c].y); ss += a * a;
        a = bflo(v[c].z); ss += a * a; a = bfhi(v[c].z); ss += a * a;
        a = bflo(v[c].w); ss += a * a; a = bfhi(v[c].w); ss += a * a;
      }
      float rs = rsqrtf(ss * (1.f / 64.f) + 1e-6f);
#pragma unroll
      for (int c = 0; c < 8; c++) {
        uint4 o;
        o.x = pack2(bflo(v[c].x) * rs * g[c * 8 + 0], bfhi(v[c].x) * rs * g[c * 8 + 1]);
        o.y = pack2(bflo(v[c].y) * rs * g[c * 8 + 2], bfhi(v[c].y) * rs * g[c * 8 + 3]);
        o.z = pack2(bflo(v[c].z) * rs * g[c * 8 + 4], bfhi(v[c].z) * rs * g[c * 8 + 5]);
        o.w = pack2(bflo(v[c].w) * rs * g[c * 8 + 6], bfhi(v[c].w) * rs * g[c * 8 + 7]);
        ((uint4*)ptr)[c] = o;
      }
      continue;
    }
    it -= N_QK;
    if (it < N_POOL) {
      int row0 = it * 16;
      int base, T;
      if (row0 < ML_ROWS) { base = (row0 >> 11) << 11; T = 2048; }
      else { base = ML_ROWS + (((row0 - ML_ROWS) >> 8) << 8); T = 256; }
      int t0 = row0 - base;
      int ch = tid, g = ch >> 6;
      int wdw = 2 << g;
      __syncthreads();
      for (int tt = 0; tt < 16; tt++) {
        int t = t0 + tt;
        int lo = max(t - wdw / 2, 0), hi = min(t + (wdw - wdw / 2 - 1), T - 1);
        float s = 0.f;
        for (int tau = lo; tau <= hi; tau++) s += bf2f(p.U[(size_t)(base + tau) * INC + 1536 + ch]);
        float self = bf2f(p.U[(size_t)(base + t) * INC + 1536 + ch]);
        pl[tt * 256 + ch] = s / (float)(hi - lo + 1) - self;
      }
      __syncthreads();
      float acc[16];
#pragma unroll
      for (int tt = 0; tt < 16; tt++) acc[tt] = 0.f;
      int d = ch & 63;
      const float* pw = p.pool_w + ((size_t)(l * 4 + g) * 64) * 64 + d;
      for (int c = 0; c < 64; c++) {
        float wv = pw[c * 64];
#pragma unroll
        for (int tt = 0; tt < 16; tt++) acc[tt] += pl[tt * 256 + g * 64 + c] * wv;
      }
      float ps = p.pool_scale[l * 256 + ch];
#pragma unroll
      for (int tt = 0; tt < 16; tt++) p.Y[(size_t)(row0 + tt) * 1024 + 512 + ch] = f2bf(acc[tt] * ps);
      continue;
    }
    it -= N_POOL;
    {
      const int row0 = it * 8;
      int base, T;
      if (row0 < ML_ROWS) { base = (row0 >> 11) << 11; T = 2048; }
      else { base = ML_ROWS + (((row0 - ML_ROWS) >> 8) << 8); T = 256; }
      const int t0 = row0 - base;
      const int qk = tid >> 7, hh = (tid >> 5) & 3, ax = (tid >> 4) & 1, f = tid & 15;
      const int ca = qk * 256 + hh * 64 + ax * 32 + f, cb = ca + 16;
      float ua[12], ub[12];
#pragma unroll
      for (int j = 0; j < 12; j++) {
        int tt = t0 + j - 2;
        bool ok = (tt >= 0) && (tt < T);
        const u16* ur = p.U + (size_t)(base + (ok ? tt : t0)) * INC + 1792;
        ua[j] = ok ? bf2f(ur[ca]) : 0.f;
        ub[j] = ok ? bf2f(ur[cb]) : 0.f;
      }
      float wa[5], wb[5];
#pragma unroll
      for (int j = 0; j < 5; j++) { wa[j] = p.ml_conv[(l * 5 + j) * 512 + ca]; wb[j] = p.ml_conv[(l * 5 + j) * 512 + cb]; }
      const float inv = __expf(-(float)f * (9.210340371976184f / 16.f));
#pragma unroll
      for (int i = 0; i < 8; i++) {
        float a = 0.f, b = 0.f;
#pragma unroll
        for (int j = 0; j < 5; j++) { a += wa[j] * ua[i + j]; b += wb[j] * ub[i + j]; }
        a = siluf_(a);
        b = siluf_(b);
        if (row0 < ML_ROWS) {
          int t = t0 + i;
          float pos = (float)(ax == 0 ? (t >> 6) : (t & 63));
          float ang = pos * inv;
          float cs = __cosf(ang), sn = __sinf(ang);
          float oa = a * cs - b * sn, ob = a * sn + b * cs;
          a = oa; b = ob;
        }
        if (qk) { a *= 0.125f; b *= 0.125f; }
        p.MQK[(size_t)(row0 + i) * 512 + ca] = a;
        p.MQK[(size_t)(row0 + i) * 512 + cb] = b;
      }
      if (tid < 128) {
        int gi = tid & 15;
        float gv = p.G[row0 * 16 + tid] + p.ml_gate_b[l * 16 + gi];
        if ((gi >> 2) & 1) gv = fminf(gv, 0.f) - log1pf(__expf(-fabsf(gv)));
        p.G[row0 * 16 + tid] = gv;
      }
    }
  }
}

#define VT_CTX_OFF ((size_t)8 * 8 * 64 * 2048)
__device__ __forceinline__ void vt_item(const P& p, int it, u16* tl) {
  const int tid = threadIdx.x;
  int b, h, tt, row0, TK;
  u16* dst;
  if (it < 2048) { b = it >> 8; h = (it >> 5) & 7; tt = it & 31; row0 = b * 2048 + tt * 64; TK = 2048; dst = p.VT + (size_t)((b * 8 + h) * 64) * 2048 + tt * 64; }
  else { int ci = it - 2048; b = ci >> 5; h = (ci >> 2) & 7; tt = ci & 3; row0 = ML_ROWS + b * 256 + tt * 64; TK = 256; dst = p.VT + VT_CTX_OFF + (size_t)((b * 8 + h) * 64) * 256 + tt * 64; }
  __syncthreads();
  {
    int i = tid >> 2, part = tid & 3;
    const uint4* src = (const uint4*)(p.U + (size_t)(row0 + i) * INC + 1024 + h * 64 + part * 16);
    uint4 v0 = src[0], v1 = src[1];
    unsigned* t32 = (unsigned*)(tl + i * 66 + part * 16);
    t32[0] = v0.x; t32[1] = v0.y; t32[2] = v0.z; t32[3] = v0.w;
    t32[4] = v1.x; t32[5] = v1.y; t32[6] = v1.z; t32[7] = v1.w;
  }
  __syncthreads();
  {
    int d = tid >> 2, part = tid & 3;
    unsigned o[8];
#pragma unroll
    for (int k = 0; k < 8; k++) {
      unsigned lo = tl[(part * 16 + 2 * k) * 66 + d], hi = tl[(part * 16 + 2 * k + 1) * 66 + d];
      o[k] = lo | (hi << 16);
    }
    uint4* dp = (uint4*)(dst + (size_t)d * TK + part * 16);
    dp[0] = make_uint4(o[0], o[1], o[2], o[3]);
    dp[1] = make_uint4(o[4], o[5], o[6], o[7]);
  }
}

__device__ __forceinline__ void attn_item(const P& p, int l, int item, float* sb) {
  const int tid = threadIdx.x, lane = tid & 63, w = tid >> 6, q = lane & 15, quad = lane >> 4;
  const bool latent = item < 2048;
  int b, r = 0, h, qb = 0;
  if (latent) { b = item >> 8; r = (item >> 3) & 31; h = item & 7; }
  else { int ci = item - 2048; b = ci >> 5; qb = (ci >> 3) & 3; h = ci & 7; }
  const int r0 = min(max(r - 4, 0), 24);
  __syncthreads();
  if (latent) {
    int kr = tid >> 5, j = tid & 31;
    if (j < 31) sb[tid] = p.na_rpb[(size_t)((l * 8 + h) * 15 + (r0 + kr - r + 7)) * 31 + j];
  }
  __syncthreads();
  const int qc = w * 16 + q;
  const int qrow = latent ? (b * 2048 + r * 64 + qc) : (ML_ROWS + b * 256 + qb * 64 + qc);
  const int cs = (w == 0) ? 0 : (w == 1) ? 8 : (w == 2) ? 24 : 32;
  const int c0 = min(max(qc - 8, 0), 48);
  const bf16x8 bq0 = *(const bf16x8*)(p.U + (size_t)qrow * INC + h * 64 + quad * 8);
  const bf16x8 bq1 = *(const bf16x8*)(p.U + (size_t)qrow * INC + h * 64 + 32 + quad * 8);
  const int mrow = (q >> 2) * 8 + (q & 3);
  const u16* vt_lat = p.VT + (size_t)((b * 8 + h) * 64 + q) * 2048 + quad * 8;
  const u16* vt_ctx = p.VT + VT_CTX_OFF + (size_t)((b * 8 + h) * 64 + q) * 256 + quad * 8;
  float m = -INFINITY, lsum = 0.f;
  f32x4 o[4];
#pragma unroll
  for (int dt = 0; dt < 4; dt++) o[dt] = (f32x4){0.f, 0.f, 0.f, 0.f};
#pragma unroll 1
  for (int chunk = (latent ? 0 : 2); chunk < 4; chunk++) {
    f32x4 s[4][2];
#pragma unroll
    for (int blk = 0; blk < 4; blk++) {
      int rowbase = (chunk < 2) ? (b * 2048 + (r0 + chunk * 4 + blk) * 64 + cs) : (ML_ROWS + b * 256 + (chunk - 2) * 128 + blk * 32);
#pragma unroll
      for (int T = 0; T < 2; T++) {
        const u16* kp = p.U + (size_t)(rowbase + mrow + T * 4) * INC + 512 + h * 64 + quad * 8;
        bf16x8 a0 = *(const bf16x8*)kp;
        bf16x8 a1 = *(const bf16x8*)(kp + 32);
        f32x4 acc = (f32x4){0.f, 0.f, 0.f, 0.f};
        acc = __builtin_amdgcn_mfma_f32_16x16x32_bf16(a0, bq0, acc, 0, 0, 0);
        acc = __builtin_amdgcn_mfma_f32_16x16x32_bf16(a1, bq1, acc, 0, 0, 0);
        s[blk][T] = acc;
      }
    }
    float mx = -INFINITY;
    if (chunk < 2) {
#pragma unroll
      for (int blk = 0; blk < 4; blk++)
#pragma unroll
        for (int T = 0; T < 2; T++)
#pragma unroll
          for (int rr = 0; rr < 4; rr++) {
            int kc = cs + quad * 8 + T * 4 + rr;
            bool valid = (kc >= c0) && (kc < c0 + 16);
            int bi = (chunk * 4 + blk) * 32 + min(max(kc - qc + 15, 0), 30);
            float v = valid ? (s[blk][T][rr] * 0.125f + sb[bi]) : -INFINITY;
            s[blk][T][rr] = v;
            mx = fmaxf(mx, v);
          }
    } else {
#pragma unroll
      for (int blk = 0; blk < 4; blk++)
#pragma unroll
        for (int T = 0; T < 2; T++)
#pragma unroll
          for (int rr = 0; rr < 4; rr++) {
            float v = s[blk][T][rr] * 0.125f;
            s[blk][T][rr] = v;
            mx = fmaxf(mx, v);
          }
    }
    mx = fmaxf(mx, __shfl_xor(mx, 16));
    mx = fmaxf(mx, __shfl_xor(mx, 32));
    float mn = fmaxf(m, mx);
    float sc = __expf(m - mn);
    lsum *= sc;
#pragma unroll
    for (int dt = 0; dt < 4; dt++) o[dt] *= sc;
    m = mn;
#pragma unroll
    for (int blk = 0; blk < 4; blk++) {
      float pv[8];
#pragma unroll
      for (int T = 0; T < 2; T++)
#pragma unroll
        for (int rr = 0; rr < 4; rr++) {
          float e = __expf(s[blk][T][rr] - mn);
          pv[T * 4 + rr] = e;
          lsum += e;
        }
      union { bf16x8 v; unsigned u[4]; } pk;
      pk.u[0] = pack2(pv[0], pv[1]); pk.u[1] = pack2(pv[2], pv[3]); pk.u[2] = pack2(pv[4], pv[5]); pk.u[3] = pack2(pv[6], pv[7]);
      const u16* vb = (chunk < 2) ? (vt_lat + (r0 + chunk * 4 + blk) * 64 + cs) : (vt_ctx + (chunk - 2) * 128 + blk * 32);
      const size_t dstr = (chunk < 2) ? (size_t)16 * 2048 : (size_t)16 * 256;
#pragma unroll
      for (int dt = 0; dt < 4; dt++) {
        bf16x8 av = *(const bf16x8*)(vb + dt * dstr);
        o[dt] = __builtin_amdgcn_mfma_f32_16x16x32_bf16(av, pk.v, o[dt], 0, 0, 0);
      }
    }
  }
  lsum += __shfl_xor(lsum, 16);
  lsum += __shfl_xor(lsum, 32);
  float il = 1.f / lsum;
#pragma unroll
  for (int dt = 0; dt < 4; dt++) {
    uint2 ov;
    ov.x = pack2(o[dt][0] * il, o[dt][1] * il);
    ov.y = pack2(o[dt][2] * il, o[dt][3] * il);
    *(uint2*)(p.Y + (size_t)qrow * 1024 + h * 64 + dt * 16 + quad * 4) = ov;
  }
}

__device__ __forceinline__ int ml_row(int b, int dir, int j, int pp) {
  if (j < 4) {
    int pos = j * 64 + pp;
    int t = dir ? 255 - pos : pos;
    return ML_ROWS + b * 256 + t;
  } else {
    int pos = (j - 4) * 64 + pp;
    int t = dir ? 2047 - pos : pos;
    return b * 2048 + t;
  }
}

__device__ __forceinline__ void mlstmA_item(const P& p, int it, float* sm) {
  const int tid = threadIdx.x;
  int seq = it / 36, j = it % 36;
  int b = seq >> 3, h = (seq >> 1) & 3, dir = seq & 1;
  float* ks = sm;
  float* vs = sm + 64 * 65;
  float* ic = sm + 2 * 64 * 65;
  float* fc = ic + 64;
  float* bb = fc + 64;
  float* wsm = bb + 64;
  float* scal = wsm + 64;
  __syncthreads();
  for (int idx = tid; idx < 4096; idx += 256) {
    int pp = idx >> 6, d = idx & 63;
    int row = ml_row(b, dir, j, pp);
    ks[pp * 65 + d] = p.MQK[(size_t)row * 512 + 256 + h * 64 + d];
    vs[pp * 65 + d] = bf2f(p.U[(size_t)row * INC + 2304 + h * 64 + d]);
  }
  if (tid < 64) {
    int row = ml_row(b, dir, j, tid);
    ic[tid] = p.G[row * 16 + (dir * 2) * 4 + h];
    fc[tid] = p.G[row * 16 + (dir * 2 + 1) * 4 + h];
  }
  __syncthreads();
  if (tid == 0) {
    float acc = 0.f;
    for (int pp = 0; pp < 64; pp++) { acc += fc[pp]; bb[pp] = acc; }
    float bl = acc, ml = -INFINITY;
    for (int pp = 0; pp < 64; pp++) ml = fmaxf(ml, bl - bb[pp] + ic[pp]);
    scal[0] = bl; scal[1] = ml;
  }
  __syncthreads();
  if (tid < 64) wsm[tid] = __expf(scal[0] - bb[tid] + ic[tid] - scal[1]);
  __syncthreads();
  float* slot = p.mst + (size_t)it * SLOT;
  {
    int e = tid & 63, dg = tid >> 6;
    float acc[16];
#pragma unroll
    for (int dd = 0; dd < 16; dd++) acc[dd] = 0.f;
    for (int pp = 0; pp < 64; pp++) {
      float wv = wsm[pp] * vs[pp * 65 + e];
#pragma unroll
      for (int dd = 0; dd < 16; dd++) acc[dd] += ks[pp * 65 + dg * 16 + dd] * wv;
    }
#pragma unroll
    for (int dd = 0; dd < 16; dd++) slot[(dg * 16 + dd) * 64 + e] = acc[dd];
  }
  if (tid < 64) {
    float a = 0.f;
    for (int pp = 0; pp < 64; pp++) a += wsm[pp] * ks[pp * 65 + tid];
    slot[4096 + tid] = a;
  }
  if (tid == 0) { slot[4160] = scal[0]; slot[4161] = scal[1]; }
}

#define ATT_SPLIT 768
__device__ __forceinline__ void phase_attn_mlA(const P& p, int l, char* smem) {
  const int N_MLA = 64 * 36;
  const int total = ATT_SPLIT + N_MLA;
  for (int item = blockIdx.x; item < total; item += gridDim.x) {
    if (item < N_MLA) mlstmA_item(p, item, (float*)smem);
    else attn_item(p, l, item - N_MLA, (float*)smem);
  }
}
__device__ __forceinline__ void mlB_item(const P& p, int item);
__device__ __forceinline__ void phase_attn_mlB(const P& p, int l, char* smem) {
  const int N_ATT = (l == 0 ? 2304 : 2048) - ATT_SPLIT;
  const int N_MLB = 64 * 17;
  const int total = N_ATT + N_MLB;
  for (int item = blockIdx.x; item < total; item += gridDim.x) {
    if (item < N_MLB) mlB_item(p, item);
    else attn_item(p, l, ATT_SPLIT + item - N_MLB, (float*)smem);
  }
}

__device__ __forceinline__ void mlB_item(const P& p, int item) {
  const int tid = threadIdx.x;
  int seq = item / 17, ech = item - seq * 17;
  int el = ech * 256 + tid;
  if (el >= 4160) return;
  float* base = p.mst + (size_t)(seq * 36) * SLOT;
  float loc[36], bl[36], ml[36];
#pragma unroll
  for (int j = 0; j < 36; j++) {
    loc[j] = base[(size_t)j * SLOT + el];
    bl[j] = base[(size_t)j * SLOT + 4160];
    ml[j] = base[(size_t)j * SLOT + 4161];
  }
  float m = 0.f, val = 0.f;
#pragma unroll
  for (int j = 0; j < 36; j++) {
    base[(size_t)j * SLOT + el] = val;
    if (el == 0) base[(size_t)j * SLOT + 4162] = m;
    float mn = fmaxf(bl[j] + m, ml[j]);
    val = __expf(bl[j] + m - mn) * val + __expf(ml[j] - mn) * loc[j];
    m = mn;
  }
}

__device__ __forceinline__ void phase_mlC(const P& p, int l, char* smem) {
  const int tid = threadIdx.x;
  float* qs = (float*)smem;
  float* kb = qs + 64 * 65;
  float* Ss = kb + 64 * 65;
  float* hs = Ss + 64 * 65;
  float* ic = hs + 64 * 65;
  float* fc = ic + 64;
  float* bb = fc + 64;
  float* mt = bb + 64;
  float* rsn = mt + 64;
  const int nch = (l == 0) ? 36 : 32;
  const int total = 32 * nch;
  for (int item = blockIdx.x; item < total; item += gridDim.x) {
    int bh = item / nch, c = item % nch + (l == 0 ? 0 : 4);
    int b = bh >> 2, h = bh & 3;
    for (int dir = 0; dir < 2; dir++) {
      int j = dir ? (c < 4 ? 3 - c : 4 + 31 - (c - 4)) : c;
      const float* slot = p.mst + (size_t)(((b * 4 + h) * 2 + dir) * 36 + j) * SLOT;
      float m0 = slot[4162];
      __syncthreads();
      for (int idx = tid; idx < 4096; idx += 256) {
        int pp = idx >> 6, d = idx & 63;
        int row = ml_row(b, dir, j, pp);
        qs[pp * 65 + d] = p.MQK[(size_t)row * 512 + h * 64 + d];
        kb[pp * 65 + d] = p.MQK[(size_t)row * 512 + 256 + h * 64 + d];
      }
      if (tid < 64) {
        int row = ml_row(b, dir, j, tid);
        ic[tid] = p.G[row * 16 + (dir * 2) * 4 + h];
        fc[tid] = p.G[row * 16 + (dir * 2 + 1) * 4 + h];
      }
      __syncthreads();
      if (tid == 0) {
        float acc = 0.f, pm = -INFINITY;
        for (int pp = 0; pp < 64; pp++) {
          acc += fc[pp];
          bb[pp] = acc;
          pm = fmaxf(pm, ic[pp] - acc);
          mt[pp] = fmaxf(acc + m0, acc + pm);
        }
      }
      __syncthreads();
      {
        int s = tid & 63, tg = tid >> 6;
        float acc[16];
#pragma unroll
        for (int tt = 0; tt < 16; tt++) acc[tt] = 0.f;
        for (int d = 0; d < 64; d++) {
          float kv = kb[s * 65 + d];
#pragma unroll
          for (int tt = 0; tt < 16; tt++) acc[tt] += qs[(tg * 16 + tt) * 65 + d] * kv;
        }
        float cs = ic[s] - bb[s];
#pragma unroll
        for (int tt = 0; tt < 16; tt++) {
          int t = tg * 16 + tt;
          float wv = (s <= t) ? acc[tt] * __expf(bb[t] + cs - mt[t]) : 0.f;
          Ss[t * 65 + s] = wv;
        }
      }
      __syncthreads();
      for (int idx = tid; idx < 4096; idx += 256) {
        int pp = idx >> 6, d = idx & 63;
        int row = ml_row(b, dir, j, pp);
        kb[pp * 65 + d] = bf2f(p.U[(size_t)row * INC + 2304 + h * 64 + d]);
      }
      __syncthreads();
      {
        int e = tid & 63, tg = tid >> 6;
        float a1[16], a2[16], ds[16], dq[16];
#pragma unroll
        for (int tt = 0; tt < 16; tt++) { a1[tt] = 0.f; a2[tt] = 0.f; ds[tt] = 0.f; dq[tt] = 0.f; }
        for (int s = 0; s < 64; s++) {
          float vv = kb[s * 65 + e];
#pragma unroll
          for (int tt = 0; tt < 16; tt++) {
            float wv = Ss[(tg * 16 + tt) * 65 + s];
            a1[tt] += wv * vv;
            ds[tt] += wv;
          }
        }
        for (int d = 0; d < 64; d++) {
          float cv = slot[d * 64 + e];
          float nv = slot[4096 + d];
#pragma unroll
          for (int tt = 0; tt < 16; tt++) {
            float qv = qs[(tg * 16 + tt) * 65 + d];
            a2[tt] += qv * cv;
            dq[tt] += qv * nv;
          }
        }
#pragma unroll
        for (int tt = 0; tt < 16; tt++) {
          int t = tg * 16 + tt;
          float wi = __expf(bb[t] + m0 - mt[t]);
          float num = a1[tt] + wi * a2[tt];
          float den = ds[tt] + wi * dq[tt];
          float hv = num / fmaxf(fabsf(den), __expf(-mt[t]));
          int to = dir ? 63 - t : t;
          if (dir == 0) hs[to * 65 + e] = hv;
          else hs[to * 65 + e] += hv;
        }
      }
    }
    __syncthreads();
    {
      int t = tid >> 2, part = tid & 3;
      float ss = 0.f;
#pragma unroll
      for (int i = 0; i < 16; i++) { float v = hs[t * 65 + part * 16 + i]; ss += v * v; }
      ss += __shfl_xor(ss, 1);
      ss += __shfl_xor(ss, 2);
      if (part == 0) rsn[t] = rsqrtf(ss * (1.f / 64.f) + 1e-6f);
    }
    __syncthreads();
    {
      int e = tid & 63, tg = tid >> 6;
      float ng = p.ml_norm_g[l * 256 + h * 64 + e];
#pragma unroll 4
      for (int tt = 0; tt < 16; tt++) {
        int t = tg * 16 + tt;
        int row = (c < 4) ? (ML_ROWS + b * 256 + c * 64 + t) : (b * 2048 + (c - 4) * 64 + t);
        float uo = bf2f(p.U[(size_t)row * INC + 2560 + h * 64 + e]);
        float v = hs[t * 65 + e] * rsn[t] * ng * sigmoidf_(uo);
        p.Y[(size_t)row * 1024 + 768 + h * 64 + e] = f2bf(v);
      }
    }
    __syncthreads();
  }
}

typedef __attribute__((ext_vector_type(2))) float f32x2;
__device__ __forceinline__ float gelu_tanh(float x) {
  float u = 0.7978845608028654f * (x + 0.044715f * x * x * x);
  float th = 1.f - 2.f / (1.f + __expf(2.f * u));
  return 0.5f * x * (1.f + th);
}
__device__ __forceinline__ float dot16_fp8(const f32x2* xr, uint4 v) {
  f32x2 s = __builtin_amdgcn_cvt_pk_f32_fp8((int)v.x, false) * xr[0];
  s += __builtin_amdgcn_cvt_pk_f32_fp8((int)v.x, true) * xr[1];
  s += __builtin_amdgcn_cvt_pk_f32_fp8((int)v.y, false) * xr[2];
  s += __builtin_amdgcn_cvt_pk_f32_fp8((int)v.y, true) * xr[3];
  s += __builtin_amdgcn_cvt_pk_f32_fp8((int)v.z, false) * xr[4];
  s += __builtin_amdgcn_cvt_pk_f32_fp8((int)v.z, true) * xr[5];
  s += __builtin_amdgcn_cvt_pk_f32_fp8((int)v.w, false) * xr[6];
  s += __builtin_amdgcn_cvt_pk_f32_fp8((int)v.w, true) * xr[7];
  return s.x + s.y;
}
__device__ __forceinline__ void axpy16_fp8(f32x2* acc, float a, uint4 v) {
  f32x2 av = (f32x2){a, a};
  acc[0] += av * __builtin_amdgcn_cvt_pk_f32_fp8((int)v.x, false);
  acc[1] += av * __builtin_amdgcn_cvt_pk_f32_fp8((int)v.x, true);
  acc[2] += av * __builtin_amdgcn_cvt_pk_f32_fp8((int)v.y, false);
  acc[3] += av * __builtin_amdgcn_cvt_pk_f32_fp8((int)v.y, true);
  acc[4] += av * __builtin_amdgcn_cvt_pk_f32_fp8((int)v.z, false);
  acc[5] += av * __builtin_amdgcn_cvt_pk_f32_fp8((int)v.z, true);
  acc[6] += av * __builtin_amdgcn_cvt_pk_f32_fp8((int)v.w, false);
  acc[7] += av * __builtin_amdgcn_cvt_pk_f32_fp8((int)v.w, true);
}

__device__ __forceinline__ unsigned fkey(float f) {
  unsigned u = __float_as_uint(f);
  return (u & 0x80000000u) ? ~u : (u | 0x80000000u);
}
__device__ __forceinline__ int mbcnt64(unsigned long long m) {
  return __builtin_amdgcn_mbcnt_hi((unsigned)(m >> 32), __builtin_amdgcn_mbcnt_lo((unsigned)m, 0));
}
#define WAVE_LDS_FENCE() do { __builtin_amdgcn_fence(__ATOMIC_RELEASE, "wavefront"); __builtin_amdgcn_wave_barrier(); __builtin_amdgcn_fence(__ATOMIC_ACQUIRE, "wavefront"); } while (0)

__device__ __forceinline__ void phase_peer(const P& p, int l, char* smem) {
  const int tid = threadIdx.x, lane = tid & 63, w = tid >> 6;
  float* wl = (float*)smem + w * 512;
  float* cs = wl;
  int* ci = (int*)(wl + 32);
  int* el = (int*)(wl + 64);
  float* sl = wl + 192;
  float* as = wl + 320;
  const int nrows = (l == 1) ? ML_ROWS : MT_ROWS;
  const unsigned char* Ub = (const unsigned char*)p.Ub + (size_t)l * 16384 * 1024;
  const unsigned char* Vb = (const unsigned char*)p.Vb + (size_t)l * 16384 * 1024;
  const bool hi5 = (lane & 32) != 0, hi4 = (lane & 16) != 0, hi3 = (lane & 8) != 0, hi2 = (lane & 4) != 0;
  const int nw = gridDim.x * 4;
  for (int row = blockIdx.x * 4 + w; row < nrows; row += nw) {
    float na0, na1, nb0, nb1;
    {
      const float* sp0 = p.S + (size_t)row * 2048;
      na0 = sp0[lane]; na1 = sp0[64 + lane]; nb0 = sp0[128 + lane]; nb1 = sp0[192 + lane];
    }
#pragma unroll 1
    for (int h = 0; h < 8; h++) {
      float a0 = na0, a1 = na1, b0 = nb0, b1 = nb1;
      {
        const float* spn = p.S + (size_t)row * 2048 + ((h + 1) & 7) * 256;
        na0 = spn[lane]; na1 = spn[64 + lane]; nb0 = spn[128 + lane]; nb1 = spn[192 + lane];
      }
      unsigned kA0 = fkey(a0), kA1 = fkey(a1), kB0 = fkey(b0), kB1 = fkey(b1);
      unsigned pA = 0, pB = 0;
      bool dA = false, dB = false;
#pragma unroll 1
      for (int bit = 31; bit >= 0; --bit) {
        unsigned cA = pA | (1u << bit), cB = pB | (1u << bit);
        int nA = __popcll(__ballot(kA0 >= cA)) + __popcll(__ballot(kA1 >= cA));
        int nB = __popcll(__ballot(kB0 >= cB)) + __popcll(__ballot(kB1 >= cB));
        if (!dA && nA >= 16) { pA = cA; dA = (nA == 16); }
        if (!dB && nB >= 16) { pB = cB; dB = (nB == 16); }
        if (dA && dB) break;
      }
      {
        unsigned long long m0 = __ballot(kA0 >= pA), m1 = __ballot(kA1 >= pA);
        int p0 = mbcnt64(m0), p1 = __popcll(m0) + mbcnt64(m1);
        if (kA0 >= pA && p0 < 16) { cs[p0] = a0; ci[p0] = lane; }
        if (kA1 >= pA && p1 < 16) { cs[p1] = a1; ci[p1] = lane + 64; }
        m0 = __ballot(kB0 >= pB); m1 = __ballot(kB1 >= pB);
        p0 = mbcnt64(m0); p1 = __popcll(m0) + mbcnt64(m1);
        if (kB0 >= pB && p0 < 16) { cs[16 + p0] = b0; ci[16 + p0] = lane; }
        if (kB1 >= pB && p1 < 16) { cs[16 + p1] = b1; ci[16 + p1] = lane + 64; }
      }
      WAVE_LDS_FENCE();
      const int ii = lane >> 2, jb = (lane & 3) * 4;
      float s1 = cs[ii];
      float c0 = s1 + cs[16 + jb + 0], c1 = s1 + cs[16 + jb + 1], c2 = s1 + cs[16 + jb + 2], c3 = s1 + cs[16 + jb + 3];
      int e1 = ci[ii] * 128;
      int f0 = e1 + ci[16 + jb + 0], f1 = e1 + ci[16 + jb + 1], f2 = e1 + ci[16 + jb + 2], f3 = e1 + ci[16 + jb + 3];
      unsigned k0 = fkey(c0), k1 = fkey(c1), k2 = fkey(c2), k3 = fkey(c3);
      unsigned pC = 0;
#pragma unroll 1
      for (int bit = 31; bit >= 0; --bit) {
        unsigned cC = pC | (1u << bit);
        int n = __popcll(__ballot(k0 >= cC)) + __popcll(__ballot(k1 >= cC)) + __popcll(__ballot(k2 >= cC)) + __popcll(__ballot(k3 >= cC));
        if (n >= 16) { pC = cC; if (n == 16) break; }
      }
      {
        unsigned long long m0 = __ballot(k0 >= pC), m1 = __ballot(k1 >= pC), m2 = __ballot(k2 >= pC), m3 = __ballot(k3 >= pC);
        int q0 = mbcnt64(m0);
        int q1 = __popcll(m0) + mbcnt64(m1);
        int q2 = __popcll(m0) + __popcll(m1) + mbcnt64(m2);
        int q3 = __popcll(m0) + __popcll(m1) + __popcll(m2) + mbcnt64(m3);
        if (k0 >= pC && q0 < 16) { el[h * 16 + q0] = f0; sl[h * 16 + q0] = c0; }
        if (k1 >= pC && q1 < 16) { el[h * 16 + q1] = f1; sl[h * 16 + q1] = c1; }
        if (k2 >= pC && q2 < 16) { el[h * 16 + q2] = f2; sl[h * 16 + q2] = c2; }
        if (k3 >= pC && q3 < 16) { el[h * 16 + q3] = f3; sl[h * 16 + q3] = c3; }
      }
      WAVE_LDS_FENCE();
    }
    {
      float v0 = sl[lane], v1 = sl[64 + lane];
      float m0 = v0, m1 = v1;
#pragma unroll
      for (int o = 1; o < 16; o <<= 1) { m0 = fmaxf(m0, __shfl_xor(m0, o)); m1 = fmaxf(m1, __shfl_xor(m1, o)); }
      float e0 = __expf(v0 - m0), e1 = __expf(v1 - m1);
      float s0 = e0, s1 = e1;
#pragma unroll
      for (int o = 1; o < 16; o <<= 1) { s0 += __shfl_xor(s0, o); s1 += __shfl_xor(s1, o); }
      sl[lane] = e0 / s0;
      sl[64 + lane] = e1 / s1;
    }
    f32x2 xr[8];
    {
      const uint4* xp = (const uint4*)(p.xn + (size_t)row * 1024 + lane * 16);
#pragma unroll
      for (int c = 0; c < 2; c++) {
        uint4 v = xp[c];
        xr[c * 4 + 0] = (f32x2){bflo(v.x), bfhi(v.x)}; xr[c * 4 + 1] = (f32x2){bflo(v.y), bfhi(v.y)};
        xr[c * 4 + 2] = (f32x2){bflo(v.z), bfhi(v.z)}; xr[c * 4 + 3] = (f32x2){bflo(v.w), bfhi(v.w)};
      }
    }
    WAVE_LDS_FENCE();
    uint4 cur[8];
#pragma unroll
    for (int i = 0; i < 8; i++) cur[i] = *(const uint4*)(Ub + (size_t)el[i] * 1024 + lane * 16);
#pragma unroll 1
    for (int bt = 0; bt < 16; bt++) {
      uint4 nxt[8];
      {
        const unsigned char* tb = (bt < 15) ? Ub : Vb;
        const int nb = ((bt + 1) & 15) * 8;
#pragma unroll
        for (int i = 0; i < 8; i++) nxt[i] = *(const uint4*)(tb + (size_t)el[nb + i] * 1024 + lane * 16);
      }
      float d0 = dot16_fp8(xr, cur[0]), d1 = dot16_fp8(xr, cur[1]), d2 = dot16_fp8(xr, cur[2]), d3 = dot16_fp8(xr, cur[3]);
      float d4 = dot16_fp8(xr, cur[4]), d5 = dot16_fp8(xr, cur[5]), d6 = dot16_fp8(xr, cur[6]), d7 = dot16_fp8(xr, cur[7]);
      float k0 = (hi5 ? d4 : d0) + __shfl_xor(hi5 ? d0 : d4, 32);
      float k1 = (hi5 ? d5 : d1) + __shfl_xor(hi5 ? d1 : d5, 32);
      float k2 = (hi5 ? d6 : d2) + __shfl_xor(hi5 ? d2 : d6, 32);
      float k3 = (hi5 ? d7 : d3) + __shfl_xor(hi5 ? d3 : d7, 32);
      float j0 = (hi4 ? k2 : k0) + __shfl_xor(hi4 ? k0 : k2, 16);
      float j1 = (hi4 ? k3 : k1) + __shfl_xor(hi4 ? k1 : k3, 16);
      float i0 = (hi3 ? j1 : j0) + __shfl_xor(hi3 ? j0 : j1, 8);
      i0 += __shfl_xor(i0, 4);
      i0 += __shfl_xor(i0, 2);
      i0 += __shfl_xor(i0, 1);
      if ((lane & 7) == 0) {
        int k = bt * 8 + (lane >> 3);
        as[k] = gelu_tanh(i0 * (1.f / 64.f)) * sl[k];
      }
#pragma unroll
      for (int i = 0; i < 8; i++) cur[i] = nxt[i];
    }
    WAVE_LDS_FENCE();
    f32x2 acc[8];
#pragma unroll
    for (int i = 0; i < 8; i++) acc[i] = (f32x2){0.f, 0.f};
#pragma unroll 1
    for (int bt = 0; bt < 16; bt++) {
      uint4 nxt[8];
      if (bt < 15) {
#pragma unroll
        for (int i = 0; i < 8; i++) nxt[i] = *(const uint4*)(Vb + (size_t)el[(bt + 1) * 8 + i] * 1024 + lane * 16);
      }
#pragma unroll
      for (int i = 0; i < 8; i++) axpy16_fp8(acc, as[bt * 8 + i], cur[i]);
      if (bt < 15) {
#pragma unroll
        for (int i = 0; i < 8; i++) cur[i] = nxt[i];
      }
    }
    {
      int mr = row < ML_ROWS ? (row >> 11) : 8;
      const float4* g2p = (const float4*)(p.mod + (size_t)(l * 9 + mr) * 6144 + 5120 + lane * 16);
      float4* dst = (float4*)(row < ML_ROWS ? p.out + (size_t)row * 1024 + lane * 16 : p.hc + (size_t)(row - ML_ROWS) * 1024 + lane * 16);
#pragma unroll
      for (int i = 0; i < 4; i++) {
        float4 g2 = g2p[i];
        float4 cur = dst[i];
        cur.x += g2.x * 0.125f * acc[i * 2 + 0].x;
        cur.y += g2.y * 0.125f * acc[i * 2 + 0].y;
        cur.z += g2.z * 0.125f * acc[i * 2 + 1].x;
        cur.w += g2.w * 0.125f * acc[i * 2 + 1].y;
        dst[i] = cur;
      }
    }
    WAVE_LDS_FENCE();
  }
}

#define RUN(k, call)                         \
  if (lo <= (k) && (k) < hi) {               \
    call;                                    \
    if ((k) + 1 < hi) { if ((k) == 0) grid.sync(); else xcd_barrier(xb); } \
  }
#define LAYER(l, base)                                                                                                    \
  RUN(base + 0, phase_norm(p, l, 1))                                                                                     \
  RUN(base + 1, phase_gemm<0>(p, l, p.xn, p.WinT + (size_t)l * INC_PAD * 1024, MT_ROWS / 128, INC_PAD / 128, smem))     \
  RUN(base + 2, phase_mixprep(p, l, smem))                                                                               \
  RUN(base + 3, phase_attn_mlA(p, l, smem))                                                                              \
  RUN(base + 4, phase_attn_mlB(p, l, smem))                                                                                            \
  RUN(base + 5, phase_mlC(p, l, smem))                                                                                   \
  RUN(base + 6, phase_gemm<1>(p, l, p.Y, p.WoutT + (size_t)l * 1024 * 1024, (l == 0 ? MT_ROWS : ML_ROWS) / 128, 8, smem)) \
  RUN(base + 7, phase_norm(p, l, 2))                                                                                     \
  RUN(base + 8, phase_gemm<2>(p, l, p.xn, p.WsT + (size_t)l * 2048 * 1024, (l == 0 ? MT_ROWS : ML_ROWS) / 128, 16, smem)) \
  RUN(base + 9, phase_peer(p, l, smem))

__global__ void __launch_bounds__(256, 2) fwd_kernel(P p) {
  __shared__ __attribute__((aligned(16))) char smem[SMEM_BYTES];
  __shared__ uint4 xb_words;
  cg::grid_group grid = cg::this_grid();
  const int lo = (int)p.ph_lo, hi = (int)p.ph_hi;
  if (threadIdx.x == 0) xb_words = make_uint4(0u, 0u, 0u, 0u);
  __syncthreads();
  XcdBarrier xb = xcd_barrier_post(p.bar, (volatile LAS unsigned*)&xb_words);
  RUN(0, phase_prologue(p, smem))
  LAYER(0, 1)
  LAYER(1, 11)
}

extern "C" void kernel_launch(void* const* d_in, const int* in_sizes, int n_in, void* d_out, int out_size, void* d_ws,
                              size_t ws_size, hipStream_t stream) {
  static int grid_blocks = 0;
  if (!grid_blocks) {
    int dev = 0, cus = 0, per_cu = 0;
    hipGetDevice(&dev);
    hipDeviceGetAttribute(&cus, hipDeviceAttributeMultiprocessorCount, dev);
    hipOccupancyMaxActiveBlocksPerMultiprocessor(&per_cu, fwd_kernel, 256, 0);
    if (per_cu < 1) per_cu = 1;
    if (per_cu > 2) per_cu = 2;
    grid_blocks = cus * per_cu;
  }
  P p{};
  const float** ins = (const float**)&p;
  for (int i = 0; i < 22; i++) ins[i] = (const float*)d_in[i];
  p.out = (float*)d_out;
  char* ws = (char*)d_ws;
  size_t off = 0;
  auto take = [&](size_t bytes) { char* r = ws + off; off += (bytes + 255) & ~(size_t)255; return r; };
  p.WinT = (u16*)take((size_t)2 * INC_PAD * 1024 * 2);
  p.WoutT = (u16*)take((size_t)2 * 1024 * 1024 * 2);
  p.WsT = (u16*)take((size_t)2 * 2048 * 1024 * 2);
  p.Ub = (u16*)take((size_t)2 * 16384 * 1024 * 2);
  p.Vb = (u16*)take((size_t)2 * 16384 * 1024 * 2);
  p.mod = (float*)take((size_t)2 * 9 * 6144 * 4);
  p.xn = (u16*)take((size_t)MT_ROWS * 1024 * 2);
  p.U = (u16*)take((size_t)MT_ROWS * INC * 2);
  p.MQK = (float*)take((size_t)MT_ROWS * 512 * 4);
  p.Y = (u16*)take((size_t)MT_ROWS * 1024 * 2);
  p.S = (float*)p.U;
  p.G = (float*)take((size_t)MT_ROWS * 16 * 4);
  p.mst = (float*)take((size_t)2304 * SLOT * 4);
  p.hc = (float*)take((size_t)MC_ROWS * 1024 * 4);
  p.bar = (unsigned*)take((size_t)XCD_BAR_WORDS * 4);
  p.VT = (u16*)take((size_t)(8 * 8 * 64) * (2048 + 256) * 2);
  if (off > ws_size) { fprintf(stderr, "workspace too small: need %zu have %zu\n", off, ws_size); return; }
  (void)hipMemsetAsync(p.bar, 0, (size_t)XCD_BAR_WORDS * 4, stream);
#if MEGA
  p.ph_lo = 0; p.ph_hi = NPHASES;
  void* args[] = {&p};
  hipError_t e = hipLaunchCooperativeKernel((void*)fwd_kernel, dim3(grid_blocks), dim3(256), args, 0, stream);
  if (e != hipSuccess) fprintf(stderr, "cooperative launch failed: %s (grid %d)\n", hipGetErrorString(e), grid_blocks);
#else
  for (int ph = 0; ph < NPHASES; ph++) {
    p.ph_lo = ph; p.ph_hi = ph + 1;
    void* args[] = {&p};
    hipError_t e = hipLaunchCooperativeKernel((void*)fwd_kernel, dim3(grid_blocks), dim3(256), args, 0, stream);
    if (e != hipSuccess) fprintf(stderr, "cooperative launch failed: %s (grid %d)\n", hipGetErrorString(e), grid_blocks);
  }
#endif
}
```

```cpp
#include <hip/hip_runtime.h>
#include <hip/hip_cooperative_groups.h>
#include <cstdio>
namespace cg = cooperative_groups;

#ifndef MEGA
#define MEGA 1
#endif

typedef unsigned short u16;
typedef __attribute__((ext_vector_type(8))) short bf16x8;
typedef __attribute__((ext_vector_type(4))) float f32x4;

#define ML_ROWS 16384
#define MC_ROWS 2048
#define MT_ROWS 18432
#define INC 2832
#define INC_PAD 2944
#define SLOT 4480
#define SMEM_BYTES 69632
#define NPHASES 21

struct P {
  const float *x, *c, *ctx, *c_ctx, *w_ada, *b_ada, *norm1_g, *w_in, *ml_gate_b, *na_q_g, *na_k_g, *na_rpb,
      *pool_w, *pool_scale, *ml_conv, *ml_norm_g, *w_out, *norm2_g, *peer_wq, *peer_keys, *peer_u, *peer_v;
  float* out;
  u16 *WinT, *WoutT, *WsT, *Ub, *Vb;
  float* mod;
  u16* xn;
  u16* U;
  float* MQK;
  u16* Y;
  float* S;
  float* G;
  float* mst;
  float* hc;
  u16* VT;
  u16* VTm;
  unsigned* bar;
  long long ph_lo, ph_hi;
};

__device__ __forceinline__ u16 f2bf(float f) {
  unsigned u = __float_as_uint(f);
  u += 0x7fffu + ((u >> 16) & 1u);
  return (u16)(u >> 16);
}
__device__ __forceinline__ float bf2f(u16 h) { return __uint_as_float(((unsigned)h) << 16); }
__device__ __forceinline__ float bflo(unsigned u) { return __uint_as_float(u << 16); }
__device__ __forceinline__ float bfhi(unsigned u) { return __uint_as_float(u & 0xffff0000u); }
__device__ __forceinline__ unsigned pack2(float a, float b) { return (unsigned)f2bf(a) | ((unsigned)f2bf(b) << 16); }
__device__ __forceinline__ float wave_sum(float v) {
#pragma unroll
  for (int o = 32; o; o >>= 1) v += __shfl_xor(v, o);
  return v;
}
__device__ __forceinline__ void wave_argmax(float& v, int& i) {
#pragma unroll
  for (int o = 32; o; o >>= 1) {
    float ov = __shfl_xor(v, o);
    int oi = __shfl_xor(i, o);
    if (ov > v || (ov == v && oi < i)) { v = ov; i = oi; }
  }
}
__device__ __forceinline__ float sigmoidf_(float x) { return 1.f / (1.f + __expf(-x)); }
__device__ __forceinline__ float siluf_(float x) { return x / (1.f + __expf(-x)); }

#define XB_TMO      128
#define XB_XCNT(j)  (256  + 64 * (j))
#define XB_XSUB(j)  (1280 + 64 * (j))
#define XB_XGEN(j)  (2304 + 64 * (j))
#define XB_TOP      3328
#define XB_TOPGEN   3392
#define XCD_BAR_WORDS 3456
#define XB_SPIN_CAP (1u << 18)
#define LAS __attribute__((address_space(3)))
__device__ __forceinline__ unsigned xb_ld(unsigned* p)              { return __hip_atomic_load(p, __ATOMIC_RELAXED, __HIP_MEMORY_SCOPE_AGENT); }
__device__ __forceinline__ unsigned xb_add(unsigned* p, unsigned v) { return __hip_atomic_fetch_add(p, v, __ATOMIC_RELAXED, __HIP_MEMORY_SCOPE_AGENT); }
__device__ __forceinline__ unsigned xb_xcc_id() { return (unsigned)__builtin_amdgcn_s_getreg((3 << 11) | 20) & 0xFu; }
#define XB_SPIN(cond, bar) do { unsigned _sp = 0; while (cond) { __builtin_amdgcn_s_sleep(1); \
    if ((++_sp & 255u) == 0u) { if (xb_ld(&(bar)[XB_TMO])) break; if (_sp > XB_SPIN_CAP) { atomicAdd(&(bar)[XB_TMO], 1u); break; } } } } while (0)
struct XcdBarrier { unsigned* bar; unsigned x; volatile LAS unsigned* st; };
__device__ __forceinline__ XcdBarrier xcd_barrier_post(unsigned* bar, volatile LAS unsigned* st) {
    XcdBarrier b; b.bar = bar; b.x = xb_xcc_id(); b.st = st;
    if (threadIdx.x == 0) (void)xb_add(&bar[XB_XCNT(b.x)], 1u);
    return b;
}
__device__ __forceinline__ void xcd_barrier_complete(unsigned* bar, unsigned x, unsigned& nloc, unsigned& nx) {
    const unsigned G = gridDim.x * gridDim.y * gridDim.z;
    unsigned sum, cnt, mine, sp = 0u;
    for (;;) {
        sum = 0u; cnt = 0u; mine = 0u;
#pragma unroll
        for (unsigned j = 0; j < 16; ++j) { const unsigned c = xb_ld(&bar[XB_XCNT(j)]); sum += c; cnt += (c > 0u) ? 1u : 0u; mine = (j == x) ? c : mine; }
        if (sum == G) break;
        __builtin_amdgcn_s_sleep(1);
        if ((++sp & 255u) == 0u) { if (xb_ld(&bar[XB_TMO])) break; if (sp > XB_SPIN_CAP) { atomicAdd(&bar[XB_TMO], 1u); break; } }
    }
    nloc = mine > 0u ? mine : 1u; nx = cnt > 0u ? cnt : 1u;
}
__device__ __forceinline__ void xcd_barrier(const XcdBarrier& b) {
    asm volatile("s_waitcnt vmcnt(0)" ::: "memory");
    __syncthreads();
    if (threadIdx.x == 0) {
        unsigned* bar = b.bar;
        __builtin_amdgcn_s_waitcnt(0);
        unsigned nloc = b.st[0], nx = b.st[1];
        if (nloc == 0u) { xcd_barrier_complete(bar, b.x, nloc, nx); b.st[0] = nloc; b.st[1] = nx; }
        const unsigned old = xb_add(&bar[XB_XSUB(b.x)], 1u);
        const unsigned gen = old / nloc;
        if (old + 1u == (gen + 1u) * nloc) {
            __builtin_amdgcn_fence(__ATOMIC_RELEASE, "agent");
            asm volatile("s_waitcnt vmcnt(0)" ::: "memory");
            const unsigned og = xb_add(&bar[XB_TOP], 1u);
            const unsigned tg = og / nx;
            if (og + 1u == (tg + 1u) * nx) xb_add(&bar[XB_TOPGEN], 1u);
            else XB_SPIN(xb_ld(&bar[XB_TOPGEN]) == tg, bar);
            __builtin_amdgcn_fence(__ATOMIC_ACQUIRE, "agent");
            xb_add(&bar[XB_XGEN(b.x)], 1u);
            asm volatile("s_waitcnt vmcnt(0)" ::: "memory");
        } else {
            XB_SPIN(xb_ld(&bar[XB_XGEN(b.x)]) == gen, bar);
            __builtin_amdgcn_fence(__ATOMIC_ACQUIRE, "agent");
            asm volatile("s_waitcnt vmcnt(0)" ::: "memory");
        }
    }
    __syncthreads();
}

__device__ __forceinline__ void transpose_item(const float* __restrict__ src, int N, u16* __restrict__ dst, int kt, int nt, float* tl) {
  const int tid = threadIdx.x;
#pragma unroll 4
  for (int i = 0; i < 16; i++) {
    int idx = tid + 256 * i;
    int kk = idx >> 6, nn = idx & 63;
    int n = nt * 64 + nn;
    float v = (n < N) ? src[(size_t)(kt * 64 + kk) * N + n] : 0.f;
    tl[kk * 65 + nn] = v;
  }
  __syncthreads();
#pragma unroll 4
  for (int i = 0; i < 16; i++) {
    int idx = tid + 256 * i;
    int nn = idx >> 6, kk = idx & 63;
    dst[(size_t)(nt * 64 + nn) * 1024 + kt * 64 + kk] = f2bf(tl[kk * 65 + nn]);
  }
  __syncthreads();
}

__device__ __forceinline__ void wst_item(const P& p, int it, float* sm) {
  const int tid = threadIdx.x;
  int l = it >> 8, hp = (it >> 4) & 15, dt = it & 15;
  float* As = sm;
  float* Ks = sm + 64 * 33;
  const float* wq = p.peer_wq + (size_t)l * 1024 * 2048;
  const float* keys = p.peer_keys + ((size_t)l * 16 + hp) * 128 * 128;
  int d = tid & 63, cg_ = tid >> 6;
  float acc[32];
#pragma unroll
  for (int c = 0; c < 32; c++) acc[c] = 0.f;
  for (int jc = 0; jc < 4; jc++) {
    __syncthreads();
#pragma unroll
    for (int i = 0; i < 8; i++) {
      int idx = tid + 256 * i;
      int dd = idx >> 5, j = idx & 31;
      As[dd * 33 + j] = wq[(size_t)(dt * 64 + dd) * 2048 + hp * 128 + jc * 32 + j];
    }
#pragma unroll
    for (int i = 0; i < 16; i++) {
      int idx = tid + 256 * i;
      int k = idx >> 5, j = idx & 31;
      Ks[k * 33 + j] = keys[k * 128 + jc * 32 + j];
    }
    __syncthreads();
    for (int j = 0; j < 32; j++) {
      float a = As[d * 33 + j];
#pragma unroll
      for (int c = 0; c < 32; c++) acc[c] += a * Ks[(cg_ * 32 + c) * 33 + j];
    }
  }
  u16* dst = p.WsT + (size_t)l * 2048 * 1024;
#pragma unroll
  for (int c = 0; c < 32; c++) dst[(size_t)(hp * 128 + cg_ * 32 + c) * 1024 + dt * 64 + d] = f2bf(acc[c]);
  __syncthreads();
}

__device__ __forceinline__ void mod_item(const P& p, int it, float* sm) {
  const int tid = threadIdx.x;
  int l = it / 96, cc = it % 96;
  float* sc = sm;
  float* red = sm + 9216;
  for (int idx = tid; idx < 9216; idx += 256) {
    int r = idx >> 10, k = idx & 1023;
    float v = (r < 8) ? p.c[r * 1024 + k] : p.c_ctx[k];
    sc[idx] = siluf_(v);
  }
  __syncthreads();
  int cl = tid & 63, kg = tid >> 6;
  int col = cc * 64 + cl;
  float acc[9];
#pragma unroll
  for (int r = 0; r < 9; r++) acc[r] = 0.f;
  const float* wa = p.w_ada + (size_t)l * 1024 * 6144;
#pragma unroll 16
  for (int k = kg * 256; k < kg * 256 + 256; k++) {
    float w = wa[(size_t)k * 6144 + col];
#pragma unroll
    for (int r = 0; r < 9; r++) acc[r] += sc[r * 1024 + k] * w;
  }
#pragma unroll
  for (int r = 0; r < 9; r++) red[(kg * 9 + r) * 64 + cl] = acc[r];
  __syncthreads();
  if (kg == 0) {
    float bb = p.b_ada[l * 6144 + col];
#pragma unroll
    for (int r = 0; r < 9; r++) {
      float s = red[(0 * 9 + r) * 64 + cl] + red[(1 * 9 + r) * 64 + cl] + red[(2 * 9 + r) * 64 + cl] + red[(3 * 9 + r) * 64 + cl];
      p.mod[(size_t)(l * 9 + r) * 6144 + col] = s + bb;
    }
  }
  __syncthreads();
}

__device__ __forceinline__ void phase_prologue(const P& p, char* smem) {
  float* sm = (float*)smem;
  const int tid = threadIdx.x;
  const int N_A = 2 * 16 * 46, N_B = 2 * 16 * 16, N_C = 512, N_D = 192, N_E = 4096;
  const int total = N_A + N_B + N_C + N_D + N_E;
  for (int item = blockIdx.x; item < total; item += gridDim.x) {
    int it = item;
    if (it < N_D) { mod_item(p, it, sm); continue; }
    it -= N_D;
    if (it < N_C) { wst_item(p, it, sm); continue; }
    it -= N_C;
    if (it < N_A) {
      int l = it / (16 * 46), r = it % (16 * 46);
      transpose_item(p.w_in + (size_t)l * 1024 * INC, INC, p.WinT + (size_t)l * INC_PAD * 1024, r / 46, r % 46, sm);
      continue;
    }
    it -= N_A;
    if (it < N_B) {
      int l = it >> 8, r = it & 255;
      transpose_item(p.w_out + (size_t)l * 1024 * 1024, 1024, p.WoutT + (size_t)l * 1024 * 1024, r >> 4, r & 15, sm);
      continue;
    }
    it -= N_B;
    {
      int tab = it >> 11;
      int chunk = it & 2047;
      const float scl = tab ? 8.f : 64.f;
      const float4* src = (const float4*)(tab ? p.peer_v : p.peer_u) + (size_t)chunk * 4096;
      uint4* dst = (uint4*)(tab ? p.Vb : p.Ub) + (size_t)chunk * 1024;
#pragma unroll
      for (int i = 0; i < 4; i++) {
        int q = i * 256 + tid;
        float4 v0 = src[q * 4 + 0], v1 = src[q * 4 + 1], v2 = src[q * 4 + 2], v3 = src[q * 4 + 3];
        uint4 o;
        int w_;
        w_ = __builtin_amdgcn_cvt_pk_fp8_f32(v0.x * scl, v0.y * scl, 0, false);
        w_ = __builtin_amdgcn_cvt_pk_fp8_f32(v0.z * scl, v0.w * scl, w_, true);
        o.x = (unsigned)w_;
        w_ = __builtin_amdgcn_cvt_pk_fp8_f32(v1.x * scl, v1.y * scl, 0, false);
        w_ = __builtin_amdgcn_cvt_pk_fp8_f32(v1.z * scl, v1.w * scl, w_, true);
        o.y = (unsigned)w_;
        w_ = __builtin_amdgcn_cvt_pk_fp8_f32(v2.x * scl, v2.y * scl, 0, false);
        w_ = __builtin_amdgcn_cvt_pk_fp8_f32(v2.z * scl, v2.w * scl, w_, true);
        o.z = (unsigned)w_;
        w_ = __builtin_amdgcn_cvt_pk_fp8_f32(v3.x * scl, v3.y * scl, 0, false);
        w_ = __builtin_amdgcn_cvt_pk_fp8_f32(v3.z * scl, v3.w * scl, w_, true);
        o.w = (unsigned)w_;
        dst[q] = o;
      }
    }
  }
}

__device__ __forceinline__ void phase_norm(const P& p, int l, int which) {
  const int tid = threadIdx.x, lane = tid & 63, w = tid >> 6;
  const int nrows = (which == 2 && l == 1) ? ML_ROWS : MT_ROWS;
  const float* g = (which == 1 ? p.norm1_g : p.norm2_g) + l * 1024;
  for (int item = blockIdx.x; item * 4 < nrows; item += gridDim.x) {
    int row = item * 4 + w;
    const float* src;
    if (l == 0 && which == 1) src = row < ML_ROWS ? p.x + (size_t)row * 1024 : p.ctx + (size_t)(row - ML_ROWS) * 1024;
    else src = row < ML_ROWS ? p.out + (size_t)row * 1024 : p.hc + (size_t)(row - ML_ROWS) * 1024;
    int mr = row < ML_ROWS ? (row >> 11) : 8;
    const float* modp = p.mod + (size_t)(l * 9 + mr) * 6144;
    const float* sh = modp + (which == 1 ? 0 : 3072);
    const float* sc = modp + (which == 1 ? 1024 : 4096);
    float4 v[4];
    float ss = 0.f;
#pragma unroll
    for (int i = 0; i < 4; i++) {
      v[i] = ((const float4*)src)[i * 64 + lane];
      ss += v[i].x * v[i].x + v[i].y * v[i].y + v[i].z * v[i].z + v[i].w * v[i].w;
    }
    ss = wave_sum(ss);
    float rs = rsqrtf(ss * (1.f / 1024.f) + 1e-6f);
#pragma unroll
    for (int i = 0; i < 4; i++) {
      int d = (i * 64 + lane) * 4;
      float4 gg = *(const float4*)(g + d);
      float4 s4 = *(const float4*)(sc + d);
      float4 h4 = *(const float4*)(sh + d);
      float o0 = v[i].x * rs * gg.x * (1.f + s4.x) + h4.x;
      float o1 = v[i].y * rs * gg.y * (1.f + s4.y) + h4.y;
      float o2 = v[i].z * rs * gg.z * (1.f + s4.z) + h4.z;
      float o3 = v[i].w * rs * gg.w * (1.f + s4.w) + h4.w;
      uint2 o;
      o.x = pack2(o0, o1);
      o.y = pack2(o2, o3);
      ((uint2*)(p.xn + (size_t)row * 1024))[i * 64 + lane] = o;
    }
  }
}

template <int EPI>
__device__ __forceinline__ void phase_gemm(const P& p, int l, const u16* __restrict__ A, const u16* __restrict__ Bt, int mtiles, int ntiles,
                           char* smem) {
  u16* As = (u16*)smem;
  u16* Bs = As + 128 * 40;
  const int tid = threadIdx.x, lane = tid & 63, w = tid >> 6, wm = w >> 1, wn = w & 1;
  const int lr = lane & 15, quad = lane >> 4;
  const int nitems = mtiles * ntiles;
  for (int item = blockIdx.x; item < nitems; item += gridDim.x) {
    int mt = item / ntiles, nt = item - mt * ntiles;
    int m0 = mt * 128, n0 = nt * 128;
    f32x4 acc[4][4];
#pragma unroll
    for (int i = 0; i < 4; i++)
#pragma unroll
      for (int j = 0; j < 4; j++) acc[i][j] = (f32x4){0.f, 0.f, 0.f, 0.f};
    const int r0_ = tid >> 2, ch_ = tid & 3;
    const u16* Ap0 = A + (size_t)(m0 + r0_) * 1024 + ch_ * 8;
    const u16* Ap1 = Ap0 + (size_t)64 * 1024;
    const u16* Bp0 = Bt + (size_t)(n0 + r0_) * 1024 + ch_ * 8;
    const u16* Bp1 = Bp0 + (size_t)64 * 1024;
    uint4 ra0 = *(const uint4*)Ap0, ra1 = *(const uint4*)Ap1, rb0 = *(const uint4*)Bp0, rb1 = *(const uint4*)Bp1;
    for (int kt = 0; kt < 32; kt++) {
      __syncthreads();
      *(uint4*)(As + r0_ * 40 + ch_ * 8) = ra0;
      *(uint4*)(As + (r0_ + 64) * 40 + ch_ * 8) = ra1;
      *(uint4*)(Bs + r0_ * 40 + ch_ * 8) = rb0;
      *(uint4*)(Bs + (r0_ + 64) * 40 + ch_ * 8) = rb1;
      __syncthreads();
      if (kt < 31) {
        ra0 = *(const uint4*)(Ap0 + (kt + 1) * 32);
        ra1 = *(const uint4*)(Ap1 + (kt + 1) * 32);
        rb0 = *(const uint4*)(Bp0 + (kt + 1) * 32);
        rb1 = *(const uint4*)(Bp1 + (kt + 1) * 32);
      }
      bf16x8 a[4], b[4];
#pragma unroll
      for (int i = 0; i < 4; i++) {
        a[i] = *(const bf16x8*)(As + (wm * 64 + i * 16 + lr) * 40 + quad * 8);
        b[i] = *(const bf16x8*)(Bs + (wn * 64 + i * 16 + lr) * 40 + quad * 8);
      }
#pragma unroll
      for (int i = 0; i < 4; i++)
#pragma unroll
        for (int j = 0; j < 4; j++) acc[i][j] = __builtin_amdgcn_mfma_f32_16x16x32_bf16(a[i], b[j], acc[i][j], 0, 0, 0);
    }
#pragma unroll
    for (int i = 0; i < 4; i++)
#pragma unroll
      for (int j = 0; j < 4; j++)
#pragma unroll
        for (int r = 0; r < 4; r++) {
          int row = m0 + wm * 64 + i * 16 + quad * 4 + r;
          int col = n0 + wn * 64 + j * 16 + lr;
          float v = acc[i][j][r];
          if (EPI == 0) {
            if (col < INC) {
              p.U[(size_t)row * INC + col] = f2bf(v);
              if (col >= 2816) p.G[row * 16 + (col - 2816)] = v;
            }
          } else if (EPI == 1) {
            int mr = row < ML_ROWS ? (row >> 11) : 8;
            float g1 = p.mod[(size_t)(l * 9 + mr) * 6144 + 2048 + col];
            float sv;
            if (l == 0) sv = row < ML_ROWS ? p.x[(size_t)row * 1024 + col] : p.ctx[(size_t)(row - ML_ROWS) * 1024 + col];
            else sv = p.out[(size_t)row * 1024 + col];
            float* dst = row < ML_ROWS ? p.out + (size_t)row * 1024 + col : p.hc + (size_t)(row - ML_ROWS) * 1024 + col;
            *dst = sv + g1 * v;
          } else {
            p.S[(size_t)row * 2048 + col] = v;
          }
        }
  }
}

__device__ __forceinline__ void vt_item(const P& p, int it, u16* tl);
__device__ __forceinline__ void phase_mixprep(const P& p, int l, char* smem) {
  const int tid = threadIdx.x;
  float* pl = (float*)smem;
  const int N_QK = MT_ROWS * 16 / 256;
  const int N_POOL = (l == 0 ? MT_ROWS : ML_ROWS) / 16;
  const int N_PREP = MT_ROWS / 8;
  const int N_VT = 2304 + 1152;
  const int total = N_QK + N_POOL + N_PREP + N_VT;
  for (int item = blockIdx.x; item < total; item += gridDim.x) {
    int it = item;
    if (it >= N_QK + N_POOL + N_PREP) { vt_item(p, it - (N_QK + N_POOL + N_PREP), (u16*)smem); continue; }
    if (it < N_QK) {
      int gi = it * 256 + tid;
      int row = gi >> 4, sub = gi & 15;
      int qk = sub >> 3, h = sub & 7;
      u16* ptr = p.U + (size_t)row * INC + qk * 512 + h * 64;
      const float* g = (qk ? p.na_k_g : p.na_q_g) + l * 64;
      uint4 v[8];
      float ss = 0.f;
#pragma unroll
      for (int c = 0; c < 8; c++) {
        v[c] = ((const uint4*)ptr)[c];
        float a;
        a = bflo(v[c].x); ss += a * a; a = bfhi(v[c].x); ss += a * a;
        a = bflo(v[c].y); ss += a * a; a = bfhi(v[c].y); ss += a * a;
        a = bflo(v[c].z); ss += a * a; a = bfhi(v[c].z); ss += a * a;
        a = bflo(v[c].w); ss += a * a; a = bfhi(v[c].w); ss += a * a;
      }
      float rs = rsqrtf(ss * (1.f / 64.f) + 1e-6f);
#pragma unroll
      for (int c = 0; c < 8; c++) {
        uint4 o;
        o.x = pack2(bflo(v[c].x) * rs * g[c * 8 + 0], bfhi(v[c].x) * rs * g[c * 8 + 1]);
        o.y = pack2(bflo(v[c].y) * rs * g[c * 8 + 2], bfhi(v[c].y) * rs * g[c * 8 + 3]);
        o.z = pack2(bflo(v[c].z) * rs * g[c * 8 + 4], bfhi(v[c].z) * rs * g[c * 8 + 5]);
        o.w = pack2(bflo(v[c].w) * rs * g[c * 8 + 6], bfhi(v[c].w) * rs * g[c * 8 + 7]);
        ((uint4*)ptr)[c] = o;
      }
      continue;
    }
    it -= N_QK;
    if (it < N_POOL) {
      int row0 = it * 16;
      int base, T;
      if (row0 < ML_ROWS) { base = (row0 >> 11) << 11; T = 2048; }
      else { base = ML_ROWS + (((row0 - ML_ROWS) >> 8) << 8); T = 256; }
      int t0 = row0 - base;
      int ch = tid, g = ch >> 6;
      int wdw = 2 << g;
      __syncthreads();
      {
        float vals[31];
#pragma unroll
        for (int j = 0; j < 31; j++) {
          int tau = t0 - 8 + j;
          bool ok = (tau >= 0) && (tau < T);
          vals[j] = ok ? bf2f(p.U[(size_t)(base + (ok ? tau : t0)) * INC + 1536 + ch]) : 0.f;
        }
        const int hl = wdw / 2, hr = wdw - wdw / 2 - 1;
#pragma unroll
        for (int tt = 0; tt < 16; tt++) {
          int t = t0 + tt;
          int lo = max(t - hl, 0), hi = min(t + hr, T - 1);
          float s = 0.f;
#pragma unroll
          for (int j = 0; j < 31; j++) {
            int rel = j - 8 - tt;
            if (rel >= -8 && rel <= 7) s += (rel >= -hl && rel <= hr) ? vals[j] : 0.f;
          }
          pl[tt * 256 + ch] = s / (float)(hi - lo + 1) - vals[8 + tt];
        }
      }
      __syncthreads();
      float acc[16];
#pragma unroll
      for (int tt = 0; tt < 16; tt++) acc[tt] = 0.f;
      int d = ch & 63;
      const float* pw = p.pool_w + ((size_t)(l * 4 + g) * 64) * 64 + d;
      for (int c = 0; c < 64; c++) {
        float wv = pw[c * 64];
#pragma unroll
        for (int tt = 0; tt < 16; tt++) acc[tt] += pl[tt * 256 + g * 64 + c] * wv;
      }
      float ps = p.pool_scale[l * 256 + ch];
#pragma unroll
      for (int tt = 0; tt < 16; tt++) p.Y[(size_t)(row0 + tt) * 1024 + 512 + ch] = f2bf(acc[tt] * ps);
      continue;
    }
    it -= N_POOL;
    {
      const int row0 = it * 8;
      int base, T;
      if (row0 < ML_ROWS) { base = (row0 >> 11) << 11; T = 2048; }
      else { base = ML_ROWS + (((row0 - ML_ROWS) >> 8) << 8); T = 256; }
      const int t0 = row0 - base;
      const int qk = tid >> 7, hh = (tid >> 5) & 3, ax = (tid >> 4) & 1, f = tid & 15;
      const int ca = qk * 256 + hh * 64 + ax * 32 + f, cb = ca + 16;
      float ua[12], ub[12];
#pragma unroll
      for (int j = 0; j < 12; j++) {
        int tt = t0 + j - 2;
        bool ok = (tt >= 0) && (tt < T);
        const u16* ur = p.U + (size_t)(base + (ok ? tt : t0)) * INC + 1792;
        ua[j] = ok ? bf2f(ur[ca]) : 0.f;
        ub[j] = ok ? bf2f(ur[cb]) : 0.f;
      }
      float wa[5], wb[5];
#pragma unroll
      for (int j = 0; j < 5; j++) { wa[j] = p.ml_conv[(l * 5 + j) * 512 + ca]; wb[j] = p.ml_conv[(l * 5 + j) * 512 + cb]; }
      const float inv = __expf(-(float)f * (9.210340371976184f / 16.f));
#pragma unroll
      for (int i = 0; i < 8; i++) {
        float a = 0.f, b = 0.f;
#pragma unroll
        for (int j = 0; j < 5; j++) { a += wa[j] * ua[i + j]; b += wb[j] * ub[i + j]; }
        a = siluf_(a);
        b = siluf_(b);
        if (row0 < ML_ROWS) {
          int t = t0 + i;
          float pos = (float)(ax == 0 ? (t >> 6) : (t & 63));
          float ang = pos * inv;
          float cs = __cosf(ang), sn = __sinf(ang);
          float oa = a * cs - b * sn, ob = a * sn + b * cs;
          a = oa; b = ob;
        }
        if (qk) { a *= 0.125f; b *= 0.125f; }
        ((u16*)p.MQK)[(size_t)(row0 + i) * 512 + ca] = f2bf(a);
        ((u16*)p.MQK)[(size_t)(row0 + i) * 512 + cb] = f2bf(b);
      }
      if (tid < 128) {
        int gi = tid & 15;
        float gv = p.G[row0 * 16 + tid] + p.ml_gate_b[l * 16 + gi];
        if ((gi >> 2) & 1) gv = fminf(gv, 0.f) - log1pf(__expf(-fabsf(gv)));
        p.G[row0 * 16 + tid] = gv;
      }
    }
  }
}

#define VT_CTX_OFF ((size_t)8 * 8 * 64 * 2048)
#define VTM_CTX_OFF ((size_t)8 * 4 * 64 * 2048)
__device__ __forceinline__ void vt_item(const P& p, int it, u16* tl) {
  const int tid = threadIdx.x;
  int b, h, tt, row0, TK, col0;
  u16* dst;
  if (it < 2048) { b = it >> 8; h = (it >> 5) & 7; tt = it & 31; row0 = b * 2048 + tt * 64; TK = 2048; col0 = 1024 + h * 64; dst = p.VT + (size_t)((b * 8 + h) * 64) * 2048 + tt * 64; }
  else if (it < 2304) { int ci = it - 2048; b = ci >> 5; h = (ci >> 2) & 7; tt = ci & 3; row0 = ML_ROWS + b * 256 + tt * 64; TK = 256; col0 = 1024 + h * 64; dst = p.VT + VT_CTX_OFF + (size_t)((b * 8 + h) * 64) * 256 + tt * 64; }
  else if (it < 2304 + 1024) { int mi = it - 2304; b = mi >> 7; h = (mi >> 5) & 3; tt = mi & 31; row0 = b * 2048 + tt * 64; TK = 2048; col0 = 2304 + h * 64; dst = p.VTm + (size_t)((b * 4 + h) * 64) * 2048 + tt * 64; }
  else { int mi = it - 3328; b = mi >> 4; h = (mi >> 2) & 3; tt = mi & 3; row0 = ML_ROWS + b * 256 + tt * 64; TK = 256; col0 = 2304 + h * 64; dst = p.VTm + VTM_CTX_OFF + (size_t)((b * 4 + h) * 64) * 256 + tt * 64; }
  __syncthreads();
  {
    int i = tid >> 2, part = tid & 3;
    const uint4* src = (const uint4*)(p.U + (size_t)(row0 + i) * INC + col0 + part * 16);
    uint4 v0 = src[0], v1 = src[1];
    unsigned* t32 = (unsigned*)(tl + i * 66 + part * 16);
    t32[0] = v0.x; t32[1] = v0.y; t32[2] = v0.z; t32[3] = v0.w;
    t32[4] = v1.x; t32[5] = v1.y; t32[6] = v1.z; t32[7] = v1.w;
  }
  __syncthreads();
  {
    int d = tid >> 2, part = tid & 3;
    unsigned o[8];
#pragma unroll
    for (int k = 0; k < 8; k++) {
      unsigned lo = tl[(part * 16 + 2 * k) * 66 + d], hi = tl[(part * 16 + 2 * k + 1) * 66 + d];
      o[k] = lo | (hi << 16);
    }
    uint4* dp = (uint4*)(dst + (size_t)d * TK + part * 16);
    dp[0] = make_uint4(o[0], o[1], o[2], o[3]);
    dp[1] = make_uint4(o[4], o[5], o[6], o[7]);
  }
}

__device__ __forceinline__ void attn_item(const P& p, int l, int item, float* sb) {
  const int tid = threadIdx.x, lane = tid & 63, w = tid >> 6, q = lane & 15, quad = lane >> 4;
  const bool latent = item < 2048;
  int b, r = 0, h, qb = 0;
  if (latent) { b = item >> 8; r = (item >> 3) & 31; h = item & 7; }
  else { int ci = item - 2048; b = ci >> 5; qb = (ci >> 3) & 3; h = ci & 7; }
  const int r0 = min(max(r - 4, 0), 24);
  __syncthreads();
  if (latent) {
    int kr = tid >> 5, j = tid & 31;
    if (j < 31) sb[tid] = p.na_rpb[(size_t)((l * 8 + h) * 15 + (r0 + kr - r + 7)) * 31 + j];
  }
  __syncthreads();
  const int qc = w * 16 + q;
  const int qrow = latent ? (b * 2048 + r * 64 + qc) : (ML_ROWS + b * 256 + qb * 64 + qc);
  const int cs = (w == 0) ? 0 : (w == 1) ? 8 : (w == 2) ? 24 : 32;
  const int c0 = min(max(qc - 8, 0), 48);
  const bf16x8 bq0 = *(const bf16x8*)(p.U + (size_t)qrow * INC + h * 64 + quad * 8);
  const bf16x8 bq1 = *(const bf16x8*)(p.U + (size_t)qrow * INC + h * 64 + 32 + quad * 8);
  const int mrow = (q >> 2) * 8 + (q & 3);
  const u16* vt_lat = p.VT + (size_t)((b * 8 + h) * 64 + q) * 2048 + quad * 8;
  const u16* vt_ctx = p.VT + VT_CTX_OFF + (size_t)((b * 8 + h) * 64 + q) * 256 + quad * 8;
  float m = -INFINITY, lsum = 0.f;
  f32x4 o[4];
#pragma unroll
  for (int dt = 0; dt < 4; dt++) o[dt] = (f32x4){0.f, 0.f, 0.f, 0.f};
#pragma unroll 1
  for (int chunk = (latent ? 0 : 2); chunk < 4; chunk++) {
    f32x4 s[4][2];
#pragma unroll
    for (int blk = 0; blk < 4; blk++) {
      int rowbase = (chunk < 2) ? (b * 2048 + (r0 + chunk * 4 + blk) * 64 + cs) : (ML_ROWS + b * 256 + (chunk - 2) * 128 + blk * 32);
#pragma unroll
      for (int T = 0; T < 2; T++) {
        const u16* kp = p.U + (size_t)(rowbase + mrow + T * 4) * INC + 512 + h * 64 + quad * 8;
        bf16x8 a0 = *(const bf16x8*)kp;
        bf16x8 a1 = *(const bf16x8*)(kp + 32);
        f32x4 acc = (f32x4){0.f, 0.f, 0.f, 0.f};
        acc = __builtin_amdgcn_mfma_f32_16x16x32_bf16(a0, bq0, acc, 0, 0, 0);
        acc = __builtin_amdgcn_mfma_f32_16x16x32_bf16(a1, bq1, acc, 0, 0, 0);
        s[blk][T] = acc;
      }
    }
    float mx = -INFINITY;
    if (chunk < 2) {
#pragma unroll
      for (int blk = 0; blk < 4; blk++)
#pragma unroll
        for (int T = 0; T < 2; T++)
#pragma unroll
          for (int rr = 0; rr < 4; rr++) {
            int kc = cs + quad * 8 + T * 4 + rr;
            bool valid = (kc >= c0) && (kc < c0 + 16);
            int bi = (chunk * 4 + blk) * 32 + min(max(kc - qc + 15, 0), 30);
            float v = valid ? (s[blk][T][rr] * 0.125f + sb[bi]) : -INFINITY;
            s[blk][T][rr] = v;
            mx = fmaxf(mx, v);
          }
    } else {
#pragma unroll
      for (int blk = 0; blk < 4; blk++)
#pragma unroll
        for (int T = 0; T < 2; T++)
#pragma unroll
          for (int rr = 0; rr < 4; rr++) {
            float v = s[blk][T][rr] * 0.125f;
            s[blk][T][rr] = v;
            mx = fmaxf(mx, v);
          }
    }
    mx = fmaxf(mx, __shfl_xor(mx, 16));
    mx = fmaxf(mx, __shfl_xor(mx, 32));
    float mn = fmaxf(m, mx);
    float sc = __expf(m - mn);
    lsum *= sc;
#pragma unroll
    for (int dt = 0; dt < 4; dt++) o[dt] *= sc;
    m = mn;
#pragma unroll
    for (int blk = 0; blk < 4; blk++) {
      float pv[8];
#pragma unroll
      for (int T = 0; T < 2; T++)
#pragma unroll
        for (int rr = 0; rr < 4; rr++) {
          float e = __expf(s[blk][T][rr] - mn);
          pv[T * 4 + rr] = e;
          lsum += e;
        }
      union { bf16x8 v; unsigned u[4]; } pk;
      pk.u[0] = pack2(pv[0], pv[1]); pk.u[1] = pack2(pv[2], pv[3]); pk.u[2] = pack2(pv[4], pv[5]); pk.u[3] = pack2(pv[6], pv[7]);
      const u16* vb = (chunk < 2) ? (vt_lat + (r0 + chunk * 4 + blk) * 64 + cs) : (vt_ctx + (chunk - 2) * 128 + blk * 32);
      const size_t dstr = (chunk < 2) ? (size_t)16 * 2048 : (size_t)16 * 256;
#pragma unroll
      for (int dt = 0; dt < 4; dt++) {
        bf16x8 av = *(const bf16x8*)(vb + dt * dstr);
        o[dt] = __builtin_amdgcn_mfma_f32_16x16x32_bf16(av, pk.v, o[dt], 0, 0, 0);
      }
    }
  }
  lsum += __shfl_xor(lsum, 16);
  lsum += __shfl_xor(lsum, 32);
  float il = 1.f / lsum;
#pragma unroll
  for (int dt = 0; dt < 4; dt++) {
    uint2 ov;
    ov.x = pack2(o[dt][0] * il, o[dt][1] * il);
    ov.y = pack2(o[dt][2] * il, o[dt][3] * il);
    *(uint2*)(p.Y + (size_t)qrow * 1024 + h * 64 + dt * 16 + quad * 4) = ov;
  }
}

__device__ __forceinline__ int ml_row(int b, int dir, int j, int pp) {
  if (j < 4) {
    int pos = j * 64 + pp;
    int t = dir ? 255 - pos : pos;
    return ML_ROWS + b * 256 + t;
  } else {
    int pos = (j - 4) * 64 + pp;
    int t = dir ? 2047 - pos : pos;
    return b * 2048 + t;
  }
}

__device__ __forceinline__ void mlstmA_item(const P& p, int it, float* sm) {
  const int tid = threadIdx.x, lane = tid & 63;
  int seq = it / 36, j = it % 36;
  int b = seq >> 3, h = (seq >> 1) & 3, dir = seq & 1;
  float* ks = sm;
  float* vs = sm + 64 * 65;
  float* wsm = sm + 2 * 64 * 65;
  float* slot = p.mst + (size_t)it * SLOT;
  const u16* mqk = (const u16*)p.MQK;
  __syncthreads();
  for (int idx = tid; idx < 4096; idx += 256) {
    int pp = idx >> 6, d = idx & 63;
    int row = ml_row(b, dir, j, pp);
    ks[pp * 65 + d] = bf2f(mqk[(size_t)row * 512 + 256 + h * 64 + d]);
    vs[pp * 65 + d] = bf2f(p.U[(size_t)row * INC + 2304 + h * 64 + d]);
  }
  if (tid < 64) {
    int row = ml_row(b, dir, j, lane);
    float ic = p.G[row * 16 + (dir * 2) * 4 + h];
    float fc = p.G[row * 16 + (dir * 2 + 1) * 4 + h];
    float bbv = fc;
#pragma unroll
    for (int o = 1; o < 64; o <<= 1) { float u = __shfl_up(bbv, o); if (lane >= o) bbv += u; }
    float cs = ic - bbv;
    float pm = cs;
#pragma unroll
    for (int o = 1; o < 64; o <<= 1) { float u = __shfl_up(pm, o); if (lane >= o) pm = fmaxf(pm, u); }
    float bl = __shfl(bbv, 63);
    float ml = __shfl(pm, 63) + bl;
    wsm[lane] = __expf(bl + cs - ml);
    slot[4224 + lane] = bbv;
    slot[4288 + lane] = cs;
    slot[4352 + lane] = pm;
    if (lane == 0) { slot[4160] = bl; slot[4161] = ml; }
  }
  __syncthreads();
  {
    int e = tid & 63, dg = tid >> 6;
    float acc[16];
#pragma unroll
    for (int dd = 0; dd < 16; dd++) acc[dd] = 0.f;
    for (int pp = 0; pp < 64; pp++) {
      float wv = wsm[pp] * vs[pp * 65 + e];
#pragma unroll
      for (int dd = 0; dd < 16; dd++) acc[dd] += ks[pp * 65 + dg * 16 + dd] * wv;
    }
#pragma unroll
    for (int q4 = 0; q4 < 4; q4++)
      *(float4*)(slot + e * 64 + dg * 16 + q4 * 4) = make_float4(acc[q4 * 4], acc[q4 * 4 + 1], acc[q4 * 4 + 2], acc[q4 * 4 + 3]);
  }
  if (tid < 64) {
    float a = 0.f;
    for (int pp = 0; pp < 64; pp++) a += wsm[pp] * ks[pp * 65 + tid];
    slot[4096 + tid] = a;
  }
}

#define ATT_SPLIT 768
__device__ __forceinline__ void phase_attn_mlA(const P& p, int l, char* smem) {
  const int N_MLA = 64 * 36;
  const int total = ATT_SPLIT + N_MLA;
  for (int item = blockIdx.x; item < total; item += gridDim.x) {
    if (item < N_MLA) mlstmA_item(p, item, (float*)smem);
    else attn_item(p, l, item - N_MLA, (float*)smem);
  }
}
__device__ __forceinline__ void mlB_item(const P& p, int item);
__device__ __forceinline__ void phase_attn_mlB(const P& p, int l, char* smem) {
  const int N_ATT = (l == 0 ? 2304 : 2048) - ATT_SPLIT;
  const int N_MLB = 64 * 17;
  const int total = N_ATT + N_MLB;
  for (int item = blockIdx.x; item < total; item += gridDim.x) {
    if (item < N_MLB) mlB_item(p, item);
    else attn_item(p, l, ATT_SPLIT + item - N_MLB, (float*)smem);
  }
}

__device__ __forceinline__ void mlB_item(const P& p, int item) {
  const int tid = threadIdx.x;
  int seq = item / 17, ech = item - seq * 17;
  int el = ech * 256 + tid;
  if (el >= 4160) return;
  float* base = p.mst + (size_t)(seq * 36) * SLOT;
  float loc[36], bl[36], ml[36];
#pragma unroll
  for (int j = 0; j < 36; j++) {
    loc[j] = base[(size_t)j * SLOT + el];
    bl[j] = base[(size_t)j * SLOT + 4160];
    ml[j] = base[(size_t)j * SLOT + 4161];
  }
  float m = 0.f, val = 0.f;
#pragma unroll
  for (int j = 0; j < 36; j++) {
    base[(size_t)j * SLOT + el] = val;
    if (el == 0) base[(size_t)j * SLOT + 4162] = m;
    float mn = fmaxf(bl[j] + m, ml[j]);
    val = __expf(bl[j] + m - mn) * val + __expf(ml[j] - mn) * loc[j];
    m = mn;
  }
}

__device__ __forceinline__ bf16x8 pack8(float4 a, float4 b) {
  union { bf16x8 v; unsigned u[4]; } r;
  r.u[0] = pack2(a.x, a.y); r.u[1] = pack2(a.z, a.w); r.u[2] = pack2(b.x, b.y); r.u[3] = pack2(b.z, b.w);
  return r.v;
}
__device__ __forceinline__ void phase_mlC(const P& p, int l, char* smem) {
  const int tid = threadIdx.x, lane = tid & 63, w = tid >> 6, q = lane & 15, quad = lane >> 4;
  const u16* mqk = (const u16*)p.MQK;
  const int nch = (l == 0) ? 36 : 32;
  const int total = 32 * nch;
  const int mrow = (q >> 2) * 8 + (q & 3);
  for (int item = blockIdx.x; item < total; item += gridDim.x) {
    int bh = item / nch, c = item % nch + (l == 0 ? 0 : 4);
    int b = bh >> 2, h = bh & 3;
    const int rowbase = (c < 4) ? (ML_ROWS + b * 256 + c * 64) : (b * 2048 + (c - 4) * 64);
    const int tau_t = w * 16 + q;
    const int trow = rowbase + tau_t;
    const bf16x8 bq0 = *(const bf16x8*)(mqk + (size_t)trow * 512 + h * 64 + quad * 8);
    const bf16x8 bq1 = *(const bf16x8*)(mqk + (size_t)trow * 512 + h * 64 + 32 + quad * 8);
    const u16* vt = (c < 4) ? (p.VTm + VTM_CTX_OFF + (size_t)((b * 4 + h) * 64 + q) * 256 + c * 64 + quad * 8)
                            : (p.VTm + (size_t)((b * 4 + h) * 64 + q) * 2048 + (c - 4) * 64 + quad * 8);
    const size_t vstr = (c < 4) ? (size_t)16 * 256 : (size_t)16 * 2048;
    f32x4 hs[4];
#pragma unroll
    for (int et = 0; et < 4; et++) hs[et] = (f32x4){0.f, 0.f, 0.f, 0.f};
#pragma unroll 1
    for (int dir = 0; dir < 2; dir++) {
      int j = dir ? (c < 4 ? 3 - c : 4 + 31 - (c - 4)) : c;
      const float* slot = p.mst + (size_t)(((b * 4 + h) * 2 + dir) * 36 + j) * SLOT;
      const int pt = dir ? 63 - tau_t : tau_t;
      const float m0 = slot[4162];
      const float bt = slot[4224 + pt];
      const float mt = bt + fmaxf(m0, slot[4352 + pt]);
      const float winter = __expf(bt + m0 - mt);
      f32x4 aw[4], ac[4];
#pragma unroll
      for (int et = 0; et < 4; et++) { aw[et] = (f32x4){0.f, 0.f, 0.f, 0.f}; ac[et] = (f32x4){0.f, 0.f, 0.f, 0.f}; }
      float dsum = 0.f;
#pragma unroll
      for (int kb = 0; kb < 2; kb++) {
        float wv[8];
#pragma unroll
        for (int T = 0; T < 2; T++) {
          const u16* kp = mqk + (size_t)(rowbase + kb * 32 + mrow + T * 4) * 512 + 256 + h * 64 + quad * 8;
          bf16x8 a0 = *(const bf16x8*)kp;
          bf16x8 a1 = *(const bf16x8*)(kp + 32);
          f32x4 sacc = (f32x4){0.f, 0.f, 0.f, 0.f};
          sacc = __builtin_amdgcn_mfma_f32_16x16x32_bf16(a0, bq0, sacc, 0, 0, 0);
          sacc = __builtin_amdgcn_mfma_f32_16x16x32_bf16(a1, bq1, sacc, 0, 0, 0);
#pragma unroll
          for (int rr = 0; rr < 4; rr++) {
            int tau_s = kb * 32 + quad * 8 + T * 4 + rr;
            int ps = dir ? 63 - tau_s : tau_s;
            bool valid = dir ? (tau_s >= tau_t) : (tau_s <= tau_t);
            float cs = slot[4288 + ps];
            float v = valid ? sacc[rr] * __expf(bt - mt + cs) : 0.f;
            wv[T * 4 + rr] = v;
            dsum += v;
          }
        }
        union { bf16x8 v; unsigned u[4]; } pk;
        pk.u[0] = pack2(wv[0], wv[1]); pk.u[1] = pack2(wv[2], wv[3]); pk.u[2] = pack2(wv[4], wv[5]); pk.u[3] = pack2(wv[6], wv[7]);
#pragma unroll
        for (int et = 0; et < 4; et++) {
          bf16x8 av = *(const bf16x8*)(vt + et * vstr + kb * 32);
          aw[et] = __builtin_amdgcn_mfma_f32_16x16x32_bf16(av, pk.v, aw[et], 0, 0, 0);
        }
      }
#pragma unroll
      for (int et = 0; et < 4; et++) {
        const float* cp = slot + (et * 16 + q) * 64 + quad * 8;
        bf16x8 c0 = pack8(*(const float4*)cp, *(const float4*)(cp + 4));
        bf16x8 c1 = pack8(*(const float4*)(cp + 32), *(const float4*)(cp + 36));
        ac[et] = __builtin_amdgcn_mfma_f32_16x16x32_bf16(c0, bq0, ac[et], 0, 0, 0);
        ac[et] = __builtin_amdgcn_mfma_f32_16x16x32_bf16(c1, bq1, ac[et], 0, 0, 0);
      }
      float qn = 0.f;
      {
        const float* np_ = slot + 4096 + quad * 8;
        float4 n0 = *(const float4*)np_, n1 = *(const float4*)(np_ + 4), n2 = *(const float4*)(np_ + 32), n3 = *(const float4*)(np_ + 36);
        union { bf16x8 v; unsigned u[4]; } q0, q1;
        q0.v = bq0; q1.v = bq1;
        qn += bflo(q0.u[0]) * n0.x + bfhi(q0.u[0]) * n0.y + bflo(q0.u[1]) * n0.z + bfhi(q0.u[1]) * n0.w;
        qn += bflo(q0.u[2]) * n1.x + bfhi(q0.u[2]) * n1.y + bflo(q0.u[3]) * n1.z + bfhi(q0.u[3]) * n1.w;
        qn += bflo(q1.u[0]) * n2.x + bfhi(q1.u[0]) * n2.y + bflo(q1.u[1]) * n2.z + bfhi(q1.u[1]) * n2.w;
        qn += bflo(q1.u[2]) * n3.x + bfhi(q1.u[2]) * n3.y + bflo(q1.u[3]) * n3.z + bfhi(q1.u[3]) * n3.w;
      }
      qn += __shfl_xor(qn, 16);
      qn += __shfl_xor(qn, 32);
      dsum += __shfl_xor(dsum, 16);
      dsum += __shfl_xor(dsum, 32);
      float den = dsum + winter * qn;
      float ih = 1.f / fmaxf(fabsf(den), __expf(-mt));
#pragma unroll
      for (int et = 0; et < 4; et++)
#pragma unroll
        for (int rr = 0; rr < 4; rr++) hs[et][rr] += (aw[et][rr] + winter * ac[et][rr]) * ih;
    }
    float ss = 0.f;
#pragma unroll
    for (int et = 0; et < 4; et++)
#pragma unroll
      for (int rr = 0; rr < 4; rr++) ss += hs[et][rr] * hs[et][rr];
    ss += __shfl_xor(ss, 16);
    ss += __shfl_xor(ss, 32);
    float rs = rsqrtf(ss * (1.f / 64.f) + 1e-6f);
#pragma unroll
    for (int et = 0; et < 4; et++) {
      int e0 = h * 64 + et * 16 + quad * 4;
      uint2 uo = *(const uint2*)(p.U + (size_t)trow * INC + 2560 + e0);
      float4 ng = *(const float4*)(p.ml_norm_g + l * 256 + e0);
      float o0 = hs[et][0] * rs * ng.x * sigmoidf_(bflo(uo.x));
      float o1 = hs[et][1] * rs * ng.y * sigmoidf_(bfhi(uo.x));
      float o2 = hs[et][2] * rs * ng.z * sigmoidf_(bflo(uo.y));
      float o3 = hs[et][3] * rs * ng.w * sigmoidf_(bfhi(uo.y));
      uint2 ov;
      ov.x = pack2(o0, o1);
      ov.y = pack2(o2, o3);
      *(uint2*)(p.Y + (size_t)trow * 1024 + 768 + e0) = ov;
    }
  }
}

typedef __attribute__((ext_vector_type(2))) float f32x2;
__device__ __forceinline__ float gelu_tanh(float x) {
  float u = 0.7978845608028654f * (x + 0.044715f * x * x * x);
  float th = 1.f - 2.f / (1.f + __expf(2.f * u));
  return 0.5f * x * (1.f + th);
}
__device__ __forceinline__ float dot16_fp8(const f32x2* xr, uint4 v) {
  f32x2 s = __builtin_amdgcn_cvt_pk_f32_fp8((int)v.x, false) * xr[0];
  s += __builtin_amdgcn_cvt_pk_f32_fp8((int)v.x, true) * xr[1];
  s += __builtin_amdgcn_cvt_pk_f32_fp8((int)v.y, false) * xr[2];
  s += __builtin_amdgcn_cvt_pk_f32_fp8((int)v.y, true) * xr[3];
  s += __builtin_amdgcn_cvt_pk_f32_fp8((int)v.z, false) * xr[4];
  s += __builtin_amdgcn_cvt_pk_f32_fp8((int)v.z, true) * xr[5];
  s += __builtin_amdgcn_cvt_pk_f32_fp8((int)v.w, false) * xr[6];
  s += __builtin_amdgcn_cvt_pk_f32_fp8((int)v.w, true) * xr[7];
  return s.x + s.y;
}
__device__ __forceinline__ void axpy16_fp8(f32x2* acc, float a, uint4 v) {
  f32x2 av = (f32x2){a, a};
  acc[0] += av * __builtin_amdgcn_cvt_pk_f32_fp8((int)v.x, false);
  acc[1] += av * __builtin_amdgcn_cvt_pk_f32_fp8((int)v.x, true);
  acc[2] += av * __builtin_amdgcn_cvt_pk_f32_fp8((int)v.y, false);
  acc[3] += av * __builtin_amdgcn_cvt_pk_f32_fp8((int)v.y, true);
  acc[4] += av * __builtin_amdgcn_cvt_pk_f32_fp8((int)v.z, false);
  acc[5] += av * __builtin_amdgcn_cvt_pk_f32_fp8((int)v.z, true);
  acc[6] += av * __builtin_amdgcn_cvt_pk_f32_fp8((int)v.w, false);
  acc[7] += av * __builtin_amdgcn_cvt_pk_f32_fp8((int)v.w, true);
}

__device__ __forceinline__ unsigned fkey(float f) {
  unsigned u = __float_as_uint(f);
  return (u & 0x80000000u) ? ~u : (u | 0x80000000u);
}
__device__ __forceinline__ int mbcnt64(unsigned long long m) {
  return __builtin_amdgcn_mbcnt_hi((unsigned)(m >> 32), __builtin_amdgcn_mbcnt_lo((unsigned)m, 0));
}
#define WAVE_LDS_FENCE() do { __builtin_amdgcn_fence(__ATOMIC_RELEASE, "wavefront"); __builtin_amdgcn_wave_barrier(); __builtin_amdgcn_fence(__ATOMIC_ACQUIRE, "wavefront"); } while (0)

__device__ __forceinline__ void phase_peer(const P& p, int l, char* smem) {
  const int tid = threadIdx.x, lane = tid & 63, w = tid >> 6;
  float* wl = (float*)smem + w * 512;
  float* cs = wl;
  int* ci = (int*)(wl + 32);
  int* el = (int*)(wl + 64);
  float* sl = wl + 192;
  float* as = wl + 320;
  const int nrows = (l == 1) ? ML_ROWS : MT_ROWS;
  const unsigned char* Ub = (const unsigned char*)p.Ub + (size_t)l * 16384 * 1024;
  const unsigned char* Vb = (const unsigned char*)p.Vb + (size_t)l * 16384 * 1024;
  const bool hi5 = (lane & 32) != 0, hi4 = (lane & 16) != 0, hi3 = (lane & 8) != 0, hi2 = (lane & 4) != 0;
  const int nw = gridDim.x * 4;
  for (int row = blockIdx.x * 4 + w; row < nrows; row += nw) {
    float na0, na1, nb0, nb1;
    {
      const float* sp0 = p.S + (size_t)row * 2048;
      na0 = sp0[lane]; na1 = sp0[64 + lane]; nb0 = sp0[128 + lane]; nb1 = sp0[192 + lane];
    }
#pragma unroll 1
    for (int h = 0; h < 8; h++) {
      float a0 = na0, a1 = na1, b0 = nb0, b1 = nb1;
      {
        const float* spn = p.S + (size_t)row * 2048 + ((h + 1) & 7) * 256;
        na0 = spn[lane]; na1 = spn[64 + lane]; nb0 = spn[128 + lane]; nb1 = spn[192 + lane];
      }
      unsigned kA0 = fkey(a0), kA1 = fkey(a1), kB0 = fkey(b0), kB1 = fkey(b1);
      unsigned pA = 0, pB = 0;
      bool dA = false, dB = false;
#pragma unroll 1
      for (int bit = 31; bit >= 0; --bit) {
        unsigned cA = pA | (1u << bit), cB = pB | (1u << bit);
        int nA = __popcll(__ballot(kA0 >= cA)) + __popcll(__ballot(kA1 >= cA));
        int nB = __popcll(__ballot(kB0 >= cB)) + __popcll(__ballot(kB1 >= cB));
        if (!dA && nA >= 16) { pA = cA; dA = (nA == 16); }
        if (!dB && nB >= 16) { pB = cB; dB = (nB == 16); }
        if (dA && dB) break;
      }
      {
        unsigned long long m0 = __ballot(kA0 >= pA), m1 = __ballot(kA1 >= pA);
        int p0 = mbcnt64(m0), p1 = __popcll(m0) + mbcnt64(m1);
        if (kA0 >= pA && p0 < 16) { cs[p0] = a0; ci[p0] = lane; }
        if (kA1 >= pA && p1 < 16) { cs[p1] = a1; ci[p1] = lane + 64; }
        m0 = __ballot(kB0 >= pB); m1 = __ballot(kB1 >= pB);
        p0 = mbcnt64(m0); p1 = __popcll(m0) + mbcnt64(m1);
        if (kB0 >= pB && p0 < 16) { cs[16 + p0] = b0; ci[16 + p0] = lane; }
        if (kB1 >= pB && p1 < 16) { cs[16 + p1] = b1; ci[16 + p1] = lane + 64; }
      }
      WAVE_LDS_FENCE();
      const int ii = lane >> 2, jb = (lane & 3) * 4;
      float s1 = cs[ii];
      float c0 = s1 + cs[16 + jb + 0], c1 = s1 + cs[16 + jb + 1], c2 = s1 + cs[16 + jb + 2], c3 = s1 + cs[16 + jb + 3];
      int e1 = ci[ii] * 128;
      int f0 = e1 + ci[16 + jb + 0], f1 = e1 + ci[16 + jb + 1], f2 = e1 + ci[16 + jb + 2], f3 = e1 + ci[16 + jb + 3];
      unsigned k0 = fkey(c0), k1 = fkey(c1), k2 = fkey(c2), k3 = fkey(c3);
      unsigned pC = 0;
#pragma unroll 1
      for (int bit = 31; bit >= 0; --bit) {
        unsigned cC = pC | (1u << bit);
        int n = __popcll(__ballot(k0 >= cC)) + __popcll(__ballot(k1 >= cC)) + __popcll(__ballot(k2 >= cC)) + __popcll(__ballot(k3 >= cC));
        if (n >= 16) { pC = cC; if (n == 16) break; }
      }
      {
        unsigned long long m0 = __ballot(k0 >= pC), m1 = __ballot(k1 >= pC), m2 = __ballot(k2 >= pC), m3 = __ballot(k3 >= pC);
        int q0 = mbcnt64(m0);
        int q1 = __popcll(m0) + mbcnt64(m1);
        int q2 = __popcll(m0) + __popcll(m1) + mbcnt64(m2);
        int q3 = __popcll(m0) + __popcll(m1) + __popcll(m2) + mbcnt64(m3);
        if (k0 >= pC && q0 < 16) { el[h * 16 + q0] = f0; sl[h * 16 + q0] = c0; }
        if (k1 >= pC && q1 < 16) { el[h * 16 + q1] = f1; sl[h * 16 + q1] = c1; }
        if (k2 >= pC && q2 < 16) { el[h * 16 + q2] = f2; sl[h * 16 + q2] = c2; }
        if (k3 >= pC && q3 < 16) { el[h * 16 + q3] = f3; sl[h * 16 + q3] = c3; }
      }
      WAVE_LDS_FENCE();
    }
    {
      float v0 = sl[lane], v1 = sl[64 + lane];
      float m0 = v0, m1 = v1;
#pragma unroll
      for (int o = 1; o < 16; o <<= 1) { m0 = fmaxf(m0, __shfl_xor(m0, o)); m1 = fmaxf(m1, __shfl_xor(m1, o)); }
      float e0 = __expf(v0 - m0), e1 = __expf(v1 - m1);
      float s0 = e0, s1 = e1;
#pragma unroll
      for (int o = 1; o < 16; o <<= 1) { s0 += __shfl_xor(s0, o); s1 += __shfl_xor(s1, o); }
      sl[lane] = e0 / s0;
      sl[64 + lane] = e1 / s1;
    }
    f32x2 xr[8];
    {
      const uint4* xp = (const uint4*)(p.xn + (size_t)row * 1024 + lane * 16);
#pragma unroll
      for (int c = 0; c < 2; c++) {
        uint4 v = xp[c];
        xr[c * 4 + 0] = (f32x2){bflo(v.x), bfhi(v.x)}; xr[c * 4 + 1] = (f32x2){bflo(v.y), bfhi(v.y)};
        xr[c * 4 + 2] = (f32x2){bflo(v.z), bfhi(v.z)}; xr[c * 4 + 3] = (f32x2){bflo(v.w), bfhi(v.w)};
      }
    }
    WAVE_LDS_FENCE();
    uint4 cur[8];
#pragma unroll
    for (int i = 0; i < 8; i++) cur[i] = *(const uint4*)(Ub + (size_t)el[i] * 1024 + lane * 16);
#pragma unroll 1
    for (int bt = 0; bt < 16; bt++) {
      uint4 nxt[8];
      {
        const unsigned char* tb = (bt < 15) ? Ub : Vb;
        const int nb = ((bt + 1) & 15) * 8;
#pragma unroll
        for (int i = 0; i < 8; i++) nxt[i] = *(const uint4*)(tb + (size_t)el[nb + i] * 1024 + lane * 16);
      }
      float d0 = dot16_fp8(xr, cur[0]), d1 = dot16_fp8(xr, cur[1]), d2 = dot16_fp8(xr, cur[2]), d3 = dot16_fp8(xr, cur[3]);
      float d4 = dot16_fp8(xr, cur[4]), d5 = dot16_fp8(xr, cur[5]), d6 = dot16_fp8(xr, cur[6]), d7 = dot16_fp8(xr, cur[7]);
      float k0 = (hi5 ? d4 : d0) + __shfl_xor(hi5 ? d0 : d4, 32);
      float k1 = (hi5 ? d5 : d1) + __shfl_xor(hi5 ? d1 : d5, 32);
      float k2 = (hi5 ? d6 : d2) + __shfl_xor(hi5 ? d2 : d6, 32);
      float k3 = (hi5 ? d7 : d3) + __shfl_xor(hi5 ? d3 : d7, 32);
      float j0 = (hi4 ? k2 : k0) + __shfl_xor(hi4 ? k0 : k2, 16);
      float j1 = (hi4 ? k3 : k1) + __shfl_xor(hi4 ? k1 : k3, 16);
      float i0 = (hi3 ? j1 : j0) + __shfl_xor(hi3 ? j0 : j1, 8);
      i0 += __shfl_xor(i0, 4);
      i0 += __shfl_xor(i0, 2);
      i0 += __shfl_xor(i0, 1);
      if ((lane & 7) == 0) {
        int k = bt * 8 + (lane >> 3);
        as[k] = gelu_tanh(i0 * (1.f / 64.f)) * sl[k];
      }
#pragma unroll
      for (int i = 0; i < 8; i++) cur[i] = nxt[i];
    }
    WAVE_LDS_FENCE();
    f32x2 acc[8];
#pragma unroll
    for (int i = 0; i < 8; i++) acc[i] = (f32x2){0.f, 0.f};
#pragma unroll 1
    for (int bt = 0; bt < 16; bt++) {
      uint4 nxt[8];
      if (bt < 15) {
#pragma unroll
        for (int i = 0; i < 8; i++) nxt[i] = *(const uint4*)(Vb + (size_t)el[(bt + 1) * 8 + i] * 1024 + lane * 16);
      }
#pragma unroll
      for (int i = 0; i < 8; i++) axpy16_fp8(acc, as[bt * 8 + i], cur[i]);
      if (bt < 15) {
#pragma unroll
        for (int i = 0; i < 8; i++) cur[i] = nxt[i];
      }
    }
    {
      int mr = row < ML_ROWS ? (row >> 11) : 8;
      const float4* g2p = (const float4*)(p.mod + (size_t)(l * 9 + mr) * 6144 + 5120 + lane * 16);
      float4* dst = (float4*)(row < ML_ROWS ? p.out + (size_t)row * 1024 + lane * 16 : p.hc + (size_t)(row - ML_ROWS) * 1024 + lane * 16);
#pragma unroll
      for (int i = 0; i < 4; i++) {
        float4 g2 = g2p[i];
        float4 cur = dst[i];
        cur.x += g2.x * 0.125f * acc[i * 2 + 0].x;
        cur.y += g2.y * 0.125f * acc[i * 2 + 0].y;
        cur.z += g2.z * 0.125f * acc[i * 2 + 1].x;
        cur.w += g2.w * 0.125f * acc[i * 2 + 1].y;
        dst[i] = cur;
      }
    }
    WAVE_LDS_FENCE();
  }
}

#define RUN(k, call)                         \
  if (lo <= (k) && (k) < hi) {               \
    call;                                    \
    if ((k) + 1 < hi) xcd_barrier(xb);       \
  }
#define LAYER(l, base)                                                                                                    \
  RUN(base + 0, phase_norm(p, l, 1))                                                                                     \
  RUN(base + 1, phase_gemm<0>(p, l, p.xn, p.WinT + (size_t)l * INC_PAD * 1024, MT_ROWS / 128, INC_PAD / 128, smem))     \
  RUN(base + 2, phase_mixprep(p, l, smem))                                                                               \
  RUN(base + 3, phase_attn_mlA(p, l, smem))                                                                              \
  RUN(base + 4, phase_attn_mlB(p, l, smem))                                                                                            \
  RUN(base + 5, phase_mlC(p, l, smem))                                                                                   \
  RUN(base + 6, phase_gemm<1>(p, l, p.Y, p.WoutT + (size_t)l * 1024 * 1024, (l == 0 ? MT_ROWS : ML_ROWS) / 128, 8, smem)) \
  RUN(base + 7, phase_norm(p, l, 2))                                                                                     \
  RUN(base + 8, phase_gemm<2>(p, l, p.xn, p.WsT + (size_t)l * 2048 * 1024, (l == 0 ? MT_ROWS : ML_ROWS) / 128, 16, smem)) \
  RUN(base + 9, phase_peer(p, l, smem))

__global__ void __launch_bounds__(256, 2) fwd_kernel(P p) {
  __shared__ __attribute__((aligned(16))) char smem[SMEM_BYTES];
  __shared__ uint4 xb_words;
  cg::grid_group grid = cg::this_grid();
  const int lo = (int)p.ph_lo, hi = (int)p.ph_hi;
  if (threadIdx.x == 0) xb_words = make_uint4(0u, 0u, 0u, 0u);
  __syncthreads();
  XcdBarrier xb = xcd_barrier_post(p.bar, (volatile LAS unsigned*)&xb_words);
  if (hi - lo > 1) grid.sync();
  RUN(0, phase_prologue(p, smem))
  LAYER(0, 1)
  LAYER(1, 11)
}

extern "C" void kernel_launch(void* const* d_in, const int* in_sizes, int n_in, void* d_out, int out_size, void* d_ws,
                              size_t ws_size, hipStream_t stream) {
  static int grid_blocks = 0;
  if (!grid_blocks) {
    int dev = 0, cus = 0, per_cu = 0;
    hipGetDevice(&dev);
    hipDeviceGetAttribute(&cus, hipDeviceAttributeMultiprocessorCount, dev);
    hipOccupancyMaxActiveBlocksPerMultiprocessor(&per_cu, fwd_kernel, 256, 0);
    if (per_cu < 1) per_cu = 1;
    if (per_cu > 2) per_cu = 2;
    grid_blocks = cus * per_cu;
  }
  P p{};
  const float** ins = (const float**)&p;
  for (int i = 0; i < 22; i++) ins[i] = (const float*)d_in[i];
  p.out = (float*)d_out;
  char* ws = (char*)d_ws;
  size_t off = 0;
  auto take = [&](size_t bytes) { char* r = ws + off; off += (bytes + 255) & ~(size_t)255; return r; };
  p.WinT = (u16*)take((size_t)2 * INC_PAD * 1024 * 2);
  p.WoutT = (u16*)take((size_t)2 * 1024 * 1024 * 2);
  p.WsT = (u16*)take((size_t)2 * 2048 * 1024 * 2);
  p.Ub = (u16*)take((size_t)2 * 16384 * 1024 * 2);
  p.Vb = (u16*)take((size_t)2 * 16384 * 1024 * 2);
  p.mod = (float*)take((size_t)2 * 9 * 6144 * 4);
  p.xn = (u16*)take((size_t)MT_ROWS * 1024 * 2);
  p.U = (u16*)take((size_t)MT_ROWS * INC * 2);
  p.MQK = (float*)take((size_t)MT_ROWS * 512 * 4);
  p.Y = (u16*)take((size_t)MT_ROWS * 1024 * 2);
  p.S = (float*)p.U;
  p.G = (float*)take((size_t)MT_ROWS * 16 * 4);
  p.mst = (float*)take((size_t)2304 * SLOT * 4);
  p.hc = (float*)take((size_t)MC_ROWS * 1024 * 4);
  p.bar = (unsigned*)take((size_t)XCD_BAR_WORDS * 4);
  p.VTm = (u16*)take((size_t)(8 * 4 * 64) * (2048 + 256) * 2);
  p.VT = (u16*)take((size_t)(8 * 8 * 64) * (2048 + 256) * 2);
  if (off > ws_size) { fprintf(stderr, "workspace too small: need %zu have %zu\n", off, ws_size); return; }
  (void)hipMemsetAsync(p.bar, 0, (size_t)XCD_BAR_WORDS * 4, stream);
#if MEGA
  p.ph_lo = 0; p.ph_hi = NPHASES;
  void* args[] = {&p};
  hipError_t e = hipLaunchCooperativeKernel((void*)fwd_kernel, dim3(grid_blocks), dim3(256), args, 0, stream);
  if (e != hipSuccess) fprintf(stderr, "cooperative launch failed: %s (grid %d)\n", hipGetErrorString(e), grid_blocks);
#else
  for (int ph = 0; ph < NPHASES; ph++) {
    p.ph_lo = ph; p.ph_hi = ph + 1;
    void* args[] = {&p};
    hipError_t e = hipLaunchCooperativeKernel((void*)fwd_kernel, dim3(grid_blocks), dim3(256), args, 0, stream);
    if (e != hipSuccess) fprintf(stderr, "cooperative launch failed: %s (grid %d)\n", hipGetErrorString(e), grid_blocks);
  }
#endif
}
```

```cpp
#include <hip/hip_runtime.h>
#include <hip/hip_cooperative_groups.h>
#include <cstdio>
namespace cg = cooperative_groups;

#ifndef MEGA
#define MEGA 1
#endif

typedef unsigned short u16;
typedef __attribute__((ext_vector_type(8))) short bf16x8;
typedef __attribute__((ext_vector_type(4))) float f32x4;

#define ML_ROWS 16384
#define MC_ROWS 2048
#define MT_ROWS 18432
#define INC 2832
#define INC_PAD 2944
#define SLOT 4480
#define SMEM_BYTES 69632
#define NPHASES 25

struct P {
  const float *x, *c, *ctx, *c_ctx, *w_ada, *b_ada, *norm1_g, *w_in, *ml_gate_b, *na_q_g, *na_k_g, *na_rpb,
      *pool_w, *pool_scale, *ml_conv, *ml_norm_g, *w_out, *norm2_g, *peer_wq, *peer_keys, *peer_u, *peer_v;
  float* out;
  u16 *WinT, *WoutT, *WsT, *Ub, *Vb;
  float* mod;
  u16* xn;
  u16* U;
  float* MQK;
  u16* Y;
  float* S;
  float* G;
  float* mst;
  float* hc;
  u16* VT;
  u16* VTm;
  int* elist;
  float* glist;
  float* hp;
  unsigned* bar;
  long long ph_lo, ph_hi;
};

__device__ __forceinline__ u16 f2bf(float f) {
  unsigned u = __float_as_uint(f);
  u += 0x7fffu + ((u >> 16) & 1u);
  return (u16)(u >> 16);
}
__device__ __forceinline__ float bf2f(u16 h) { return __uint_as_float(((unsigned)h) << 16); }
__device__ __forceinline__ float bflo(unsigned u) { return __uint_as_float(u << 16); }
__device__ __forceinline__ float bfhi(unsigned u) { return __uint_as_float(u & 0xffff0000u); }
__device__ __forceinline__ unsigned pack2(float a, float b) { return (unsigned)f2bf(a) | ((unsigned)f2bf(b) << 16); }
__device__ __forceinline__ float wave_sum(float v) {
#pragma unroll
  for (int o = 32; o; o >>= 1) v += __shfl_xor(v, o);
  return v;
}
__device__ __forceinline__ void wave_argmax(float& v, int& i) {
#pragma unroll
  for (int o = 32; o; o >>= 1) {
    float ov = __shfl_xor(v, o);
    int oi = __shfl_xor(i, o);
    if (ov > v || (ov == v && oi < i)) { v = ov; i = oi; }
  }
}
__device__ __forceinline__ float sigmoidf_(float x) { return 1.f / (1.f + __expf(-x)); }
__device__ __forceinline__ float siluf_(float x) { return x / (1.f + __expf(-x)); }

#define XB_TMO      128
#define XB_XCNT(j)  (256  + 64 * (j))
#define XB_XSUB(j)  (1280 + 64 * (j))
#define XB_XGEN(j)  (2304 + 64 * (j))
#define XB_TOP      3328
#define XB_TOPGEN   3392
#define XCD_BAR_WORDS 3456
#define XB_SPIN_CAP (1u << 18)
#define LAS __attribute__((address_space(3)))
__device__ __forceinline__ unsigned xb_ld(unsigned* p)              { return __hip_atomic_load(p, __ATOMIC_RELAXED, __HIP_MEMORY_SCOPE_AGENT); }
__device__ __forceinline__ unsigned xb_add(unsigned* p, unsigned v) { return __hip_atomic_fetch_add(p, v, __ATOMIC_RELAXED, __HIP_MEMORY_SCOPE_AGENT); }
__device__ __forceinline__ unsigned xb_xcc_id() { return (unsigned)__builtin_amdgcn_s_getreg((3 << 11) | 20) & 0xFu; }
#define XB_SPIN(cond, bar) do { unsigned _sp = 0; while (cond) { __builtin_amdgcn_s_sleep(1); \
    if ((++_sp & 255u) == 0u) { if (xb_ld(&(bar)[XB_TMO])) break; if (_sp > XB_SPIN_CAP) { atomicAdd(&(bar)[XB_TMO], 1u); break; } } } } while (0)
struct XcdBarrier { unsigned* bar; unsigned x; volatile LAS unsigned* st; };
__device__ __forceinline__ XcdBarrier xcd_barrier_post(unsigned* bar, volatile LAS unsigned* st) {
    XcdBarrier b; b.bar = bar; b.x = xb_xcc_id(); b.st = st;
    if (threadIdx.x == 0) (void)xb_add(&bar[XB_XCNT(b.x)], 1u);
    return b;
}
__device__ __forceinline__ void xcd_barrier_complete(unsigned* bar, unsigned x, unsigned& nloc, unsigned& nx) {
    const unsigned G = gridDim.x * gridDim.y * gridDim.z;
    unsigned sum, cnt, mine, sp = 0u;
    for (;;) {
        sum = 0u; cnt = 0u; mine = 0u;
#pragma unroll
        for (unsigned j = 0; j < 16; ++j) { const unsigned c = xb_ld(&bar[XB_XCNT(j)]); sum += c; cnt += (c > 0u) ? 1u : 0u; mine = (j == x) ? c : mine; }
        if (sum == G) break;
        __builtin_amdgcn_s_sleep(1);
        if ((++sp & 255u) == 0u) { if (xb_ld(&bar[XB_TMO])) break; if (sp > XB_SPIN_CAP) { atomicAdd(&bar[XB_TMO], 1u); break; } }
    }
    nloc = mine > 0u ? mine : 1u; nx = cnt > 0u ? cnt : 1u;
}
__device__ __forceinline__ void xcd_barrier(const XcdBarrier& b) {
    asm volatile("s_waitcnt vmcnt(0)" ::: "memory");
    __syncthreads();
    if (threadIdx.x == 0) {
        unsigned* bar = b.bar;
        __builtin_amdgcn_s_waitcnt(0);
        unsigned nloc = b.st[0], nx = b.st[1];
        if (nloc == 0u) { xcd_barrier_complete(bar, b.x, nloc, nx); b.st[0] = nloc; b.st[1] = nx; }
        const unsigned old = xb_add(&bar[XB_XSUB(b.x)], 1u);
        const unsigned gen = old / nloc;
        if (old + 1u == (gen + 1u) * nloc) {
            __builtin_amdgcn_fence(__ATOMIC_RELEASE, "agent");
            asm volatile("s_waitcnt vmcnt(0)" ::: "memory");
            const unsigned og = xb_add(&bar[XB_TOP], 1u);
            const unsigned tg = og / nx;
            if (og + 1u == (tg + 1u) * nx) xb_add(&bar[XB_TOPGEN], 1u);
            else XB_SPIN(xb_ld(&bar[XB_TOPGEN]) == tg, bar);
            __builtin_amdgcn_fence(__ATOMIC_ACQUIRE, "agent");
            xb_add(&bar[XB_XGEN(b.x)], 1u);
            asm volatile("s_waitcnt vmcnt(0)" ::: "memory");
        } else {
            XB_SPIN(xb_ld(&bar[XB_XGEN(b.x)]) == gen, bar);
            __builtin_amdgcn_fence(__ATOMIC_ACQUIRE, "agent");
            asm volatile("s_waitcnt vmcnt(0)" ::: "memory");
        }
    }
    __syncthreads();
}

__device__ __forceinline__ void transpose_item(const float* __restrict__ src, int N, u16* __restrict__ dst, int kt, int nt, float* tl) {
  const int tid = threadIdx.x;
#pragma unroll 4
  for (int i = 0; i < 16; i++) {
    int idx = tid + 256 * i;
    int kk = idx >> 6, nn = idx & 63;
    int n = nt * 64 + nn;
    float v = (n < N) ? src[(size_t)(kt * 64 + kk) * N + n] : 0.f;
    tl[kk * 65 + nn] = v;
  }
  __syncthreads();
#pragma unroll 4
  for (int i = 0; i < 16; i++) {
    int idx = tid + 256 * i;
    int nn = idx >> 6, kk = idx & 63;
    dst[(size_t)(nt * 64 + nn) * 1024 + kt * 64 + kk] = f2bf(tl[kk * 65 + nn]);
  }
  __syncthreads();
}

__device__ __forceinline__ void wst_item(const P& p, int it, float* sm) {
  const int tid = threadIdx.x;
  int l = it >> 8, hp = (it >> 4) & 15, dt = it & 15;
  float* As = sm;
  float* Ks = sm + 64 * 33;
  const float* wq = p.peer_wq + (size_t)l * 1024 * 2048;
  const float* keys = p.peer_keys + ((size_t)l * 16 + hp) * 128 * 128;
  int d = tid & 63, cg_ = tid >> 6;
  float acc[32];
#pragma unroll
  for (int c = 0; c < 32; c++) acc[c] = 0.f;
  for (int jc = 0; jc < 4; jc++) {
    __syncthreads();
#pragma unroll
    for (int i = 0; i < 8; i++) {
      int idx = tid + 256 * i;
      int dd = idx >> 5, j = idx & 31;
      As[dd * 33 + j] = wq[(size_t)(dt * 64 + dd) * 2048 + hp * 128 + jc * 32 + j];
    }
#pragma unroll
    for (int i = 0; i < 16; i++) {
      int idx = tid + 256 * i;
      int k = idx >> 5, j = idx & 31;
      Ks[k * 33 + j] = keys[k * 128 + jc * 32 + j];
    }
    __syncthreads();
    for (int j = 0; j < 32; j++) {
      float a = As[d * 33 + j];
#pragma unroll
      for (int c = 0; c < 32; c++) acc[c] += a * Ks[(cg_ * 32 + c) * 33 + j];
    }
  }
  u16* dst = p.WsT + (size_t)l * 2048 * 1024;
#pragma unroll
  for (int c = 0; c < 32; c++) dst[(size_t)(hp * 128 + cg_ * 32 + c) * 1024 + dt * 64 + d] = f2bf(acc[c]);
  __syncthreads();
}

__device__ __forceinline__ void mod_item(const P& p, int it, float* sm) {
  const int tid = threadIdx.x;
  int l = it / 96, cc = it % 96;
  float* sc = sm;
  float* red = sm + 9216;
  for (int idx = tid; idx < 9216; idx += 256) {
    int r = idx >> 10, k = idx & 1023;
    float v = (r < 8) ? p.c[r * 1024 + k] : p.c_ctx[k];
    sc[idx] = siluf_(v);
  }
  __syncthreads();
  int cl = tid & 63, kg = tid >> 6;
  int col = cc * 64 + cl;
  float acc[9];
#pragma unroll
  for (int r = 0; r < 9; r++) acc[r] = 0.f;
  const float* wa = p.w_ada + (size_t)l * 1024 * 6144;
#pragma unroll 16
  for (int k = kg * 256; k < kg * 256 + 256; k++) {
    float w = wa[(size_t)k * 6144 + col];
#pragma unroll
    for (int r = 0; r < 9; r++) acc[r] += sc[r * 1024 + k] * w;
  }
#pragma unroll
  for (int r = 0; r < 9; r++) red[(kg * 9 + r) * 64 + cl] = acc[r];
  __syncthreads();
  if (kg == 0) {
    float bb = p.b_ada[l * 6144 + col];
#pragma unroll
    for (int r = 0; r < 9; r++) {
      float s = red[(0 * 9 + r) * 64 + cl] + red[(1 * 9 + r) * 64 + cl] + red[(2 * 9 + r) * 64 + cl] + red[(3 * 9 + r) * 64 + cl];
      p.mod[(size_t)(l * 9 + r) * 6144 + col] = s + bb;
    }
  }
  __syncthreads();
}

__device__ __forceinline__ void phase_prologue(const P& p, char* smem) {
  float* sm = (float*)smem;
  const int tid = threadIdx.x;
  const int N_A = 2 * 16 * 46, N_B = 2 * 16 * 16, N_C = 512, N_D = 192, N_E = 4096;
  const int total = N_A + N_B + N_C + N_D + N_E;
  for (int item = blockIdx.x; item < total; item += gridDim.x) {
    int it = item;
    if (it < N_D) { mod_item(p, it, sm); continue; }
    it -= N_D;
    if (it < N_C) { wst_item(p, it, sm); continue; }
    it -= N_C;
    if (it < N_A) {
      int l = it / (16 * 46), r = it % (16 * 46);
      transpose_item(p.w_in + (size_t)l * 1024 * INC, INC, p.WinT + (size_t)l * INC_PAD * 1024, r / 46, r % 46, sm);
      continue;
    }
    it -= N_A;
    if (it < N_B) {
      int l = it >> 8, r = it & 255;
      transpose_item(p.w_out + (size_t)l * 1024 * 1024, 1024, p.WoutT + (size_t)l * 1024 * 1024, r >> 4, r & 15, sm);
      continue;
    }
    it -= N_B;
    {
      int tab = it >> 11;
      int chunk = it & 2047;
      const float scl = tab ? 8.f : 64.f;
      const float4* src = (const float4*)(tab ? p.peer_v : p.peer_u) + (size_t)chunk * 4096;
      unsigned char* dstb = (unsigned char*)(tab ? p.Vb : p.Ub);
#pragma unroll
      for (int i = 0; i < 4; i++) {
        int q = i * 256 + tid;
        float4 v0 = src[q * 4 + 0], v1 = src[q * 4 + 1], v2 = src[q * 4 + 2], v3 = src[q * 4 + 3];
        uint4 o;
        int w_;
        w_ = __builtin_amdgcn_cvt_pk_fp8_f32(v0.x * scl, v0.y * scl, 0, false);
        w_ = __builtin_amdgcn_cvt_pk_fp8_f32(v0.z * scl, v0.w * scl, w_, true);
        o.x = (unsigned)w_;
        w_ = __builtin_amdgcn_cvt_pk_fp8_f32(v1.x * scl, v1.y * scl, 0, false);
        w_ = __builtin_amdgcn_cvt_pk_fp8_f32(v1.z * scl, v1.w * scl, w_, true);
        o.y = (unsigned)w_;
        w_ = __builtin_amdgcn_cvt_pk_fp8_f32(v2.x * scl, v2.y * scl, 0, false);
        w_ = __builtin_amdgcn_cvt_pk_fp8_f32(v2.z * scl, v2.w * scl, w_, true);
        o.z = (unsigned)w_;
        w_ = __builtin_amdgcn_cvt_pk_fp8_f32(v3.x * scl, v3.y * scl, 0, false);
        w_ = __builtin_amdgcn_cvt_pk_fp8_f32(v3.z * scl, v3.w * scl, w_, true);
        o.w = (unsigned)w_;
        {
          unsigned G = (unsigned)chunk * 1024u + (unsigned)q;
          unsigned ll = G >> 20, ee = (G >> 6) & 16383u, cgp = G & 63u;
          size_t off = ((size_t)((ll * 8u + (cgp >> 3)) * 16384u + ee)) * 128 + (cgp & 7u) * 16;
          *(uint4*)(dstb + off) = o;
        }
      }
    }
  }
}

__device__ __forceinline__ void phase_norm(const P& p, int l, int which) {
  const int tid = threadIdx.x, lane = tid & 63, w = tid >> 6;
  const int nrows = (which == 2 && l == 1) ? ML_ROWS : MT_ROWS;
  const float* g = (which == 1 ? p.norm1_g : p.norm2_g) + l * 1024;
  for (int item = blockIdx.x; item * 4 < nrows; item += gridDim.x) {
    int row = item * 4 + w;
    const float* src;
    if (l == 0 && which == 1) src = row < ML_ROWS ? p.x + (size_t)row * 1024 : p.ctx + (size_t)(row - ML_ROWS) * 1024;
    else src = row < ML_ROWS ? p.out + (size_t)row * 1024 : p.hc + (size_t)(row - ML_ROWS) * 1024;
    int mr = row < ML_ROWS ? (row >> 11) : 8;
    const float* modp = p.mod + (size_t)(l * 9 + mr) * 6144;
    const float* sh = modp + (which == 1 ? 0 : 3072);
    const float* sc = modp + (which == 1 ? 1024 : 4096);
    float4 v[4];
    float ss = 0.f;
#pragma unroll
    for (int i = 0; i < 4; i++) {
      v[i] = ((const float4*)src)[i * 64 + lane];
      ss += v[i].x * v[i].x + v[i].y * v[i].y + v[i].z * v[i].z + v[i].w * v[i].w;
    }
    ss = wave_sum(ss);
    float rs = rsqrtf(ss * (1.f / 1024.f) + 1e-6f);
#pragma unroll
    for (int i = 0; i < 4; i++) {
      int d = (i * 64 + lane) * 4;
      float4 gg = *(const float4*)(g + d);
      float4 s4 = *(const float4*)(sc + d);
      float4 h4 = *(const float4*)(sh + d);
      float o0 = v[i].x * rs * gg.x * (1.f + s4.x) + h4.x;
      float o1 = v[i].y * rs * gg.y * (1.f + s4.y) + h4.y;
      float o2 = v[i].z * rs * gg.z * (1.f + s4.z) + h4.z;
      float o3 = v[i].w * rs * gg.w * (1.f + s4.w) + h4.w;
      uint2 o;
      o.x = pack2(o0, o1);
      o.y = pack2(o2, o3);
      ((uint2*)(p.xn + (size_t)row * 1024))[i * 64 + lane] = o;
    }
  }
}

template <int EPI>
__device__ __forceinline__ void phase_gemm(const P& p, int l, const u16* __restrict__ A, const u16* __restrict__ Bt, int mtiles, int ntiles,
                           char* smem) {
  u16* As = (u16*)smem;
  u16* Bs = As + 128 * 40;
  const int tid = threadIdx.x, lane = tid & 63, w = tid >> 6, wm = w >> 1, wn = w & 1;
  const int lr = lane & 15, quad = lane >> 4;
  const int nitems = mtiles * ntiles;
  for (int item = blockIdx.x; item < nitems; item += gridDim.x) {
    int mt = item / ntiles, nt = item - mt * ntiles;
    int m0 = mt * 128, n0 = nt * 128;
    f32x4 acc[4][4];
#pragma unroll
    for (int i = 0; i < 4; i++)
#pragma unroll
      for (int j = 0; j < 4; j++) acc[i][j] = (f32x4){0.f, 0.f, 0.f, 0.f};
    const int r0_ = tid >> 2, ch_ = tid & 3;
    const u16* Ap0 = A + (size_t)(m0 + r0_) * 1024 + ch_ * 8;
    const u16* Ap1 = Ap0 + (size_t)64 * 1024;
    const u16* Bp0 = Bt + (size_t)(n0 + r0_) * 1024 + ch_ * 8;
    const u16* Bp1 = Bp0 + (size_t)64 * 1024;
    uint4 ra0 = *(const uint4*)Ap0, ra1 = *(const uint4*)Ap1, rb0 = *(const uint4*)Bp0, rb1 = *(const uint4*)Bp1;
    for (int kt = 0; kt < 32; kt++) {
      __syncthreads();
      *(uint4*)(As + r0_ * 40 + ch_ * 8) = ra0;
      *(uint4*)(As + (r0_ + 64) * 40 + ch_ * 8) = ra1;
      *(uint4*)(Bs + r0_ * 40 + ch_ * 8) = rb0;
      *(uint4*)(Bs + (r0_ + 64) * 40 + ch_ * 8) = rb1;
      __syncthreads();
      if (kt < 31) {
        ra0 = *(const uint4*)(Ap0 + (kt + 1) * 32);
        ra1 = *(const uint4*)(Ap1 + (kt + 1) * 32);
        rb0 = *(const uint4*)(Bp0 + (kt + 1) * 32);
        rb1 = *(const uint4*)(Bp1 + (kt + 1) * 32);
      }
      bf16x8 a[4], b[4];
#pragma unroll
      for (int i = 0; i < 4; i++) {
        a[i] = *(const bf16x8*)(As + (wm * 64 + i * 16 + lr) * 40 + quad * 8);
        b[i] = *(const bf16x8*)(Bs + (wn * 64 + i * 16 + lr) * 40 + quad * 8);
      }
#pragma unroll
      for (int i = 0; i < 4; i++)
#pragma unroll
        for (int j = 0; j < 4; j++) acc[i][j] = __builtin_amdgcn_mfma_f32_16x16x32_bf16(a[i], b[j], acc[i][j], 0, 0, 0);
    }
#pragma unroll
    for (int i = 0; i < 4; i++)
#pragma unroll
      for (int j = 0; j < 4; j++)
#pragma unroll
        for (int r = 0; r < 4; r++) {
          int row = m0 + wm * 64 + i * 16 + quad * 4 + r;
          int col = n0 + wn * 64 + j * 16 + lr;
          float v = acc[i][j][r];
          if (EPI == 0) {
            if (col < INC) {
              p.U[(size_t)row * INC + col] = f2bf(v);
              if (col >= 2816) p.G[row * 16 + (col - 2816)] = v;
            }
          } else if (EPI == 1) {
            int mr = row < ML_ROWS ? (row >> 11) : 8;
            float g1 = p.mod[(size_t)(l * 9 + mr) * 6144 + 2048 + col];
            float sv;
            if (l == 0) sv = row < ML_ROWS ? p.x[(size_t)row * 1024 + col] : p.ctx[(size_t)(row - ML_ROWS) * 1024 + col];
            else sv = p.out[(size_t)row * 1024 + col];
            float* dst = row < ML_ROWS ? p.out + (size_t)row * 1024 + col : p.hc + (size_t)(row - ML_ROWS) * 1024 + col;
            *dst = sv + g1 * v;
          } else {
            p.S[(size_t)row * 2048 + col] = v;
          }
        }
  }
}

__device__ __forceinline__ void vt_item(const P& p, int it, u16* tl);
__device__ __forceinline__ void phase_mixprep(const P& p, int l, char* smem) {
  const int tid = threadIdx.x;
  float* pl = (float*)smem;
  const int N_QK = MT_ROWS * 16 / 256;
  const int N_POOL = (l == 0 ? MT_ROWS : ML_ROWS) / 16;
  const int N_PREP = MT_ROWS / 8;
  const int N_VT = 2304 + 1152;
  const int total = N_QK + N_POOL + N_PREP + N_VT;
  for (int item = blockIdx.x; item < total; item += gridDim.x) {
    int it = item;
    if (it >= N_QK + N_POOL + N_PREP) { vt_item(p, it - (N_QK + N_POOL + N_PREP), (u16*)smem); continue; }
    if (it < N_QK) {
      int gi = it * 256 + tid;
      int row = gi >> 4, sub = gi & 15;
      int qk = sub >> 3, h = sub & 7;
      u16* ptr = p.U + (size_t)row * INC + qk * 512 + h * 64;
      const float* g = (qk ? p.na_k_g : p.na_q_g) + l * 64;
      uint4 v[8];
      float ss = 0.f;
#pragma unroll
      for (int c = 0; c < 8; c++) {
        v[c] = ((const uint4*)ptr)[c];
        float a;
        a = bflo(v[c].x); ss += a * a; a = bfhi(v[c].x); ss += a * a;
        a = bflo(v[c].y); ss += a * a; a = bfhi(v[c].y); ss += a * a;
        a = bflo(v[c].z); ss += a * a; a = bfhi(v[c].z); ss += a * a;
        a = bflo(v[c].w); ss += a * a; a = bfhi(v[c].w); ss += a * a;
      }
      float rs = rsqrtf(ss * (1.f / 64.f) + 1e-6f);
#pragma unroll
      for (int c = 0; c < 8; c++) {
        uint4 o;
        o.x = pack2(bflo(v[c].x) * rs * g[c * 8 + 0], bfhi(v[c].x) * rs * g[c * 8 + 1]);
        o.y = pack2(bflo(v[c].y) * rs * g[c * 8 + 2], bfhi(v[c].y) * rs * g[c * 8 + 3]);
        o.z = pack2(bflo(v[c].z) * rs * g[c * 8 + 4], bfhi(v[c].z) * rs * g[c * 8 + 5]);
        o.w = pack2(bflo(v[c].w) * rs * g[c * 8 + 6], bfhi(v[c].w) * rs * g[c * 8 + 7]);
        ((uint4*)ptr)[c] = o;
      }
      continue;
    }
    it -= N_QK;
    if (it < N_POOL) {
      int row0 = it * 16;
      int base, T;
      if (row0 < ML_ROWS) { base = (row0 >> 11) << 11; T = 2048; }
      else { base = ML_ROWS + (((row0 - ML_ROWS) >> 8) << 8); T = 256; }
      int t0 = row0 - base;
      int ch = tid, g = ch >> 6;
      int wdw = 2 << g;
      __syncthreads();
      {
        float vals[31];
#pragma unroll
        for (int j = 0; j < 31; j++) {
          int tau = t0 - 8 + j;
          bool ok = (tau >= 0) && (tau < T);
          vals[j] = ok ? bf2f(p.U[(size_t)(base + (ok ? tau : t0)) * INC + 1536 + ch]) : 0.f;
        }
        const int hl = wdw / 2, hr = wdw - wdw / 2 - 1;
#pragma unroll
        for (int tt = 0; tt < 16; tt++) {
          int t = t0 + tt;
          int lo = max(t - hl, 0), hi = min(t + hr, T - 1);
          float s = 0.f;
#pragma unroll
          for (int j = 0; j < 31; j++) {
            int rel = j - 8 - tt;
            if (rel >= -8 && rel <= 7) s += (rel >= -hl && rel <= hr) ? vals[j] : 0.f;
          }
          pl[tt * 256 + ch] = s / (float)(hi - lo + 1) - vals[8 + tt];
        }
      }
      __syncthreads();
      float acc[16];
#pragma unroll
      for (int tt = 0; tt < 16; tt++) acc[tt] = 0.f;
      int d = ch & 63;
      const float* pw = p.pool_w + ((size_t)(l * 4 + g) * 64) * 64 + d;
      for (int c = 0; c < 64; c++) {
        float wv = pw[c * 64];
#pragma unroll
        for (int tt = 0; tt < 16; tt++) acc[tt] += pl[tt * 256 + g * 64 + c] * wv;
      }
      float ps = p.pool_scale[l * 256 + ch];
#pragma unroll
      for (int tt = 0; tt < 16; tt++) p.Y[(size_t)(row0 + tt) * 1024 + 512 + ch] = f2bf(acc[tt] * ps);
      continue;
    }
    it -= N_POOL;
    {
      const int row0 = it * 8;
      int base, T;
      if (row0 < ML_ROWS) { base = (row0 >> 11) << 11; T = 2048; }
      else { base = ML_ROWS + (((row0 - ML_ROWS) >> 8) << 8); T = 256; }
      const int t0 = row0 - base;
      const int qk = tid >> 7, hh = (tid >> 5) & 3, ax = (tid >> 4) & 1, f = tid & 15;
      const int ca = qk * 256 + hh * 64 + ax * 32 + f, cb = ca + 16;
      float ua[12], ub[12];
#pragma unroll
      for (int j = 0; j < 12; j++) {
        int tt = t0 + j - 2;
        bool ok = (tt >= 0) && (tt < T);
        const u16* ur = p.U + (size_t)(base + (ok ? tt : t0)) * INC + 1792;
        ua[j] = ok ? bf2f(ur[ca]) : 0.f;
        ub[j] = ok ? bf2f(ur[cb]) : 0.f;
      }
      float wa[5], wb[5];
#pragma unroll
      for (int j = 0; j < 5; j++) { wa[j] = p.ml_conv[(l * 5 + j) * 512 + ca]; wb[j] = p.ml_conv[(l * 5 + j) * 512 + cb]; }
      const float inv = __expf(-(float)f * (9.210340371976184f / 16.f));
#pragma unroll
      for (int i = 0; i < 8; i++) {
        float a = 0.f, b = 0.f;
#pragma unroll
        for (int j = 0; j < 5; j++) { a += wa[j] * ua[i + j]; b += wb[j] * ub[i + j]; }
        a = siluf_(a);
        b = siluf_(b);
        if (row0 < ML_ROWS) {
          int t = t0 + i;
          float pos = (float)(ax == 0 ? (t >> 6) : (t & 63));
          float ang = pos * inv;
          float cs = __cosf(ang), sn = __sinf(ang);
          float oa = a * cs - b * sn, ob = a * sn + b * cs;
          a = oa; b = ob;
        }
        if (qk) { a *= 0.125f; b *= 0.125f; }
        ((u16*)p.MQK)[(size_t)(row0 + i) * 512 + ca] = f2bf(a);
        ((u16*)p.MQK)[(size_t)(row0 + i) * 512 + cb] = f2bf(b);
      }
      if (tid < 128) {
        int gi = tid & 15;
        float gv = p.G[row0 * 16 + tid] + p.ml_gate_b[l * 16 + gi];
        if ((gi >> 2) & 1) gv = fminf(gv, 0.f) - log1pf(__expf(-fabsf(gv)));
        p.G[row0 * 16 + tid] = gv;
      }
    }
  }
}

#define VT_CTX_OFF ((size_t)8 * 8 * 64 * 2048)
#define VTM_CTX_OFF ((size_t)8 * 4 * 64 * 2048)
__device__ __forceinline__ void vt_item(const P& p, int it, u16* tl) {
  const int tid = threadIdx.x;
  int b, h, tt, row0, TK, col0;
  u16* dst;
  if (it < 2048) { b = it >> 8; h = (it >> 5) & 7; tt = it & 31; row0 = b * 2048 + tt * 64; TK = 2048; col0 = 1024 + h * 64; dst = p.VT + (size_t)((b * 8 + h) * 64) * 2048 + tt * 64; }
  else if (it < 2304) { int ci = it - 2048; b = ci >> 5; h = (ci >> 2) & 7; tt = ci & 3; row0 = ML_ROWS + b * 256 + tt * 64; TK = 256; col0 = 1024 + h * 64; dst = p.VT + VT_CTX_OFF + (size_t)((b * 8 + h) * 64) * 256 + tt * 64; }
  else if (it < 2304 + 1024) { int mi = it - 2304; b = mi >> 7; h = (mi >> 5) & 3; tt = mi & 31; row0 = b * 2048 + tt * 64; TK = 2048; col0 = 2304 + h * 64; dst = p.VTm + (size_t)((b * 4 + h) * 64) * 2048 + tt * 64; }
  else { int mi = it - 3328; b = mi >> 4; h = (mi >> 2) & 3; tt = mi & 3; row0 = ML_ROWS + b * 256 + tt * 64; TK = 256; col0 = 2304 + h * 64; dst = p.VTm + VTM_CTX_OFF + (size_t)((b * 4 + h) * 64) * 256 + tt * 64; }
  __syncthreads();
  {
    int i = tid >> 2, part = tid & 3;
    const uint4* src = (const uint4*)(p.U + (size_t)(row0 + i) * INC + col0 + part * 16);
    uint4 v0 = src[0], v1 = src[1];
    unsigned* t32 = (unsigned*)(tl + i * 66 + part * 16);
    t32[0] = v0.x; t32[1] = v0.y; t32[2] = v0.z; t32[3] = v0.w;
    t32[4] = v1.x; t32[5] = v1.y; t32[6] = v1.z; t32[7] = v1.w;
  }
  __syncthreads();
  {
    int d = tid >> 2, part = tid & 3;
    unsigned o[8];
#pragma unroll
    for (int k = 0; k < 8; k++) {
      unsigned lo = tl[(part * 16 + 2 * k) * 66 + d], hi = tl[(part * 16 + 2 * k + 1) * 66 + d];
      o[k] = lo | (hi << 16);
    }
    uint4* dp = (uint4*)(dst + (size_t)d * TK + part * 16);
    dp[0] = make_uint4(o[0], o[1], o[2], o[3]);
    dp[1] = make_uint4(o[4], o[5], o[6], o[7]);
  }
}

__device__ __forceinline__ void attn_item(const P& p, int l, int item, float* sb) {
  const int tid = threadIdx.x, lane = tid & 63, w = tid >> 6, q = lane & 15, quad = lane >> 4;
  const bool latent = item < 2048;
  int b, r = 0, h, qb = 0;
  if (latent) { b = item >> 8; r = (item >> 3) & 31; h = item & 7; }
  else { int ci = item - 2048; b = ci >> 5; qb = (ci >> 3) & 3; h = ci & 7; }
  const int r0 = min(max(r - 4, 0), 24);
  __syncthreads();
  if (latent) {
    int kr = tid >> 5, j = tid & 31;
    if (j < 31) sb[tid] = p.na_rpb[(size_t)((l * 8 + h) * 15 + (r0 + kr - r + 7)) * 31 + j];
  }
  __syncthreads();
  const int qc = w * 16 + q;
  const int qrow = latent ? (b * 2048 + r * 64 + qc) : (ML_ROWS + b * 256 + qb * 64 + qc);
  const int cs = (w == 0) ? 0 : (w == 1) ? 8 : (w == 2) ? 24 : 32;
  const int c0 = min(max(qc - 8, 0), 48);
  const bf16x8 bq0 = *(const bf16x8*)(p.U + (size_t)qrow * INC + h * 64 + quad * 8);
  const bf16x8 bq1 = *(const bf16x8*)(p.U + (size_t)qrow * INC + h * 64 + 32 + quad * 8);
  const int mrow = (q >> 2) * 8 + (q & 3);
  const u16* vt_lat = p.VT + (size_t)((b * 8 + h) * 64 + q) * 2048 + quad * 8;
  const u16* vt_ctx = p.VT + VT_CTX_OFF + (size_t)((b * 8 + h) * 64 + q) * 256 + quad * 8;
  float m = -INFINITY, lsum = 0.f;
  f32x4 o[4];
#pragma unroll
  for (int dt = 0; dt < 4; dt++) o[dt] = (f32x4){0.f, 0.f, 0.f, 0.f};
#pragma unroll 1
  for (int chunk = (latent ? 0 : 2); chunk < 4; chunk++) {
    f32x4 s[4][2];
#pragma unroll
    for (int blk = 0; blk < 4; blk++) {
      int rowbase = (chunk < 2) ? (b * 2048 + (r0 + chunk * 4 + blk) * 64 + cs) : (ML_ROWS + b * 256 + (chunk - 2) * 128 + blk * 32);
#pragma unroll
      for (int T = 0; T < 2; T++) {
        const u16* kp = p.U + (size_t)(rowbase + mrow + T * 4) * INC + 512 + h * 64 + quad * 8;
        bf16x8 a0 = *(const bf16x8*)kp;
        bf16x8 a1 = *(const bf16x8*)(kp + 32);
        f32x4 acc = (f32x4){0.f, 0.f, 0.f, 0.f};
        acc = __builtin_amdgcn_mfma_f32_16x16x32_bf16(a0, bq0, acc, 0, 0, 0);
        acc = __builtin_amdgcn_mfma_f32_16x16x32_bf16(a1, bq1, acc, 0, 0, 0);
        s[blk][T] = acc;
      }
    }
    float mx = -INFINITY;
    if (chunk < 2) {
#pragma unroll
      for (int blk = 0; blk < 4; blk++)
#pragma unroll
        for (int T = 0; T < 2; T++)
#pragma unroll
          for (int rr = 0; rr < 4; rr++) {
            int kc = cs + quad * 8 + T * 4 + rr;
            bool valid = (kc >= c0) && (kc < c0 + 16);
            int bi = (chunk * 4 + blk) * 32 + min(max(kc - qc + 15, 0), 30);
            float v = valid ? (s[blk][T][rr] * 0.125f + sb[bi]) : -INFINITY;
            s[blk][T][rr] = v;
            mx = fmaxf(mx, v);
          }
    } else {
#pragma unroll
      for (int blk = 0; blk < 4; blk++)
#pragma unroll
        for (int T = 0; T < 2; T++)
#pragma unroll
          for (int rr = 0; rr < 4; rr++) {
            float v = s[blk][T][rr] * 0.125f;
            s[blk][T][rr] = v;
            mx = fmaxf(mx, v);
          }
    }
    mx = fmaxf(mx, __shfl_xor(mx, 16));
    mx = fmaxf(mx, __shfl_xor(mx, 32));
    float mn = fmaxf(m, mx);
    float sc = __expf(m - mn);
    lsum *= sc;
#pragma unroll
    for (int dt = 0; dt < 4; dt++) o[dt] *= sc;
    m = mn;
#pragma unroll
    for (int blk = 0; blk < 4; blk++) {
      float pv[8];
#pragma unroll
      for (int T = 0; T < 2; T++)
#pragma unroll
        for (int rr = 0; rr < 4; rr++) {
          float e = __expf(s[blk][T][rr] - mn);
          pv[T * 4 + rr] = e;
          lsum += e;
        }
      union { bf16x8 v; unsigned u[4]; } pk;
      pk.u[0] = pack2(pv[0], pv[1]); pk.u[1] = pack2(pv[2], pv[3]); pk.u[2] = pack2(pv[4], pv[5]); pk.u[3] = pack2(pv[6], pv[7]);
      const u16* vb = (chunk < 2) ? (vt_lat + (r0 + chunk * 4 + blk) * 64 + cs) : (vt_ctx + (chunk - 2) * 128 + blk * 32);
      const size_t dstr = (chunk < 2) ? (size_t)16 * 2048 : (size_t)16 * 256;
#pragma unroll
      for (int dt = 0; dt < 4; dt++) {
        bf16x8 av = *(const bf16x8*)(vb + dt * dstr);
        o[dt] = __builtin_amdgcn_mfma_f32_16x16x32_bf16(av, pk.v, o[dt], 0, 0, 0);
      }
    }
  }
  lsum += __shfl_xor(lsum, 16);
  lsum += __shfl_xor(lsum, 32);
  float il = 1.f / lsum;
#pragma unroll
  for (int dt = 0; dt < 4; dt++) {
    uint2 ov;
    ov.x = pack2(o[dt][0] * il, o[dt][1] * il);
    ov.y = pack2(o[dt][2] * il, o[dt][3] * il);
    *(uint2*)(p.Y + (size_t)qrow * 1024 + h * 64 + dt * 16 + quad * 4) = ov;
  }
}

__device__ __forceinline__ int ml_row(int b, int dir, int j, int pp) {
  if (j < 4) {
    int pos = j * 64 + pp;
    int t = dir ? 255 - pos : pos;
    return ML_ROWS + b * 256 + t;
  } else {
    int pos = (j - 4) * 64 + pp;
    int t = dir ? 2047 - pos : pos;
    return b * 2048 + t;
  }
}

__device__ __forceinline__ void mlstmA_item(const P& p, int it, float* sm) {
  const int tid = threadIdx.x, lane = tid & 63;
  int seq = it / 36, j = it % 36;
  int b = seq >> 3, h = (seq >> 1) & 3, dir = seq & 1;
  float* ks = sm;
  float* vs = sm + 64 * 65;
  float* wsm = sm + 2 * 64 * 65;
  float* slot = p.mst + (size_t)it * SLOT;
  const u16* mqk = (const u16*)p.MQK;
  __syncthreads();
  for (int idx = tid; idx < 4096; idx += 256) {
    int pp = idx >> 6, d = idx & 63;
    int row = ml_row(b, dir, j, pp);
    ks[pp * 65 + d] = bf2f(mqk[(size_t)row * 512 + 256 + h * 64 + d]);
    vs[pp * 65 + d] = bf2f(p.U[(size_t)row * INC + 2304 + h * 64 + d]);
  }
  if (tid < 64) {
    int row = ml_row(b, dir, j, lane);
    float ic = p.G[row * 16 + (dir * 2) * 4 + h];
    float fc = p.G[row * 16 + (dir * 2 + 1) * 4 + h];
    float bbv = fc;
#pragma unroll
    for (int o = 1; o < 64; o <<= 1) { float u = __shfl_up(bbv, o); if (lane >= o) bbv += u; }
    float cs = ic - bbv;
    float pm = cs;
#pragma unroll
    for (int o = 1; o < 64; o <<= 1) { float u = __shfl_up(pm, o); if (lane >= o) pm = fmaxf(pm, u); }
    float bl = __shfl(bbv, 63);
    float ml = __shfl(pm, 63) + bl;
    wsm[lane] = __expf(bl + cs - ml);
    slot[4224 + lane] = bbv;
    slot[4288 + lane] = cs;
    slot[4352 + lane] = pm;
    if (lane == 0) { slot[4160] = bl; slot[4161] = ml; }
  }
  __syncthreads();
  {
    int e = tid & 63, dg = tid >> 6;
    float acc[16];
#pragma unroll
    for (int dd = 0; dd < 16; dd++) acc[dd] = 0.f;
    for (int pp = 0; pp < 64; pp++) {
      float wv = wsm[pp] * vs[pp * 65 + e];
#pragma unroll
      for (int dd = 0; dd < 16; dd++) acc[dd] += ks[pp * 65 + dg * 16 + dd] * wv;
    }
#pragma unroll
    for (int q4 = 0; q4 < 4; q4++)
      *(float4*)(slot + e * 64 + dg * 16 + q4 * 4) = make_float4(acc[q4 * 4], acc[q4 * 4 + 1], acc[q4 * 4 + 2], acc[q4 * 4 + 3]);
  }
  if (tid < 64) {
    float a = 0.f;
    for (int pp = 0; pp < 64; pp++) a += wsm[pp] * ks[pp * 65 + tid];
    slot[4096 + tid] = a;
  }
}

#define ATT_SPLIT 768
__device__ __forceinline__ void phase_attn_mlA(const P& p, int l, char* smem) {
  const int N_MLA = 64 * 36;
  const int total = ATT_SPLIT + N_MLA;
  for (int item = blockIdx.x; item < total; item += gridDim.x) {
    if (item < N_MLA) mlstmA_item(p, item, (float*)smem);
    else attn_item(p, l, item - N_MLA, (float*)smem);
  }
}
__device__ __forceinline__ void mlB_item(const P& p, int item);
__device__ __forceinline__ void phase_attn_mlB(const P& p, int l, char* smem) {
  const int N_ATT = (l == 0 ? 2304 : 2048) - ATT_SPLIT;
  const int N_MLB = 64 * 17;
  const int total = N_ATT + N_MLB;
  for (int item = blockIdx.x; item < total; item += gridDim.x) {
    if (item < N_MLB) mlB_item(p, item);
    else attn_item(p, l, ATT_SPLIT + item - N_MLB, (float*)smem);
  }
}

__device__ __forceinline__ void mlB_item(const P& p, int item) {
  const int tid = threadIdx.x;
  int seq = item / 17, ech = item - seq * 17;
  int el = ech * 256 + tid;
  if (el >= 4160) return;
  float* base = p.mst + (size_t)(seq * 36) * SLOT;
  float loc[36], bl[36], ml[36];
#pragma unroll
  for (int j = 0; j < 36; j++) {
    loc[j] = base[(size_t)j * SLOT + el];
    bl[j] = base[(size_t)j * SLOT + 4160];
    ml[j] = base[(size_t)j * SLOT + 4161];
  }
  float m = 0.f, val = 0.f;
#pragma unroll
  for (int j = 0; j < 36; j++) {
    base[(size_t)j * SLOT + el] = val;
    if (el == 0) base[(size_t)j * SLOT + 4162] = m;
    float mn = fmaxf(bl[j] + m, ml[j]);
    val = __expf(bl[j] + m - mn) * val + __expf(ml[j] - mn) * loc[j];
    m = mn;
  }
}

__device__ __forceinline__ bf16x8 pack8(float4 a, float4 b) {
  union { bf16x8 v; unsigned u[4]; } r;
  r.u[0] = pack2(a.x, a.y); r.u[1] = pack2(a.z, a.w); r.u[2] = pack2(b.x, b.y); r.u[3] = pack2(b.z, b.w);
  return r.v;
}
__device__ __forceinline__ void phase_mlC(const P& p, int l, char* smem) {
  const int tid = threadIdx.x, lane = tid & 63, w = tid >> 6, q = lane & 15, quad = lane >> 4;
  const u16* mqk = (const u16*)p.MQK;
  const int nch = (l == 0) ? 36 : 32;
  const int total = 32 * nch;
  const int mrow = (q >> 2) * 8 + (q & 3);
  for (int item = blockIdx.x; item < total; item += gridDim.x) {
    int bh = item / nch, c = item % nch + (l == 0 ? 0 : 4);
    int b = bh >> 2, h = bh & 3;
    const int rowbase = (c < 4) ? (ML_ROWS + b * 256 + c * 64) : (b * 2048 + (c - 4) * 64);
    const int tau_t = w * 16 + q;
    const int trow = rowbase + tau_t;
    const bf16x8 bq0 = *(const bf16x8*)(mqk + (size_t)trow * 512 + h * 64 + quad * 8);
    const bf16x8 bq1 = *(const bf16x8*)(mqk + (size_t)trow * 512 + h * 64 + 32 + quad * 8);
    const u16* vt = (c < 4) ? (p.VTm + VTM_CTX_OFF + (size_t)((b * 4 + h) * 64 + q) * 256 + c * 64 + quad * 8)
                            : (p.VTm + (size_t)((b * 4 + h) * 64 + q) * 2048 + (c - 4) * 64 + quad * 8);
    const size_t vstr = (c < 4) ? (size_t)16 * 256 : (size_t)16 * 2048;
    f32x4 hs[4];
#pragma unroll
    for (int et = 0; et < 4; et++) hs[et] = (f32x4){0.f, 0.f, 0.f, 0.f};
#pragma unroll 1
    for (int dir = 0; dir < 2; dir++) {
      int j = dir ? (c < 4 ? 3 - c : 4 + 31 - (c - 4)) : c;
      const float* slot = p.mst + (size_t)(((b * 4 + h) * 2 + dir) * 36 + j) * SLOT;
      const int pt = dir ? 63 - tau_t : tau_t;
      const float m0 = slot[4162];
      const float bt = slot[4224 + pt];
      const float mt = bt + fmaxf(m0, slot[4352 + pt]);
      const float winter = __expf(bt + m0 - mt);
      f32x4 aw[4], ac[4];
#pragma unroll
      for (int et = 0; et < 4; et++) { aw[et] = (f32x4){0.f, 0.f, 0.f, 0.f}; ac[et] = (f32x4){0.f, 0.f, 0.f, 0.f}; }
      float dsum = 0.f;
#pragma unroll
      for (int kb = 0; kb < 2; kb++) {
        float wv[8];
#pragma unroll
        for (int T = 0; T < 2; T++) {
          const u16* kp = mqk + (size_t)(rowbase + kb * 32 + mrow + T * 4) * 512 + 256 + h * 64 + quad * 8;
          bf16x8 a0 = *(const bf16x8*)kp;
          bf16x8 a1 = *(const bf16x8*)(kp + 32);
          f32x4 sacc = (f32x4){0.f, 0.f, 0.f, 0.f};
          sacc = __builtin_amdgcn_mfma_f32_16x16x32_bf16(a0, bq0, sacc, 0, 0, 0);
          sacc = __builtin_amdgcn_mfma_f32_16x16x32_bf16(a1, bq1, sacc, 0, 0, 0);
#pragma unroll
          for (int rr = 0; rr < 4; rr++) {
            int tau_s = kb * 32 + quad * 8 + T * 4 + rr;
            int ps = dir ? 63 - tau_s : tau_s;
            bool valid = dir ? (tau_s >= tau_t) : (tau_s <= tau_t);
            float cs = slot[4288 + ps];
            float v = valid ? sacc[rr] * __expf(bt - mt + cs) : 0.f;
            wv[T * 4 + rr] = v;
            dsum += v;
          }
        }
        union { bf16x8 v; unsigned u[4]; } pk;
        pk.u[0] = pack2(wv[0], wv[1]); pk.u[1] = pack2(wv[2], wv[3]); pk.u[2] = pack2(wv[4], wv[5]); pk.u[3] = pack2(wv[6], wv[7]);
#pragma unroll
        for (int et = 0; et < 4; et++) {
          bf16x8 av = *(const bf16x8*)(vt + et * vstr + kb * 32);
          aw[et] = __builtin_amdgcn_mfma_f32_16x16x32_bf16(av, pk.v, aw[et], 0, 0, 0);
        }
      }
#pragma unroll
      for (int et = 0; et < 4; et++) {
        const float* cp = slot + (et * 16 + q) * 64 + quad * 8;
        bf16x8 c0 = pack8(*(const float4*)cp, *(const float4*)(cp + 4));
        bf16x8 c1 = pack8(*(const float4*)(cp + 32), *(const float4*)(cp + 36));
        ac[et] = __builtin_amdgcn_mfma_f32_16x16x32_bf16(c0, bq0, ac[et], 0, 0, 0);
        ac[et] = __builtin_amdgcn_mfma_f32_16x16x32_bf16(c1, bq1, ac[et], 0, 0, 0);
      }
      float qn = 0.f;
      {
        const float* np_ = slot + 4096 + quad * 8;
        float4 n0 = *(const float4*)np_, n1 = *(const float4*)(np_ + 4), n2 = *(const float4*)(np_ + 32), n3 = *(const float4*)(np_ + 36);
        union { bf16x8 v; unsigned u[4]; } q0, q1;
        q0.v = bq0; q1.v = bq1;
        qn += bflo(q0.u[0]) * n0.x + bfhi(q0.u[0]) * n0.y + bflo(q0.u[1]) * n0.z + bfhi(q0.u[1]) * n0.w;
        qn += bflo(q0.u[2]) * n1.x + bfhi(q0.u[2]) * n1.y + bflo(q0.u[3]) * n1.z + bfhi(q0.u[3]) * n1.w;
        qn += bflo(q1.u[0]) * n2.x + bfhi(q1.u[0]) * n2.y + bflo(q1.u[1]) * n2.z + bfhi(q1.u[1]) * n2.w;
        qn += bflo(q1.u[2]) * n3.x + bfhi(q1.u[2]) * n3.y + bflo(q1.u[3]) * n3.z + bfhi(q1.u[3]) * n3.w;
      }
      qn += __shfl_xor(qn, 16);
      qn += __shfl_xor(qn, 32);
      dsum += __shfl_xor(dsum, 16);
      dsum += __shfl_xor(dsum, 32);
      float den = dsum + winter * qn;
      float ih = 1.f / fmaxf(fabsf(den), __expf(-mt));
#pragma unroll
      for (int et = 0; et < 4; et++)
#pragma unroll
        for (int rr = 0; rr < 4; rr++) hs[et][rr] += (aw[et][rr] + winter * ac[et][rr]) * ih;
    }
    float ss = 0.f;
#pragma unroll
    for (int et = 0; et < 4; et++)
#pragma unroll
      for (int rr = 0; rr < 4; rr++) ss += hs[et][rr] * hs[et][rr];
    ss += __shfl_xor(ss, 16);
    ss += __shfl_xor(ss, 32);
    float rs = rsqrtf(ss * (1.f / 64.f) + 1e-6f);
#pragma unroll
    for (int et = 0; et < 4; et++) {
      int e0 = h * 64 + et * 16 + quad * 4;
      uint2 uo = *(const uint2*)(p.U + (size_t)trow * INC + 2560 + e0);
      float4 ng = *(const float4*)(p.ml_norm_g + l * 256 + e0);
      float o0 = hs[et][0] * rs * ng.x * sigmoidf_(bflo(uo.x));
      float o1 = hs[et][1] * rs * ng.y * sigmoidf_(bfhi(uo.x));
      float o2 = hs[et][2] * rs * ng.z * sigmoidf_(bflo(uo.y));
      float o3 = hs[et][3] * rs * ng.w * sigmoidf_(bfhi(uo.y));
      uint2 ov;
      ov.x = pack2(o0, o1);
      ov.y = pack2(o2, o3);
      *(uint2*)(p.Y + (size_t)trow * 1024 + 768 + e0) = ov;
    }
  }
}

typedef __attribute__((ext_vector_type(2))) float f32x2;
__device__ __forceinline__ float gelu_tanh(float x) {
  float u = 0.7978845608028654f * (x + 0.044715f * x * x * x);
  float th = 1.f - 2.f / (1.f + __expf(2.f * u));
  return 0.5f * x * (1.f + th);
}
__device__ __forceinline__ float dot16_fp8(const f32x2* xr, uint4 v) {
  f32x2 s = __builtin_amdgcn_cvt_pk_f32_fp8((int)v.x, false) * xr[0];
  s += __builtin_amdgcn_cvt_pk_f32_fp8((int)v.x, true) * xr[1];
  s += __builtin_amdgcn_cvt_pk_f32_fp8((int)v.y, false) * xr[2];
  s += __builtin_amdgcn_cvt_pk_f32_fp8((int)v.y, true) * xr[3];
  s += __builtin_amdgcn_cvt_pk_f32_fp8((int)v.z, false) * xr[4];
  s += __builtin_amdgcn_cvt_pk_f32_fp8((int)v.z, true) * xr[5];
  s += __builtin_amdgcn_cvt_pk_f32_fp8((int)v.w, false) * xr[6];
  s += __builtin_amdgcn_cvt_pk_f32_fp8((int)v.w, true) * xr[7];
  return s.x + s.y;
}
__device__ __forceinline__ void axpy16_fp8(f32x2* acc, float a, uint4 v) {
  f32x2 av = (f32x2){a, a};
  acc[0] += av * __builtin_amdgcn_cvt_pk_f32_fp8((int)v.x, false);
  acc[1] += av * __builtin_amdgcn_cvt_pk_f32_fp8((int)v.x, true);
  acc[2] += av * __builtin_amdgcn_cvt_pk_f32_fp8((int)v.y, false);
  acc[3] += av * __builtin_amdgcn_cvt_pk_f32_fp8((int)v.y, true);
  acc[4] += av * __builtin_amdgcn_cvt_pk_f32_fp8((int)v.z, false);
  acc[5] += av * __builtin_amdgcn_cvt_pk_f32_fp8((int)v.z, true);
  acc[6] += av * __builtin_amdgcn_cvt_pk_f32_fp8((int)v.w, false);
  acc[7] += av * __builtin_amdgcn_cvt_pk_f32_fp8((int)v.w, true);
}

__device__ __forceinline__ unsigned fkey(float f) {
  unsigned u = __float_as_uint(f);
  return (u & 0x80000000u) ? ~u : (u | 0x80000000u);
}
__device__ __forceinline__ int mbcnt64(unsigned long long m) {
  return __builtin_amdgcn_mbcnt_hi((unsigned)(m >> 32), __builtin_amdgcn_mbcnt_lo((unsigned)m, 0));
}
#define WAVE_LDS_FENCE() do { __builtin_amdgcn_fence(__ATOMIC_RELEASE, "wavefront"); __builtin_amdgcn_wave_barrier(); __builtin_amdgcn_fence(__ATOMIC_ACQUIRE, "wavefront"); } while (0)

__device__ __forceinline__ void phase_peer_topk(const P& p, int l, char* smem) {
  const int tid = threadIdx.x, lane = tid & 63, w = tid >> 6;
  float* wl = (float*)smem + w * 512;
  float* cs = wl;
  int* ci = (int*)(wl + 32);
  int* el = (int*)(wl + 64);
  float* sl = wl + 192;
  const int nrows = (l == 1) ? ML_ROWS : MT_ROWS;
  const int nw = gridDim.x * 4;
  for (int row = blockIdx.x * 4 + w; row < nrows; row += nw) {
    float na0, na1, nb0, nb1;
    {
      const float* sp0 = p.S + (size_t)row * 2048;
      na0 = sp0[lane]; na1 = sp0[64 + lane]; nb0 = sp0[128 + lane]; nb1 = sp0[192 + lane];
    }
#pragma unroll 1
    for (int h = 0; h < 8; h++) {
      float a0 = na0, a1 = na1, b0 = nb0, b1 = nb1;
      {
        const float* spn = p.S + (size_t)row * 2048 + ((h + 1) & 7) * 256;
        na0 = spn[lane]; na1 = spn[64 + lane]; nb0 = spn[128 + lane]; nb1 = spn[192 + lane];
      }
      unsigned kA0 = fkey(a0), kA1 = fkey(a1), kB0 = fkey(b0), kB1 = fkey(b1);
      unsigned pA = 0, pB = 0;
      bool dA = false, dB = false;
#pragma unroll 1
      for (int bit = 31; bit >= 0; --bit) {
        unsigned cA = pA | (1u << bit), cB = pB | (1u << bit);
        int nA = __popcll(__ballot(kA0 >= cA)) + __popcll(__ballot(kA1 >= cA));
        int nB = __popcll(__ballot(kB0 >= cB)) + __popcll(__ballot(kB1 >= cB));
        if (!dA && nA >= 16) { pA = cA; dA = (nA == 16); }
        if (!dB && nB >= 16) { pB = cB; dB = (nB == 16); }
        if (dA && dB) break;
      }
      {
        unsigned long long m0 = __ballot(kA0 >= pA), m1 = __ballot(kA1 >= pA);
        int p0 = mbcnt64(m0), p1 = __popcll(m0) + mbcnt64(m1);
        if (kA0 >= pA && p0 < 16) { cs[p0] = a0; ci[p0] = lane; }
        if (kA1 >= pA && p1 < 16) { cs[p1] = a1; ci[p1] = lane + 64; }
        m0 = __ballot(kB0 >= pB); m1 = __ballot(kB1 >= pB);
        p0 = mbcnt64(m0); p1 = __popcll(m0) + mbcnt64(m1);
        if (kB0 >= pB && p0 < 16) { cs[16 + p0] = b0; ci[16 + p0] = lane; }
        if (kB1 >= pB && p1 < 16) { cs[16 + p1] = b1; ci[16 + p1] = lane + 64; }
      }
      WAVE_LDS_FENCE();
      const int ii = lane >> 2, jb = (lane & 3) * 4;
      float s1 = cs[ii];
      float c0 = s1 + cs[16 + jb + 0], c1 = s1 + cs[16 + jb + 1], c2 = s1 + cs[16 + jb + 2], c3 = s1 + cs[16 + jb + 3];
      int e1 = ci[ii] * 128;
      int f0 = e1 + ci[16 + jb + 0], f1 = e1 + ci[16 + jb + 1], f2 = e1 + ci[16 + jb + 2], f3 = e1 + ci[16 + jb + 3];
      unsigned k0 = fkey(c0), k1 = fkey(c1), k2 = fkey(c2), k3 = fkey(c3);
      unsigned pC = 0;
#pragma unroll 1
      for (int bit = 31; bit >= 0; --bit) {
        unsigned cC = pC | (1u << bit);
        int n = __popcll(__ballot(k0 >= cC)) + __popcll(__ballot(k1 >= cC)) + __popcll(__ballot(k2 >= cC)) + __popcll(__ballot(k3 >= cC));
        if (n >= 16) { pC = cC; if (n == 16) break; }
      }
      {
        unsigned long long m0 = __ballot(k0 >= pC), m1 = __ballot(k1 >= pC), m2 = __ballot(k2 >= pC), m3 = __ballot(k3 >= pC);
        int q0 = mbcnt64(m0);
        int q1 = __popcll(m0) + mbcnt64(m1);
        int q2 = __popcll(m0) + __popcll(m1) + mbcnt64(m2);
        int q3 = __popcll(m0) + __popcll(m1) + __popcll(m2) + mbcnt64(m3);
        if (k0 >= pC && q0 < 16) { el[h * 16 + q0] = f0; sl[h * 16 + q0] = c0; }
        if (k1 >= pC && q1 < 16) { el[h * 16 + q1] = f1; sl[h * 16 + q1] = c1; }
        if (k2 >= pC && q2 < 16) { el[h * 16 + q2] = f2; sl[h * 16 + q2] = c2; }
        if (k3 >= pC && q3 < 16) { el[h * 16 + q3] = f3; sl[h * 16 + q3] = c3; }
      }
      WAVE_LDS_FENCE();
    }
    {
      float v0 = sl[lane], v1 = sl[64 + lane];
      float m0 = v0, m1 = v1;
#pragma unroll
      for (int o = 1; o < 16; o <<= 1) { m0 = fmaxf(m0, __shfl_xor(m0, o)); m1 = fmaxf(m1, __shfl_xor(m1, o)); }
      float e0 = __expf(v0 - m0), e1 = __expf(v1 - m1);
      float s0 = e0, s1 = e1;
#pragma unroll
      for (int o = 1; o < 16; o <<= 1) { s0 += __shfl_xor(s0, o); s1 += __shfl_xor(s1, o); }
      sl[lane] = e0 / s0;
      sl[64 + lane] = e1 / s1;
    }
    WAVE_LDS_FENCE();
    p.elist[(size_t)row * 128 + lane] = el[lane];
    p.elist[(size_t)row * 128 + 64 + lane] = el[64 + lane];
    p.glist[(size_t)row * 128 + lane] = sl[lane];
    p.glist[(size_t)row * 128 + 64 + lane] = sl[64 + lane];
    WAVE_LDS_FENCE();
  }
}

template <int PH>
__device__ __forceinline__ void phase_peer_uv(const P& p, int l, char* smem) {
  const int tid = threadIdx.x, lane = tid & 63, w = tid >> 6;
  int* idl = (int*)smem + w * 256;
  float* al = (float*)smem + w * 256 + 128;
  const int nrows = (l == 1) ? ML_ROWS : MT_ROWS;
  const int k = blockIdx.x & 7;
  const int gw = (blockIdx.x >> 3) * 4 + w, ngw = (gridDim.x >> 3) * 4;
  const unsigned char* tab = (const unsigned char*)(PH == 0 ? p.Ub : p.Vb) + (size_t)((l * 8 + k) * 16384) * 128 + (lane & 7) * 16;
  const int es = lane >> 3;
  const int s0 = (PH == 0) ? 1 : 8, s1 = (PH == 0) ? 2 : 16, s2 = (PH == 0) ? 4 : 32;
  const bool c0 = (lane & s0) != 0, c1 = (lane & s1) != 0, c2 = (lane & s2) != 0;
  const int B = (c0 ? 8 : 0) + (c1 ? 4 : 0) + (c2 ? 2 : 0);
  int nid0 = 0, nid1 = 0;
  uint4 nx0 = make_uint4(0, 0, 0, 0), nx1 = nx0;
  float nh0[8], nh1[8], ng0 = 0.f, ng1 = 0.f;
#pragma unroll
  for (int kk = 0; kk < 8; kk++) { nh0[kk] = 0.f; nh1[kk] = 0.f; }
  int t = gw;
  if (t < nrows) {
    nid0 = p.elist[(size_t)t * 128 + lane];
    nid1 = p.elist[(size_t)t * 128 + 64 + lane];
    if (PH == 0) {
      const uint4* xp = (const uint4*)(p.xn + (size_t)t * 1024 + k * 128 + (lane & 7) * 16);
      nx0 = xp[0]; nx1 = xp[1];
    } else {
#pragma unroll
      for (int kk = 0; kk < 8; kk++) {
        nh0[kk] = p.hp[((size_t)t * 8 + kk) * 128 + lane];
        nh1[kk] = p.hp[((size_t)t * 8 + kk) * 128 + 64 + lane];
      }
      ng0 = p.glist[(size_t)t * 128 + lane];
      ng1 = p.glist[(size_t)t * 128 + 64 + lane];
    }
  }
  while (t < nrows) {
    idl[lane] = nid0;
    idl[64 + lane] = nid1;
    f32x2 xr[8];
    if (PH == 0) {
      xr[0] = (f32x2){bflo(nx0.x), bfhi(nx0.x)}; xr[1] = (f32x2){bflo(nx0.y), bfhi(nx0.y)};
      xr[2] = (f32x2){bflo(nx0.z), bfhi(nx0.z)}; xr[3] = (f32x2){bflo(nx0.w), bfhi(nx0.w)};
      xr[4] = (f32x2){bflo(nx1.x), bfhi(nx1.x)}; xr[5] = (f32x2){bflo(nx1.y), bfhi(nx1.y)};
      xr[6] = (f32x2){bflo(nx1.z), bfhi(nx1.z)}; xr[7] = (f32x2){bflo(nx1.w), bfhi(nx1.w)};
    } else {
      float h0 = ((nh0[0] + nh0[1]) + (nh0[2] + nh0[3])) + ((nh0[4] + nh0[5]) + (nh0[6] + nh0[7]));
      float h1 = ((nh1[0] + nh1[1]) + (nh1[2] + nh1[3])) + ((nh1[4] + nh1[5]) + (nh1[6] + nh1[7]));
      al[lane] = gelu_tanh(h0 * (1.f / 64.f)) * ng0;
      al[64 + lane] = gelu_tanh(h1 * (1.f / 64.f)) * ng1;
    }
    WAVE_LDS_FENCE();
    uint4 rr[16];
#pragma unroll
    for (int i = 0; i < 16; i++) rr[i] = *(const uint4*)(tab + (size_t)idl[i * 8 + es] * 128);
    const int tn = t + ngw;
    if (tn < nrows) {
      nid0 = p.elist[(size_t)tn * 128 + lane];
      nid1 = p.elist[(size_t)tn * 128 + 64 + lane];
      if (PH == 0) {
        const uint4* xp = (const uint4*)(p.xn + (size_t)tn * 1024 + k * 128 + (lane & 7) * 16);
        nx0 = xp[0]; nx1 = xp[1];
      } else {
#pragma unroll
        for (int kk = 0; kk < 8; kk++) {
          nh0[kk] = p.hp[((size_t)tn * 8 + kk) * 128 + lane];
          nh1[kk] = p.hp[((size_t)tn * 8 + kk) * 128 + 64 + lane];
        }
        ng0 = p.glist[(size_t)tn * 128 + lane];
        ng1 = p.glist[(size_t)tn * 128 + 64 + lane];
      }
    }
    float v[16];
    if (PH == 0) {
#pragma unroll
      for (int i = 0; i < 16; i++) v[i] = dot16_fp8(xr, rr[i]);
    } else {
      f32x2 acc[8];
#pragma unroll
      for (int i = 0; i < 8; i++) acc[i] = (f32x2){0.f, 0.f};
#pragma unroll
      for (int i = 0; i < 16; i++) axpy16_fp8(acc, al[i * 8 + es], rr[i]);
#pragma unroll
      for (int i = 0; i < 8; i++) { v[2 * i] = acc[i].x; v[2 * i + 1] = acc[i].y; }
    }
    float k8[8], k4[4], k2[2];
#pragma unroll
    for (int i = 0; i < 8; i++) k8[i] = (c0 ? v[i + 8] : v[i]) + __shfl_xor(c0 ? v[i] : v[i + 8], s0);
#pragma unroll
    for (int i = 0; i < 4; i++) k4[i] = (c1 ? k8[i + 4] : k8[i]) + __shfl_xor(c1 ? k8[i] : k8[i + 4], s1);
#pragma unroll
    for (int i = 0; i < 2; i++) k2[i] = (c2 ? k4[i + 2] : k4[i]) + __shfl_xor(c2 ? k4[i] : k4[i + 2], s2);
    if (PH == 0) {
      float* hq = p.hp + ((size_t)t * 8 + k) * 128;
      hq[(B + 0) * 8 + es] = k2[0];
      hq[(B + 1) * 8 + es] = k2[1];
    } else {
      const int col = k * 128 + (lane & 7) * 16 + B;
      const int mr = t < ML_ROWS ? (t >> 11) : 8;
      const float2 g2 = *(const float2*)(p.mod + (size_t)(l * 9 + mr) * 6144 + 5120 + col);
      float2* dst = (float2*)(t < ML_ROWS ? p.out + (size_t)t * 1024 + col : p.hc + (size_t)(t - ML_ROWS) * 1024 + col);
      float2 cur = *dst;
      cur.x += g2.x * 0.125f * k2[0];
      cur.y += g2.y * 0.125f * k2[1];
      *dst = cur;
    }
    WAVE_LDS_FENCE();
    t = tn;
  }
}

#define RUN(k, call)                         \
  if (lo <= (k) && (k) < hi) {               \
    call;                                    \
    if ((k) + 1 < hi) xcd_barrier(xb);       \
  }
#define LAYER(l, base)                                                                                                    \
  RUN(base + 0, phase_norm(p, l, 1))                                                                                     \
  RUN(base + 1, phase_gemm<0>(p, l, p.xn, p.WinT + (size_t)l * INC_PAD * 1024, MT_ROWS / 128, INC_PAD / 128, smem))     \
  RUN(base + 2, phase_mixprep(p, l, smem))                                                                               \
  RUN(base + 3, phase_attn_mlA(p, l, smem))                                                                              \
  RUN(base + 4, phase_attn_mlB(p, l, smem))                                                                                            \
  RUN(base + 5, phase_mlC(p, l, smem))                                                                                   \
  RUN(base + 6, phase_gemm<1>(p, l, p.Y, p.WoutT + (size_t)l * 1024 * 1024, (l == 0 ? MT_ROWS : ML_ROWS) / 128, 8, smem)) \
  RUN(base + 7, phase_norm(p, l, 2))                                                                                     \
  RUN(base + 8, phase_gemm<2>(p, l, p.xn, p.WsT + (size_t)l * 2048 * 1024, (l == 0 ? MT_ROWS : ML_ROWS) / 128, 16, smem)) \
  RUN(base + 9, phase_peer_topk(p, l, smem))                                                                             \
  RUN(base + 10, phase_peer_uv<0>(p, l, smem))                                                                            \
  RUN(base + 11, phase_peer_uv<1>(p, l, smem))

__global__ void __launch_bounds__(256, 2) fwd_kernel(P p) {
  __shared__ __attribute__((aligned(16))) char smem[SMEM_BYTES];
  __shared__ uint4 xb_words;
  cg::grid_group grid = cg::this_grid();
  const int lo = (int)p.ph_lo, hi = (int)p.ph_hi;
  if (threadIdx.x == 0) xb_words = make_uint4(0u, 0u, 0u, 0u);
  __syncthreads();
  XcdBarrier xb = xcd_barrier_post(p.bar, (volatile LAS unsigned*)&xb_words);
  if (hi - lo > 1) grid.sync();
  RUN(0, phase_prologue(p, smem))
  LAYER(0, 1)
  LAYER(1, 13)
}

extern "C" void kernel_launch(void* const* d_in, const int* in_sizes, int n_in, void* d_out, int out_size, void* d_ws,
                              size_t ws_size, hipStream_t stream) {
  static int grid_blocks = 0;
  if (!grid_blocks) {
    int dev = 0, cus = 0, per_cu = 0;
    hipGetDevice(&dev);
    hipDeviceGetAttribute(&cus, hipDeviceAttributeMultiprocessorCount, dev);
    hipOccupancyMaxActiveBlocksPerMultiprocessor(&per_cu, fwd_kernel, 256, 0);
    if (per_cu < 1) per_cu = 1;
    if (per_cu > 2) per_cu = 2;
    grid_blocks = (cus * per_cu) & ~7;
  }
  P p{};
  const float** ins = (const float**)&p;
  for (int i = 0; i < 22; i++) ins[i] = (const float*)d_in[i];
  p.out = (float*)d_out;
  char* ws = (char*)d_ws;
  size_t off = 0;
  auto take = [&](size_t bytes) { char* r = ws + off; off += (bytes + 255) & ~(size_t)255; return r; };
  p.WinT = (u16*)take((size_t)2 * INC_PAD * 1024 * 2);
  p.WoutT = (u16*)take((size_t)2 * 1024 * 1024 * 2);
  p.WsT = (u16*)take((size_t)2 * 2048 * 1024 * 2);
  p.Ub = (u16*)take((size_t)2 * 16384 * 1024);
  p.Vb = (u16*)take((size_t)2 * 16384 * 1024);
  p.elist = (int*)take((size_t)MT_ROWS * 128 * 4);
  p.glist = (float*)take((size_t)MT_ROWS * 128 * 4);
  p.mod = (float*)take((size_t)2 * 9 * 6144 * 4);
  p.xn = (u16*)take((size_t)MT_ROWS * 1024 * 2);
  p.U = (u16*)take((size_t)MT_ROWS * INC * 2);
  p.MQK = (float*)take((size_t)MT_ROWS * 512 * 4);
  p.Y = (u16*)take((size_t)MT_ROWS * 1024 * 2);
  p.S = (float*)p.U;
  p.hp = (float*)take((size_t)MT_ROWS * 8 * 128 * 4);
  p.G = (float*)take((size_t)MT_ROWS * 16 * 4);
  p.mst = (float*)take((size_t)2304 * SLOT * 4);
  p.hc = (float*)take((size_t)MC_ROWS * 1024 * 4);
  p.bar = (unsigned*)take((size_t)XCD_BAR_WORDS * 4);
  p.VTm = (u16*)take((size_t)(8 * 4 * 64) * (2048 + 256) * 2);
  p.VT = (u16*)take((size_t)(8 * 8 * 64) * (2048 + 256) * 2);
  if (off > ws_size) { fprintf(stderr, "workspace too small: need %zu have %zu\n", off, ws_size); return; }
  (void)hipMemsetAsync(p.bar, 0, (size_t)XCD_BAR_WORDS * 4, stream);
#if MEGA
  p.ph_lo = 0; p.ph_hi = NPHASES;
  void* args[] = {&p};
  hipError_t e = hipLaunchCooperativeKernel((void*)fwd_kernel, dim3(grid_blocks), dim3(256), args, 0, stream);
  if (e != hipSuccess) fprintf(stderr, "cooperative launch failed: %s (grid %d)\n", hipGetErrorString(e), grid_blocks);
#else
  for (int ph = 0; ph < NPHASES; ph++) {
    p.ph_lo = ph; p.ph_hi = ph + 1;
    void* args[] = {&p};
    hipError_t e = hipLaunchCooperativeKernel((void*)fwd_kernel, dim3(grid_blocks), dim3(256), args, 0, stream);
    if (e != hipSuccess) fprintf(stderr, "cooperative launch failed: %s (grid %d)\n", hipGetErrorString(e), grid_blocks);
  }
#endif
}
```

```cpp
#include <hip/hip_runtime.h>
#include <hip/hip_cooperative_groups.h>
#include <cstdio>
namespace cg = cooperative_groups;

#ifndef MEGA
#define MEGA 1
#endif

typedef unsigned short u16;
typedef __attribute__((ext_vector_type(8))) short bf16x8;
typedef __attribute__((ext_vector_type(4))) float f32x4;

#define ML_ROWS 16384
#define MC_ROWS 2048
#define MT_ROWS 18432
#define INC 2832
#define INC_PAD 2944
#define SLOT 4480
#define SMEM_BYTES 69632
#define NPHASES 25

struct P {
  const float *x, *c, *ctx, *c_ctx, *w_ada, *b_ada, *norm1_g, *w_in, *ml_gate_b, *na_q_g, *na_k_g, *na_rpb,
      *pool_w, *pool_scale, *ml_conv, *ml_norm_g, *w_out, *norm2_g, *peer_wq, *peer_keys, *peer_u, *peer_v;
  float* out;
  u16 *WinT, *WoutT, *WsT, *Ub, *Vb;
  float* mod;
  u16* xn;
  u16* U;
  float* MQK;
  u16* Y;
  float* S;
  float* G;
  float* mst;
  float* hc;
  u16* VT;
  u16* VTm;
  signed char* xq;
  float* sx;
  float* su;
  float* slist;
  int* elist;
  float* glist;
  float* hp;
  unsigned* bar;
  long long ph_lo, ph_hi;
};

__device__ __forceinline__ u16 f2bf(float f) {
  unsigned u = __float_as_uint(f);
  u += 0x7fffu + ((u >> 16) & 1u);
  return (u16)(u >> 16);
}
__device__ __forceinline__ float bf2f(u16 h) { return __uint_as_float(((unsigned)h) << 16); }
__device__ __forceinline__ float bflo(unsigned u) { return __uint_as_float(u << 16); }
__device__ __forceinline__ float bfhi(unsigned u) { return __uint_as_float(u & 0xffff0000u); }
__device__ __forceinline__ unsigned pack2(float a, float b) { return (unsigned)f2bf(a) | ((unsigned)f2bf(b) << 16); }
__device__ __forceinline__ unsigned q8pack(float a, float b, float c, float d) {
  int qa = __float2int_rn(a), qb = __float2int_rn(b), qc = __float2int_rn(c), qd = __float2int_rn(d);
  return (unsigned)(qa & 0xff) | ((unsigned)(qb & 0xff) << 8) | ((unsigned)(qc & 0xff) << 16) | ((unsigned)(qd & 0xff) << 24);
}
__device__ __forceinline__ float wave_sum(float v) {
#pragma unroll
  for (int o = 32; o; o >>= 1) v += __shfl_xor(v, o);
  return v;
}
__device__ __forceinline__ void wave_argmax(float& v, int& i) {
#pragma unroll
  for (int o = 32; o; o >>= 1) {
    float ov = __shfl_xor(v, o);
    int oi = __shfl_xor(i, o);
    if (ov > v || (ov == v && oi < i)) { v = ov; i = oi; }
  }
}
__device__ __forceinline__ float sigmoidf_(float x) { return 1.f / (1.f + __expf(-x)); }
__device__ __forceinline__ float siluf_(float x) { return x / (1.f + __expf(-x)); }

#define XB_TMO      128
#define XB_XCNT(j)  (256  + 64 * (j))
#define XB_XSUB(j)  (1280 + 64 * (j))
#define XB_XGEN(j)  (2304 + 64 * (j))
#define XB_TOP      3328
#define XB_TOPGEN   3392
#define XCD_BAR_WORDS 3456
#define XB_SPIN_CAP (1u << 18)
#define LAS __attribute__((address_space(3)))
__device__ __forceinline__ unsigned xb_ld(unsigned* p)              { return __hip_atomic_load(p, __ATOMIC_RELAXED, __HIP_MEMORY_SCOPE_AGENT); }
__device__ __forceinline__ unsigned xb_add(unsigned* p, unsigned v) { return __hip_atomic_fetch_add(p, v, __ATOMIC_RELAXED, __HIP_MEMORY_SCOPE_AGENT); }
__device__ __forceinline__ unsigned xb_xcc_id() { return (unsigned)__builtin_amdgcn_s_getreg((3 << 11) | 20) & 0xFu; }
#define XB_SPIN(cond, bar) do { unsigned _sp = 0; while (cond) { __builtin_amdgcn_s_sleep(1); \
    if ((++_sp & 255u) == 0u) { if (xb_ld(&(bar)[XB_TMO])) break; if (_sp > XB_SPIN_CAP) { atomicAdd(&(bar)[XB_TMO], 1u); break; } } } } while (0)
struct XcdBarrier { unsigned* bar; unsigned x; volatile LAS unsigned* st; };
__device__ __forceinline__ XcdBarrier xcd_barrier_post(unsigned* bar, volatile LAS unsigned* st) {
    XcdBarrier b; b.bar = bar; b.x = xb_xcc_id(); b.st = st;
    if (threadIdx.x == 0) (void)xb_add(&bar[XB_XCNT(b.x)], 1u);
    return b;
}
__device__ __forceinline__ void xcd_barrier_complete(unsigned* bar, unsigned x, unsigned& nloc, unsigned& nx) {
    const unsigned G = gridDim.x * gridDim.y * gridDim.z;
    unsigned sum, cnt, mine, sp = 0u;
    for (;;) {
        sum = 0u; cnt = 0u; mine = 0u;
#pragma unroll
        for (unsigned j = 0; j < 16; ++j) { const unsigned c = xb_ld(&bar[XB_XCNT(j)]); sum += c; cnt += (c > 0u) ? 1u : 0u; mine = (j == x) ? c : mine; }
        if (sum == G) break;
        __builtin_amdgcn_s_sleep(1);
        if ((++sp & 255u) == 0u) { if (xb_ld(&bar[XB_TMO])) break; if (sp > XB_SPIN_CAP) { atomicAdd(&bar[XB_TMO], 1u); break; } }
    }
    nloc = mine > 0u ? mine : 1u; nx = cnt > 0u ? cnt : 1u;
}
__device__ __forceinline__ void xcd_barrier(const XcdBarrier& b) {
    asm volatile("s_waitcnt vmcnt(0)" ::: "memory");
    __syncthreads();
    if (threadIdx.x == 0) {
        unsigned* bar = b.bar;
        __builtin_amdgcn_s_waitcnt(0);
        unsigned nloc = b.st[0], nx = b.st[1];
        if (nloc == 0u) { xcd_barrier_complete(bar, b.x, nloc, nx); b.st[0] = nloc; b.st[1] = nx; }
        const unsigned old = xb_add(&bar[XB_XSUB(b.x)], 1u);
        const unsigned gen = old / nloc;
        if (old + 1u == (gen + 1u) * nloc) {
            __builtin_amdgcn_fence(__ATOMIC_RELEASE, "agent");
            asm volatile("s_waitcnt vmcnt(0)" ::: "memory");
            const unsigned og = xb_add(&bar[XB_TOP], 1u);
            const unsigned tg = og / nx;
            if (og + 1u == (tg + 1u) * nx) xb_add(&bar[XB_TOPGEN], 1u);
            else XB_SPIN(xb_ld(&bar[XB_TOPGEN]) == tg, bar);
            __builtin_amdgcn_fence(__ATOMIC_ACQUIRE, "agent");
            xb_add(&bar[XB_XGEN(b.x)], 1u);
            asm volatile("s_waitcnt vmcnt(0)" ::: "memory");
        } else {
            XB_SPIN(xb_ld(&bar[XB_XGEN(b.x)]) == gen, bar);
            __builtin_amdgcn_fence(__ATOMIC_ACQUIRE, "agent");
            asm volatile("s_waitcnt vmcnt(0)" ::: "memory");
        }
    }
    __syncthreads();
}

__device__ __forceinline__ void transpose_item(const float* __restrict__ src, int N, u16* __restrict__ dst, int kt, int nt, float* tl) {
  const int tid = threadIdx.x;
#pragma unroll 4
  for (int i = 0; i < 16; i++) {
    int idx = tid + 256 * i;
    int kk = idx >> 6, nn = idx & 63;
    int n = nt * 64 + nn;
    float v = (n < N) ? src[(size_t)(kt * 64 + kk) * N + n] : 0.f;
    tl[kk * 65 + nn] = v;
  }
  __syncthreads();
#pragma unroll 4
  for (int i = 0; i < 16; i++) {
    int idx = tid + 256 * i;
    int nn = idx >> 6, kk = idx & 63;
    dst[(size_t)(nt * 64 + nn) * 1024 + kt * 64 + kk] = f2bf(tl[kk * 65 + nn]);
  }
  __syncthreads();
}

__device__ __forceinline__ void wst_item(const P& p, int it, float* sm) {
  const int tid = threadIdx.x;
  int l = it >> 8, hp = (it >> 4) & 15, dt = it & 15;
  float* As = sm;
  float* Ks = sm + 64 * 33;
  const float* wq = p.peer_wq + (size_t)l * 1024 * 2048;
  const float* keys = p.peer_keys + ((size_t)l * 16 + hp) * 128 * 128;
  int d = tid & 63, cg_ = tid >> 6;
  float acc[32];
#pragma unroll
  for (int c = 0; c < 32; c++) acc[c] = 0.f;
  for (int jc = 0; jc < 4; jc++) {
    __syncthreads();
#pragma unroll
    for (int i = 0; i < 8; i++) {
      int idx = tid + 256 * i;
      int dd = idx >> 5, j = idx & 31;
      As[dd * 33 + j] = wq[(size_t)(dt * 64 + dd) * 2048 + hp * 128 + jc * 32 + j];
    }
#pragma unroll
    for (int i = 0; i < 16; i++) {
      int idx = tid + 256 * i;
      int k = idx >> 5, j = idx & 31;
      Ks[k * 33 + j] = keys[k * 128 + jc * 32 + j];
    }
    __syncthreads();
    for (int j = 0; j < 32; j++) {
      float a = As[d * 33 + j];
#pragma unroll
      for (int c = 0; c < 32; c++) acc[c] += a * Ks[(cg_ * 32 + c) * 33 + j];
    }
  }
  u16* dst = p.WsT + (size_t)l * 2048 * 1024;
#pragma unroll
  for (int c = 0; c < 32; c++) dst[(size_t)(hp * 128 + cg_ * 32 + c) * 1024 + dt * 64 + d] = f2bf(acc[c]);
  __syncthreads();
}

__device__ __forceinline__ void mod_item(const P& p, int it, float* sm) {
  const int tid = threadIdx.x;
  int l = it / 96, cc = it % 96;
  float* sc = sm;
  float* red = sm + 9216;
  for (int idx = tid; idx < 9216; idx += 256) {
    int r = idx >> 10, k = idx & 1023;
    float v = (r < 8) ? p.c[r * 1024 + k] : p.c_ctx[k];
    sc[idx] = siluf_(v);
  }
  __syncthreads();
  int cl = tid & 63, kg = tid >> 6;
  int col = cc * 64 + cl;
  float acc[9];
#pragma unroll
  for (int r = 0; r < 9; r++) acc[r] = 0.f;
  const float* wa = p.w_ada + (size_t)l * 1024 * 6144;
#pragma unroll 16
  for (int k = kg * 256; k < kg * 256 + 256; k++) {
    float w = wa[(size_t)k * 6144 + col];
#pragma unroll
    for (int r = 0; r < 9; r++) acc[r] += sc[r * 1024 + k] * w;
  }
#pragma unroll
  for (int r = 0; r < 9; r++) red[(kg * 9 + r) * 64 + cl] = acc[r];
  __syncthreads();
  if (kg == 0) {
    float bb = p.b_ada[l * 6144 + col];
#pragma unroll
    for (int r = 0; r < 9; r++) {
      float s = red[(0 * 9 + r) * 64 + cl] + red[(1 * 9 + r) * 64 + cl] + red[(2 * 9 + r) * 64 + cl] + red[(3 * 9 + r) * 64 + cl];
      p.mod[(size_t)(l * 9 + r) * 6144 + col] = s + bb;
    }
  }
  __syncthreads();
}

__device__ __forceinline__ void phase_prologue(const P& p, char* smem) {
  float* sm = (float*)smem;
  const int tid = threadIdx.x;
  const int N_A = 2 * 16 * 46, N_B = 2 * 16 * 16, N_C = 512, N_D = 192, N_E = 4096;
  const int total = N_A + N_B + N_C + N_D + N_E;
  for (int item = blockIdx.x; item < total; item += gridDim.x) {
    int it = item;
    if (it < N_D) { mod_item(p, it, sm); continue; }
    it -= N_D;
    if (it < N_C) { wst_item(p, it, sm); continue; }
    it -= N_C;
    if (it < N_A) {
      int l = it / (16 * 46), r = it % (16 * 46);
      transpose_item(p.w_in + (size_t)l * 1024 * INC, INC, p.WinT + (size_t)l * INC_PAD * 1024, r / 46, r % 46, sm);
      continue;
    }
    it -= N_A;
    if (it < N_B) {
      int l = it >> 8, r = it & 255;
      transpose_item(p.w_out + (size_t)l * 1024 * 1024, 1024, p.WoutT + (size_t)l * 1024 * 1024, r >> 4, r & 15, sm);
      continue;
    }
    it -= N_B;
    {
      if ((it >> 11) == 0) {
        const int lane_ = tid & 63, w_ = tid >> 6;
        const int chunk_ = it & 2047;
#pragma unroll
        for (int rr = 0; rr < 4; rr++) {
          const int R = chunk_ * 16 + w_ * 4 + rr;
          const float4* src = (const float4*)(p.peer_u + (size_t)R * 1024 + lane_ * 16);
          float4 v0 = src[0], v1 = src[1], v2 = src[2], v3 = src[3];
          float mx = fmaxf(fmaxf(fmaxf(fabsf(v0.x), fabsf(v0.y)), fmaxf(fabsf(v0.z), fabsf(v0.w))), fmaxf(fmaxf(fabsf(v1.x), fabsf(v1.y)), fmaxf(fabsf(v1.z), fabsf(v1.w))));
          mx = fmaxf(mx, fmaxf(fmaxf(fmaxf(fabsf(v2.x), fabsf(v2.y)), fmaxf(fabsf(v2.z), fabsf(v2.w))), fmaxf(fmaxf(fabsf(v3.x), fabsf(v3.y)), fmaxf(fabsf(v3.z), fabsf(v3.w)))));
#pragma unroll
          for (int o = 32; o; o >>= 1) mx = fmaxf(mx, __shfl_xor(mx, o));
          const float inv = mx > 0.f ? 127.f / mx : 0.f;
          uint4 o;
          o.x = q8pack(v0.x * inv, v0.y * inv, v0.z * inv, v0.w * inv);
          o.y = q8pack(v1.x * inv, v1.y * inv, v1.z * inv, v1.w * inv);
          o.z = q8pack(v2.x * inv, v2.y * inv, v2.z * inv, v2.w * inv);
          o.w = q8pack(v3.x * inv, v3.y * inv, v3.z * inv, v3.w * inv);
          const unsigned ll = (unsigned)R >> 14, ee = (unsigned)R & 16383u;
          size_t off = ((size_t)((ll * 8u + (unsigned)(lane_ >> 3)) * 16384u + ee)) * 128 + (lane_ & 7) * 16;
          *(uint4*)((unsigned char*)p.Ub + off) = o;
          if (lane_ == 0) p.su[R] = mx * (1.f / 127.f);
        }
        continue;
      }
      int tab = it >> 11;
      int chunk = it & 2047;
      const float scl = tab ? 8.f : 64.f;
      const float4* src = (const float4*)(tab ? p.peer_v : p.peer_u) + (size_t)chunk * 4096;
      unsigned char* dstb = (unsigned char*)(tab ? p.Vb : p.Ub);
#pragma unroll
      for (int i = 0; i < 4; i++) {
        int q = i * 256 + tid;
        float4 v0 = src[q * 4 + 0], v1 = src[q * 4 + 1], v2 = src[q * 4 + 2], v3 = src[q * 4 + 3];
        uint4 o;
        int w_;
        w_ = __builtin_amdgcn_cvt_pk_fp8_f32(v0.x * scl, v0.y * scl, 0, false);
        w_ = __builtin_amdgcn_cvt_pk_fp8_f32(v0.z * scl, v0.w * scl, w_, true);
        o.x = (unsigned)w_;
        w_ = __builtin_amdgcn_cvt_pk_fp8_f32(v1.x * scl, v1.y * scl, 0, false);
        w_ = __builtin_amdgcn_cvt_pk_fp8_f32(v1.z * scl, v1.w * scl, w_, true);
        o.y = (unsigned)w_;
        w_ = __builtin_amdgcn_cvt_pk_fp8_f32(v2.x * scl, v2.y * scl, 0, false);
        w_ = __builtin_amdgcn_cvt_pk_fp8_f32(v2.z * scl, v2.w * scl, w_, true);
        o.z = (unsigned)w_;
        w_ = __builtin_amdgcn_cvt_pk_fp8_f32(v3.x * scl, v3.y * scl, 0, false);
        w_ = __builtin_amdgcn_cvt_pk_fp8_f32(v3.z * scl, v3.w * scl, w_, true);
        o.w = (unsigned)w_;
        {
          unsigned G = (unsigned)chunk * 1024u + (unsigned)q;
          unsigned ll = G >> 20, ee = (G >> 6) & 16383u, cgp = G & 63u;
          size_t off = ((size_t)((ll * 8u + (cgp >> 3)) * 16384u + ee)) * 128 + (cgp & 7u) * 16;
          *(uint4*)(dstb + off) = o;
        }
      }
    }
  }
}

__device__ __forceinline__ void phase_norm(const P& p, int l, int which) {
  const int tid = threadIdx.x, lane = tid & 63, w = tid >> 6;
  const int nrows = (which == 2 && l == 1) ? ML_ROWS : MT_ROWS;
  const float* g = (which == 1 ? p.norm1_g : p.norm2_g) + l * 1024;
  for (int item = blockIdx.x; item * 4 < nrows; item += gridDim.x) {
    int row = item * 4 + w;
    const float* src;
    if (l == 0 && which == 1) src = row < ML_ROWS ? p.x + (size_t)row * 1024 : p.ctx + (size_t)(row - ML_ROWS) * 1024;
    else src = row < ML_ROWS ? p.out + (size_t)row * 1024 : p.hc + (size_t)(row - ML_ROWS) * 1024;
    int mr = row < ML_ROWS ? (row >> 11) : 8;
    const float* modp = p.mod + (size_t)(l * 9 + mr) * 6144;
    const float* sh = modp + (which == 1 ? 0 : 3072);
    const float* sc = modp + (which == 1 ? 1024 : 4096);
    float4 v[4];
    float ss = 0.f;
#pragma unroll
    for (int i = 0; i < 4; i++) {
      v[i] = ((const float4*)src)[i * 64 + lane];
      ss += v[i].x * v[i].x + v[i].y * v[i].y + v[i].z * v[i].z + v[i].w * v[i].w;
    }
    ss = wave_sum(ss);
    float rs = rsqrtf(ss * (1.f / 1024.f) + 1e-6f);
    float ov[16];
    float omax = 0.f;
#pragma unroll
    for (int i = 0; i < 4; i++) {
      int d = (i * 64 + lane) * 4;
      float4 gg = *(const float4*)(g + d);
      float4 s4 = *(const float4*)(sc + d);
      float4 h4 = *(const float4*)(sh + d);
      float o0 = v[i].x * rs * gg.x * (1.f + s4.x) + h4.x;
      float o1 = v[i].y * rs * gg.y * (1.f + s4.y) + h4.y;
      float o2 = v[i].z * rs * gg.z * (1.f + s4.z) + h4.z;
      float o3 = v[i].w * rs * gg.w * (1.f + s4.w) + h4.w;
      uint2 o;
      o.x = pack2(o0, o1);
      o.y = pack2(o2, o3);
      ((uint2*)(p.xn + (size_t)row * 1024))[i * 64 + lane] = o;
      ov[i * 4 + 0] = o0; ov[i * 4 + 1] = o1; ov[i * 4 + 2] = o2; ov[i * 4 + 3] = o3;
      omax = fmaxf(omax, fmaxf(fmaxf(fabsf(o0), fabsf(o1)), fmaxf(fabsf(o2), fabsf(o3))));
    }
    if (which == 2) {
#pragma unroll
      for (int o = 32; o; o >>= 1) omax = fmaxf(omax, __shfl_xor(omax, o));
      const float inv = omax > 0.f ? 127.f / omax : 0.f;
#pragma unroll
      for (int i = 0; i < 4; i++)
        ((unsigned*)(p.xq + (size_t)row * 1024))[i * 64 + lane] = q8pack(ov[i * 4] * inv, ov[i * 4 + 1] * inv, ov[i * 4 + 2] * inv, ov[i * 4 + 3] * inv);
      if (lane == 0) p.sx[row] = omax * (1.f / 127.f);
    }
  }
}

template <int EPI>
__device__ __forceinline__ void phase_gemm(const P& p, int l, const u16* __restrict__ A, const u16* __restrict__ Bt, int mtiles, int ntiles,
                           char* smem) {
  u16* As = (u16*)smem;
  u16* Bs = As + 128 * 72;
  const int tid = threadIdx.x, lane = tid & 63, w = tid >> 6, wm = w >> 1, wn = w & 1;
  const int lr = lane & 15, quad = lane >> 4;
  const int nitems = mtiles * ntiles;
  for (int item = blockIdx.x; item < nitems; item += gridDim.x) {
    int mt = item / ntiles, nt = item - mt * ntiles;
    int m0 = mt * 128, n0 = nt * 128;
    f32x4 acc[4][4];
#pragma unroll
    for (int i = 0; i < 4; i++)
#pragma unroll
      for (int j = 0; j < 4; j++) acc[i][j] = (f32x4){0.f, 0.f, 0.f, 0.f};
    const int r0_ = tid >> 3, ch_ = tid & 7;
    const u16* Ap0 = A + (size_t)(m0 + r0_) * 1024 + ch_ * 8;
    const u16* Bp0 = Bt + (size_t)(n0 + r0_) * 1024 + ch_ * 8;
    uint4 ra0 = *(const uint4*)Ap0, ra1 = *(const uint4*)(Ap0 + 32 * 1024), ra2 = *(const uint4*)(Ap0 + 64 * 1024), ra3 = *(const uint4*)(Ap0 + 96 * 1024);
    uint4 rb0 = *(const uint4*)Bp0, rb1 = *(const uint4*)(Bp0 + 32 * 1024), rb2 = *(const uint4*)(Bp0 + 64 * 1024), rb3 = *(const uint4*)(Bp0 + 96 * 1024);
    for (int kt = 0; kt < 16; kt++) {
      __syncthreads();
      *(uint4*)(As + r0_ * 72 + ch_ * 8) = ra0;
      *(uint4*)(As + (r0_ + 32) * 72 + ch_ * 8) = ra1;
      *(uint4*)(As + (r0_ + 64) * 72 + ch_ * 8) = ra2;
      *(uint4*)(As + (r0_ + 96) * 72 + ch_ * 8) = ra3;
      *(uint4*)(Bs + r0_ * 72 + ch_ * 8) = rb0;
      *(uint4*)(Bs + (r0_ + 32) * 72 + ch_ * 8) = rb1;
      *(uint4*)(Bs + (r0_ + 64) * 72 + ch_ * 8) = rb2;
      *(uint4*)(Bs + (r0_ + 96) * 72 + ch_ * 8) = rb3;
      __syncthreads();
      if (kt < 15) {
        const int ko = (kt + 1) * 64;
        ra0 = *(const uint4*)(Ap0 + ko); ra1 = *(const uint4*)(Ap0 + 32 * 1024 + ko); ra2 = *(const uint4*)(Ap0 + 64 * 1024 + ko); ra3 = *(const uint4*)(Ap0 + 96 * 1024 + ko);
        rb0 = *(const uint4*)(Bp0 + ko); rb1 = *(const uint4*)(Bp0 + 32 * 1024 + ko); rb2 = *(const uint4*)(Bp0 + 64 * 1024 + ko); rb3 = *(const uint4*)(Bp0 + 96 * 1024 + ko);
      }
#pragma unroll
      for (int ks = 0; ks < 2; ks++) {
        bf16x8 a[4], b[4];
#pragma unroll
        for (int i = 0; i < 4; i++) {
          a[i] = *(const bf16x8*)(As + (wm * 64 + i * 16 + lr) * 72 + ks * 32 + quad * 8);
          b[i] = *(const bf16x8*)(Bs + (wn * 64 + i * 16 + lr) * 72 + ks * 32 + quad * 8);
        }
#pragma unroll
        for (int i = 0; i < 4; i++)
#pragma unroll
          for (int j = 0; j < 4; j++) acc[i][j] = __builtin_amdgcn_mfma_f32_16x16x32_bf16(a[i], b[j], acc[i][j], 0, 0, 0);
      }
    }
#pragma unroll
    for (int i = 0; i < 4; i++)
#pragma unroll
      for (int j = 0; j < 4; j++)
#pragma unroll
        for (int r = 0; r < 4; r++) {
          int row = m0 + wm * 64 + i * 16 + quad * 4 + r;
          int col = n0 + wn * 64 + j * 16 + lr;
          float v = acc[i][j][r];
          if (EPI == 0) {
            if (col < INC) {
              p.U[(size_t)row * INC + col] = f2bf(v);
              if (col >= 2816) p.G[row * 16 + (col - 2816)] = v;
            }
          } else if (EPI == 1) {
            int mr = row < ML_ROWS ? (row >> 11) : 8;
            float g1 = p.mod[(size_t)(l * 9 + mr) * 6144 + 2048 + col];
            float sv;
            if (l == 0) sv = row < ML_ROWS ? p.x[(size_t)row * 1024 + col] : p.ctx[(size_t)(row - ML_ROWS) * 1024 + col];
            else sv = p.out[(size_t)row * 1024 + col];
            float* dst = row < ML_ROWS ? p.out + (size_t)row * 1024 + col : p.hc + (size_t)(row - ML_ROWS) * 1024 + col;
            *dst = sv + g1 * v;
          } else {
            p.S[(size_t)row * 2048 + col] = v;
          }
        }
  }
}

__device__ __forceinline__ void vt_item(const P& p, int it, u16* tl);
__device__ __forceinline__ void phase_mixprep(const P& p, int l, char* smem) {
  const int tid = threadIdx.x;
  float* pl = (float*)smem;
  const int N_QK = MT_ROWS * 16 / 256;
  const int N_POOL = (l == 0 ? MT_ROWS : ML_ROWS) / 16;
  const int N_PREP = MT_ROWS / 8;
  const int N_VT = 2304 + 1152;
  const int total = N_QK + N_POOL + N_PREP + N_VT;
  for (int item = blockIdx.x; item < total; item += gridDim.x) {
    int it = item;
    if (it >= N_QK + N_POOL + N_PREP) { vt_item(p, it - (N_QK + N_POOL + N_PREP), (u16*)smem); continue; }
    if (it < N_QK) {
      int gi = it * 256 + tid;
      int row = gi >> 4, sub = gi & 15;
      int qk = sub >> 3, h = sub & 7;
      u16* ptr = p.U + (size_t)row * INC + qk * 512 + h * 64;
      const float* g = (qk ? p.na_k_g : p.na_q_g) + l * 64;
      uint4 v[8];
      float ss = 0.f;
#pragma unroll
      for (int c = 0; c < 8; c++) {
        v[c] = ((const uint4*)ptr)[c];
        float a;
        a = bflo(v[c].x); ss += a * a; a = bfhi(v[c].x); ss += a * a;
        a = bflo(v[c].y); ss += a * a; a = bfhi(v[c].y); ss += a * a;
        a = bflo(v[c].z); ss += a * a; a = bfhi(v[c].z); ss += a * a;
        a = bflo(v[c].w); ss += a * a; a = bfhi(v[c].w); ss += a * a;
      }
      float rs = rsqrtf(ss * (1.f / 64.f) + 1e-6f);
#pragma unroll
      for (int c = 0; c < 8; c++) {
        uint4 o;
        o.x = pack2(bflo(v[c].x) * rs * g[c * 8 + 0], bfhi(v[c].x) * rs * g[c * 8 + 1]);
        o.y = pack2(bflo(v[c].y) * rs * g[c * 8 + 2], bfhi(v[c].y) * rs * g[c * 8 + 3]);
        o.z = pack2(bflo(v[c].z) * rs * g[c * 8 + 4], bfhi(v[c].z) * rs * g[c * 8 + 5]);
        o.w = pack2(bflo(v[c].w) * rs * g[c * 8 + 6], bfhi(v[c].w) * rs * g[c * 8 + 7]);
        ((uint4*)ptr)[c] = o;
      }
      continue;
    }
    it -= N_QK;
    if (it < N_POOL) {
      int row0 = it * 16;
      int base, T;
      if (row0 < ML_ROWS) { base = (row0 >> 11) << 11; T = 2048; }
      else { base = ML_ROWS + (((row0 - ML_ROWS) >> 8) << 8); T = 256; }
      int t0 = row0 - base;
      int ch = tid, g = ch >> 6;
      int wdw = 2 << g;
      __syncthreads();
      {
        float vals[31];
#pragma unroll
        for (int j = 0; j < 31; j++) {
          int tau = t0 - 8 + j;
          bool ok = (tau >= 0) && (tau < T);
          vals[j] = ok ? bf2f(p.U[(size_t)(base + (ok ? tau : t0)) * INC + 1536 + ch]) : 0.f;
        }
        const int hl = wdw / 2, hr = wdw - wdw / 2 - 1;
#pragma unroll
        for (int tt = 0; tt < 16; tt++) {
          int t = t0 + tt;
          int lo = max(t - hl, 0), hi = min(t + hr, T - 1);
          float s = 0.f;
#pragma unroll
          for (int j = 0; j < 31; j++) {
            int rel = j - 8 - tt;
            if (rel >= -8 && rel <= 7) s += (rel >= -hl && rel <= hr) ? vals[j] : 0.f;
          }
          pl[tt * 256 + ch] = s / (float)(hi - lo + 1) - vals[8 + tt];
        }
      }
      __syncthreads();
      float acc[16];
#pragma unroll
      for (int tt = 0; tt < 16; tt++) acc[tt] = 0.f;
      int d = ch & 63;
      const float* pw = p.pool_w + ((size_t)(l * 4 + g) * 64) * 64 + d;
      for (int c = 0; c < 64; c++) {
        float wv = pw[c * 64];
#pragma unroll
        for (int tt = 0; tt < 16; tt++) acc[tt] += pl[tt * 256 + g * 64 + c] * wv;
      }
      float ps = p.pool_scale[l * 256 + ch];
#pragma unroll
      for (int tt = 0; tt < 16; tt++) p.Y[(size_t)(row0 + tt) * 1024 + 512 + ch] = f2bf(acc[tt] * ps);
      continue;
    }
    it -= N_POOL;
    {
      const int row0 = it * 8;
      int base, T;
      if (row0 < ML_ROWS) { base = (row0 >> 11) << 11; T = 2048; }
      else { base = ML_ROWS + (((row0 - ML_ROWS) >> 8) << 8); T = 256; }
      const int t0 = row0 - base;
      const int qk = tid >> 7, hh = (tid >> 5) & 3, ax = (tid >> 4) & 1, f = tid & 15;
      const int ca = qk * 256 + hh * 64 + ax * 32 + f, cb = ca + 16;
      float ua[12], ub[12];
#pragma unroll
      for (int j = 0; j < 12; j++) {
        int tt = t0 + j - 2;
        bool ok = (tt >= 0) && (tt < T);
        const u16* ur = p.U + (size_t)(base + (ok ? tt : t0)) * INC + 1792;
        ua[j] = ok ? bf2f(ur[ca]) : 0.f;
        ub[j] = ok ? bf2f(ur[cb]) : 0.f;
      }
      float wa[5], wb[5];
#pragma unroll
      for (int j = 0; j < 5; j++) { wa[j] = p.ml_conv[(l * 5 + j) * 512 + ca]; wb[j] = p.ml_conv[(l * 5 + j) * 512 + cb]; }
      const float inv = __expf(-(float)f * (9.210340371976184f / 16.f));
#pragma unroll
      for (int i = 0; i < 8; i++) {
        float a = 0.f, b = 0.f;
#pragma unroll
        for (int j = 0; j < 5; j++) { a += wa[j] * ua[i + j]; b += wb[j] * ub[i + j]; }
        a = siluf_(a);
        b = siluf_(b);
        if (row0 < ML_ROWS) {
          int t = t0 + i;
          float pos = (float)(ax == 0 ? (t >> 6) : (t & 63));
          float ang = pos * inv;
          float cs = __cosf(ang), sn = __sinf(ang);
          float oa = a * cs - b * sn, ob = a * sn + b * cs;
          a = oa; b = ob;
        }
        if (qk) { a *= 0.125f; b *= 0.125f; }
        ((u16*)p.MQK)[(size_t)(row0 + i) * 512 + ca] = f2bf(a);
        ((u16*)p.MQK)[(size_t)(row0 + i) * 512 + cb] = f2bf(b);
      }
      if (tid < 128) {
        int gi = tid & 15;
        float gv = p.G[row0 * 16 + tid] + p.ml_gate_b[l * 16 + gi];
        if ((gi >> 2) & 1) gv = fminf(gv, 0.f) - log1pf(__expf(-fabsf(gv)));
        p.G[row0 * 16 + tid] = gv;
      }
    }
  }
}

#define VT_CTX_OFF ((size_t)8 * 8 * 64 * 2048)
#define VTM_CTX_OFF ((size_t)8 * 4 * 64 * 2048)
__device__ __forceinline__ void vt_item(const P& p, int it, u16* tl) {
  const int tid = threadIdx.x;
  int b, h, tt, row0, TK, col0;
  u16* dst;
  if (it < 2048) { b = it >> 8; h = (it >> 5) & 7; tt = it & 31; row0 = b * 2048 + tt * 64; TK = 2048; col0 = 1024 + h * 64; dst = p.VT + (size_t)((b * 8 + h) * 64) * 2048 + tt * 64; }
  else if (it < 2304) { int ci = it - 2048; b = ci >> 5; h = (ci >> 2) & 7; tt = ci & 3; row0 = ML_ROWS + b * 256 + tt * 64; TK = 256; col0 = 1024 + h * 64; dst = p.VT + VT_CTX_OFF + (size_t)((b * 8 + h) * 64) * 256 + tt * 64; }
  else if (it < 2304 + 1024) { int mi = it - 2304; b = mi >> 7; h = (mi >> 5) & 3; tt = mi & 31; row0 = b * 2048 + tt * 64; TK = 2048; col0 = 2304 + h * 64; dst = p.VTm + (size_t)((b * 4 + h) * 64) * 2048 + tt * 64; }
  else { int mi = it - 3328; b = mi >> 4; h = (mi >> 2) & 3; tt = mi & 3; row0 = ML_ROWS + b * 256 + tt * 64; TK = 256; col0 = 2304 + h * 64; dst = p.VTm + VTM_CTX_OFF + (size_t)((b * 4 + h) * 64) * 256 + tt * 64; }
  __syncthreads();
  {
    int i = tid >> 2, part = tid & 3;
    const uint4* src = (const uint4*)(p.U + (size_t)(row0 + i) * INC + col0 + part * 16);
    uint4 v0 = src[0], v1 = src[1];
    unsigned* t32 = (unsigned*)(tl + i * 66 + part * 16);
    t32[0] = v0.x; t32[1] = v0.y; t32[2] = v0.z; t32[3] = v0.w;
    t32[4] = v1.x; t32[5] = v1.y; t32[6] = v1.z; t32[7] = v1.w;
  }
  __syncthreads();
  {
    int d = tid >> 2, part = tid & 3;
    unsigned o[8];
#pragma unroll
    for (int k = 0; k < 8; k++) {
      unsigned lo = tl[(part * 16 + 2 * k) * 66 + d], hi = tl[(part * 16 + 2 * k + 1) * 66 + d];
      o[k] = lo | (hi << 16);
    }
    uint4* dp = (uint4*)(dst + (size_t)d * TK + part * 16);
    dp[0] = make_uint4(o[0], o[1], o[2], o[3]);
    dp[1] = make_uint4(o[4], o[5], o[6], o[7]);
  }
}

__device__ __forceinline__ void attn_item(const P& p, int l, int item, float* sb) {
  const int tid = threadIdx.x, lane = tid & 63, w = tid >> 6, q = lane & 15, quad = lane >> 4;
  const bool latent = item < 2048;
  int b, r = 0, h, qb = 0;
  if (latent) { b = item >> 8; r = (item >> 3) & 31; h = item & 7; }
  else { int ci = item - 2048; b = ci >> 5; qb = (ci >> 3) & 3; h = ci & 7; }
  const int r0 = min(max(r - 4, 0), 24);
  __syncthreads();
  if (latent) {
    int kr = tid >> 5, j = tid & 31;
    if (j < 31) sb[tid] = p.na_rpb[(size_t)((l * 8 + h) * 15 + (r0 + kr - r + 7)) * 31 + j];
  }
  __syncthreads();
  const int qc = w * 16 + q;
  const int qrow = latent ? (b * 2048 + r * 64 + qc) : (ML_ROWS + b * 256 + qb * 64 + qc);
  const int cs = (w == 0) ? 0 : (w == 1) ? 8 : (w == 2) ? 24 : 32;
  const int c0 = min(max(qc - 8, 0), 48);
  const bf16x8 bq0 = *(const bf16x8*)(p.U + (size_t)qrow * INC + h * 64 + quad * 8);
  const bf16x8 bq1 = *(const bf16x8*)(p.U + (size_t)qrow * INC + h * 64 + 32 + quad * 8);
  const int mrow = (q >> 2) * 8 + (q & 3);
  const u16* vt_lat = p.VT + (size_t)((b * 8 + h) * 64 + q) * 2048 + quad * 8;
  const u16* vt_ctx = p.VT + VT_CTX_OFF + (size_t)((b * 8 + h) * 64 + q) * 256 + quad * 8;
  float m = -INFINITY, lsum = 0.f;
  f32x4 o[4];
#pragma unroll
  for (int dt = 0; dt < 4; dt++) o[dt] = (f32x4){0.f, 0.f, 0.f, 0.f};
#pragma unroll 1
  for (int chunk = (latent ? 0 : 2); chunk < 4; chunk++) {
    f32x4 s[4][2];
#pragma unroll
    for (int blk = 0; blk < 4; blk++) {
      int rowbase = (chunk < 2) ? (b * 2048 + (r0 + chunk * 4 + blk) * 64 + cs) : (ML_ROWS + b * 256 + (chunk - 2) * 128 + blk * 32);
#pragma unroll
      for (int T = 0; T < 2; T++) {
        const u16* kp = p.U + (size_t)(rowbase + mrow + T * 4) * INC + 512 + h * 64 + quad * 8;
        bf16x8 a0 = *(const bf16x8*)kp;
        bf16x8 a1 = *(const bf16x8*)(kp + 32);
        f32x4 acc = (f32x4){0.f, 0.f, 0.f, 0.f};
        acc = __builtin_amdgcn_mfma_f32_16x16x32_bf16(a0, bq0, acc, 0, 0, 0);
        acc = __builtin_amdgcn_mfma_f32_16x16x32_bf16(a1, bq1, acc, 0, 0, 0);
        s[blk][T] = acc;
      }
    }
    float mx = -INFINITY;
    if (chunk < 2) {
#pragma unroll
      for (int blk = 0; blk < 4; blk++)
#pragma unroll
        for (int T = 0; T < 2; T++)
#pragma unroll
          for (int rr = 0; rr < 4; rr++) {
            int kc = cs + quad * 8 + T * 4 + rr;
            bool valid = (kc >= c0) && (kc < c0 + 16);
            int bi = (chunk * 4 + blk) * 32 + min(max(kc - qc + 15, 0), 30);
            float v = valid ? (s[blk][T][rr] * 0.125f + sb[bi]) : -INFINITY;
            s[blk][T][rr] = v;
            mx = fmaxf(mx, v);
          }
    } else {
#pragma unroll
      for (int blk = 0; blk < 4; blk++)
#pragma unroll
        for (int T = 0; T < 2; T++)
#pragma unroll
          for (int rr = 0; rr < 4; rr++) {
            float v = s[blk][T][rr] * 0.125f;
            s[blk][T][rr] = v;
            mx = fmaxf(mx, v);
          }
    }
    mx = fmaxf(mx, __shfl_xor(mx, 16));
    mx = fmaxf(mx, __shfl_xor(mx, 32));
    float mn = fmaxf(m, mx);
    float sc = __expf(m - mn);
    lsum *= sc;
#pragma unroll
    for (int dt = 0; dt < 4; dt++) o[dt] *= sc;
    m = mn;
#pragma unroll
    for (int blk = 0; blk < 4; blk++) {
      float pv[8];
#pragma unroll
      for (int T = 0; T < 2; T++)
#pragma unroll
        for (int rr = 0; rr < 4; rr++) {
          float e = __expf(s[blk][T][rr] - mn);
          pv[T * 4 + rr] = e;
          lsum += e;
        }
      union { bf16x8 v; unsigned u[4]; } pk;
      pk.u[0] = pack2(pv[0], pv[1]); pk.u[1] = pack2(pv[2], pv[3]); pk.u[2] = pack2(pv[4], pv[5]); pk.u[3] = pack2(pv[6], pv[7]);
      const u16* vb = (chunk < 2) ? (vt_lat + (r0 + chunk * 4 + blk) * 64 + cs) : (vt_ctx + (chunk - 2) * 128 + blk * 32);
      const size_t dstr = (chunk < 2) ? (size_t)16 * 2048 : (size_t)16 * 256;
#pragma unroll
      for (int dt = 0; dt < 4; dt++) {
        bf16x8 av = *(const bf16x8*)(vb + dt * dstr);
        o[dt] = __builtin_amdgcn_mfma_f32_16x16x32_bf16(av, pk.v, o[dt], 0, 0, 0);
      }
    }
  }
  lsum += __shfl_xor(lsum, 16);
  lsum += __shfl_xor(lsum, 32);
  float il = 1.f / lsum;
#pragma unroll
  for (int dt = 0; dt < 4; dt++) {
    uint2 ov;
    ov.x = pack2(o[dt][0] * il, o[dt][1] * il);
    ov.y = pack2(o[dt][2] * il, o[dt][3] * il);
    *(uint2*)(p.Y + (size_t)qrow * 1024 + h * 64 + dt * 16 + quad * 4) = ov;
  }
}

__device__ __forceinline__ int ml_row(int b, int dir, int j, int pp) {
  if (j < 4) {
    int pos = j * 64 + pp;
    int t = dir ? 255 - pos : pos;
    return ML_ROWS + b * 256 + t;
  } else {
    int pos = (j - 4) * 64 + pp;
    int t = dir ? 2047 - pos : pos;
    return b * 2048 + t;
  }
}

__device__ __forceinline__ void mlstmA_item(const P& p, int it, float* sm) {
  const int tid = threadIdx.x, lane = tid & 63;
  int seq = it / 36, j = it % 36;
  int b = seq >> 3, h = (seq >> 1) & 3, dir = seq & 1;
  float* ks = sm;
  float* vs = sm + 64 * 65;
  float* wsm = sm + 2 * 64 * 65;
  float* slot = p.mst + (size_t)it * SLOT;
  const u16* mqk = (const u16*)p.MQK;
  __syncthreads();
  for (int idx = tid; idx < 4096; idx += 256) {
    int pp = idx >> 6, d = idx & 63;
    int row = ml_row(b, dir, j, pp);
    ks[pp * 65 + d] = bf2f(mqk[(size_t)row * 512 + 256 + h * 64 + d]);
    vs[pp * 65 + d] = bf2f(p.U[(size_t)row * INC + 2304 + h * 64 + d]);
  }
  if (tid < 64) {
    int row = ml_row(b, dir, j, lane);
    float ic = p.G[row * 16 + (dir * 2) * 4 + h];
    float fc = p.G[row * 16 + (dir * 2 + 1) * 4 + h];
    float bbv = fc;
#pragma unroll
    for (int o = 1; o < 64; o <<= 1) { float u = __shfl_up(bbv, o); if (lane >= o) bbv += u; }
    float cs = ic - bbv;
    float pm = cs;
#pragma unroll
    for (int o = 1; o < 64; o <<= 1) { float u = __shfl_up(pm, o); if (lane >= o) pm = fmaxf(pm, u); }
    float bl = __shfl(bbv, 63);
    float ml = __shfl(pm, 63) + bl;
    wsm[lane] = __expf(bl + cs - ml);
    slot[4224 + lane] = bbv;
    slot[4288 + lane] = cs;
    slot[4352 + lane] = pm;
    if (lane == 0) { slot[4160] = bl; slot[4161] = ml; }
  }
  __syncthreads();
  {
    int e = tid & 63, dg = tid >> 6;
    float acc[16];
#pragma unroll
    for (int dd = 0; dd < 16; dd++) acc[dd] = 0.f;
    for (int pp = 0; pp < 64; pp++) {
      float wv = wsm[pp] * vs[pp * 65 + e];
#pragma unroll
      for (int dd = 0; dd < 16; dd++) acc[dd] += ks[pp * 65 + dg * 16 + dd] * wv;
    }
#pragma unroll
    for (int q4 = 0; q4 < 4; q4++)
      *(float4*)(slot + e * 64 + dg * 16 + q4 * 4) = make_float4(acc[q4 * 4], acc[q4 * 4 + 1], acc[q4 * 4 + 2], acc[q4 * 4 + 3]);
  }
  if (tid < 64) {
    float a = 0.f;
    for (int pp = 0; pp < 64; pp++) a += wsm[pp] * ks[pp * 65 + tid];
    slot[4096 + tid] = a;
  }
}

#define ATT_SPLIT 768
__device__ __forceinline__ void phase_attn_mlA(const P& p, int l, char* smem) {
  const int N_MLA = 64 * 36;
  const int total = ATT_SPLIT + N_MLA;
  for (int item = blockIdx.x; item < total; item += gridDim.x) {
    if (item < N_MLA) mlstmA_item(p, item, (float*)smem);
    else attn_item(p, l, item - N_MLA, (float*)smem);
  }
}
__device__ __forceinline__ void mlB_item(const P& p, int item);
__device__ __forceinline__ void phase_attn_mlB(const P& p, int l, char* smem) {
  const int N_ATT = (l == 0 ? 2304 : 2048) - ATT_SPLIT;
  const int N_MLB = 64 * 17;
  const int total = N_ATT + N_MLB;
  for (int item = blockIdx.x; item < total; item += gridDim.x) {
    if (item < N_MLB) mlB_item(p, item);
    else attn_item(p, l, ATT_SPLIT + item - N_MLB, (float*)smem);
  }
}

__device__ __forceinline__ void mlB_item(const P& p, int item) {
  const int tid = threadIdx.x;
  int seq = item / 17, ech = item - seq * 17;
  int el = ech * 256 + tid;
  if (el >= 4160) return;
  float* base = p.mst + (size_t)(seq * 36) * SLOT;
  float loc[36], bl[36], ml[36];
#pragma unroll
  for (int j = 0; j < 36; j++) {
    loc[j] = base[(size_t)j * SLOT + el];
    bl[j] = base[(size_t)j * SLOT + 4160];
    ml[j] = base[(size_t)j * SLOT + 4161];
  }
  float m = 0.f, val = 0.f;
#pragma unroll
  for (int j = 0; j < 36; j++) {
    base[(size_t)j * SLOT + el] = val;
    if (el == 0) base[(size_t)j * SLOT + 4162] = m;
    float mn = fmaxf(bl[j] + m, ml[j]);
    val = __expf(bl[j] + m - mn) * val + __expf(ml[j] - mn) * loc[j];
    m = mn;
  }
}

__device__ __forceinline__ bf16x8 pack8(float4 a, float4 b) {
  union { bf16x8 v; unsigned u[4]; } r;
  r.u[0] = pack2(a.x, a.y); r.u[1] = pack2(a.z, a.w); r.u[2] = pack2(b.x, b.y); r.u[3] = pack2(b.z, b.w);
  return r.v;
}
__device__ __forceinline__ void phase_mlC(const P& p, int l, char* smem) {
  const int tid = threadIdx.x, lane = tid & 63, w = tid >> 6, q = lane & 15, quad = lane >> 4;
  const u16* mqk = (const u16*)p.MQK;
  const int nch = (l == 0) ? 36 : 32;
  const int total = 32 * nch;
  const int mrow = (q >> 2) * 8 + (q & 3);
  for (int item = blockIdx.x; item < total; item += gridDim.x) {
    int bh = item / nch, c = item % nch + (l == 0 ? 0 : 4);
    int b = bh >> 2, h = bh & 3;
    const int rowbase = (c < 4) ? (ML_ROWS + b * 256 + c * 64) : (b * 2048 + (c - 4) * 64);
    const int tau_t = w * 16 + q;
    const int trow = rowbase + tau_t;
    const bf16x8 bq0 = *(const bf16x8*)(mqk + (size_t)trow * 512 + h * 64 + quad * 8);
    const bf16x8 bq1 = *(const bf16x8*)(mqk + (size_t)trow * 512 + h * 64 + 32 + quad * 8);
    const u16* vt = (c < 4) ? (p.VTm + VTM_CTX_OFF + (size_t)((b * 4 + h) * 64 + q) * 256 + c * 64 + quad * 8)
                            : (p.VTm + (size_t)((b * 4 + h) * 64 + q) * 2048 + (c - 4) * 64 + quad * 8);
    const size_t vstr = (c < 4) ? (size_t)16 * 256 : (size_t)16 * 2048;
    f32x4 hs[4];
#pragma unroll
    for (int et = 0; et < 4; et++) hs[et] = (f32x4){0.f, 0.f, 0.f, 0.f};
#pragma unroll 1
    for (int dir = 0; dir < 2; dir++) {
      int j = dir ? (c < 4 ? 3 - c : 4 + 31 - (c - 4)) : c;
      const float* slot = p.mst + (size_t)(((b * 4 + h) * 2 + dir) * 36 + j) * SLOT;
      const int pt = dir ? 63 - tau_t : tau_t;
      const float m0 = slot[4162];
      const float bt = slot[4224 + pt];
      const float mt = bt + fmaxf(m0, slot[4352 + pt]);
      const float winter = __expf(bt + m0 - mt);
      f32x4 aw[4], ac[4];
#pragma unroll
      for (int et = 0; et < 4; et++) { aw[et] = (f32x4){0.f, 0.f, 0.f, 0.f}; ac[et] = (f32x4){0.f, 0.f, 0.f, 0.f}; }
      float dsum = 0.f;
#pragma unroll
      for (int kb = 0; kb < 2; kb++) {
        float wv[8];
#pragma unroll
        for (int T = 0; T < 2; T++) {
          const u16* kp = mqk + (size_t)(rowbase + kb * 32 + mrow + T * 4) * 512 + 256 + h * 64 + quad * 8;
          bf16x8 a0 = *(const bf16x8*)kp;
          bf16x8 a1 = *(const bf16x8*)(kp + 32);
          f32x4 sacc = (f32x4){0.f, 0.f, 0.f, 0.f};
          sacc = __builtin_amdgcn_mfma_f32_16x16x32_bf16(a0, bq0, sacc, 0, 0, 0);
          sacc = __builtin_amdgcn_mfma_f32_16x16x32_bf16(a1, bq1, sacc, 0, 0, 0);
#pragma unroll
          for (int rr = 0; rr < 4; rr++) {
            int tau_s = kb * 32 + quad * 8 + T * 4 + rr;
            int ps = dir ? 63 - tau_s : tau_s;
            bool valid = dir ? (tau_s >= tau_t) : (tau_s <= tau_t);
            float cs = slot[4288 + ps];
            float v = valid ? sacc[rr] * __expf(bt - mt + cs) : 0.f;
            wv[T * 4 + rr] = v;
            dsum += v;
          }
        }
        union { bf16x8 v; unsigned u[4]; } pk;
        pk.u[0] = pack2(wv[0], wv[1]); pk.u[1] = pack2(wv[2], wv[3]); pk.u[2] = pack2(wv[4], wv[5]); pk.u[3] = pack2(wv[6], wv[7]);
#pragma unroll
        for (int et = 0; et < 4; et++) {
          bf16x8 av = *(const bf16x8*)(vt + et * vstr + kb * 32);
          aw[et] = __builtin_amdgcn_mfma_f32_16x16x32_bf16(av, pk.v, aw[et], 0, 0, 0);
        }
      }
#pragma unroll
      for (int et = 0; et < 4; et++) {
        const float* cp = slot + (et * 16 + q) * 64 + quad * 8;
        bf16x8 c0 = pack8(*(const float4*)cp, *(const float4*)(cp + 4));
        bf16x8 c1 = pack8(*(const float4*)(cp + 32), *(const float4*)(cp + 36));
        ac[et] = __builtin_amdgcn_mfma_f32_16x16x32_bf16(c0, bq0, ac[et], 0, 0, 0);
        ac[et] = __builtin_amdgcn_mfma_f32_16x16x32_bf16(c1, bq1, ac[et], 0, 0, 0);
      }
      float qn = 0.f;
      {
        const float* np_ = slot + 4096 + quad * 8;
        float4 n0 = *(const float4*)np_, n1 = *(const float4*)(np_ + 4), n2 = *(const float4*)(np_ + 32), n3 = *(const float4*)(np_ + 36);
        union { bf16x8 v; unsigned u[4]; } q0, q1;
        q0.v = bq0; q1.v = bq1;
        qn += bflo(q0.u[0]) * n0.x + bfhi(q0.u[0]) * n0.y + bflo(q0.u[1]) * n0.z + bfhi(q0.u[1]) * n0.w;
        qn += bflo(q0.u[2]) * n1.x + bfhi(q0.u[2]) * n1.y + bflo(q0.u[3]) * n1.z + bfhi(q0.u[3]) * n1.w;
        qn += bflo(q1.u[0]) * n2.x + bfhi(q1.u[0]) * n2.y + bflo(q1.u[1]) * n2.z + bfhi(q1.u[1]) * n2.w;
        qn += bflo(q1.u[2]) * n3.x + bfhi(q1.u[2]) * n3.y + bflo(q1.u[3]) * n3.z + bfhi(q1.u[3]) * n3.w;
      }
      qn += __shfl_xor(qn, 16);
      qn += __shfl_xor(qn, 32);
      dsum += __shfl_xor(dsum, 16);
      dsum += __shfl_xor(dsum, 32);
      float den = dsum + winter * qn;
      float ih = 1.f / fmaxf(fabsf(den), __expf(-mt));
#pragma unroll
      for (int et = 0; et < 4; et++)
#pragma unroll
        for (int rr = 0; rr < 4; rr++) hs[et][rr] += (aw[et][rr] + winter * ac[et][rr]) * ih;
    }
    float ss = 0.f;
#pragma unroll
    for (int et = 0; et < 4; et++)
#pragma unroll
      for (int rr = 0; rr < 4; rr++) ss += hs[et][rr] * hs[et][rr];
    ss += __shfl_xor(ss, 16);
    ss += __shfl_xor(ss, 32);
    float rs = rsqrtf(ss * (1.f / 64.f) + 1e-6f);
#pragma unroll
    for (int et = 0; et < 4; et++) {
      int e0 = h * 64 + et * 16 + quad * 4;
      uint2 uo = *(const uint2*)(p.U + (size_t)trow * INC + 2560 + e0);
      float4 ng = *(const float4*)(p.ml_norm_g + l * 256 + e0);
      float o0 = hs[et][0] * rs * ng.x * sigmoidf_(bflo(uo.x));
      float o1 = hs[et][1] * rs * ng.y * sigmoidf_(bfhi(uo.x));
      float o2 = hs[et][2] * rs * ng.z * sigmoidf_(bflo(uo.y));
      float o3 = hs[et][3] * rs * ng.w * sigmoidf_(bfhi(uo.y));
      uint2 ov;
      ov.x = pack2(o0, o1);
      ov.y = pack2(o2, o3);
      *(uint2*)(p.Y + (size_t)trow * 1024 + 768 + e0) = ov;
    }
  }
}

typedef __attribute__((ext_vector_type(2))) float f32x2;
__device__ __forceinline__ float gelu_tanh(float x) {
  float u = 0.7978845608028654f * (x + 0.044715f * x * x * x);
  float th = 1.f - 2.f / (1.f + __expf(2.f * u));
  return 0.5f * x * (1.f + th);
}
__device__ __forceinline__ float dot16_fp8(const f32x2* xr, uint4 v) {
  f32x2 s = __builtin_amdgcn_cvt_pk_f32_fp8((int)v.x, false) * xr[0];
  s += __builtin_amdgcn_cvt_pk_f32_fp8((int)v.x, true) * xr[1];
  s += __builtin_amdgcn_cvt_pk_f32_fp8((int)v.y, false) * xr[2];
  s += __builtin_amdgcn_cvt_pk_f32_fp8((int)v.y, true) * xr[3];
  s += __builtin_amdgcn_cvt_pk_f32_fp8((int)v.z, false) * xr[4];
  s += __builtin_amdgcn_cvt_pk_f32_fp8((int)v.z, true) * xr[5];
  s += __builtin_amdgcn_cvt_pk_f32_fp8((int)v.w, false) * xr[6];
  s += __builtin_amdgcn_cvt_pk_f32_fp8((int)v.w, true) * xr[7];
  return s.x + s.y;
}
__device__ __forceinline__ void axpy16_fp8(f32x2* acc, float a, uint4 v) {
  f32x2 av = (f32x2){a, a};
  acc[0] += av * __builtin_amdgcn_cvt_pk_f32_fp8((int)v.x, false);
  acc[1] += av * __builtin_amdgcn_cvt_pk_f32_fp8((int)v.x, true);
  acc[2] += av * __builtin_amdgcn_cvt_pk_f32_fp8((int)v.y, false);
  acc[3] += av * __builtin_amdgcn_cvt_pk_f32_fp8((int)v.y, true);
  acc[4] += av * __builtin_amdgcn_cvt_pk_f32_fp8((int)v.z, false);
  acc[5] += av * __builtin_amdgcn_cvt_pk_f32_fp8((int)v.z, true);
  acc[6] += av * __builtin_amdgcn_cvt_pk_f32_fp8((int)v.w, false);
  acc[7] += av * __builtin_amdgcn_cvt_pk_f32_fp8((int)v.w, true);
}

__device__ __forceinline__ unsigned fkey(float f) {
  unsigned u = __float_as_uint(f);
  return (u & 0x80000000u) ? ~u : (u | 0x80000000u);
}
__device__ __forceinline__ int mbcnt64(unsigned long long m) {
  return __builtin_amdgcn_mbcnt_hi((unsigned)(m >> 32), __builtin_amdgcn_mbcnt_lo((unsigned)m, 0));
}
#define WAVE_LDS_FENCE() do { __builtin_amdgcn_fence(__ATOMIC_RELEASE, "wavefront"); __builtin_amdgcn_wave_barrier(); __builtin_amdgcn_fence(__ATOMIC_ACQUIRE, "wavefront"); } while (0)

#define RADIX_BODY(COUNT)                                                                  \
  unsigned pf = 0;                                                                         \
  int bit = 31;                                                                            \
  bool done = false;                                                                       \
  {                                                                                        \
    unsigned c = 0xC1000000u;                                                \
    int n = COUNT;                                                                         \
    n = __builtin_amdgcn_readfirstlane(n);                                                 \
    if (n < 16) {                                                                          \
      _Pragma("unroll 1") for (c = 0xC0800000u; c >= 0xBE800000u; c -= 0x00800000u) {      \
        n = COUNT;                                                                         \
        n = __builtin_amdgcn_readfirstlane(n);                                             \
        if (n >= 16) { pf = c; bit = 22; done = (n == 16); break; }                        \
      }                                                                                    \
    }                                                                                      \
  }                                                                                        \
  if (!done) {                                                                             \
    _Pragma("unroll 1") for (; bit >= 0; --bit) {                                          \
      const unsigned c = pf | (1u << bit);                                                 \
      int n = COUNT;                                                                       \
      n = __builtin_amdgcn_readfirstlane(n);                                               \
      if (n >= 16) { pf = c; if (n == 16) break; }                                         \
    }                                                                                      \
  }                                                                                        \
  return (unsigned)__builtin_amdgcn_readfirstlane((int)pf);
__device__ __forceinline__ unsigned radix_thr2(unsigned k0, unsigned k1) {
  RADIX_BODY((__popcll(__ballot(k0 >= c)) + __popcll(__ballot(k1 >= c))))
}
__device__ __forceinline__ unsigned radix_thr4(unsigned k0, unsigned k1, unsigned k2, unsigned k3) {
  RADIX_BODY((__popcll(__ballot(k0 >= c)) + __popcll(__ballot(k1 >= c)) + __popcll(__ballot(k2 >= c)) + __popcll(__ballot(k3 >= c))))
}
__device__ __forceinline__ void phase_peer_topk(const P& p, int l, char* smem) {
  const int tid = threadIdx.x, lane = tid & 63, w = tid >> 6;
  float* wl = (float*)smem + w * 512;
  float* cs = wl;
  int* ci = (int*)(wl + 32);
  int* el = (int*)(wl + 64);
  float* sl = wl + 192;
  const int nrows = (l == 1) ? ML_ROWS : MT_ROWS;
  const int nw = gridDim.x * 4;
  for (int row = blockIdx.x * 4 + w; row < nrows; row += nw) {
    float na0, na1, nb0, nb1;
    {
      const float* sp0 = p.S + (size_t)row * 2048;
      na0 = sp0[lane]; na1 = sp0[64 + lane]; nb0 = sp0[128 + lane]; nb1 = sp0[192 + lane];
    }
#pragma unroll 1
    for (int h = 0; h < 8; h++) {
      float a0 = na0, a1 = na1, b0 = nb0, b1 = nb1;
      {
        const float* spn = p.S + (size_t)row * 2048 + ((h + 1) & 7) * 256;
        na0 = spn[lane]; na1 = spn[64 + lane]; nb0 = spn[128 + lane]; nb1 = spn[192 + lane];
      }
      unsigned kA0 = fkey(a0), kA1 = fkey(a1), kB0 = fkey(b0), kB1 = fkey(b1);
      const unsigned pA = radix_thr2(kA0, kA1), pB = radix_thr2(kB0, kB1);
      {
        unsigned long long m0 = __ballot(kA0 >= pA), m1 = __ballot(kA1 >= pA);
        int p0 = mbcnt64(m0), p1 = __popcll(m0) + mbcnt64(m1);
        if (kA0 >= pA && p0 < 16) { cs[p0] = a0; ci[p0] = lane; }
        if (kA1 >= pA && p1 < 16) { cs[p1] = a1; ci[p1] = lane + 64; }
        m0 = __ballot(kB0 >= pB); m1 = __ballot(kB1 >= pB);
        p0 = mbcnt64(m0); p1 = __popcll(m0) + mbcnt64(m1);
        if (kB0 >= pB && p0 < 16) { cs[16 + p0] = b0; ci[16 + p0] = lane; }
        if (kB1 >= pB && p1 < 16) { cs[16 + p1] = b1; ci[16 + p1] = lane + 64; }
      }
      WAVE_LDS_FENCE();
      const int ii = lane >> 2, jb = (lane & 3) * 4;
      float s1 = cs[ii];
      float c0 = s1 + cs[16 + jb + 0], c1 = s1 + cs[16 + jb + 1], c2 = s1 + cs[16 + jb + 2], c3 = s1 + cs[16 + jb + 3];
      int e1 = ci[ii] * 128;
      int f0 = e1 + ci[16 + jb + 0], f1 = e1 + ci[16 + jb + 1], f2 = e1 + ci[16 + jb + 2], f3 = e1 + ci[16 + jb + 3];
      unsigned k0 = fkey(c0), k1 = fkey(c1), k2 = fkey(c2), k3 = fkey(c3);
      const unsigned pC = radix_thr4(k0, k1, k2, k3);
      {
        unsigned long long m0 = __ballot(k0 >= pC), m1 = __ballot(k1 >= pC), m2 = __ballot(k2 >= pC), m3 = __ballot(k3 >= pC);
        int q0 = mbcnt64(m0);
        int q1 = __popcll(m0) + mbcnt64(m1);
        int q2 = __popcll(m0) + __popcll(m1) + mbcnt64(m2);
        int q3 = __popcll(m0) + __popcll(m1) + __popcll(m2) + mbcnt64(m3);
        if (k0 >= pC && q0 < 16) { el[h * 16 + q0] = f0; sl[h * 16 + q0] = c0; }
        if (k1 >= pC && q1 < 16) { el[h * 16 + q1] = f1; sl[h * 16 + q1] = c1; }
        if (k2 >= pC && q2 < 16) { el[h * 16 + q2] = f2; sl[h * 16 + q2] = c2; }
        if (k3 >= pC && q3 < 16) { el[h * 16 + q3] = f3; sl[h * 16 + q3] = c3; }
      }
      WAVE_LDS_FENCE();
    }
    {
      float v0 = sl[lane], v1 = sl[64 + lane];
      float m0 = v0, m1 = v1;
#pragma unroll
      for (int o = 1; o < 16; o <<= 1) { m0 = fmaxf(m0, __shfl_xor(m0, o)); m1 = fmaxf(m1, __shfl_xor(m1, o)); }
      float e0 = __expf(v0 - m0), e1 = __expf(v1 - m1);
      float s0 = e0, s1 = e1;
#pragma unroll
      for (int o = 1; o < 16; o <<= 1) { s0 += __shfl_xor(s0, o); s1 += __shfl_xor(s1, o); }
      sl[lane] = e0 / s0;
      sl[64 + lane] = e1 / s1;
    }
    WAVE_LDS_FENCE();
    p.elist[(size_t)row * 128 + lane] = el[lane];
    p.elist[(size_t)row * 128 + 64 + lane] = el[64 + lane];
    p.glist[(size_t)row * 128 + lane] = sl[lane];
    p.glist[(size_t)row * 128 + 64 + lane] = sl[64 + lane];
    p.slist[(size_t)row * 128 + lane] = p.su[l * 16384 + el[lane]];
    p.slist[(size_t)row * 128 + 64 + lane] = p.su[l * 16384 + el[64 + lane]];
    WAVE_LDS_FENCE();
  }
}

struct PeerMeta {
  int id0, id1;
  uint4 xq;
  float h0[8], h1[8], g0, g1, s0, s1;
};
template <int PH>
__device__ __forceinline__ void peer_load_meta(const P& p, int t, int k, int lane, PeerMeta& m) {
  m.id0 = p.elist[(size_t)t * 128 + lane];
  m.id1 = p.elist[(size_t)t * 128 + 64 + lane];
  if (PH == 0) {
    m.xq = *(const uint4*)(p.xq + (size_t)t * 1024 + k * 128 + (lane & 7) * 16);
  } else {
#pragma unroll
    for (int kk = 0; kk < 8; kk++) {
      m.h0[kk] = p.hp[((size_t)t * 8 + kk) * 128 + lane];
      m.h1[kk] = p.hp[((size_t)t * 8 + kk) * 128 + 64 + lane];
    }
    m.g0 = p.glist[(size_t)t * 128 + lane];
    m.g1 = p.glist[(size_t)t * 128 + 64 + lane];
    const float sxt = p.sx[t];
    m.s0 = p.slist[(size_t)t * 128 + lane] * sxt;
    m.s1 = p.slist[(size_t)t * 128 + 64 + lane] * sxt;
  }
}
template <int PH>
__device__ __forceinline__ void peer_issue(const PeerMeta& m, int* idb, float* alb, const unsigned char* tab, int lane, uint4* rr, uint4& xq) {
  idb[lane] = m.id0;
  idb[64 + lane] = m.id1;
  if (PH == 0) {
    xq = m.xq;
  } else {
    float h0 = ((m.h0[0] + m.h0[1]) + (m.h0[2] + m.h0[3])) + ((m.h0[4] + m.h0[5]) + (m.h0[6] + m.h0[7]));
    float h1 = ((m.h1[0] + m.h1[1]) + (m.h1[2] + m.h1[3])) + ((m.h1[4] + m.h1[5]) + (m.h1[6] + m.h1[7]));
    alb[lane] = gelu_tanh(h0 * m.s0) * m.g0;
    alb[64 + lane] = gelu_tanh(h1 * m.s1) * m.g1;
  }
  WAVE_LDS_FENCE();
  const int es = lane >> 3;
#pragma unroll
  for (int i = 0; i < 16; i++) rr[i] = *(const uint4*)(tab + (size_t)idb[i * 8 + es] * 128);
}
template <int PH>
__device__ __forceinline__ void peer_compute(const P& p, int l, int t, bool valid, int k, int lane, const uint4* rr, const uint4& xq4, const float* alb) {
  const int es = lane >> 3;
  const int s0 = (PH == 0) ? 1 : 8, s1 = (PH == 0) ? 2 : 16, s2 = (PH == 0) ? 4 : 32;
  const bool c0 = (lane & s0) != 0, c1 = (lane & s1) != 0, c2 = (lane & s2) != 0;
  const int B = (c0 ? 8 : 0) + (c1 ? 4 : 0) + (c2 ? 2 : 0);
  float v[16];
  if (PH == 0) {
#pragma unroll
    for (int i = 0; i < 16; i++) {
      int a_ = __builtin_amdgcn_sdot4((int)rr[i].x, (int)xq4.x, 0, false);
      a_ = __builtin_amdgcn_sdot4((int)rr[i].y, (int)xq4.y, a_, false);
      a_ = __builtin_amdgcn_sdot4((int)rr[i].z, (int)xq4.z, a_, false);
      a_ = __builtin_amdgcn_sdot4((int)rr[i].w, (int)xq4.w, a_, false);
      v[i] = (float)a_;
    }
  } else {
    f32x2 acc[8];
#pragma unroll
    for (int i = 0; i < 8; i++) acc[i] = (f32x2){0.f, 0.f};
#pragma unroll
    for (int i = 0; i < 16; i++) axpy16_fp8(acc, alb[i * 8 + es], rr[i]);
#pragma unroll
    for (int i = 0; i < 8; i++) { v[2 * i] = acc[i].x; v[2 * i + 1] = acc[i].y; }
  }
  float k8[8], k4[4], k2[2];
#pragma unroll
  for (int i = 0; i < 8; i++) k8[i] = (c0 ? v[i + 8] : v[i]) + __shfl_xor(c0 ? v[i] : v[i + 8], s0);
#pragma unroll
  for (int i = 0; i < 4; i++) k4[i] = (c1 ? k8[i + 4] : k8[i]) + __shfl_xor(c1 ? k8[i] : k8[i + 4], s1);
#pragma unroll
  for (int i = 0; i < 2; i++) k2[i] = (c2 ? k4[i + 2] : k4[i]) + __shfl_xor(c2 ? k4[i] : k4[i + 2], s2);
  if (PH == 0) {
    float* hq = p.hp + ((size_t)t * 8 + k) * 128;
    if (valid) {
      hq[(B + 0) * 8 + es] = k2[0];
      hq[(B + 1) * 8 + es] = k2[1];
    }
  } else {
    const int col = k * 128 + (lane & 7) * 16 + B;
    const int mr = t < ML_ROWS ? (t >> 11) : 8;
    const float2 g2 = *(const float2*)(p.mod + (size_t)(l * 9 + mr) * 6144 + 5120 + col);
    float2* dst = (float2*)(t < ML_ROWS ? p.out + (size_t)t * 1024 + col : p.hc + (size_t)(t - ML_ROWS) * 1024 + col);
    float2 cur = *dst;
    cur.x += g2.x * 0.125f * k2[0];
    cur.y += g2.y * 0.125f * k2[1];
    if (valid) *dst = cur;
  }
}
template <int PH>
__device__ __forceinline__ void phase_peer_uv(const P& p, int l, char* smem) {
  const int tid = threadIdx.x, lane = tid & 63, w = tid >> 6;
  int* idA = (int*)smem + w * 512;
  int* idB = idA + 128;
  float* alA = (float*)(idA + 256);
  float* alB = alA + 128;
  const int nrows = (l == 1) ? ML_ROWS : MT_ROWS;
  const int k = blockIdx.x & 7;
  const int gw = (blockIdx.x >> 3) * 4 + w, ngw = (gridDim.x >> 3) * 4;
  const unsigned char* tab = (const unsigned char*)(PH == 0 ? p.Ub : p.Vb) + (size_t)((l * 8 + k) * 16384) * 128 + (lane & 7) * 16;
  PeerMeta M;
  uint4 rrA[16], rrB[16];
  uint4 xqA = make_uint4(0, 0, 0, 0), xqB = xqA;
  if (gw >= nrows) return;
  const int nit = (nrows - gw + ngw - 1) / ngw;
  const int tlast = gw + (nit - 1) * ngw;
  peer_load_meta<PH>(p, gw, k, lane, M);
  peer_issue<PH>(M, idA, alA, tab, lane, rrA, xqA);
  peer_load_meta<PH>(p, min(gw + ngw, tlast), k, lane, M);
#pragma unroll 1
  for (int i = 0; i < nit; i += 2) {
    const int tA = gw + i * ngw, tB = tA + ngw;
    peer_issue<PH>(M, idB, alB, tab, lane, rrB, xqB);
    peer_load_meta<PH>(p, min(tB + ngw, tlast), k, lane, M);
    peer_compute<PH>(p, l, tA, true, k, lane, rrA, xqA, alA);
    peer_issue<PH>(M, idA, alA, tab, lane, rrA, xqA);
    peer_load_meta<PH>(p, min(tB + 2 * ngw, tlast), k, lane, M);
    peer_compute<PH>(p, l, min(tB, tlast), tB <= tlast, k, lane, rrB, xqB, alB);
  }
}

#define RUN(k, call)                         \
  if (lo <= (k) && (k) < hi) {               \
    call;                                    \
    if ((k) + 1 < hi) xcd_barrier(xb);       \
  }
#define LAYER(l, base)                                                                                                    \
  RUN(base + 0, phase_norm(p, l, 1))                                                                                     \
  RUN(base + 1, phase_gemm<0>(p, l, p.xn, p.WinT + (size_t)l * INC_PAD * 1024, MT_ROWS / 128, INC_PAD / 128, smem))     \
  RUN(base + 2, phase_mixprep(p, l, smem))                                                                               \
  RUN(base + 3, phase_attn_mlA(p, l, smem))                                                                              \
  RUN(base + 4, phase_attn_mlB(p, l, smem))                                                                                            \
  RUN(base + 5, phase_mlC(p, l, smem))                                                                                   \
  RUN(base + 6, phase_gemm<1>(p, l, p.Y, p.WoutT + (size_t)l * 1024 * 1024, (l == 0 ? MT_ROWS : ML_ROWS) / 128, 8, smem)) \
  RUN(base + 7, phase_norm(p, l, 2))                                                                                     \
  RUN(base + 8, phase_gemm<2>(p, l, p.xn, p.WsT + (size_t)l * 2048 * 1024, (l == 0 ? MT_ROWS : ML_ROWS) / 128, 16, smem)) \
  RUN(base + 9, phase_peer_topk(p, l, smem))                                                                             \
  RUN(base + 10, phase_peer_uv<0>(p, l, smem))                                                                            \
  RUN(base + 11, phase_peer_uv<1>(p, l, smem))

__global__ void __launch_bounds__(256, 2) fwd_kernel(P p) {
  __shared__ __attribute__((aligned(16))) char smem[SMEM_BYTES];
  __shared__ uint4 xb_words;
  cg::grid_group grid = cg::this_grid();
  const int lo = (int)p.ph_lo, hi = (int)p.ph_hi;
  if (threadIdx.x == 0) xb_words = make_uint4(0u, 0u, 0u, 0u);
  __syncthreads();
  XcdBarrier xb = xcd_barrier_post(p.bar, (volatile LAS unsigned*)&xb_words);
  if (hi - lo > 1) grid.sync();
  RUN(0, phase_prologue(p, smem))
  LAYER(0, 1)
  LAYER(1, 13)
}

extern "C" void kernel_launch(void* const* d_in, const int* in_sizes, int n_in, void* d_out, int out_size, void* d_ws,
                              size_t ws_size, hipStream_t stream) {
  static int grid_blocks = 0;
  if (!grid_blocks) {
    int dev = 0, cus = 0, per_cu = 0;
    hipGetDevice(&dev);
    hipDeviceGetAttribute(&cus, hipDeviceAttributeMultiprocessorCount, dev);
    hipOccupancyMaxActiveBlocksPerMultiprocessor(&per_cu, fwd_kernel, 256, 0);
    if (per_cu < 1) per_cu = 1;
    if (per_cu > 2) per_cu = 2;
    grid_blocks = (cus * per_cu) & ~7;
  }
  P p{};
  const float** ins = (const float**)&p;
  for (int i = 0; i < 22; i++) ins[i] = (const float*)d_in[i];
  p.out = (float*)d_out;
  char* ws = (char*)d_ws;
  size_t off = 0;
  auto take = [&](size_t bytes) { char* r = ws + off; off += (bytes + 255) & ~(size_t)255; return r; };
  p.WinT = (u16*)take((size_t)2 * INC_PAD * 1024 * 2);
  p.WoutT = (u16*)take((size_t)2 * 1024 * 1024 * 2);
  p.WsT = (u16*)take((size_t)2 * 2048 * 1024 * 2);
  p.Ub = (u16*)take((size_t)2 * 16384 * 1024);
  p.Vb = (u16*)take((size_t)2 * 16384 * 1024);
  p.xq = (signed char*)take((size_t)MT_ROWS * 1024);
  p.sx = (float*)take((size_t)MT_ROWS * 4);
  p.su = (float*)take((size_t)2 * 16384 * 4);
  p.slist = (float*)take((size_t)MT_ROWS * 128 * 4);
  p.elist = (int*)take((size_t)MT_ROWS * 128 * 4);
  p.glist = (float*)take((size_t)MT_ROWS * 128 * 4);
  p.mod = (float*)take((size_t)2 * 9 * 6144 * 4);
  p.xn = (u16*)take((size_t)MT_ROWS * 1024 * 2);
  p.U = (u16*)take((size_t)MT_ROWS * INC * 2);
  p.MQK = (float*)take((size_t)MT_ROWS * 512 * 2);
  p.Y = (u16*)take((size_t)MT_ROWS * 1024 * 2);
  p.S = (float*)p.U;
  p.hp = (float*)take((size_t)MT_ROWS * 8 * 128 * 4);
  p.G = (float*)take((size_t)MT_ROWS * 16 * 4);
  p.mst = (float*)take((size_t)2304 * SLOT * 4);
  p.hc = (float*)take((size_t)MC_ROWS * 1024 * 4);
  p.bar = (unsigned*)take((size_t)XCD_BAR_WORDS * 4);
  p.VTm = (u16*)take((size_t)(8 * 4 * 64) * (2048 + 256) * 2);
  p.VT = (u16*)take((size_t)(8 * 8 * 64) * (2048 + 256) * 2);
  if (off > ws_size) { fprintf(stderr, "workspace too small: need %zu have %zu\n", off, ws_size); return; }
  (void)hipMemsetAsync(p.bar, 0, (size_t)XCD_BAR_WORDS * 4, stream);
#if MEGA
  p.ph_lo = 0; p.ph_hi = NPHASES;
  void* args[] = {&p};
  hipError_t e = hipLaunchCooperativeKernel((void*)fwd_kernel, dim3(grid_blocks), dim3(256), args, 0, stream);
  if (e != hipSuccess) fprintf(stderr, "cooperative launch failed: %s (grid %d)\n", hipGetErrorString(e), grid_blocks);
#else
  for (int ph = 0; ph < NPHASES; ph++) {
    p.ph_lo = ph; p.ph_hi = ph + 1;
    void* args[] = {&p};
    hipError_t e = hipLaunchCooperativeKernel((void*)fwd_kernel, dim3(grid_blocks), dim3(256), args, 0, stream);
    if (e != hipSuccess) fprintf(stderr, "cooperative launch failed: %s (grid %d)\n", hipGetErrorString(e), grid_blocks);
  }
#endif
}
```

```cpp
#include <hip/hip_runtime.h>
#include <hip/hip_cooperative_groups.h>
#include <cstdio>
namespace cg = cooperative_groups;

#ifndef MEGA
#define MEGA 1
#endif

typedef unsigned short u16;
typedef __attribute__((ext_vector_type(8))) short bf16x8;
typedef __attribute__((ext_vector_type(4))) float f32x4;

#define ML_ROWS 16384
#define MC_ROWS 2048
#define MT_ROWS 18432
#define INC 2832
#define INC_PAD 2944
#define SLOT 4480
#define SMEM_BYTES 69632
#define NPHASES 25

struct P {
  const float *x, *c, *ctx, *c_ctx, *w_ada, *b_ada, *norm1_g, *w_in, *ml_gate_b, *na_q_g, *na_k_g, *na_rpb,
      *pool_w, *pool_scale, *ml_conv, *ml_norm_g, *w_out, *norm2_g, *peer_wq, *peer_keys, *peer_u, *peer_v;
  float* out;
  u16 *WinT, *WoutT, *WsT, *Ub, *Vb;
  float* mod;
  u16* xn;
  u16* U;
  float* MQK;
  u16* Y;
  float* S;
  float* G;
  float* mst;
  float* hc;
  u16* VT;
  u16* VTm;
  signed char* xq;
  float* sx;
  float* su;
  float* slist;
  int* elist;
  float* glist;
  float* hp;
  unsigned* bar;
  long long ph_lo, ph_hi;
};

__device__ __forceinline__ u16 f2bf(float f) {
  unsigned u = __float_as_uint(f);
  u += 0x7fffu + ((u >> 16) & 1u);
  return (u16)(u >> 16);
}
__device__ __forceinline__ float bf2f(u16 h) { return __uint_as_float(((unsigned)h) << 16); }
__device__ __forceinline__ float bflo(unsigned u) { return __uint_as_float(u << 16); }
__device__ __forceinline__ float bfhi(unsigned u) { return __uint_as_float(u & 0xffff0000u); }
__device__ __forceinline__ unsigned pack2(float a, float b) { return (unsigned)f2bf(a) | ((unsigned)f2bf(b) << 16); }
__device__ __forceinline__ unsigned q8pack(float a, float b, float c, float d) {
  int qa = __float2int_rn(a), qb = __float2int_rn(b), qc = __float2int_rn(c), qd = __float2int_rn(d);
  return (unsigned)(qa & 0xff) | ((unsigned)(qb & 0xff) << 8) | ((unsigned)(qc & 0xff) << 16) | ((unsigned)(qd & 0xff) << 24);
}
__device__ __forceinline__ float wave_sum(float v) {
#pragma unroll
  for (int o = 32; o; o >>= 1) v += __shfl_xor(v, o);
  return v;
}
__device__ __forceinline__ void wave_argmax(float& v, int& i) {
#pragma unroll
  for (int o = 32; o; o >>= 1) {
    float ov = __shfl_xor(v, o);
    int oi = __shfl_xor(i, o);
    if (ov > v || (ov == v && oi < i)) { v = ov; i = oi; }
  }
}
__device__ __forceinline__ float sigmoidf_(float x) { return 1.f / (1.f + __expf(-x)); }
__device__ __forceinline__ float siluf_(float x) { return x / (1.f + __expf(-x)); }

#define XB_TMO      128
#define XB_XCNT(j)  (256  + 64 * (j))
#define XB_XSUB(j)  (1280 + 64 * (j))
#define XB_XGEN(j)  (2304 + 64 * (j))
#define XB_TOP      3328
#define XB_TOPGEN   3392
#define XCD_BAR_WORDS 3456
#define XB_SPIN_CAP (1u << 18)
#define LAS __attribute__((address_space(3)))
__device__ __forceinline__ unsigned xb_ld(unsigned* p)              { return __hip_atomic_load(p, __ATOMIC_RELAXED, __HIP_MEMORY_SCOPE_AGENT); }
__device__ __forceinline__ unsigned xb_add(unsigned* p, unsigned v) { return __hip_atomic_fetch_add(p, v, __ATOMIC_RELAXED, __HIP_MEMORY_SCOPE_AGENT); }
__device__ __forceinline__ unsigned xb_xcc_id() { return (unsigned)__builtin_amdgcn_s_getreg((3 << 11) | 20) & 0xFu; }
#define XB_SPIN(cond, bar) do { unsigned _sp = 0; while (cond) { __builtin_amdgcn_s_sleep(1); \
    if ((++_sp & 255u) == 0u) { if (xb_ld(&(bar)[XB_TMO])) break; if (_sp > XB_SPIN_CAP) { atomicAdd(&(bar)[XB_TMO], 1u); break; } } } } while (0)
struct XcdBarrier { unsigned* bar; unsigned x; volatile LAS unsigned* st; };
__device__ __forceinline__ XcdBarrier xcd_barrier_post(unsigned* bar, volatile LAS unsigned* st) {
    XcdBarrier b; b.bar = bar; b.x = xb_xcc_id(); b.st = st;
    if (threadIdx.x == 0) (void)xb_add(&bar[XB_XCNT(b.x)], 1u);
    return b;
}
__device__ __forceinline__ void xcd_barrier_complete(unsigned* bar, unsigned x, unsigned& nloc, unsigned& nx) {
    const unsigned G = gridDim.x * gridDim.y * gridDim.z;
    unsigned sum, cnt, mine, sp = 0u;
    for (;;) {
        sum = 0u; cnt = 0u; mine = 0u;
#pragma unroll
        for (unsigned j = 0; j < 16; ++j) { const unsigned c = xb_ld(&bar[XB_XCNT(j)]); sum += c; cnt += (c > 0u) ? 1u : 0u; mine = (j == x) ? c : mine; }
        if (sum == G) break;
        __builtin_amdgcn_s_sleep(1);
        if ((++sp & 255u) == 0u) { if (xb_ld(&bar[XB_TMO])) break; if (sp > XB_SPIN_CAP) { atomicAdd(&bar[XB_TMO], 1u); break; } }
    }
    nloc = mine > 0u ? mine : 1u; nx = cnt > 0u ? cnt : 1u;
}
__device__ __forceinline__ void xcd_barrier(const XcdBarrier& b) {
    asm volatile("s_waitcnt vmcnt(0)" ::: "memory");
    __syncthreads();
    if (threadIdx.x == 0) {
        unsigned* bar = b.bar;
        __builtin_amdgcn_s_waitcnt(0);
        unsigned nloc = b.st[0], nx = b.st[1];
        if (nloc == 0u) { xcd_barrier_complete(bar, b.x, nloc, nx); b.st[0] = nloc; b.st[1] = nx; }
        const unsigned old = xb_add(&bar[XB_XSUB(b.x)], 1u);
        const unsigned gen = old / nloc;
        if (old + 1u == (gen + 1u) * nloc) {
            __builtin_amdgcn_fence(__ATOMIC_RELEASE, "agent");
            asm volatile("s_waitcnt vmcnt(0)" ::: "memory");
            const unsigned og = xb_add(&bar[XB_TOP], 1u);
            const unsigned tg = og / nx;
            if (og + 1u == (tg + 1u) * nx) xb_add(&bar[XB_TOPGEN], 1u);
            else XB_SPIN(xb_ld(&bar[XB_TOPGEN]) == tg, bar);
            __builtin_amdgcn_fence(__ATOMIC_ACQUIRE, "agent");
            xb_add(&bar[XB_XGEN(b.x)], 1u);
            asm volatile("s_waitcnt vmcnt(0)" ::: "memory");
        } else {
            XB_SPIN(xb_ld(&bar[XB_XGEN(b.x)]) == gen, bar);
            __builtin_amdgcn_fence(__ATOMIC_ACQUIRE, "agent");
            asm volatile("s_waitcnt vmcnt(0)" ::: "memory");
        }
    }
    __syncthreads();
}

__device__ __forceinline__ void transpose_item(const float* __restrict__ src, int N, u16* __restrict__ dst, int kt, int nt, float* tl) {
  const int tid = threadIdx.x;
#pragma unroll 4
  for (int i = 0; i < 16; i++) {
    int idx = tid + 256 * i;
    int kk = idx >> 6, nn = idx & 63;
    int n = nt * 64 + nn;
    float v = (n < N) ? src[(size_t)(kt * 64 + kk) * N + n] : 0.f;
    tl[kk * 65 + nn] = v;
  }
  __syncthreads();
#pragma unroll 4
  for (int i = 0; i < 16; i++) {
    int idx = tid + 256 * i;
    int nn = idx >> 6, kk = idx & 63;
    dst[(size_t)(nt * 64 + nn) * 1024 + kt * 64 + kk] = f2bf(tl[kk * 65 + nn]);
  }
  __syncthreads();
}

__device__ __forceinline__ void wst_item(const P& p, int it, float* sm) {
  const int tid = threadIdx.x;
  int l = it >> 8, hp = (it >> 4) & 15, dt = it & 15;
  float* As = sm;
  float* Ks = sm + 64 * 33;
  const float* wq = p.peer_wq + (size_t)l * 1024 * 2048;
  const float* keys = p.peer_keys + ((size_t)l * 16 + hp) * 128 * 128;
  int d = tid & 63, cg_ = tid >> 6;
  float acc[32];
#pragma unroll
  for (int c = 0; c < 32; c++) acc[c] = 0.f;
  for (int jc = 0; jc < 4; jc++) {
    __syncthreads();
#pragma unroll
    for (int i = 0; i < 8; i++) {
      int idx = tid + 256 * i;
      int dd = idx >> 5, j = idx & 31;
      As[dd * 33 + j] = wq[(size_t)(dt * 64 + dd) * 2048 + hp * 128 + jc * 32 + j];
    }
#pragma unroll
    for (int i = 0; i < 16; i++) {
      int idx = tid + 256 * i;
      int k = idx >> 5, j = idx & 31;
      Ks[k * 33 + j] = keys[k * 128 + jc * 32 + j];
    }
    __syncthreads();
    for (int j = 0; j < 32; j++) {
      float a = As[d * 33 + j];
#pragma unroll
      for (int c = 0; c < 32; c++) acc[c] += a * Ks[(cg_ * 32 + c) * 33 + j];
    }
  }
  u16* dst = p.WsT + (size_t)l * 2048 * 1024;
#pragma unroll
  for (int c = 0; c < 32; c++) dst[(size_t)(hp * 128 + cg_ * 32 + c) * 1024 + dt * 64 + d] = f2bf(acc[c]);
  __syncthreads();
}

__device__ __forceinline__ void mod_item(const P& p, int it, float* sm) {
  const int tid = threadIdx.x;
  int l = it / 96, cc = it % 96;
  float* sc = sm;
  float* red = sm + 9216;
  for (int idx = tid; idx < 9216; idx += 256) {
    int r = idx >> 10, k = idx & 1023;
    float v = (r < 8) ? p.c[r * 1024 + k] : p.c_ctx[k];
    sc[idx] = siluf_(v);
  }
  __syncthreads();
  int cl = tid & 63, kg = tid >> 6;
  int col = cc * 64 + cl;
  float acc[9];
#pragma unroll
  for (int r = 0; r < 9; r++) acc[r] = 0.f;
  const float* wa = p.w_ada + (size_t)l * 1024 * 6144;
#pragma unroll 16
  for (int k = kg * 256; k < kg * 256 + 256; k++) {
    float w = wa[(size_t)k * 6144 + col];
#pragma unroll
    for (int r = 0; r < 9; r++) acc[r] += sc[r * 1024 + k] * w;
  }
#pragma unroll
  for (int r = 0; r < 9; r++) red[(kg * 9 + r) * 64 + cl] = acc[r];
  __syncthreads();
  if (kg == 0) {
    float bb = p.b_ada[l * 6144 + col];
#pragma unroll
    for (int r = 0; r < 9; r++) {
      float s = red[(0 * 9 + r) * 64 + cl] + red[(1 * 9 + r) * 64 + cl] + red[(2 * 9 + r) * 64 + cl] + red[(3 * 9 + r) * 64 + cl];
      p.mod[(size_t)(l * 9 + r) * 6144 + col] = s + bb;
    }
  }
  __syncthreads();
}

__device__ __forceinline__ void phase_prologue(const P& p, char* smem) {
  float* sm = (float*)smem;
  const int tid = threadIdx.x;
  const int N_A = 2 * 16 * 46, N_B = 2 * 16 * 16, N_C = 512, N_D = 192, N_E = 4096;
  const int total = N_A + N_B + N_C + N_D + N_E;
  for (int item = blockIdx.x; item < total; item += gridDim.x) {
    int it = item;
    if (it < N_D) { mod_item(p, it, sm); continue; }
    it -= N_D;
    if (it < N_C) { wst_item(p, it, sm); continue; }
    it -= N_C;
    if (it < N_A) {
      int l = it / (16 * 46), r = it % (16 * 46);
      transpose_item(p.w_in + (size_t)l * 1024 * INC, INC, p.WinT + (size_t)l * INC_PAD * 1024, r / 46, r % 46, sm);
      continue;
    }
    it -= N_A;
    if (it < N_B) {
      int l = it >> 8, r = it & 255;
      transpose_item(p.w_out + (size_t)l * 1024 * 1024, 1024, p.WoutT + (size_t)l * 1024 * 1024, r >> 4, r & 15, sm);
      continue;
    }
    it -= N_B;
    {
      if ((it >> 11) == 0) {
        const int lane_ = tid & 63, w_ = tid >> 6;
        const int chunk_ = it & 2047;
#pragma unroll
        for (int rr = 0; rr < 4; rr++) {
          const int R = chunk_ * 16 + w_ * 4 + rr;
          const float4* src = (const float4*)(p.peer_u + (size_t)R * 1024 + lane_ * 16);
          float4 v0 = src[0], v1 = src[1], v2 = src[2], v3 = src[3];
          float mx = fmaxf(fmaxf(fmaxf(fabsf(v0.x), fabsf(v0.y)), fmaxf(fabsf(v0.z), fabsf(v0.w))), fmaxf(fmaxf(fabsf(v1.x), fabsf(v1.y)), fmaxf(fabsf(v1.z), fabsf(v1.w))));
          mx = fmaxf(mx, fmaxf(fmaxf(fmaxf(fabsf(v2.x), fabsf(v2.y)), fmaxf(fabsf(v2.z), fabsf(v2.w))), fmaxf(fmaxf(fabsf(v3.x), fabsf(v3.y)), fmaxf(fabsf(v3.z), fabsf(v3.w)))));
#pragma unroll
          for (int o = 32; o; o >>= 1) mx = fmaxf(mx, __shfl_xor(mx, o));
          const float inv = mx > 0.f ? 127.f / mx : 0.f;
          uint4 o;
          o.x = q8pack(v0.x * inv, v0.y * inv, v0.z * inv, v0.w * inv);
          o.y = q8pack(v1.x * inv, v1.y * inv, v1.z * inv, v1.w * inv);
          o.z = q8pack(v2.x * inv, v2.y * inv, v2.z * inv, v2.w * inv);
          o.w = q8pack(v3.x * inv, v3.y * inv, v3.z * inv, v3.w * inv);
          const unsigned ll = (unsigned)R >> 14, ee = (unsigned)R & 16383u;
          size_t off = ((size_t)((ll * 8u + (unsigned)(lane_ >> 3)) * 16384u + ee)) * 128 + (lane_ & 7) * 16;
          *(uint4*)((unsigned char*)p.Ub + off) = o;
          if (lane_ == 0) p.su[R] = mx * (1.f / 127.f);
        }
        continue;
      }
      int tab = it >> 11;
      int chunk = it & 2047;
      const float scl = tab ? 8.f : 64.f;
      const float4* src = (const float4*)(tab ? p.peer_v : p.peer_u) + (size_t)chunk * 4096;
      unsigned char* dstb = (unsigned char*)(tab ? p.Vb : p.Ub);
#pragma unroll
      for (int i = 0; i < 4; i++) {
        int q = i * 256 + tid;
        float4 v0 = src[q * 4 + 0], v1 = src[q * 4 + 1], v2 = src[q * 4 + 2], v3 = src[q * 4 + 3];
        uint4 o;
        int w_;
        w_ = __builtin_amdgcn_cvt_pk_fp8_f32(v0.x * scl, v0.y * scl, 0, false);
        w_ = __builtin_amdgcn_cvt_pk_fp8_f32(v0.z * scl, v0.w * scl, w_, true);
        o.x = (unsigned)w_;
        w_ = __builtin_amdgcn_cvt_pk_fp8_f32(v1.x * scl, v1.y * scl, 0, false);
        w_ = __builtin_amdgcn_cvt_pk_fp8_f32(v1.z * scl, v1.w * scl, w_, true);
        o.y = (unsigned)w_;
        w_ = __builtin_amdgcn_cvt_pk_fp8_f32(v2.x * scl, v2.y * scl, 0, false);
        w_ = __builtin_amdgcn_cvt_pk_fp8_f32(v2.z * scl, v2.w * scl, w_, true);
        o.z = (unsigned)w_;
        w_ = __builtin_amdgcn_cvt_pk_fp8_f32(v3.x * scl, v3.y * scl, 0, false);
        w_ = __builtin_amdgcn_cvt_pk_fp8_f32(v3.z * scl, v3.w * scl, w_, true);
        o.w = (unsigned)w_;
        {
          unsigned G = (unsigned)chunk * 1024u + (unsigned)q;
          unsigned ll = G >> 20, ee = (G >> 6) & 16383u, cgp = G & 63u;
          size_t off = ((size_t)((ll * 8u + (cgp >> 3)) * 16384u + ee)) * 128 + (cgp & 7u) * 16;
          *(uint4*)(dstb + off) = o;
        }
      }
    }
  }
}

__device__ __forceinline__ void phase_norm(const P& p, int l, int which) {
  const int tid = threadIdx.x, lane = tid & 63, w = tid >> 6;
  const int nrows = (which == 2 && l == 1) ? ML_ROWS : MT_ROWS;
  const float* g = (which == 1 ? p.norm1_g : p.norm2_g) + l * 1024;
  for (int item = blockIdx.x; item * 4 < nrows; item += gridDim.x) {
    int row = item * 4 + w;
    const float* src;
    if (l == 0 && which == 1) src = row < ML_ROWS ? p.x + (size_t)row * 1024 : p.ctx + (size_t)(row - ML_ROWS) * 1024;
    else src = row < ML_ROWS ? p.out + (size_t)row * 1024 : p.hc + (size_t)(row - ML_ROWS) * 1024;
    int mr = row < ML_ROWS ? (row >> 11) : 8;
    const float* modp = p.mod + (size_t)(l * 9 + mr) * 6144;
    const float* sh = modp + (which == 1 ? 0 : 3072);
    const float* sc = modp + (which == 1 ? 1024 : 4096);
    float4 v[4];
    float ss = 0.f;
#pragma unroll
    for (int i = 0; i < 4; i++) {
      v[i] = ((const float4*)src)[i * 64 + lane];
      ss += v[i].x * v[i].x + v[i].y * v[i].y + v[i].z * v[i].z + v[i].w * v[i].w;
    }
    ss = wave_sum(ss);
    float rs = rsqrtf(ss * (1.f / 1024.f) + 1e-6f);
    float ov[16];
    float omax = 0.f;
#pragma unroll
    for (int i = 0; i < 4; i++) {
      int d = (i * 64 + lane) * 4;
      float4 gg = *(const float4*)(g + d);
      float4 s4 = *(const float4*)(sc + d);
      float4 h4 = *(const float4*)(sh + d);
      float o0 = v[i].x * rs * gg.x * (1.f + s4.x) + h4.x;
      float o1 = v[i].y * rs * gg.y * (1.f + s4.y) + h4.y;
      float o2 = v[i].z * rs * gg.z * (1.f + s4.z) + h4.z;
      float o3 = v[i].w * rs * gg.w * (1.f + s4.w) + h4.w;
      uint2 o;
      o.x = pack2(o0, o1);
      o.y = pack2(o2, o3);
      ((uint2*)(p.xn + (size_t)row * 1024))[i * 64 + lane] = o;
      ov[i * 4 + 0] = o0; ov[i * 4 + 1] = o1; ov[i * 4 + 2] = o2; ov[i * 4 + 3] = o3;
      omax = fmaxf(omax, fmaxf(fmaxf(fabsf(o0), fabsf(o1)), fmaxf(fabsf(o2), fabsf(o3))));
    }
    if (which == 2) {
#pragma unroll
      for (int o = 32; o; o >>= 1) omax = fmaxf(omax, __shfl_xor(omax, o));
      const float inv = omax > 0.f ? 127.f / omax : 0.f;
#pragma unroll
      for (int i = 0; i < 4; i++)
        ((unsigned*)(p.xq + (size_t)row * 1024))[i * 64 + lane] = q8pack(ov[i * 4] * inv, ov[i * 4 + 1] * inv, ov[i * 4 + 2] * inv, ov[i * 4 + 3] * inv);
      if (lane == 0) p.sx[row] = omax * (1.f / 127.f);
    }
  }
}

template <int EPI>
__device__ __forceinline__ void phase_gemm(const P& p, int l, const u16* __restrict__ A, const u16* __restrict__ Bt, int mtiles, int ntiles,
                           char* smem) {
  u16* As = (u16*)smem;
  u16* Bs = As + 128 * 72;
  const int tid = threadIdx.x, lane = tid & 63, w = tid >> 6, wm = w >> 1, wn = w & 1;
  const int lr = lane & 15, quad = lane >> 4;
  const int xk = blockIdx.x & 7, lb = blockIdx.x >> 3, nb = gridDim.x >> 3;
  const int mg = xk >> 1;
  const int nh0 = (ntiles + 1) >> 1;
  const int nbase = (xk & 1) ? nh0 : 0, nloc = (xk & 1) ? (ntiles - nh0) : nh0;
  const int mcount = (mtiles - mg + 3) >> 2;
  const int nlocal = mcount * nloc;
  for (int li = lb; li < nlocal; li += nb) {
    int mi = li / nloc;
    int mt = mg + 4 * mi, nt = nbase + (li - mi * nloc);
    int m0 = mt * 128, n0 = nt * 128;
    f32x4 acc[4][4];
#pragma unroll
    for (int i = 0; i < 4; i++)
#pragma unroll
      for (int j = 0; j < 4; j++) acc[i][j] = (f32x4){0.f, 0.f, 0.f, 0.f};
    const int r0_ = tid >> 3, ch_ = tid & 7;
    const u16* Ap0 = A + (size_t)(m0 + r0_) * 1024 + ch_ * 8;
    const u16* Bp0 = Bt + (size_t)(n0 + r0_) * 1024 + ch_ * 8;
    uint4 ra0 = *(const uint4*)Ap0, ra1 = *(const uint4*)(Ap0 + 32 * 1024), ra2 = *(const uint4*)(Ap0 + 64 * 1024), ra3 = *(const uint4*)(Ap0 + 96 * 1024);
    uint4 rb0 = *(const uint4*)Bp0, rb1 = *(const uint4*)(Bp0 + 32 * 1024), rb2 = *(const uint4*)(Bp0 + 64 * 1024), rb3 = *(const uint4*)(Bp0 + 96 * 1024);
    for (int kt = 0; kt < 16; kt++) {
      __syncthreads();
      *(uint4*)(As + r0_ * 72 + ch_ * 8) = ra0;
      *(uint4*)(As + (r0_ + 32) * 72 + ch_ * 8) = ra1;
      *(uint4*)(As + (r0_ + 64) * 72 + ch_ * 8) = ra2;
      *(uint4*)(As + (r0_ + 96) * 72 + ch_ * 8) = ra3;
      *(uint4*)(Bs + r0_ * 72 + ch_ * 8) = rb0;
      *(uint4*)(Bs + (r0_ + 32) * 72 + ch_ * 8) = rb1;
      *(uint4*)(Bs + (r0_ + 64) * 72 + ch_ * 8) = rb2;
      *(uint4*)(Bs + (r0_ + 96) * 72 + ch_ * 8) = rb3;
      __syncthreads();
      if (kt < 15) {
        const int ko = (kt + 1) * 64;
        ra0 = *(const uint4*)(Ap0 + ko); ra1 = *(const uint4*)(Ap0 + 32 * 1024 + ko); ra2 = *(const uint4*)(Ap0 + 64 * 1024 + ko); ra3 = *(const uint4*)(Ap0 + 96 * 1024 + ko);
        rb0 = *(const uint4*)(Bp0 + ko); rb1 = *(const uint4*)(Bp0 + 32 * 1024 + ko); rb2 = *(const uint4*)(Bp0 + 64 * 1024 + ko); rb3 = *(const uint4*)(Bp0 + 96 * 1024 + ko);
      }
#pragma unroll
      for (int ks = 0; ks < 2; ks++) {
        bf16x8 a[4], b[4];
#pragma unroll
        for (int i = 0; i < 4; i++) {
          a[i] = *(const bf16x8*)(As + (wm * 64 + i * 16 + lr) * 72 + ks * 32 + quad * 8);
          b[i] = *(const bf16x8*)(Bs + (wn * 64 + i * 16 + lr) * 72 + ks * 32 + quad * 8);
        }
#pragma unroll
        for (int i = 0; i < 4; i++)
#pragma unroll
          for (int j = 0; j < 4; j++) acc[i][j] = __builtin_amdgcn_mfma_f32_16x16x32_bf16(b[j], a[i], acc[i][j], 0, 0, 0);
      }
    }
#pragma unroll
    for (int i = 0; i < 4; i++)
#pragma unroll
      for (int j = 0; j < 4; j++) {
        const int row = m0 + wm * 64 + i * 16 + lr;
        const int col = n0 + wn * 64 + j * 16 + quad * 4;
        const f32x4 v = acc[i][j];
        if (EPI == 0) {
          if (col < INC) {
            uint2 o;
            o.x = pack2(v[0], v[1]);
            o.y = pack2(v[2], v[3]);
            *(uint2*)(p.U + (size_t)row * INC + col) = o;
            if (col >= 2816) *(float4*)(p.G + row * 16 + (col - 2816)) = make_float4(v[0], v[1], v[2], v[3]);
          }
        } else if (EPI == 1) {
          const int mr = row < ML_ROWS ? (row >> 11) : 8;
          const float4 g1 = *(const float4*)(p.mod + (size_t)(l * 9 + mr) * 6144 + 2048 + col);
          float4 sv;
          if (l == 0) sv = row < ML_ROWS ? *(const float4*)(p.x + (size_t)row * 1024 + col) : *(const float4*)(p.ctx + (size_t)(row - ML_ROWS) * 1024 + col);
          else sv = *(const float4*)(p.out + (size_t)row * 1024 + col);
          float* dst = row < ML_ROWS ? p.out + (size_t)row * 1024 + col : p.hc + (size_t)(row - ML_ROWS) * 1024 + col;
          *(float4*)dst = make_float4(sv.x + g1.x * v[0], sv.y + g1.y * v[1], sv.z + g1.z * v[2], sv.w + g1.w * v[3]);
        } else {
          *(float4*)(p.S + (size_t)row * 2048 + col) = make_float4(v[0], v[1], v[2], v[3]);
        }
      }
  }
}

__device__ __forceinline__ void vt_item(const P& p, int it, u16* tl);
__device__ __forceinline__ void phase_mixprep(const P& p, int l, char* smem) {
  const int tid = threadIdx.x;
  float* pl = (float*)smem;
  const int N_QK = MT_ROWS * 16 / 256;
  const int N_POOL = (l == 0 ? MT_ROWS : ML_ROWS) / 16;
  const int N_PREP = MT_ROWS / 8;
  const int N_VT = 2304 + 1152;
  const int total = N_QK + N_POOL + N_PREP + N_VT;
  for (int item = blockIdx.x; item < total; item += gridDim.x) {
    int it = item;
    if (it >= N_QK + N_POOL + N_PREP) { vt_item(p, it - (N_QK + N_POOL + N_PREP), (u16*)smem); continue; }
    if (it < N_QK) {
      int gi = it * 256 + tid;
      int row = gi >> 4, sub = gi & 15;
      int qk = sub >> 3, h = sub & 7;
      u16* ptr = p.U + (size_t)row * INC + qk * 512 + h * 64;
      const float* g = (qk ? p.na_k_g : p.na_q_g) + l * 64;
      uint4 v[8];
      float ss = 0.f;
#pragma unroll
      for (int c = 0; c < 8; c++) {
        v[c] = ((const uint4*)ptr)[c];
        float a;
        a = bflo(v[c].x); ss += a * a; a = bfhi(v[c].x); ss += a * a;
        a = bflo(v[c].y); ss += a * a; a = bfhi(v[c].y); ss += a * a;
        a = bflo(v[c].z); ss += a * a; a = bfhi(v[c].z); ss += a * a;
        a = bflo(v[c].w); ss += a * a; a = bfhi(v[c].w); ss += a * a;
      }
      float rs = rsqrtf(ss * (1.f / 64.f) + 1e-6f);
#pragma unroll
      for (int c = 0; c < 8; c++) {
        uint4 o;
        o.x = pack2(bflo(v[c].x) * rs * g[c * 8 + 0], bfhi(v[c].x) * rs * g[c * 8 + 1]);
        o.y = pack2(bflo(v[c].y) * rs * g[c * 8 + 2], bfhi(v[c].y) * rs * g[c * 8 + 3]);
        o.z = pack2(bflo(v[c].z) * rs * g[c * 8 + 4], bfhi(v[c].z) * rs * g[c * 8 + 5]);
        o.w = pack2(bflo(v[c].w) * rs * g[c * 8 + 6], bfhi(v[c].w) * rs * g[c * 8 + 7]);
        ((uint4*)ptr)[c] = o;
      }
      continue;
    }
    it -= N_QK;
    if (it < N_POOL) {
      int row0 = it * 16;
      int base, T;
      if (row0 < ML_ROWS) { base = (row0 >> 11) << 11; T = 2048; }
      else { base = ML_ROWS + (((row0 - ML_ROWS) >> 8) << 8); T = 256; }
      int t0 = row0 - base;
      int ch = tid, g = ch >> 6;
      int wdw = 2 << g;
      __syncthreads();
      {
        float vals[31];
#pragma unroll
        for (int j = 0; j < 31; j++) {
          int tau = t0 - 8 + j;
          bool ok = (tau >= 0) && (tau < T);
          vals[j] = ok ? bf2f(p.U[(size_t)(base + (ok ? tau : t0)) * INC + 1536 + ch]) : 0.f;
        }
        const int hl = wdw / 2, hr = wdw - wdw / 2 - 1;
#pragma unroll
        for (int tt = 0; tt < 16; tt++) {
          int t = t0 + tt;
          int lo = max(t - hl, 0), hi = min(t + hr, T - 1);
          float s = 0.f;
#pragma unroll
          for (int j = 0; j < 31; j++) {
            int rel = j - 8 - tt;
            if (rel >= -8 && rel <= 7) s += (rel >= -hl && rel <= hr) ? vals[j] : 0.f;
          }
          pl[tt * 256 + ch] = s / (float)(hi - lo + 1) - vals[8 + tt];
        }
      }
      __syncthreads();
      float acc[16];
#pragma unroll
      for (int tt = 0; tt < 16; tt++) acc[tt] = 0.f;
      int d = ch & 63;
      const float* pw = p.pool_w + ((size_t)(l * 4 + g) * 64) * 64 + d;
      for (int c = 0; c < 64; c++) {
        float wv = pw[c * 64];
#pragma unroll
        for (int tt = 0; tt < 16; tt++) acc[tt] += pl[tt * 256 + g * 64 + c] * wv;
      }
      float ps = p.pool_scale[l * 256 + ch];
#pragma unroll
      for (int tt = 0; tt < 16; tt++) p.Y[(size_t)(row0 + tt) * 1024 + 512 + ch] = f2bf(acc[tt] * ps);
      continue;
    }
    it -= N_POOL;
    {
      const int row0 = it * 8;
      int base, T;
      if (row0 < ML_ROWS) { base = (row0 >> 11) << 11; T = 2048; }
      else { base = ML_ROWS + (((row0 - ML_ROWS) >> 8) << 8); T = 256; }
      const int t0 = row0 - base;
      const int qk = tid >> 7, hh = (tid >> 5) & 3, ax = (tid >> 4) & 1, f = tid & 15;
      const int ca = qk * 256 + hh * 64 + ax * 32 + f, cb = ca + 16;
      float ua[12], ub[12];
#pragma unroll
      for (int j = 0; j < 12; j++) {
        int tt = t0 + j - 2;
        bool ok = (tt >= 0) && (tt < T);
        const u16* ur = p.U + (size_t)(base + (ok ? tt : t0)) * INC + 1792;
        ua[j] = ok ? bf2f(ur[ca]) : 0.f;
        ub[j] = ok ? bf2f(ur[cb]) : 0.f;
      }
      float wa[5], wb[5];
#pragma unroll
      for (int j = 0; j < 5; j++) { wa[j] = p.ml_conv[(l * 5 + j) * 512 + ca]; wb[j] = p.ml_conv[(l * 5 + j) * 512 + cb]; }
      const float inv = __expf(-(float)f * (9.210340371976184f / 16.f));
#pragma unroll
      for (int i = 0; i < 8; i++) {
        float a = 0.f, b = 0.f;
#pragma unroll
        for (int j = 0; j < 5; j++) { a += wa[j] * ua[i + j]; b += wb[j] * ub[i + j]; }
        a = siluf_(a);
        b = siluf_(b);
        if (row0 < ML_ROWS) {
          int t = t0 + i;
          float pos = (float)(ax == 0 ? (t >> 6) : (t & 63));
          float ang = pos * inv;
          float cs = __cosf(ang), sn = __sinf(ang);
          float oa = a * cs - b * sn, ob = a * sn + b * cs;
          a = oa; b = ob;
        }
        if (qk) { a *= 0.125f; b *= 0.125f; }
        ((u16*)p.MQK)[(size_t)(row0 + i) * 512 + ca] = f2bf(a);
        ((u16*)p.MQK)[(size_t)(row0 + i) * 512 + cb] = f2bf(b);
      }
      if (tid < 128) {
        int gi = tid & 15;
        float gv = p.G[row0 * 16 + tid] + p.ml_gate_b[l * 16 + gi];
        if ((gi >> 2) & 1) gv = fminf(gv, 0.f) - log1pf(__expf(-fabsf(gv)));
        p.G[row0 * 16 + tid] = gv;
      }
    }
  }
}

#define VT_CTX_OFF ((size_t)8 * 8 * 64 * 2048)
#define VTM_CTX_OFF ((size_t)8 * 4 * 64 * 2048)
__device__ __forceinline__ void vt_item(const P& p, int it, u16* tl) {
  const int tid = threadIdx.x;
  int b, h, tt, row0, TK, col0;
  u16* dst;
  if (it < 2048) { b = it >> 8; h = (it >> 5) & 7; tt = it & 31; row0 = b * 2048 + tt * 64; TK = 2048; col0 = 1024 + h * 64; dst = p.VT + (size_t)((b * 8 + h) * 64) * 2048 + tt * 64; }
  else if (it < 2304) { int ci = it - 2048; b = ci >> 5; h = (ci >> 2) & 7; tt = ci & 3; row0 = ML_ROWS + b * 256 + tt * 64; TK = 256; col0 = 1024 + h * 64; dst = p.VT + VT_CTX_OFF + (size_t)((b * 8 + h) * 64) * 256 + tt * 64; }
  else if (it < 2304 + 1024) { int mi = it - 2304; b = mi >> 7; h = (mi >> 5) & 3; tt = mi & 31; row0 = b * 2048 + tt * 64; TK = 2048; col0 = 2304 + h * 64; dst = p.VTm + (size_t)((b * 4 + h) * 64) * 2048 + tt * 64; }
  else { int mi = it - 3328; b = mi >> 4; h = (mi >> 2) & 3; tt = mi & 3; row0 = ML_ROWS + b * 256 + tt * 64; TK = 256; col0 = 2304 + h * 64; dst = p.VTm + VTM_CTX_OFF + (size_t)((b * 4 + h) * 64) * 256 + tt * 64; }
  __syncthreads();
  {
    int i = tid >> 2, part = tid & 3;
    const uint4* src = (const uint4*)(p.U + (size_t)(row0 + i) * INC + col0 + part * 16);
    uint4 v0 = src[0], v1 = src[1];
    unsigned* t32 = (unsigned*)(tl + i * 66 + part * 16);
    t32[0] = v0.x; t32[1] = v0.y; t32[2] = v0.z; t32[3] = v0.w;
    t32[4] = v1.x; t32[5] = v1.y; t32[6] = v1.z; t32[7] = v1.w;
  }
  __syncthreads();
  {
    int d = tid >> 2, part = tid & 3;
    unsigned o[8];
#pragma unroll
    for (int k = 0; k < 8; k++) {
      unsigned lo = tl[(part * 16 + 2 * k) * 66 + d], hi = tl[(part * 16 + 2 * k + 1) * 66 + d];
      o[k] = lo | (hi << 16);
    }
    uint4* dp = (uint4*)(dst + (size_t)d * TK + part * 16);
    dp[0] = make_uint4(o[0], o[1], o[2], o[3]);
    dp[1] = make_uint4(o[4], o[5], o[6], o[7]);
  }
}

__device__ __forceinline__ void attn_item(const P& p, int l, int item, float* sb) {
  const int tid = threadIdx.x, lane = tid & 63, w = tid >> 6, q = lane & 15, quad = lane >> 4;
  const bool latent = item < 2048;
  int b, r = 0, h, qb = 0;
  if (latent) { b = item >> 8; r = (item >> 3) & 31; h = item & 7; }
  else { int ci = item - 2048; b = ci >> 5; qb = (ci >> 3) & 3; h = ci & 7; }
  const int r0 = min(max(r - 4, 0), 24);
  __syncthreads();
  if (latent) {
    int kr = tid >> 5, j = tid & 31;
    if (j < 31) sb[tid] = p.na_rpb[(size_t)((l * 8 + h) * 15 + (r0 + kr - r + 7)) * 31 + j];
  }
  __syncthreads();
  const int qc = w * 16 + q;
  const int qrow = latent ? (b * 2048 + r * 64 + qc) : (ML_ROWS + b * 256 + qb * 64 + qc);
  const int cs = (w == 0) ? 0 : (w == 1) ? 8 : (w == 2) ? 24 : 32;
  const int c0 = min(max(qc - 8, 0), 48);
  const bf16x8 bq0 = *(const bf16x8*)(p.U + (size_t)qrow * INC + h * 64 + quad * 8);
  const bf16x8 bq1 = *(const bf16x8*)(p.U + (size_t)qrow * INC + h * 64 + 32 + quad * 8);
  const int mrow = (q >> 2) * 8 + (q & 3);
  const u16* vt_lat = p.VT + (size_t)((b * 8 + h) * 64 + q) * 2048 + quad * 8;
  const u16* vt_ctx = p.VT + VT_CTX_OFF + (size_t)((b * 8 + h) * 64 + q) * 256 + quad * 8;
  float m = -INFINITY, lsum = 0.f;
  f32x4 o[4];
#pragma unroll
  for (int dt = 0; dt < 4; dt++) o[dt] = (f32x4){0.f, 0.f, 0.f, 0.f};
#pragma unroll 1
  for (int chunk = (latent ? 0 : 2); chunk < 4; chunk++) {
    f32x4 s[4][2];
#pragma unroll
    for (int blk = 0; blk < 4; blk++) {
      int rowbase = (chunk < 2) ? (b * 2048 + (r0 + chunk * 4 + blk) * 64 + cs) : (ML_ROWS + b * 256 + (chunk - 2) * 128 + blk * 32);
#pragma unroll
      for (int T = 0; T < 2; T++) {
        const u16* kp = p.U + (size_t)(rowbase + mrow + T * 4) * INC + 512 + h * 64 + quad * 8;
        bf16x8 a0 = *(const bf16x8*)kp;
        bf16x8 a1 = *(const bf16x8*)(kp + 32);
        f32x4 acc = (f32x4){0.f, 0.f, 0.f, 0.f};
        acc = __builtin_amdgcn_mfma_f32_16x16x32_bf16(a0, bq0, acc, 0, 0, 0);
        acc = __builtin_amdgcn_mfma_f32_16x16x32_bf16(a1, bq1, acc, 0, 0, 0);
        s[blk][T] = acc;
      }
    }
    float mx = -INFINITY;
    if (chunk < 2) {
#pragma unroll
      for (int blk = 0; blk < 4; blk++)
#pragma unroll
        for (int T = 0; T < 2; T++)
#pragma unroll
          for (int rr = 0; rr < 4; rr++) {
            int kc = cs + quad * 8 + T * 4 + rr;
            bool valid = (kc >= c0) && (kc < c0 + 16);
            int bi = (chunk * 4 + blk) * 32 + min(max(kc - qc + 15, 0), 30);
            float v = valid ? (s[blk][T][rr] * 0.125f + sb[bi]) : -INFINITY;
            s[blk][T][rr] = v;
            mx = fmaxf(mx, v);
          }
    } else {
#pragma unroll
      for (int blk = 0; blk < 4; blk++)
#pragma unroll
        for (int T = 0; T < 2; T++)
#pragma unroll
          for (int rr = 0; rr < 4; rr++) {
            float v = s[blk][T][rr] * 0.125f;
            s[blk][T][rr] = v;
            mx = fmaxf(mx, v);
          }
    }
    mx = fmaxf(mx, __shfl_xor(mx, 16));
    mx = fmaxf(mx, __shfl_xor(mx, 32));
    float mn = fmaxf(m, mx);
    float sc = __expf(m - mn);
    lsum *= sc;
#pragma unroll
    for (int dt = 0; dt < 4; dt++) o[dt] *= sc;
    m = mn;
#pragma unroll
    for (int blk = 0; blk < 4; blk++) {
      float pv[8];
#pragma unroll
      for (int T = 0; T < 2; T++)
#pragma unroll
        for (int rr = 0; rr < 4; rr++) {
          float e = __expf(s[blk][T][rr] - mn);
          pv[T * 4 + rr] = e;
          lsum += e;
        }
      union { bf16x8 v; unsigned u[4]; } pk;
      pk.u[0] = pack2(pv[0], pv[1]); pk.u[1] = pack2(pv[2], pv[3]); pk.u[2] = pack2(pv[4], pv[5]); pk.u[3] = pack2(pv[6], pv[7]);
      const u16* vb = (chunk < 2) ? (vt_lat + (r0 + chunk * 4 + blk) * 64 + cs) : (vt_ctx + (chunk - 2) * 128 + blk * 32);
      const size_t dstr = (chunk < 2) ? (size_t)16 * 2048 : (size_t)16 * 256;
#pragma unroll
      for (int dt = 0; dt < 4; dt++) {
        bf16x8 av = *(const bf16x8*)(vb + dt * dstr);
        o[dt] = __builtin_amdgcn_mfma_f32_16x16x32_bf16(av, pk.v, o[dt], 0, 0, 0);
      }
    }
  }
  lsum += __shfl_xor(lsum, 16);
  lsum += __shfl_xor(lsum, 32);
  float il = 1.f / lsum;
#pragma unroll
  for (int dt = 0; dt < 4; dt++) {
    uint2 ov;
    ov.x = pack2(o[dt][0] * il, o[dt][1] * il);
    ov.y = pack2(o[dt][2] * il, o[dt][3] * il);
    *(uint2*)(p.Y + (size_t)qrow * 1024 + h * 64 + dt * 16 + quad * 4) = ov;
  }
}

__device__ __forceinline__ int ml_row(int b, int dir, int j, int pp) {
  if (j < 4) {
    int pos = j * 64 + pp;
    int t = dir ? 255 - pos : pos;
    return ML_ROWS + b * 256 + t;
  } else {
    int pos = (j - 4) * 64 + pp;
    int t = dir ? 2047 - pos : pos;
    return b * 2048 + t;
  }
}

__device__ __forceinline__ void mlstmA_item(const P& p, int it, float* sm) {
  const int tid = threadIdx.x, lane = tid & 63;
  int seq = it / 36, j = it % 36;
  int b = seq >> 3, h = (seq >> 1) & 3, dir = seq & 1;
  float* ks = sm;
  float* vs = sm + 64 * 65;
  float* wsm = sm + 2 * 64 * 65;
  float* slot = p.mst + (size_t)it * SLOT;
  const u16* mqk = (const u16*)p.MQK;
  __syncthreads();
  for (int idx = tid; idx < 4096; idx += 256) {
    int pp = idx >> 6, d = idx & 63;
    int row = ml_row(b, dir, j, pp);
    ks[pp * 65 + d] = bf2f(mqk[(size_t)row * 512 + 256 + h * 64 + d]);
    vs[pp * 65 + d] = bf2f(p.U[(size_t)row * INC + 2304 + h * 64 + d]);
  }
  if (tid < 64) {
    int row = ml_row(b, dir, j, lane);
    float ic = p.G[row * 16 + (dir * 2) * 4 + h];
    float fc = p.G[row * 16 + (dir * 2 + 1) * 4 + h];
    float bbv = fc;
#pragma unroll
    for (int o = 1; o < 64; o <<= 1) { float u = __shfl_up(bbv, o); if (lane >= o) bbv += u; }
    float cs = ic - bbv;
    float pm = cs;
#pragma unroll
    for (int o = 1; o < 64; o <<= 1) { float u = __shfl_up(pm, o); if (lane >= o) pm = fmaxf(pm, u); }
    float bl = __shfl(bbv, 63);
    float ml = __shfl(pm, 63) + bl;
    wsm[lane] = __expf(bl + cs - ml);
    slot[4224 + lane] = bbv;
    slot[4288 + lane] = cs;
    slot[4352 + lane] = pm;
    if (lane == 0) { slot[4160] = bl; slot[4161] = ml; }
  }
  __syncthreads();
  {
    int e = tid & 63, dg = tid >> 6;
    float acc[16];
#pragma unroll
    for (int dd = 0; dd < 16; dd++) acc[dd] = 0.f;
    for (int pp = 0; pp < 64; pp++) {
      float wv = wsm[pp] * vs[pp * 65 + e];
#pragma unroll
      for (int dd = 0; dd < 16; dd++) acc[dd] += ks[pp * 65 + dg * 16 + dd] * wv;
    }
#pragma unroll
    for (int q4 = 0; q4 < 4; q4++)
      *(float4*)(slot + e * 64 + dg * 16 + q4 * 4) = make_float4(acc[q4 * 4], acc[q4 * 4 + 1], acc[q4 * 4 + 2], acc[q4 * 4 + 3]);
  }
  if (tid < 64) {
    float a = 0.f;
    for (int pp = 0; pp < 64; pp++) a += wsm[pp] * ks[pp * 65 + tid];
    slot[4096 + tid] = a;
  }
}

#define ATT_SPLIT 768
__device__ __forceinline__ void phase_attn_mlA(const P& p, int l, char* smem) {
  const int N_MLA = 64 * 36;
  const int total = ATT_SPLIT + N_MLA;
  for (int item = blockIdx.x; item < total; item += gridDim.x) {
    if (item < N_MLA) mlstmA_item(p, item, (float*)smem);
    else attn_item(p, l, item - N_MLA, (float*)smem);
  }
}
__device__ __forceinline__ void mlB_item(const P& p, int item);
__device__ __forceinline__ void phase_attn_mlB(const P& p, int l, char* smem) {
  const int N_ATT = (l == 0 ? 2304 : 2048) - ATT_SPLIT;
  const int N_MLB = 64 * 17;
  const int total = N_ATT + N_MLB;
  for (int item = blockIdx.x; item < total; item += gridDim.x) {
    if (item < N_MLB) mlB_item(p, item);
    else attn_item(p, l, ATT_SPLIT + item - N_MLB, (float*)smem);
  }
}

__device__ __forceinline__ void mlB_item(const P& p, int item) {
  const int tid = threadIdx.x;
  int seq = item / 17, ech = item - seq * 17;
  int el = ech * 256 + tid;
  if (el >= 4160) return;
  float* base = p.mst + (size_t)(seq * 36) * SLOT;
  float loc[36], bl[36], ml[36];
#pragma unroll
  for (int j = 0; j < 36; j++) {
    loc[j] = base[(size_t)j * SLOT + el];
    bl[j] = base[(size_t)j * SLOT + 4160];
    ml[j] = base[(size_t)j * SLOT + 4161];
  }
  float m = 0.f, val = 0.f;
#pragma unroll
  for (int j = 0; j < 36; j++) {
    base[(size_t)j * SLOT + el] = val;
    if (el == 0) base[(size_t)j * SLOT + 4162] = m;
    float mn = fmaxf(bl[j] + m, ml[j]);
    val = __expf(bl[j] + m - mn) * val + __expf(ml[j] - mn) * loc[j];
    m = mn;
  }
}

__device__ __forceinline__ bf16x8 pack8(float4 a, float4 b) {
  union { bf16x8 v; unsigned u[4]; } r;
  r.u[0] = pack2(a.x, a.y); r.u[1] = pack2(a.z, a.w); r.u[2] = pack2(b.x, b.y); r.u[3] = pack2(b.z, b.w);
  return r.v;
}
__device__ __forceinline__ void phase_mlC(const P& p, int l, char* smem) {
  const int tid = threadIdx.x, lane = tid & 63, w = tid >> 6, q = lane & 15, quad = lane >> 4;
  const u16* mqk = (const u16*)p.MQK;
  const int nch = (l == 0) ? 36 : 32;
  const int total = 32 * nch;
  const int mrow = (q >> 2) * 8 + (q & 3);
  for (int item = blockIdx.x; item < total; item += gridDim.x) {
    int bh = item / nch, c = item % nch + (l == 0 ? 0 : 4);
    int b = bh >> 2, h = bh & 3;
    const int rowbase = (c < 4) ? (ML_ROWS + b * 256 + c * 64) : (b * 2048 + (c - 4) * 64);
    const int tau_t = w * 16 + q;
    const int trow = rowbase + tau_t;
    const bf16x8 bq0 = *(const bf16x8*)(mqk + (size_t)trow * 512 + h * 64 + quad * 8);
    const bf16x8 bq1 = *(const bf16x8*)(mqk + (size_t)trow * 512 + h * 64 + 32 + quad * 8);
    const u16* vt = (c < 4) ? (p.VTm + VTM_CTX_OFF + (size_t)((b * 4 + h) * 64 + q) * 256 + c * 64 + quad * 8)
                            : (p.VTm + (size_t)((b * 4 + h) * 64 + q) * 2048 + (c - 4) * 64 + quad * 8);
    const size_t vstr = (c < 4) ? (size_t)16 * 256 : (size_t)16 * 2048;
    f32x4 hs[4];
#pragma unroll
    for (int et = 0; et < 4; et++) hs[et] = (f32x4){0.f, 0.f, 0.f, 0.f};
#pragma unroll 1
    for (int dir = 0; dir < 2; dir++) {
      int j = dir ? (c < 4 ? 3 - c : 4 + 31 - (c - 4)) : c;
      const float* slot = p.mst + (size_t)(((b * 4 + h) * 2 + dir) * 36 + j) * SLOT;
      const int pt = dir ? 63 - tau_t : tau_t;
      const float m0 = slot[4162];
      const float bt = slot[4224 + pt];
      const float mt = bt + fmaxf(m0, slot[4352 + pt]);
      const float winter = __expf(bt + m0 - mt);
      f32x4 aw[4], ac[4];
#pragma unroll
      for (int et = 0; et < 4; et++) { aw[et] = (f32x4){0.f, 0.f, 0.f, 0.f}; ac[et] = (f32x4){0.f, 0.f, 0.f, 0.f}; }
      float dsum = 0.f;
#pragma unroll
      for (int kb = 0; kb < 2; kb++) {
        float wv[8];
#pragma unroll
        for (int T = 0; T < 2; T++) {
          const u16* kp = mqk + (size_t)(rowbase + kb * 32 + mrow + T * 4) * 512 + 256 + h * 64 + quad * 8;
          bf16x8 a0 = *(const bf16x8*)kp;
          bf16x8 a1 = *(const bf16x8*)(kp + 32);
          f32x4 sacc = (f32x4){0.f, 0.f, 0.f, 0.f};
          sacc = __builtin_amdgcn_mfma_f32_16x16x32_bf16(a0, bq0, sacc, 0, 0, 0);
          sacc = __builtin_amdgcn_mfma_f32_16x16x32_bf16(a1, bq1, sacc, 0, 0, 0);
#pragma unroll
          for (int rr = 0; rr < 4; rr++) {
            int tau_s = kb * 32 + quad * 8 + T * 4 + rr;
            int ps = dir ? 63 - tau_s : tau_s;
            bool valid = dir ? (tau_s >= tau_t) : (tau_s <= tau_t);
            float cs = slot[4288 + ps];
            float v = valid ? sacc[rr] * __expf(bt - mt + cs) : 0.f;
            wv[T * 4 + rr] = v;
            dsum += v;
          }
        }
        union { bf16x8 v; unsigned u[4]; } pk;
        pk.u[0] = pack2(wv[0], wv[1]); pk.u[1] = pack2(wv[2], wv[3]); pk.u[2] = pack2(wv[4], wv[5]); pk.u[3] = pack2(wv[6], wv[7]);
#pragma unroll
        for (int et = 0; et < 4; et++) {
          bf16x8 av = *(const bf16x8*)(vt + et * vstr + kb * 32);
          aw[et] = __builtin_amdgcn_mfma_f32_16x16x32_bf16(av, pk.v, aw[et], 0, 0, 0);
        }
      }
#pragma unroll
      for (int et = 0; et < 4; et++) {
        const float* cp = slot + (et * 16 + q) * 64 + quad * 8;
        bf16x8 c0 = pack8(*(const float4*)cp, *(const float4*)(cp + 4));
        bf16x8 c1 = pack8(*(const float4*)(cp + 32), *(const float4*)(cp + 36));
        ac[et] = __builtin_amdgcn_mfma_f32_16x16x32_bf16(c0, bq0, ac[et], 0, 0, 0);
        ac[et] = __builtin_amdgcn_mfma_f32_16x16x32_bf16(c1, bq1, ac[et], 0, 0, 0);
      }
      float qn = 0.f;
      {
        const float* np_ = slot + 4096 + quad * 8;
        float4 n0 = *(const float4*)np_, n1 = *(const float4*)(np_ + 4), n2 = *(const float4*)(np_ + 32), n3 = *(const float4*)(np_ + 36);
        union { bf16x8 v; unsigned u[4]; } q0, q1;
        q0.v = bq0; q1.v = bq1;
        qn += bflo(q0.u[0]) * n0.x + bfhi(q0.u[0]) * n0.y + bflo(q0.u[1]) * n0.z + bfhi(q0.u[1]) * n0.w;
        qn += bflo(q0.u[2]) * n1.x + bfhi(q0.u[2]) * n1.y + bflo(q0.u[3]) * n1.z + bfhi(q0.u[3]) * n1.w;
        qn += bflo(q1.u[0]) * n2.x + bfhi(q1.u[0]) * n2.y + bflo(q1.u[1]) * n2.z + bfhi(q1.u[1]) * n2.w;
        qn += bflo(q1.u[2]) * n3.x + bfhi(q1.u[2]) * n3.y + bflo(q1.u[3]) * n3.z + bfhi(q1.u[3]) * n3.w;
      }
      qn += __shfl_xor(qn, 16);
      qn += __shfl_xor(qn, 32);
      dsum += __shfl_xor(dsum, 16);
      dsum += __shfl_xor(dsum, 32);
      float den = dsum + winter * qn;
      float ih = 1.f / fmaxf(fabsf(den), __expf(-mt));
#pragma unroll
      for (int et = 0; et < 4; et++)
#pragma unroll
        for (int rr = 0; rr < 4; rr++) hs[et][rr] += (aw[et][rr] + winter * ac[et][rr]) * ih;
    }
    float ss = 0.f;
#pragma unroll
    for (int et = 0; et < 4; et++)
#pragma unroll
      for (int rr = 0; rr < 4; rr++) ss += hs[et][rr] * hs[et][rr];
    ss += __shfl_xor(ss, 16);
    ss += __shfl_xor(ss, 32);
    float rs = rsqrtf(ss * (1.f / 64.f) + 1e-6f);
#pragma unroll
    for (int et = 0; et < 4; et++) {
      int e0 = h * 64 + et * 16 + quad * 4;
      uint2 uo = *(const uint2*)(p.U + (size_t)trow * INC + 2560 + e0);
      float4 ng = *(const float4*)(p.ml_norm_g + l * 256 + e0);
      float o0 = hs[et][0] * rs * ng.x * sigmoidf_(bflo(uo.x));
      float o1 = hs[et][1] * rs * ng.y * sigmoidf_(bfhi(uo.x));
      float o2 = hs[et][2] * rs * ng.z * sigmoidf_(bflo(uo.y));
      float o3 = hs[et][3] * rs * ng.w * sigmoidf_(bfhi(uo.y));
      uint2 ov;
      ov.x = pack2(o0, o1);
      ov.y = pack2(o2, o3);
      *(uint2*)(p.Y + (size_t)trow * 1024 + 768 + e0) = ov;
    }
  }
}

typedef __attribute__((ext_vector_type(2))) float f32x2;
__device__ __forceinline__ float gelu_tanh(float x) {
  float u = 0.7978845608028654f * (x + 0.044715f * x * x * x);
  float th = 1.f - 2.f / (1.f + __expf(2.f * u));
  return 0.5f * x * (1.f + th);
}
__device__ __forceinline__ float dot16_fp8(const f32x2* xr, uint4 v) {
  f32x2 s = __builtin_amdgcn_cvt_pk_f32_fp8((int)v.x, false) * xr[0];
  s += __builtin_amdgcn_cvt_pk_f32_fp8((int)v.x, true) * xr[1];
  s += __builtin_amdgcn_cvt_pk_f32_fp8((int)v.y, false) * xr[2];
  s += __builtin_amdgcn_cvt_pk_f32_fp8((int)v.y, true) * xr[3];
  s += __builtin_amdgcn_cvt_pk_f32_fp8((int)v.z, false) * xr[4];
  s += __builtin_amdgcn_cvt_pk_f32_fp8((int)v.z, true) * xr[5];
  s += __builtin_amdgcn_cvt_pk_f32_fp8((int)v.w, false) * xr[6];
  s += __builtin_amdgcn_cvt_pk_f32_fp8((int)v.w, true) * xr[7];
  return s.x + s.y;
}
__device__ __forceinline__ void axpy16_fp8(f32x2* acc, float a, uint4 v) {
  f32x2 av = (f32x2){a, a};
  acc[0] += av * __builtin_amdgcn_cvt_pk_f32_fp8((int)v.x, false);
  acc[1] += av * __builtin_amdgcn_cvt_pk_f32_fp8((int)v.x, true);
  acc[2] += av * __builtin_amdgcn_cvt_pk_f32_fp8((int)v.y, false);
  acc[3] += av * __builtin_amdgcn_cvt_pk_f32_fp8((int)v.y, true);
  acc[4] += av * __builtin_amdgcn_cvt_pk_f32_fp8((int)v.z, false);
  acc[5] += av * __builtin_amdgcn_cvt_pk_f32_fp8((int)v.z, true);
  acc[6] += av * __builtin_amdgcn_cvt_pk_f32_fp8((int)v.w, false);
  acc[7] += av * __builtin_amdgcn_cvt_pk_f32_fp8((int)v.w, true);
}

__device__ __forceinline__ unsigned fkey(float f) {
  unsigned u = __float_as_uint(f);
  return (u & 0x80000000u) ? ~u : (u | 0x80000000u);
}
__device__ __forceinline__ int mbcnt64(unsigned long long m) {
  return __builtin_amdgcn_mbcnt_hi((unsigned)(m >> 32), __builtin_amdgcn_mbcnt_lo((unsigned)m, 0));
}
#define WAVE_LDS_FENCE() do { __builtin_amdgcn_fence(__ATOMIC_RELEASE, "wavefront"); __builtin_amdgcn_wave_barrier(); __builtin_amdgcn_fence(__ATOMIC_ACQUIRE, "wavefront"); } while (0)

#define RADIX_BODY(COUNT)                                                                  \
  unsigned pf = 0;                                                                         \
  int bit = 31;                                                                            \
  bool done = false;                                                                       \
  {                                                                                        \
    unsigned c = 0xC1000000u;                                                \
    int n = COUNT;                                                                         \
    n = __builtin_amdgcn_readfirstlane(n);                                                 \
    if (n < 16) {                                                                          \
      _Pragma("unroll 1") for (c = 0xC0800000u; c >= 0xBE800000u; c -= 0x00800000u) {      \
        n = COUNT;                                                                         \
        n = __builtin_amdgcn_readfirstlane(n);                                             \
        if (n >= 16) { pf = c; bit = 22; done = (n == 16); break; }                        \
      }                                                                                    \
    }                                                                                      \
  }                                                                                        \
  if (!done) {                                                                             \
    _Pragma("unroll 1") for (; bit >= 0; --bit) {                                          \
      const unsigned c = pf | (1u << bit);                                                 \
      int n = COUNT;                                                                       \
      n = __builtin_amdgcn_readfirstlane(n);                                               \
      if (n >= 16) { pf = c; if (n == 16) break; }                                         \
    }                                                                                      \
  }                                                                                        \
  return (unsigned)__builtin_amdgcn_readfirstlane((int)pf);
__device__ __forceinline__ unsigned radix_thr2(unsigned k0, unsigned k1) {
  RADIX_BODY((__popcll(__ballot(k0 >= c)) + __popcll(__ballot(k1 >= c))))
}
__device__ __forceinline__ unsigned radix_thr4(unsigned k0, unsigned k1, unsigned k2, unsigned k3) {
  RADIX_BODY((__popcll(__ballot(k0 >= c)) + __popcll(__ballot(k1 >= c)) + __popcll(__ballot(k2 >= c)) + __popcll(__ballot(k3 >= c))))
}
__device__ __forceinline__ void phase_peer_topk(const P& p, int l, char* smem) {
  const int tid = threadIdx.x, lane = tid & 63, w = tid >> 6;
  float* wl = (float*)smem + w * 512;
  float* cs = wl;
  int* ci = (int*)(wl + 32);
  int* el = (int*)(wl + 64);
  float* sl = wl + 192;
  const int nrows = (l == 1) ? ML_ROWS : MT_ROWS;
  const int nw = gridDim.x * 4;
  for (int row = blockIdx.x * 4 + w; row < nrows; row += nw) {
    float na0, na1, nb0, nb1;
    {
      const float* sp0 = p.S + (size_t)row * 2048;
      na0 = sp0[lane]; na1 = sp0[64 + lane]; nb0 = sp0[128 + lane]; nb1 = sp0[192 + lane];
    }
#pragma unroll 1
    for (int h = 0; h < 8; h++) {
      float a0 = na0, a1 = na1, b0 = nb0, b1 = nb1;
      {
        const float* spn = p.S + (size_t)row * 2048 + ((h + 1) & 7) * 256;
        na0 = spn[lane]; na1 = spn[64 + lane]; nb0 = spn[128 + lane]; nb1 = spn[192 + lane];
      }
      unsigned kA0 = fkey(a0), kA1 = fkey(a1), kB0 = fkey(b0), kB1 = fkey(b1);
      const unsigned pA = radix_thr2(kA0, kA1), pB = radix_thr2(kB0, kB1);
      {
        unsigned long long m0 = __ballot(kA0 >= pA), m1 = __ballot(kA1 >= pA);
        int p0 = mbcnt64(m0), p1 = __popcll(m0) + mbcnt64(m1);
        if (kA0 >= pA && p0 < 16) { cs[p0] = a0; ci[p0] = lane; }
        if (kA1 >= pA && p1 < 16) { cs[p1] = a1; ci[p1] = lane + 64; }
        m0 = __ballot(kB0 >= pB); m1 = __ballot(kB1 >= pB);
        p0 = mbcnt64(m0); p1 = __popcll(m0) + mbcnt64(m1);
        if (kB0 >= pB && p0 < 16) { cs[16 + p0] = b0; ci[16 + p0] = lane; }
        if (kB1 >= pB && p1 < 16) { cs[16 + p1] = b1; ci[16 + p1] = lane + 64; }
      }
      WAVE_LDS_FENCE();
      const int ii = lane >> 2, jb = (lane & 3) * 4;
      float s1 = cs[ii];
      float c0 = s1 + cs[16 + jb + 0], c1 = s1 + cs[16 + jb + 1], c2 = s1 + cs[16 + jb + 2], c3 = s1 + cs[16 + jb + 3];
      int e1 = ci[ii] * 128;
      int f0 = e1 + ci[16 + jb + 0], f1 = e1 + ci[16 + jb + 1], f2 = e1 + ci[16 + jb + 2], f3 = e1 + ci[16 + jb + 3];
      unsigned k0 = fkey(c0), k1 = fkey(c1), k2 = fkey(c2), k3 = fkey(c3);
      const unsigned pC = radix_thr4(k0, k1, k2, k3);
      {
        unsigned long long m0 = __ballot(k0 >= pC), m1 = __ballot(k1 >= pC), m2 = __ballot(k2 >= pC), m3 = __ballot(k3 >= pC);
        int q0 = mbcnt64(m0);
        int q1 = __popcll(m0) + mbcnt64(m1);
        int q2 = __popcll(m0) + __popcll(m1) + mbcnt64(m2);
        int q3 = __popcll(m0) + __popcll(m1) + __popcll(m2) + mbcnt64(m3);
        if (k0 >= pC && q0 < 16) { el[h * 16 + q0] = f0; sl[h * 16 + q0] = c0; }
        if (k1 >= pC && q1 < 16) { el[h * 16 + q1] = f1; sl[h * 16 + q1] = c1; }
        if (k2 >= pC && q2 < 16) { el[h * 16 + q2] = f2; sl[h * 16 + q2] = c2; }
        if (k3 >= pC && q3 < 16) { el[h * 16 + q3] = f3; sl[h * 16 + q3] = c3; }
      }
      WAVE_LDS_FENCE();
    }
    {
      float v0 = sl[lane], v1 = sl[64 + lane];
      float m0 = v0, m1 = v1;
#pragma unroll
      for (int o = 1; o < 16; o <<= 1) { m0 = fmaxf(m0, __shfl_xor(m0, o)); m1 = fmaxf(m1, __shfl_xor(m1, o)); }
      float e0 = __expf(v0 - m0), e1 = __expf(v1 - m1);
      float s0 = e0, s1 = e1;
#pragma unroll
      for (int o = 1; o < 16; o <<= 1) { s0 += __shfl_xor(s0, o); s1 += __shfl_xor(s1, o); }
      sl[lane] = e0 / s0;
      sl[64 + lane] = e1 / s1;
    }
    WAVE_LDS_FENCE();
    p.elist[(size_t)row * 128 + lane] = el[lane];
    p.elist[(size_t)row * 128 + 64 + lane] = el[64 + lane];
    p.glist[(size_t)row * 128 + lane] = sl[lane];
    p.glist[(size_t)row * 128 + 64 + lane] = sl[64 + lane];
    p.slist[(size_t)row * 128 + lane] = p.su[l * 16384 + el[lane]];
    p.slist[(size_t)row * 128 + 64 + lane] = p.su[l * 16384 + el[64 + lane]];
    WAVE_LDS_FENCE();
  }
}

struct PeerMeta {
  int id0, id1;
  uint4 xq;
  float h0[8], h1[8], g0, g1, s0, s1;
};
template <int PH>
__device__ __forceinline__ void peer_load_meta(const P& p, int t, int k, int lane, PeerMeta& m) {
  m.id0 = p.elist[(size_t)t * 128 + lane];
  m.id1 = p.elist[(size_t)t * 128 + 64 + lane];
  if (PH == 0) {
    m.xq = *(const uint4*)(p.xq + (size_t)t * 1024 + k * 128 + (lane & 7) * 16);
  } else {
#pragma unroll
    for (int kk = 0; kk < 8; kk++) {
      m.h0[kk] = p.hp[((size_t)t * 8 + kk) * 128 + lane];
      m.h1[kk] = p.hp[((size_t)t * 8 + kk) * 128 + 64 + lane];
    }
    m.g0 = p.glist[(size_t)t * 128 + lane];
    m.g1 = p.glist[(size_t)t * 128 + 64 + lane];
    const float sxt = p.sx[t];
    m.s0 = p.slist[(size_t)t * 128 + lane] * sxt;
    m.s1 = p.slist[(size_t)t * 128 + 64 + lane] * sxt;
  }
}
template <int PH>
__device__ __forceinline__ void peer_issue(const PeerMeta& m, int* idb, float* alb, const unsigned char* tab, int lane, uint4* rr, uint4& xq) {
  idb[lane] = m.id0;
  idb[64 + lane] = m.id1;
  if (PH == 0) {
    xq = m.xq;
  } else {
    float h0 = ((m.h0[0] + m.h0[1]) + (m.h0[2] + m.h0[3])) + ((m.h0[4] + m.h0[5]) + (m.h0[6] + m.h0[7]));
    float h1 = ((m.h1[0] + m.h1[1]) + (m.h1[2] + m.h1[3])) + ((m.h1[4] + m.h1[5]) + (m.h1[6] + m.h1[7]));
    alb[lane] = gelu_tanh(h0 * m.s0) * m.g0;
    alb[64 + lane] = gelu_tanh(h1 * m.s1) * m.g1;
  }
  WAVE_LDS_FENCE();
  const int es = lane >> 3;
#pragma unroll
  for (int i = 0; i < 16; i++) rr[i] = *(const uint4*)(tab + (size_t)idb[i * 8 + es] * 128);
}
template <int PH>
__device__ __forceinline__ void peer_compute(const P& p, int l, int t, bool valid, int k, int lane, const uint4* rr, const uint4& xq4, const float* alb) {
  const int es = lane >> 3;
  const int s0 = (PH == 0) ? 1 : 8, s1 = (PH == 0) ? 2 : 16, s2 = (PH == 0) ? 4 : 32;
  const bool c0 = (lane & s0) != 0, c1 = (lane & s1) != 0, c2 = (lane & s2) != 0;
  const int B = (c0 ? 8 : 0) + (c1 ? 4 : 0) + (c2 ? 2 : 0);
  float v[16];
  if (PH == 0) {
#pragma unroll
    for (int i = 0; i < 16; i++) {
      int a_ = __builtin_amdgcn_sdot4((int)rr[i].x, (int)xq4.x, 0, false);
      a_ = __builtin_amdgcn_sdot4((int)rr[i].y, (int)xq4.y, a_, false);
      a_ = __builtin_amdgcn_sdot4((int)rr[i].z, (int)xq4.z, a_, false);
      a_ = __builtin_amdgcn_sdot4((int)rr[i].w, (int)xq4.w, a_, false);
      v[i] = (float)a_;
    }
  } else {
    f32x2 acc[8];
#pragma unroll
    for (int i = 0; i < 8; i++) acc[i] = (f32x2){0.f, 0.f};
#pragma unroll
    for (int i = 0; i < 16; i++) axpy16_fp8(acc, alb[i * 8 + es], rr[i]);
#pragma unroll
    for (int i = 0; i < 8; i++) { v[2 * i] = acc[i].x; v[2 * i + 1] = acc[i].y; }
  }
  float k8[8], k4[4], k2[2];
#pragma unroll
  for (int i = 0; i < 8; i++) k8[i] = (c0 ? v[i + 8] : v[i]) + __shfl_xor(c0 ? v[i] : v[i + 8], s0);
#pragma unroll
  for (int i = 0; i < 4; i++) k4[i] = (c1 ? k8[i + 4] : k8[i]) + __shfl_xor(c1 ? k8[i] : k8[i + 4], s1);
#pragma unroll
  for (int i = 0; i < 2; i++) k2[i] = (c2 ? k4[i + 2] : k4[i]) + __shfl_xor(c2 ? k4[i] : k4[i + 2], s2);
  if (PH == 0) {
    float* hq = p.hp + ((size_t)t * 8 + k) * 128;
    if (valid) {
      hq[(B + 0) * 8 + es] = k2[0];
      hq[(B + 1) * 8 + es] = k2[1];
    }
  } else {
    const int col = k * 128 + (lane & 7) * 16 + B;
    const int mr = t < ML_ROWS ? (t >> 11) : 8;
    const float2 g2 = *(const float2*)(p.mod + (size_t)(l * 9 + mr) * 6144 + 5120 + col);
    float2* dst = (float2*)(t < ML_ROWS ? p.out + (size_t)t * 1024 + col : p.hc + (size_t)(t - ML_ROWS) * 1024 + col);
    float2 cur = *dst;
    cur.x += g2.x * 0.125f * k2[0];
    cur.y += g2.y * 0.125f * k2[1];
    if (valid) *dst = cur;
  }
}
template <int PH>
__device__ __forceinline__ void phase_peer_uv(const P& p, int l, char* smem) {
  const int tid = threadIdx.x, lane = tid & 63, w = tid >> 6;
  int* idA = (int*)smem + w * 512;
  int* idB = idA + 128;
  float* alA = (float*)(idA + 256);
  float* alB = alA + 128;
  const int nrows = (l == 1) ? ML_ROWS : MT_ROWS;
  const int k = blockIdx.x & 7;
  const int gw = (blockIdx.x >> 3) * 4 + w, ngw = (gridDim.x >> 3) * 4;
  const unsigned char* tab = (const unsigned char*)(PH == 0 ? p.Ub : p.Vb) + (size_t)((l * 8 + k) * 16384) * 128 + (lane & 7) * 16;
  PeerMeta M;
  uint4 rrA[16], rrB[16];
  uint4 xqA = make_uint4(0, 0, 0, 0), xqB = xqA;
  if (gw >= nrows) return;
  const int nit = (nrows - gw + ngw - 1) / ngw;
  const int tlast = gw + (nit - 1) * ngw;
  peer_load_meta<PH>(p, gw, k, lane, M);
  peer_issue<PH>(M, idA, alA, tab, lane, rrA, xqA);
  peer_load_meta<PH>(p, min(gw + ngw, tlast), k, lane, M);
#pragma unroll 1
  for (int i = 0; i < nit; i += 2) {
    const int tA = gw + i * ngw, tB = tA + ngw;
    peer_issue<PH>(M, idB, alB, tab, lane, rrB, xqB);
    peer_load_meta<PH>(p, min(tB + ngw, tlast), k, lane, M);
    peer_compute<PH>(p, l, tA, true, k, lane, rrA, xqA, alA);
    peer_issue<PH>(M, idA, alA, tab, lane, rrA, xqA);
    peer_load_meta<PH>(p, min(tB + 2 * ngw, tlast), k, lane, M);
    peer_compute<PH>(p, l, min(tB, tlast), tB <= tlast, k, lane, rrB, xqB, alB);
  }
}

#define RUN(k, call)                         \
  if (lo <= (k) && (k) < hi) {               \
    call;                                    \
    if ((k) + 1 < hi) xcd_barrier(xb);       \
  }
#define LAYER(l, base)                                                                                                    \
  RUN(base + 0, phase_norm(p, l, 1))                                                                                     \
  RUN(base + 1, phase_gemm<0>(p, l, p.xn, p.WinT + (size_t)l * INC_PAD * 1024, MT_ROWS / 128, INC_PAD / 128, smem))     \
  RUN(base + 2, phase_mixprep(p, l, smem))                                                                               \
  RUN(base + 3, phase_attn_mlA(p, l, smem))                                                                              \
  RUN(base + 4, phase_attn_mlB(p, l, smem))                                                                                            \
  RUN(base + 5, phase_mlC(p, l, smem))                                                                                   \
  RUN(base + 6, phase_gemm<1>(p, l, p.Y, p.WoutT + (size_t)l * 1024 * 1024, (l == 0 ? MT_ROWS : ML_ROWS) / 128, 8, smem)) \
  RUN(base + 7, phase_norm(p, l, 2))                                                                                     \
  RUN(base + 8, phase_gemm<2>(p, l, p.xn, p.WsT + (size_t)l * 2048 * 1024, (l == 0 ? MT_ROWS : ML_ROWS) / 128, 16, smem)) \
  RUN(base + 9, phase_peer_topk(p, l, smem))                                                                             \
  RUN(base + 10, phase_peer_uv<0>(p, l, smem))                                                                            \
  RUN(base + 11, phase_peer_uv<1>(p, l, smem))

__global__ void __launch_bounds__(256, 2) fwd_kernel(P p) {
  __shared__ __attribute__((aligned(16))) char smem[SMEM_BYTES];
  __shared__ uint4 xb_words;
  cg::grid_group grid = cg::this_grid();
  const int lo = (int)p.ph_lo, hi = (int)p.ph_hi;
  if (threadIdx.x == 0) xb_words = make_uint4(0u, 0u, 0u, 0u);
  __syncthreads();
  XcdBarrier xb = xcd_barrier_post(p.bar, (volatile LAS unsigned*)&xb_words);
  if (hi - lo > 1) grid.sync();
  RUN(0, phase_prologue(p, smem))
  LAYER(0, 1)
  LAYER(1, 13)
}

extern "C" void kernel_launch(void* const* d_in, const int* in_sizes, int n_in, void* d_out, int out_size, void* d_ws,
                              size_t ws_size, hipStream_t stream) {
  static int grid_blocks = 0;
  if (!grid_blocks) {
    int dev = 0, cus = 0, per_cu = 0;
    hipGetDevice(&dev);
    hipDeviceGetAttribute(&cus, hipDeviceAttributeMultiprocessorCount, dev);
    hipOccupancyMaxActiveBlocksPerMultiprocessor(&per_cu, fwd_kernel, 256, 0);
    if (per_cu < 1) per_cu = 1;
    if (per_cu > 2) per_cu = 2;
    grid_blocks = (cus * per_cu) & ~7;
  }
  P p{};
  const float** ins = (const float**)&p;
  for (int i = 0; i < 22; i++) ins[i] = (const float*)d_in[i];
  p.out = (float*)d_out;
  char* ws = (char*)d_ws;
  size_t off = 0;
  auto take = [&](size_t bytes) { char* r = ws + off; off += (bytes + 255) & ~(size_t)255; return r; };
  p.WinT = (u16*)take((size_t)2 * INC_PAD * 1024 * 2);
  p.WoutT = (u16*)take((size_t)2 * 1024 * 1024 * 2);
  p.WsT = (u16*)take((size_t)2 * 2048 * 1024 * 2);
  p.Ub = (u16*)take((size_t)2 * 16384 * 1024);
  p.Vb = (u16*)take((size_t)2 * 16384 * 1024);
  p.xq = (signed char*)take((size_t)MT_ROWS * 1024);
  p.sx = (float*)take((size_t)MT_ROWS * 4);
  p.su = (float*)take((size_t)2 * 16384 * 4);
  p.slist = (float*)take((size_t)MT_ROWS * 128 * 4);
  p.elist = (int*)take((size_t)MT_ROWS * 128 * 4);
  p.glist = (float*)take((size_t)MT_ROWS * 128 * 4);
  p.mod = (float*)take((size_t)2 * 9 * 6144 * 4);
  p.xn = (u16*)take((size_t)MT_ROWS * 1024 * 2);
  p.U = (u16*)take((size_t)MT_ROWS * INC * 2);
  p.MQK = (float*)take((size_t)MT_ROWS * 512 * 2);
  p.Y = (u16*)take((size_t)MT_ROWS * 1024 * 2);
  p.S = (float*)p.U;
  p.hp = (float*)take((size_t)MT_ROWS * 8 * 128 * 4);
  p.G = (float*)take((size_t)MT_ROWS * 16 * 4);
  p.mst = (float*)take((size_t)2304 * SLOT * 4);
  p.hc = (float*)take((size_t)MC_ROWS * 1024 * 4);
  p.bar = (unsigned*)take((size_t)XCD_BAR_WORDS * 4);
  p.VTm = (u16*)take((size_t)(8 * 4 * 64) * (2048 + 256) * 2);
  p.VT = (u16*)take((size_t)(8 * 8 * 64) * (2048 + 256) * 2);
  if (off > ws_size) { fprintf(stderr, "workspace too small: need %zu have %zu\n", off, ws_size); return; }
  (void)hipMemsetAsync(p.bar, 0, (size_t)XCD_BAR_WORDS * 4, stream);
#if MEGA
  p.ph_lo = 0; p.ph_hi = NPHASES;
  void* args[] = {&p};
  hipError_t e = hipLaunchCooperativeKernel((void*)fwd_kernel, dim3(grid_blocks), dim3(256), args, 0, stream);
  if (e != hipSuccess) fprintf(stderr, "cooperative launch failed: %s (grid %d)\n", hipGetErrorString(e), grid_blocks);
#else
  for (int ph = 0; ph < NPHASES; ph++) {
    p.ph_lo = ph; p.ph_hi = ph + 1;
    void* args[] = {&p};
    hipError_t e = hipLaunchCooperativeKernel((void*)fwd_kernel, dim3(grid_blocks), dim3(256), args, 0, stream);
    if (e != hipSuccess) fprintf(stderr, "cooperative launch failed: %s (grid %d)\n", hipGetErrorString(e), grid_blocks);
  }
#endif
}
```

```cpp
#include <hip/hip_runtime.h>
#include <hip/hip_cooperative_groups.h>
#include <cstdio>
namespace cg = cooperative_groups;

#ifndef MEGA
#define MEGA 1
#endif

typedef unsigned short u16;
typedef __attribute__((ext_vector_type(8))) short bf16x8;
typedef __attribute__((ext_vector_type(4))) float f32x4;

#define ML_ROWS 16384
#define MC_ROWS 2048
#define MT_ROWS 18432
#define INC 2832
#define INC_PAD 2944
#define SLOT 4480
#define SMEM_BYTES 69632
#define NPHASES 25

struct P {
  const float *x, *c, *ctx, *c_ctx, *w_ada, *b_ada, *norm1_g, *w_in, *ml_gate_b, *na_q_g, *na_k_g, *na_rpb,
      *pool_w, *pool_scale, *ml_conv, *ml_norm_g, *w_out, *norm2_g, *peer_wq, *peer_keys, *peer_u, *peer_v;
  float* out;
  u16 *WinT, *WoutT, *WsT, *Ub, *Vb;
  float* mod;
  u16* xn;
  u16* U;
  float* MQK;
  u16* Y;
  float* S;
  float* G;
  float* mst;
  float* hc;
  u16* VT;
  u16* VTm;
  signed char* xq;
  float* sx;
  float* su;
  float* slist;
  int* elist;
  float* glist;
  float* hp;
  unsigned* bar;
  long long ph_lo, ph_hi;
};

__device__ __forceinline__ u16 f2bf(float f) {
  unsigned u = __float_as_uint(f);
  u += 0x7fffu + ((u >> 16) & 1u);
  return (u16)(u >> 16);
}
__device__ __forceinline__ float bf2f(u16 h) { return __uint_as_float(((unsigned)h) << 16); }
__device__ __forceinline__ float bflo(unsigned u) { return __uint_as_float(u << 16); }
__device__ __forceinline__ float bfhi(unsigned u) { return __uint_as_float(u & 0xffff0000u); }
__device__ __forceinline__ unsigned pack2(float a, float b) { return (unsigned)f2bf(a) | ((unsigned)f2bf(b) << 16); }
__device__ __forceinline__ unsigned q8pack(float a, float b, float c, float d) {
  int qa = __float2int_rn(a), qb = __float2int_rn(b), qc = __float2int_rn(c), qd = __float2int_rn(d);
  return (unsigned)(qa & 0xff) | ((unsigned)(qb & 0xff) << 8) | ((unsigned)(qc & 0xff) << 16) | ((unsigned)(qd & 0xff) << 24);
}
__device__ __forceinline__ float wave_sum(float v) {
#pragma unroll
  for (int o = 32; o; o >>= 1) v += __shfl_xor(v, o);
  return v;
}
__device__ __forceinline__ void wave_argmax(float& v, int& i) {
#pragma unroll
  for (int o = 32; o; o >>= 1) {
    float ov = __shfl_xor(v, o);
    int oi = __shfl_xor(i, o);
    if (ov > v || (ov == v && oi < i)) { v = ov; i = oi; }
  }
}
__device__ __forceinline__ float sigmoidf_(float x) { return 1.f / (1.f + __expf(-x)); }
__device__ __forceinline__ float siluf_(float x) { return x / (1.f + __expf(-x)); }

#define XB_TMO      128
#define XB_XCNT(j)  (256  + 64 * (j))
#define XB_XSUB(j)  (1280 + 64 * (j))
#define XB_XGEN(j)  (2304 + 64 * (j))
#define XB_TOP      3328
#define XB_TOPGEN   3392
#define XCD_BAR_WORDS 3456
#define XB_SPIN_CAP (1u << 18)
#define LAS __attribute__((address_space(3)))
__device__ __forceinline__ unsigned xb_ld(unsigned* p)              { return __hip_atomic_load(p, __ATOMIC_RELAXED, __HIP_MEMORY_SCOPE_AGENT); }
__device__ __forceinline__ unsigned xb_add(unsigned* p, unsigned v) { return __hip_atomic_fetch_add(p, v, __ATOMIC_RELAXED, __HIP_MEMORY_SCOPE_AGENT); }
__device__ __forceinline__ unsigned xb_xcc_id() { return (unsigned)__builtin_amdgcn_s_getreg((3 << 11) | 20) & 0xFu; }
#define XB_SPIN(cond, bar) do { unsigned _sp = 0; while (cond) { __builtin_amdgcn_s_sleep(1); \
    if ((++_sp & 255u) == 0u) { if (xb_ld(&(bar)[XB_TMO])) break; if (_sp > XB_SPIN_CAP) { atomicAdd(&(bar)[XB_TMO], 1u); break; } } } } while (0)
struct XcdBarrier { unsigned* bar; unsigned x; volatile LAS unsigned* st; };
__device__ __forceinline__ XcdBarrier xcd_barrier_post(unsigned* bar, volatile LAS unsigned* st) {
    XcdBarrier b; b.bar = bar; b.x = xb_xcc_id(); b.st = st;
    if (threadIdx.x == 0) (void)xb_add(&bar[XB_XCNT(b.x)], 1u);
    return b;
}
__device__ __forceinline__ void xcd_barrier_complete(unsigned* bar, unsigned x, unsigned& nloc, unsigned& nx) {
    const unsigned G = gridDim.x * gridDim.y * gridDim.z;
    unsigned sum, cnt, mine, sp = 0u;
    for (;;) {
        sum = 0u; cnt = 0u; mine = 0u;
#pragma unroll
        for (unsigned j = 0; j < 16; ++j) { const unsigned c = xb_ld(&bar[XB_XCNT(j)]); sum += c; cnt += (c > 0u) ? 1u : 0u; mine = (j == x) ? c : mine; }
        if (sum == G) break;
        __builtin_amdgcn_s_sleep(1);
        if ((++sp & 255u) == 0u) { if (xb_ld(&bar[XB_TMO])) break; if (sp > XB_SPIN_CAP) { atomicAdd(&bar[XB_TMO], 1u); break; } }
    }
    nloc = mine > 0u ? mine : 1u; nx = cnt > 0u ? cnt : 1u;
}
__device__ __forceinline__ void xcd_barrier(const XcdBarrier& b) {
    asm volatile("s_waitcnt vmcnt(0)" ::: "memory");
    __syncthreads();
    if (threadIdx.x == 0) {
        unsigned* bar = b.bar;
        __builtin_amdgcn_s_waitcnt(0);
        unsigned nloc = b.st[0], nx = b.st[1];
        if (nloc == 0u) { xcd_barrier_complete(bar, b.x, nloc, nx); b.st[0] = nloc; b.st[1] = nx; }
        const unsigned old = xb_add(&bar[XB_XSUB(b.x)], 1u);
        const unsigned gen = old / nloc;
        if (old + 1u == (gen + 1u) * nloc) {
            __builtin_amdgcn_fence(__ATOMIC_RELEASE, "agent");
            asm volatile("s_waitcnt vmcnt(0)" ::: "memory");
            const unsigned og = xb_add(&bar[XB_TOP], 1u);
            const unsigned tg = og / nx;
            if (og + 1u == (tg + 1u) * nx) xb_add(&bar[XB_TOPGEN], 1u);
            else XB_SPIN(xb_ld(&bar[XB_TOPGEN]) == tg, bar);
            __builtin_amdgcn_fence(__ATOMIC_ACQUIRE, "agent");
            xb_add(&bar[XB_XGEN(b.x)], 1u);
            asm volatile("s_waitcnt vmcnt(0)" ::: "memory");
        } else {
            XB_SPIN(xb_ld(&bar[XB_XGEN(b.x)]) == gen, bar);
            __builtin_amdgcn_fence(__ATOMIC_ACQUIRE, "agent");
            asm volatile("s_waitcnt vmcnt(0)" ::: "memory");
        }
    }
    __syncthreads();
}

__device__ __forceinline__ void transpose_item(const float* __restrict__ src, int N, u16* __restrict__ dst, int kt, int nt, float* tl) {
  const int tid = threadIdx.x;
#pragma unroll 4
  for (int i = 0; i < 16; i++) {
    int idx = tid + 256 * i;
    int kk = idx >> 6, nn = idx & 63;
    int n = nt * 64 + nn;
    float v = (n < N) ? src[(size_t)(kt * 64 + kk) * N + n] : 0.f;
    tl[kk * 65 + nn] = v;
  }
  __syncthreads();
#pragma unroll 4
  for (int i = 0; i < 16; i++) {
    int idx = tid + 256 * i;
    int nn = idx >> 6, kk = idx & 63;
    dst[(size_t)(nt * 64 + nn) * 1024 + kt * 64 + kk] = f2bf(tl[kk * 65 + nn]);
  }
  __syncthreads();
}

__device__ __forceinline__ void wst_item(const P& p, int it, float* sm) {
  const int tid = threadIdx.x;
  int l = it >> 8, hp = (it >> 4) & 15, dt = it & 15;
  float* As = sm;
  float* Ks = sm + 64 * 33;
  const float* wq = p.peer_wq + (size_t)l * 1024 * 2048;
  const float* keys = p.peer_keys + ((size_t)l * 16 + hp) * 128 * 128;
  int d = tid & 63, cg_ = tid >> 6;
  float acc[32];
#pragma unroll
  for (int c = 0; c < 32; c++) acc[c] = 0.f;
  for (int jc = 0; jc < 4; jc++) {
    __syncthreads();
#pragma unroll
    for (int i = 0; i < 8; i++) {
      int idx = tid + 256 * i;
      int dd = idx >> 5, j = idx & 31;
      As[dd * 33 + j] = wq[(size_t)(dt * 64 + dd) * 2048 + hp * 128 + jc * 32 + j];
    }
#pragma unroll
    for (int i = 0; i < 16; i++) {
      int idx = tid + 256 * i;
      int k = idx >> 5, j = idx & 31;
      Ks[k * 33 + j] = keys[k * 128 + jc * 32 + j];
    }
    __syncthreads();
    for (int j = 0; j < 32; j++) {
      float a = As[d * 33 + j];
#pragma unroll
      for (int c = 0; c < 32; c++) acc[c] += a * Ks[(cg_ * 32 + c) * 33 + j];
    }
  }
  u16* dst = p.WsT + (size_t)l * 2048 * 1024;
#pragma unroll
  for (int c = 0; c < 32; c++) dst[(size_t)(hp * 128 + cg_ * 32 + c) * 1024 + dt * 64 + d] = f2bf(acc[c]);
  __syncthreads();
}

__device__ __forceinline__ void mod_item(const P& p, int it, float* sm) {
  const int tid = threadIdx.x;
  int l = it / 96, cc = it % 96;
  float* sc = sm;
  float* red = sm + 9216;
  for (int idx = tid; idx < 9216; idx += 256) {
    int r = idx >> 10, k = idx & 1023;
    float v = (r < 8) ? p.c[r * 1024 + k] : p.c_ctx[k];
    sc[idx] = siluf_(v);
  }
  __syncthreads();
  int cl = tid & 63, kg = tid >> 6;
  int col = cc * 64 + cl;
  float acc[9];
#pragma unroll
  for (int r = 0; r < 9; r++) acc[r] = 0.f;
  const float* wa = p.w_ada + (size_t)l * 1024 * 6144;
#pragma unroll 16
  for (int k = kg * 256; k < kg * 256 + 256; k++) {
    float w = wa[(size_t)k * 6144 + col];
#pragma unroll
    for (int r = 0; r < 9; r++) acc[r] += sc[r * 1024 + k] * w;
  }
#pragma unroll
  for (int r = 0; r < 9; r++) red[(kg * 9 + r) * 64 + cl] = acc[r];
  __syncthreads();
  if (kg == 0) {
    float bb = p.b_ada[l * 6144 + col];
#pragma unroll
    for (int r = 0; r < 9; r++) {
      float s = red[(0 * 9 + r) * 64 + cl] + red[(1 * 9 + r) * 64 + cl] + red[(2 * 9 + r) * 64 + cl] + red[(3 * 9 + r) * 64 + cl];
      p.mod[(size_t)(l * 9 + r) * 6144 + col] = s + bb;
    }
  }
  __syncthreads();
}

__device__ __forceinline__ void phase_prologue(const P& p, char* smem) {
  float* sm = (float*)smem;
  const int tid = threadIdx.x;
  const int N_A = 2 * 16 * 46, N_B = 2 * 16 * 16, N_C = 512, N_D = 192, N_E = 4096;
  const int total = N_A + N_B + N_C + N_D + N_E;
  for (int item = blockIdx.x; item < total; item += gridDim.x) {
    int it = item;
    if (it < N_D) { mod_item(p, it, sm); continue; }
    it -= N_D;
    if (it < N_C) { wst_item(p, it, sm); continue; }
    it -= N_C;
    if (it < N_A) {
      int l = it / (16 * 46), r = it % (16 * 46);
      transpose_item(p.w_in + (size_t)l * 1024 * INC, INC, p.WinT + (size_t)l * INC_PAD * 1024, r / 46, r % 46, sm);
      continue;
    }
    it -= N_A;
    if (it < N_B) {
      int l = it >> 8, r = it & 255;
      transpose_item(p.w_out + (size_t)l * 1024 * 1024, 1024, p.WoutT + (size_t)l * 1024 * 1024, r >> 4, r & 15, sm);
      continue;
    }
    it -= N_B;
    {
      if ((it >> 11) == 0) {
        const int lane_ = tid & 63, w_ = tid >> 6;
        const int chunk_ = it & 2047;
#pragma unroll
        for (int rr = 0; rr < 4; rr++) {
          const int R = chunk_ * 16 + w_ * 4 + rr;
          const float4* src = (const float4*)(p.peer_u + (size_t)R * 1024 + lane_ * 16);
          float4 v0 = src[0], v1 = src[1], v2 = src[2], v3 = src[3];
          float mx = fmaxf(fmaxf(fmaxf(fabsf(v0.x), fabsf(v0.y)), fmaxf(fabsf(v0.z), fabsf(v0.w))), fmaxf(fmaxf(fabsf(v1.x), fabsf(v1.y)), fmaxf(fabsf(v1.z), fabsf(v1.w))));
          mx = fmaxf(mx, fmaxf(fmaxf(fmaxf(fabsf(v2.x), fabsf(v2.y)), fmaxf(fabsf(v2.z), fabsf(v2.w))), fmaxf(fmaxf(fabsf(v3.x), fabsf(v3.y)), fmaxf(fabsf(v3.z), fabsf(v3.w)))));
#pragma unroll
          for (int o = 32; o; o >>= 1) mx = fmaxf(mx, __shfl_xor(mx, o));
          const float inv = mx > 0.f ? 127.f / mx : 0.f;
          uint4 o;
          o.x = q8pack(v0.x * inv, v0.y * inv, v0.z * inv, v0.w * inv);
          o.y = q8pack(v1.x * inv, v1.y * inv, v1.z * inv, v1.w * inv);
          o.z = q8pack(v2.x * inv, v2.y * inv, v2.z * inv, v2.w * inv);
          o.w = q8pack(v3.x * inv, v3.y * inv, v3.z * inv, v3.w * inv);
          const unsigned ll = (unsigned)R >> 14, ee = (unsigned)R & 16383u;
          size_t off = ((size_t)((ll * 8u + (unsigned)(lane_ >> 3)) * 16384u + ee)) * 128 + (lane_ & 7) * 16;
          *(uint4*)((unsigned char*)p.Ub + off) = o;
          if (lane_ == 0) p.su[R] = mx * (1.f / 127.f);
        }
        continue;
      }
      int tab = it >> 11;
      int chunk = it & 2047;
      const float scl = tab ? 8.f : 64.f;
      const float4* src = (const float4*)(tab ? p.peer_v : p.peer_u) + (size_t)chunk * 4096;
      unsigned char* dstb = (unsigned char*)(tab ? p.Vb : p.Ub);
#pragma unroll
      for (int i = 0; i < 4; i++) {
        int q = i * 256 + tid;
        float4 v0 = src[q * 4 + 0], v1 = src[q * 4 + 1], v2 = src[q * 4 + 2], v3 = src[q * 4 + 3];
        uint4 o;
        int w_;
        w_ = __builtin_amdgcn_cvt_pk_fp8_f32(v0.x * scl, v0.y * scl, 0, false);
        w_ = __builtin_amdgcn_cvt_pk_fp8_f32(v0.z * scl, v0.w * scl, w_, true);
        o.x = (unsigned)w_;
        w_ = __builtin_amdgcn_cvt_pk_fp8_f32(v1.x * scl, v1.y * scl, 0, false);
        w_ = __builtin_amdgcn_cvt_pk_fp8_f32(v1.z * scl, v1.w * scl, w_, true);
        o.y = (unsigned)w_;
        w_ = __builtin_amdgcn_cvt_pk_fp8_f32(v2.x * scl, v2.y * scl, 0, false);
        w_ = __builtin_amdgcn_cvt_pk_fp8_f32(v2.z * scl, v2.w * scl, w_, true);
        o.z = (unsigned)w_;
        w_ = __builtin_amdgcn_cvt_pk_fp8_f32(v3.x * scl, v3.y * scl, 0, false);
        w_ = __builtin_amdgcn_cvt_pk_fp8_f32(v3.z * scl, v3.w * scl, w_, true);
        o.w = (unsigned)w_;
        {
          unsigned G = (unsigned)chunk * 1024u + (unsigned)q;
          unsigned ll = G >> 20, ee = (G >> 6) & 16383u, cgp = G & 63u;
          size_t off = ((size_t)((ll * 8u + (cgp >> 3)) * 16384u + ee)) * 128 + (cgp & 7u) * 16;
          *(uint4*)(dstb + off) = o;
        }
      }
    }
  }
}

__device__ __forceinline__ void phase_norm(const P& p, int l, int which) {
  const int tid = threadIdx.x, lane = tid & 63, w = tid >> 6;
  const int nrows = (which == 2 && l == 1) ? ML_ROWS : MT_ROWS;
  const float* g = (which == 1 ? p.norm1_g : p.norm2_g) + l * 1024;
  for (int item = blockIdx.x; item * 4 < nrows; item += gridDim.x) {
    int row = item * 4 + w;
    const float* src;
    if (l == 0 && which == 1) src = row < ML_ROWS ? p.x + (size_t)row * 1024 : p.ctx + (size_t)(row - ML_ROWS) * 1024;
    else src = row < ML_ROWS ? p.out + (size_t)row * 1024 : p.hc + (size_t)(row - ML_ROWS) * 1024;
    int mr = row < ML_ROWS ? (row >> 11) : 8;
    const float* modp = p.mod + (size_t)(l * 9 + mr) * 6144;
    const float* sh = modp + (which == 1 ? 0 : 3072);
    const float* sc = modp + (which == 1 ? 1024 : 4096);
    float4 v[4];
    float ss = 0.f;
#pragma unroll
    for (int i = 0; i < 4; i++) {
      v[i] = ((const float4*)src)[i * 64 + lane];
      ss += v[i].x * v[i].x + v[i].y * v[i].y + v[i].z * v[i].z + v[i].w * v[i].w;
    }
    ss = wave_sum(ss);
    float rs = rsqrtf(ss * (1.f / 1024.f) + 1e-6f);
    float ov[16];
    float omax = 0.f;
#pragma unroll
    for (int i = 0; i < 4; i++) {
      int d = (i * 64 + lane) * 4;
      float4 gg = *(const float4*)(g + d);
      float4 s4 = *(const float4*)(sc + d);
      float4 h4 = *(const float4*)(sh + d);
      float o0 = v[i].x * rs * gg.x * (1.f + s4.x) + h4.x;
      float o1 = v[i].y * rs * gg.y * (1.f + s4.y) + h4.y;
      float o2 = v[i].z * rs * gg.z * (1.f + s4.z) + h4.z;
      float o3 = v[i].w * rs * gg.w * (1.f + s4.w) + h4.w;
      uint2 o;
      o.x = pack2(o0, o1);
      o.y = pack2(o2, o3);
      ((uint2*)(p.xn + (size_t)row * 1024))[i * 64 + lane] = o;
      ov[i * 4 + 0] = o0; ov[i * 4 + 1] = o1; ov[i * 4 + 2] = o2; ov[i * 4 + 3] = o3;
      omax = fmaxf(omax, fmaxf(fmaxf(fabsf(o0), fabsf(o1)), fmaxf(fabsf(o2), fabsf(o3))));
    }
    if (which == 2) {
#pragma unroll
      for (int o = 32; o; o >>= 1) omax = fmaxf(omax, __shfl_xor(omax, o));
      const float inv = omax > 0.f ? 127.f / omax : 0.f;
#pragma unroll
      for (int i = 0; i < 4; i++)
        ((unsigned*)(p.xq + (size_t)row * 1024))[i * 64 + lane] = q8pack(ov[i * 4] * inv, ov[i * 4 + 1] * inv, ov[i * 4 + 2] * inv, ov[i * 4 + 3] * inv);
      if (lane == 0) p.sx[row] = omax * (1.f / 127.f);
    }
  }
}

template <int EPI>
__device__ __forceinline__ void phase_gemm(const P& p, int l, const u16* __restrict__ A, const u16* __restrict__ Bt, int mtiles, int ntiles,
                           char* smem) {
  u16* As = (u16*)smem;
  u16* Bs = As + 128 * 72;
  const int tid = threadIdx.x, lane = tid & 63, w = tid >> 6, wm = w >> 1, wn = w & 1;
  const int lr = lane & 15, quad = lane >> 4;
  const int xk = blockIdx.x & 7, lb = blockIdx.x >> 3, nb = gridDim.x >> 3;
  const int mg = xk >> 1;
  const int nh0 = (ntiles + 1) >> 1;
  const int nbase = (xk & 1) ? nh0 : 0, nloc = (xk & 1) ? (ntiles - nh0) : nh0;
  const int mcount = (mtiles - mg + 3) >> 2;
  const int nlocal = mcount * nloc;
  for (int li = lb; li < nlocal; li += nb) {
    int mi = li / nloc;
    int mt = mg + 4 * mi, nt = nbase + (li - mi * nloc);
    int m0 = mt * 128, n0 = nt * 128;
    f32x4 acc[4][4];
#pragma unroll
    for (int i = 0; i < 4; i++)
#pragma unroll
      for (int j = 0; j < 4; j++) acc[i][j] = (f32x4){0.f, 0.f, 0.f, 0.f};
    const int r0_ = tid >> 3, ch_ = tid & 7;
    const u16* Ap0 = A + (size_t)(m0 + r0_) * 1024 + ch_ * 8;
    const u16* Bp0 = Bt + (size_t)(n0 + r0_) * 1024 + ch_ * 8;
    uint4 ra0 = *(const uint4*)Ap0, ra1 = *(const uint4*)(Ap0 + 32 * 1024), ra2 = *(const uint4*)(Ap0 + 64 * 1024), ra3 = *(const uint4*)(Ap0 + 96 * 1024);
    uint4 rb0 = *(const uint4*)Bp0, rb1 = *(const uint4*)(Bp0 + 32 * 1024), rb2 = *(const uint4*)(Bp0 + 64 * 1024), rb3 = *(const uint4*)(Bp0 + 96 * 1024);
    for (int kt = 0; kt < 16; kt++) {
      __syncthreads();
      *(uint4*)(As + r0_ * 72 + ch_ * 8) = ra0;
      *(uint4*)(As + (r0_ + 32) * 72 + ch_ * 8) = ra1;
      *(uint4*)(As + (r0_ + 64) * 72 + ch_ * 8) = ra2;
      *(uint4*)(As + (r0_ + 96) * 72 + ch_ * 8) = ra3;
      *(uint4*)(Bs + r0_ * 72 + ch_ * 8) = rb0;
      *(uint4*)(Bs + (r0_ + 32) * 72 + ch_ * 8) = rb1;
      *(uint4*)(Bs + (r0_ + 64) * 72 + ch_ * 8) = rb2;
      *(uint4*)(Bs + (r0_ + 96) * 72 + ch_ * 8) = rb3;
      __syncthreads();
      if (kt < 15) {
        const int ko = (kt + 1) * 64;
        ra0 = *(const uint4*)(Ap0 + ko); ra1 = *(const uint4*)(Ap0 + 32 * 1024 + ko); ra2 = *(const uint4*)(Ap0 + 64 * 1024 + ko); ra3 = *(const uint4*)(Ap0 + 96 * 1024 + ko);
        rb0 = *(const uint4*)(Bp0 + ko); rb1 = *(const uint4*)(Bp0 + 32 * 1024 + ko); rb2 = *(const uint4*)(Bp0 + 64 * 1024 + ko); rb3 = *(const uint4*)(Bp0 + 96 * 1024 + ko);
      }
#pragma unroll
      for (int ks = 0; ks < 2; ks++) {
        bf16x8 a[4], b[4];
#pragma unroll
        for (int i = 0; i < 4; i++) {
          a[i] = *(const bf16x8*)(As + (wm * 64 + i * 16 + lr) * 72 + ks * 32 + quad * 8);
          b[i] = *(const bf16x8*)(Bs + (wn * 64 + i * 16 + lr) * 72 + ks * 32 + quad * 8);
        }
#pragma unroll
        for (int i = 0; i < 4; i++)
#pragma unroll
          for (int j = 0; j < 4; j++) acc[i][j] = __builtin_amdgcn_mfma_f32_16x16x32_bf16(b[j], a[i], acc[i][j], 0, 0, 0);
      }
    }
#pragma unroll
    for (int i = 0; i < 4; i++)
#pragma unroll
      for (int j = 0; j < 4; j++) {
        const int row = m0 + wm * 64 + i * 16 + lr;
        const int col = n0 + wn * 64 + j * 16 + quad * 4;
        const f32x4 v = acc[i][j];
        if (EPI == 0) {
          if (col < INC) {
            uint2 o;
            o.x = pack2(v[0], v[1]);
            o.y = pack2(v[2], v[3]);
            *(uint2*)(p.U + (size_t)row * INC + col) = o;
            if (col >= 2816) *(float4*)(p.G + row * 16 + (col - 2816)) = make_float4(v[0], v[1], v[2], v[3]);
          }
        } else if (EPI == 1) {
          const int mr = row < ML_ROWS ? (row >> 11) : 8;
          const float4 g1 = *(const float4*)(p.mod + (size_t)(l * 9 + mr) * 6144 + 2048 + col);
          float4 sv;
          if (l == 0) sv = row < ML_ROWS ? *(const float4*)(p.x + (size_t)row * 1024 + col) : *(const float4*)(p.ctx + (size_t)(row - ML_ROWS) * 1024 + col);
          else sv = *(const float4*)(p.out + (size_t)row * 1024 + col);
          float* dst = row < ML_ROWS ? p.out + (size_t)row * 1024 + col : p.hc + (size_t)(row - ML_ROWS) * 1024 + col;
          *(float4*)dst = make_float4(sv.x + g1.x * v[0], sv.y + g1.y * v[1], sv.z + g1.z * v[2], sv.w + g1.w * v[3]);
        } else {
          *(float4*)(p.S + (size_t)row * 2048 + col) = make_float4(v[0], v[1], v[2], v[3]);
        }
      }
  }
}

__device__ __forceinline__ void vt_item(const P& p, int it, u16* tl);
__device__ __forceinline__ void phase_mixprep(const P& p, int l, char* smem) {
  const int tid = threadIdx.x;
  float* pl = (float*)smem;
  const int N_QK = MT_ROWS * 16 / 256;
  const int N_POOL = (l == 0 ? MT_ROWS : ML_ROWS) / 16;
  const int N_PREP = MT_ROWS / 8;
  const int N_VT = 2304 + 1152;
  const int total = N_QK + N_POOL + N_PREP + N_VT;
  for (int item = blockIdx.x; item < total; item += gridDim.x) {
    int it = item;
    if (it >= N_QK + N_POOL + N_PREP) { vt_item(p, it - (N_QK + N_POOL + N_PREP), (u16*)smem); continue; }
    if (it < N_QK) {
      int gi = it * 256 + tid;
      int row = gi >> 4, sub = gi & 15;
      int qk = sub >> 3, h = sub & 7;
      u16* ptr = p.U + (size_t)row * INC + qk * 512 + h * 64;
      const float* g = (qk ? p.na_k_g : p.na_q_g) + l * 64;
      uint4 v[8];
      float ss = 0.f;
#pragma unroll
      for (int c = 0; c < 8; c++) {
        v[c] = ((const uint4*)ptr)[c];
        float a;
        a = bflo(v[c].x); ss += a * a; a = bfhi(v[c].x); ss += a * a;
        a = bflo(v[c].y); ss += a * a; a = bfhi(v[c].y); ss += a * a;
        a = bflo(v[c].z); ss += a * a; a = bfhi(v[c].z); ss += a * a;
        a = bflo(v[c].w); ss += a * a; a = bfhi(v[c].w); ss += a * a;
      }
      float rs = rsqrtf(ss * (1.f / 64.f) + 1e-6f);
#pragma unroll
      for (int c = 0; c < 8; c++) {
        uint4 o;
        o.x = pack2(bflo(v[c].x) * rs * g[c * 8 + 0], bfhi(v[c].x) * rs * g[c * 8 + 1]);
        o.y = pack2(bflo(v[c].y) * rs * g[c * 8 + 2], bfhi(v[c].y) * rs * g[c * 8 + 3]);
        o.z = pack2(bflo(v[c].z) * rs * g[c * 8 + 4], bfhi(v[c].z) * rs * g[c * 8 + 5]);
        o.w = pack2(bflo(v[c].w) * rs * g[c * 8 + 6], bfhi(v[c].w) * rs * g[c * 8 + 7]);
        ((uint4*)ptr)[c] = o;
      }
      continue;
    }
    it -= N_QK;
    if (it < N_POOL) {
      int row0 = it * 16;
      int base, T;
      if (row0 < ML_ROWS) { base = (row0 >> 11) << 11; T = 2048; }
      else { base = ML_ROWS + (((row0 - ML_ROWS) >> 8) << 8); T = 256; }
      int t0 = row0 - base;
      int ch = tid, g = ch >> 6;
      int wdw = 2 << g;
      __syncthreads();
      {
        float vals[31];
#pragma unroll
        for (int j = 0; j < 31; j++) {
          int tau = t0 - 8 + j;
          bool ok = (tau >= 0) && (tau < T);
          vals[j] = ok ? bf2f(p.U[(size_t)(base + (ok ? tau : t0)) * INC + 1536 + ch]) : 0.f;
        }
        const int hl = wdw / 2, hr = wdw - wdw / 2 - 1;
#pragma unroll
        for (int tt = 0; tt < 16; tt++) {
          int t = t0 + tt;
          int lo = max(t - hl, 0), hi = min(t + hr, T - 1);
          float s = 0.f;
#pragma unroll
          for (int j = 0; j < 31; j++) {
            int rel = j - 8 - tt;
            if (rel >= -8 && rel <= 7) s += (rel >= -hl && rel <= hr) ? vals[j] : 0.f;
          }
          pl[tt * 256 + ch] = s / (float)(hi - lo + 1) - vals[8 + tt];
        }
      }
      __syncthreads();
      float acc[16];
#pragma unroll
      for (int tt = 0; tt < 16; tt++) acc[tt] = 0.f;
      int d = ch & 63;
      const float* pw = p.pool_w + ((size_t)(l * 4 + g) * 64) * 64 + d;
      for (int c = 0; c < 64; c++) {
        float wv = pw[c * 64];
#pragma unroll
        for (int tt = 0; tt < 16; tt++) acc[tt] += pl[tt * 256 + g * 64 + c] * wv;
      }
      float ps = p.pool_scale[l * 256 + ch];
#pragma unroll
      for (int tt = 0; tt < 16; tt++) p.Y[(size_t)(row0 + tt) * 1024 + 512 + ch] = f2bf(acc[tt] * ps);
      continue;
    }
    it -= N_POOL;
    {
      const int row0 = it * 8;
      int base, T;
      if (row0 < ML_ROWS) { base = (row0 >> 11) << 11; T = 2048; }
      else { base = ML_ROWS + (((row0 - ML_ROWS) >> 8) << 8); T = 256; }
      const int t0 = row0 - base;
      const int qk = tid >> 7, hh = (tid >> 5) & 3, ax = (tid >> 4) & 1, f = tid & 15;
      const int ca = qk * 256 + hh * 64 + ax * 32 + f, cb = ca + 16;
      float ua[12], ub[12];
#pragma unroll
      for (int j = 0; j < 12; j++) {
        int tt = t0 + j - 2;
        bool ok = (tt >= 0) && (tt < T);
        const u16* ur = p.U + (size_t)(base + (ok ? tt : t0)) * INC + 1792;
        ua[j] = ok ? bf2f(ur[ca]) : 0.f;
        ub[j] = ok ? bf2f(ur[cb]) : 0.f;
      }
      float wa[5], wb[5];
#pragma unroll
      for (int j = 0; j < 5; j++) { wa[j] = p.ml_conv[(l * 5 + j) * 512 + ca]; wb[j] = p.ml_conv[(l * 5 + j) * 512 + cb]; }
      const float inv = __expf(-(float)f * (9.210340371976184f / 16.f));
#pragma unroll
      for (int i = 0; i < 8; i++) {
        float a = 0.f, b = 0.f;
#pragma unroll
        for (int j = 0; j < 5; j++) { a += wa[j] * ua[i + j]; b += wb[j] * ub[i + j]; }
        a = siluf_(a);
        b = siluf_(b);
        if (row0 < ML_ROWS) {
          int t = t0 + i;
          float pos = (float)(ax == 0 ? (t >> 6) : (t & 63));
          float ang = pos * inv;
          float cs = __cosf(ang), sn = __sinf(ang);
          float oa = a * cs - b * sn, ob = a * sn + b * cs;
          a = oa; b = ob;
        }
        if (qk) { a *= 0.125f; b *= 0.125f; }
        ((u16*)p.MQK)[(size_t)(row0 + i) * 512 + ca] = f2bf(a);
        ((u16*)p.MQK)[(size_t)(row0 + i) * 512 + cb] = f2bf(b);
      }
      if (tid < 128) {
        int gi = tid & 15;
        float gv = p.G[row0 * 16 + tid] + p.ml_gate_b[l * 16 + gi];
        if ((gi >> 2) & 1) gv = fminf(gv, 0.f) - log1pf(__expf(-fabsf(gv)));
        p.G[row0 * 16 + tid] = gv;
      }
    }
  }
}

#define VT_CTX_OFF ((size_t)8 * 8 * 64 * 2048)
#define VTM_CTX_OFF ((size_t)8 * 4 * 64 * 2048)
__device__ __forceinline__ void vt_item(const P& p, int it, u16* tl) {
  const int tid = threadIdx.x;
  int b, h, tt, row0, TK, col0;
  u16* dst;
  if (it < 2048) { b = it >> 8; h = (it >> 5) & 7; tt = it & 31; row0 = b * 2048 + tt * 64; TK = 2048; col0 = 1024 + h * 64; dst = p.VT + (size_t)((b * 8 + h) * 64) * 2048 + tt * 64; }
  else if (it < 2304) { int ci = it - 2048; b = ci >> 5; h = (ci >> 2) & 7; tt = ci & 3; row0 = ML_ROWS + b * 256 + tt * 64; TK = 256; col0 = 1024 + h * 64; dst = p.VT + VT_CTX_OFF + (size_t)((b * 8 + h) * 64) * 256 + tt * 64; }
  else if (it < 2304 + 1024) { int mi = it - 2304; b = mi >> 7; h = (mi >> 5) & 3; tt = mi & 31; row0 = b * 2048 + tt * 64; TK = 2048; col0 = 2304 + h * 64; dst = p.VTm + (size_t)((b * 4 + h) * 64) * 2048 + tt * 64; }
  else { int mi = it - 3328; b = mi >> 4; h = (mi >> 2) & 3; tt = mi & 3; row0 = ML_ROWS + b * 256 + tt * 64; TK = 256; col0 = 2304 + h * 64; dst = p.VTm + VTM_CTX_OFF + (size_t)((b * 4 + h) * 64) * 256 + tt * 64; }
  __syncthreads();
  {
    int i = tid >> 2, part = tid & 3;
    const uint4* src = (const uint4*)(p.U + (size_t)(row0 + i) * INC + col0 + part * 16);
    uint4 v0 = src[0], v1 = src[1];
    unsigned* t32 = (unsigned*)(tl + i * 66 + part * 16);
    t32[0] = v0.x; t32[1] = v0.y; t32[2] = v0.z; t32[3] = v0.w;
    t32[4] = v1.x; t32[5] = v1.y; t32[6] = v1.z; t32[7] = v1.w;
  }
  __syncthreads();
  {
    int d = tid >> 2, part = tid & 3;
    unsigned o[8];
#pragma unroll
    for (int k = 0; k < 8; k++) {
      unsigned lo = tl[(part * 16 + 2 * k) * 66 + d], hi = tl[(part * 16 + 2 * k + 1) * 66 + d];
      o[k] = lo | (hi << 16);
    }
    uint4* dp = (uint4*)(dst + (size_t)d * TK + part * 16);
    dp[0] = make_uint4(o[0], o[1], o[2], o[3]);
    dp[1] = make_uint4(o[4], o[5], o[6], o[7]);
  }
}

__device__ __forceinline__ void attn_item(const P& p, int l, int item, float* sb) {
  const int tid = threadIdx.x, lane = tid & 63, w = tid >> 6, q = lane & 15, quad = lane >> 4;
  const bool latent = item < 2048;
  int b, r = 0, h, qb = 0;
  if (latent) { b = item >> 8; r = (item >> 3) & 31; h = item & 7; }
  else { int ci = item - 2048; b = ci >> 5; qb = (ci >> 3) & 3; h = ci & 7; }
  const int r0 = min(max(r - 4, 0), 24);
  __syncthreads();
  if (latent) {
    int kr = tid >> 5, j = tid & 31;
    if (j < 31) sb[tid] = p.na_rpb[(size_t)((l * 8 + h) * 15 + (r0 + kr - r + 7)) * 31 + j];
  }
  __syncthreads();
  const int qc = w * 16 + q;
  const int qrow = latent ? (b * 2048 + r * 64 + qc) : (ML_ROWS + b * 256 + qb * 64 + qc);
  const int cs = (w == 0) ? 0 : (w == 1) ? 8 : (w == 2) ? 24 : 32;
  const int c0 = min(max(qc - 8, 0), 48);
  const bf16x8 bq0 = *(const bf16x8*)(p.U + (size_t)qrow * INC + h * 64 + quad * 8);
  const bf16x8 bq1 = *(const bf16x8*)(p.U + (size_t)qrow * INC + h * 64 + 32 + quad * 8);
  const int mrow = (q >> 2) * 8 + (q & 3);
  const u16* vt_lat = p.VT + (size_t)((b * 8 + h) * 64 + q) * 2048 + quad * 8;
  const u16* vt_ctx = p.VT + VT_CTX_OFF + (size_t)((b * 8 + h) * 64 + q) * 256 + quad * 8;
  float m = -INFINITY, lsum = 0.f;
  f32x4 o[4];
#pragma unroll
  for (int dt = 0; dt < 4; dt++) o[dt] = (f32x4){0.f, 0.f, 0.f, 0.f};
  bf16x8 kf[16];
  {
    const int chunk = latent ? 0 : 2;
#pragma unroll
    for (int blk = 0; blk < 4; blk++) {
      int rowbase = (chunk < 2) ? (b * 2048 + (r0 + chunk * 4 + blk) * 64 + cs) : (ML_ROWS + b * 256 + (chunk - 2) * 128 + blk * 32);
#pragma unroll
      for (int T = 0; T < 2; T++) {
        const u16* kp = p.U + (size_t)(rowbase + mrow + T * 4) * INC + 512 + h * 64 + quad * 8;
        kf[(blk * 2 + T) * 2 + 0] = *(const bf16x8*)kp;
        kf[(blk * 2 + T) * 2 + 1] = *(const bf16x8*)(kp + 32);
      }
    }
  }
#pragma unroll 1
  for (int chunk = (latent ? 0 : 2); chunk < 4; chunk++) {
    f32x4 s[4][2];
#pragma unroll
    for (int blk = 0; blk < 4; blk++)
#pragma unroll
      for (int T = 0; T < 2; T++) {
        f32x4 acc = (f32x4){0.f, 0.f, 0.f, 0.f};
        acc = __builtin_amdgcn_mfma_f32_16x16x32_bf16(kf[(blk * 2 + T) * 2 + 0], bq0, acc, 0, 0, 0);
        acc = __builtin_amdgcn_mfma_f32_16x16x32_bf16(kf[(blk * 2 + T) * 2 + 1], bq1, acc, 0, 0, 0);
        s[blk][T] = acc;
      }
    if (chunk < 3) {
      const int nc = chunk + 1;
#pragma unroll
      for (int blk = 0; blk < 4; blk++) {
        int rowbase = (nc < 2) ? (b * 2048 + (r0 + nc * 4 + blk) * 64 + cs) : (ML_ROWS + b * 256 + (nc - 2) * 128 + blk * 32);
#pragma unroll
        for (int T = 0; T < 2; T++) {
          const u16* kp = p.U + (size_t)(rowbase + mrow + T * 4) * INC + 512 + h * 64 + quad * 8;
          kf[(blk * 2 + T) * 2 + 0] = *(const bf16x8*)kp;
          kf[(blk * 2 + T) * 2 + 1] = *(const bf16x8*)(kp + 32);
        }
      }
    }
    float mx = -INFINITY;
    if (chunk < 2) {
#pragma unroll
      for (int blk = 0; blk < 4; blk++)
#pragma unroll
        for (int T = 0; T < 2; T++)
#pragma unroll
          for (int rr = 0; rr < 4; rr++) {
            int kc = cs + quad * 8 + T * 4 + rr;
            bool valid = (kc >= c0) && (kc < c0 + 16);
            int bi = (chunk * 4 + blk) * 32 + min(max(kc - qc + 15, 0), 30);
            float v = valid ? (s[blk][T][rr] * 0.125f + sb[bi]) : -INFINITY;
            s[blk][T][rr] = v;
            mx = fmaxf(mx, v);
          }
    } else {
#pragma unroll
      for (int blk = 0; blk < 4; blk++)
#pragma unroll
        for (int T = 0; T < 2; T++)
#pragma unroll
          for (int rr = 0; rr < 4; rr++) {
            float v = s[blk][T][rr] * 0.125f;
            s[blk][T][rr] = v;
            mx = fmaxf(mx, v);
          }
    }
    mx = fmaxf(mx, __shfl_xor(mx, 16));
    mx = fmaxf(mx, __shfl_xor(mx, 32));
    float mn = fmaxf(m, mx);
    float sc = __expf(m - mn);
    lsum *= sc;
#pragma unroll
    for (int dt = 0; dt < 4; dt++) o[dt] *= sc;
    m = mn;
#pragma unroll
    for (int blk = 0; blk < 4; blk++) {
      float pv[8];
#pragma unroll
      for (int T = 0; T < 2; T++)
#pragma unroll
        for (int rr = 0; rr < 4; rr++) {
          float e = __expf(s[blk][T][rr] - mn);
          pv[T * 4 + rr] = e;
          lsum += e;
        }
      union { bf16x8 v; unsigned u[4]; } pk;
      pk.u[0] = pack2(pv[0], pv[1]); pk.u[1] = pack2(pv[2], pv[3]); pk.u[2] = pack2(pv[4], pv[5]); pk.u[3] = pack2(pv[6], pv[7]);
      const u16* vb = (chunk < 2) ? (vt_lat + (r0 + chunk * 4 + blk) * 64 + cs) : (vt_ctx + (chunk - 2) * 128 + blk * 32);
      const size_t dstr = (chunk < 2) ? (size_t)16 * 2048 : (size_t)16 * 256;
#pragma unroll
      for (int dt = 0; dt < 4; dt++) {
        bf16x8 av = *(const bf16x8*)(vb + dt * dstr);
        o[dt] = __builtin_amdgcn_mfma_f32_16x16x32_bf16(av, pk.v, o[dt], 0, 0, 0);
      }
    }
  }
  lsum += __shfl_xor(lsum, 16);
  lsum += __shfl_xor(lsum, 32);
  float il = 1.f / lsum;
#pragma unroll
  for (int dt = 0; dt < 4; dt++) {
    uint2 ov;
    ov.x = pack2(o[dt][0] * il, o[dt][1] * il);
    ov.y = pack2(o[dt][2] * il, o[dt][3] * il);
    *(uint2*)(p.Y + (size_t)qrow * 1024 + h * 64 + dt * 16 + quad * 4) = ov;
  }
}

__device__ __forceinline__ int ml_row(int b, int dir, int j, int pp) {
  if (j < 4) {
    int pos = j * 64 + pp;
    int t = dir ? 255 - pos : pos;
    return ML_ROWS + b * 256 + t;
  } else {
    int pos = (j - 4) * 64 + pp;
    int t = dir ? 2047 - pos : pos;
    return b * 2048 + t;
  }
}

__device__ __forceinline__ void mlstmA_item(const P& p, int it, float* sm) {
  const int tid = threadIdx.x, lane = tid & 63;
  int seq = it / 36, j = it % 36;
  int b = seq >> 3, h = (seq >> 1) & 3, dir = seq & 1;
  float* ks = sm;
  float* vs = sm + 64 * 65;
  float* wsm = sm + 2 * 64 * 65;
  float* slot = p.mst + (size_t)it * SLOT;
  const u16* mqk = (const u16*)p.MQK;
  __syncthreads();
  for (int idx = tid; idx < 4096; idx += 256) {
    int pp = idx >> 6, d = idx & 63;
    int row = ml_row(b, dir, j, pp);
    ks[pp * 65 + d] = bf2f(mqk[(size_t)row * 512 + 256 + h * 64 + d]);
    vs[pp * 65 + d] = bf2f(p.U[(size_t)row * INC + 2304 + h * 64 + d]);
  }
  if (tid < 64) {
    int row = ml_row(b, dir, j, lane);
    float ic = p.G[row * 16 + (dir * 2) * 4 + h];
    float fc = p.G[row * 16 + (dir * 2 + 1) * 4 + h];
    float bbv = fc;
#pragma unroll
    for (int o = 1; o < 64; o <<= 1) { float u = __shfl_up(bbv, o); if (lane >= o) bbv += u; }
    float cs = ic - bbv;
    float pm = cs;
#pragma unroll
    for (int o = 1; o < 64; o <<= 1) { float u = __shfl_up(pm, o); if (lane >= o) pm = fmaxf(pm, u); }
    float bl = __shfl(bbv, 63);
    float ml = __shfl(pm, 63) + bl;
    wsm[lane] = __expf(bl + cs - ml);
    slot[4224 + lane] = bbv;
    slot[4288 + lane] = cs;
    slot[4352 + lane] = pm;
    if (lane == 0) { slot[4160] = bl; slot[4161] = ml; }
  }
  __syncthreads();
  {
    int e = tid & 63, dg = tid >> 6;
    float acc[16];
#pragma unroll
    for (int dd = 0; dd < 16; dd++) acc[dd] = 0.f;
    for (int pp = 0; pp < 64; pp++) {
      float wv = wsm[pp] * vs[pp * 65 + e];
#pragma unroll
      for (int dd = 0; dd < 16; dd++) acc[dd] += ks[pp * 65 + dg * 16 + dd] * wv;
    }
#pragma unroll
    for (int q4 = 0; q4 < 4; q4++)
      *(float4*)(slot + e * 64 + dg * 16 + q4 * 4) = make_float4(acc[q4 * 4], acc[q4 * 4 + 1], acc[q4 * 4 + 2], acc[q4 * 4 + 3]);
  }
  if (tid < 64) {
    float a = 0.f;
    for (int pp = 0; pp < 64; pp++) a += wsm[pp] * ks[pp * 65 + tid];
    slot[4096 + tid] = a;
  }
}

#define ATT_SPLIT 768
__device__ __forceinline__ void phase_attn_mlA(const P& p, int l, char* smem) {
  const int N_MLA = 64 * 36;
  const int total = ATT_SPLIT + N_MLA;
  for (int item = blockIdx.x; item < total; item += gridDim.x) {
    if (item < N_MLA) mlstmA_item(p, item, (float*)smem);
    else attn_item(p, l, item - N_MLA, (float*)smem);
  }
}
__device__ __forceinline__ void mlB_item(const P& p, int item);
__device__ __forceinline__ void phase_attn_mlB(const P& p, int l, char* smem) {
  const int N_ATT = (l == 0 ? 2304 : 2048) - ATT_SPLIT;
  const int N_MLB = 64 * 17;
  const int total = N_ATT + N_MLB;
  for (int item = blockIdx.x; item < total; item += gridDim.x) {
    if (item < N_MLB) mlB_item(p, item);
    else attn_item(p, l, ATT_SPLIT + item - N_MLB, (float*)smem);
  }
}

__device__ __forceinline__ void mlB_item(const P& p, int item) {
  const int tid = threadIdx.x;
  int seq = item / 17, ech = item - seq * 17;
  int el = ech * 256 + tid;
  if (el >= 4160) return;
  float* base = p.mst + (size_t)(seq * 36) * SLOT;
  float loc[36], bl[36], ml[36];
#pragma unroll
  for (int j = 0; j < 36; j++) {
    loc[j] = base[(size_t)j * SLOT + el];
    bl[j] = base[(size_t)j * SLOT + 4160];
    ml[j] = base[(size_t)j * SLOT + 4161];
  }
  float m = 0.f, val = 0.f;
#pragma unroll
  for (int j = 0; j < 36; j++) {
    base[(size_t)j * SLOT + el] = val;
    if (el == 0) base[(size_t)j * SLOT + 4162] = m;
    float mn = fmaxf(bl[j] + m, ml[j]);
    val = __expf(bl[j] + m - mn) * val + __expf(ml[j] - mn) * loc[j];
    m = mn;
  }
}

__device__ __forceinline__ bf16x8 pack8(float4 a, float4 b) {
  union { bf16x8 v; unsigned u[4]; } r;
  r.u[0] = pack2(a.x, a.y); r.u[1] = pack2(a.z, a.w); r.u[2] = pack2(b.x, b.y); r.u[3] = pack2(b.z, b.w);
  return r.v;
}
__device__ __forceinline__ void phase_mlC(const P& p, int l, char* smem) {
  const int tid = threadIdx.x, lane = tid & 63, w = tid >> 6, q = lane & 15, quad = lane >> 4;
  const u16* mqk = (const u16*)p.MQK;
  const int nch = (l == 0) ? 36 : 32;
  const int total = 32 * nch;
  const int mrow = (q >> 2) * 8 + (q & 3);
  for (int item = blockIdx.x; item < total; item += gridDim.x) {
    int bh = item / nch, c = item % nch + (l == 0 ? 0 : 4);
    int b = bh >> 2, h = bh & 3;
    const int rowbase = (c < 4) ? (ML_ROWS + b * 256 + c * 64) : (b * 2048 + (c - 4) * 64);
    const int tau_t = w * 16 + q;
    const int trow = rowbase + tau_t;
    const bf16x8 bq0 = *(const bf16x8*)(mqk + (size_t)trow * 512 + h * 64 + quad * 8);
    const bf16x8 bq1 = *(const bf16x8*)(mqk + (size_t)trow * 512 + h * 64 + 32 + quad * 8);
    const u16* vt = (c < 4) ? (p.VTm + VTM_CTX_OFF + (size_t)((b * 4 + h) * 64 + q) * 256 + c * 64 + quad * 8)
                            : (p.VTm + (size_t)((b * 4 + h) * 64 + q) * 2048 + (c - 4) * 64 + quad * 8);
    const size_t vstr = (c < 4) ? (size_t)16 * 256 : (size_t)16 * 2048;
    f32x4 hs[4];
#pragma unroll
    for (int et = 0; et < 4; et++) hs[et] = (f32x4){0.f, 0.f, 0.f, 0.f};
#pragma unroll 1
    for (int dir = 0; dir < 2; dir++) {
      int j = dir ? (c < 4 ? 3 - c : 4 + 31 - (c - 4)) : c;
      const float* slot = p.mst + (size_t)(((b * 4 + h) * 2 + dir) * 36 + j) * SLOT;
      const int pt = dir ? 63 - tau_t : tau_t;
      const float m0 = slot[4162];
      const float bt = slot[4224 + pt];
      const float mt = bt + fmaxf(m0, slot[4352 + pt]);
      const float winter = __expf(bt + m0 - mt);
      f32x4 aw[4], ac[4];
#pragma unroll
      for (int et = 0; et < 4; et++) { aw[et] = (f32x4){0.f, 0.f, 0.f, 0.f}; ac[et] = (f32x4){0.f, 0.f, 0.f, 0.f}; }
      float dsum = 0.f;
#pragma unroll
      for (int kb = 0; kb < 2; kb++) {
        float wv[8];
#pragma unroll
        for (int T = 0; T < 2; T++) {
          const u16* kp = mqk + (size_t)(rowbase + kb * 32 + mrow + T * 4) * 512 + 256 + h * 64 + quad * 8;
          bf16x8 a0 = *(const bf16x8*)kp;
          bf16x8 a1 = *(const bf16x8*)(kp + 32);
          f32x4 sacc = (f32x4){0.f, 0.f, 0.f, 0.f};
          sacc = __builtin_amdgcn_mfma_f32_16x16x32_bf16(a0, bq0, sacc, 0, 0, 0);
          sacc = __builtin_amdgcn_mfma_f32_16x16x32_bf16(a1, bq1, sacc, 0, 0, 0);
#pragma unroll
          for (int rr = 0; rr < 4; rr++) {
            int tau_s = kb * 32 + quad * 8 + T * 4 + rr;
            int ps = dir ? 63 - tau_s : tau_s;
            bool valid = dir ? (tau_s >= tau_t) : (tau_s <= tau_t);
            float cs = slot[4288 + ps];
            float v = valid ? sacc[rr] * __expf(bt - mt + cs) : 0.f;
            wv[T * 4 + rr] = v;
            dsum += v;
          }
        }
        union { bf16x8 v; unsigned u[4]; } pk;
        pk.u[0] = pack2(wv[0], wv[1]); pk.u[1] = pack2(wv[2], wv[3]); pk.u[2] = pack2(wv[4], wv[5]); pk.u[3] = pack2(wv[6], wv[7]);
#pragma unroll
        for (int et = 0; et < 4; et++) {
          bf16x8 av = *(const bf16x8*)(vt + et * vstr + kb * 32);
          aw[et] = __builtin_amdgcn_mfma_f32_16x16x32_bf16(av, pk.v, aw[et], 0, 0, 0);
        }
      }
#pragma unroll
      for (int et = 0; et < 4; et++) {
        const float* cp = slot + (et * 16 + q) * 64 + quad * 8;
        bf16x8 c0 = pack8(*(const float4*)cp, *(const float4*)(cp + 4));
        bf16x8 c1 = pack8(*(const float4*)(cp + 32), *(const float4*)(cp + 36));
        ac[et] = __builtin_amdgcn_mfma_f32_16x16x32_bf16(c0, bq0, ac[et], 0, 0, 0);
        ac[et] = __builtin_amdgcn_mfma_f32_16x16x32_bf16(c1, bq1, ac[et], 0, 0, 0);
      }
      float qn = 0.f;
      {
        const float* np_ = slot + 4096 + quad * 8;
        float4 n0 = *(const float4*)np_, n1 = *(const float4*)(np_ + 4), n2 = *(const float4*)(np_ + 32), n3 = *(const float4*)(np_ + 36);
        union { bf16x8 v; unsigned u[4]; } q0, q1;
        q0.v = bq0; q1.v = bq1;
        qn += bflo(q0.u[0]) * n0.x + bfhi(q0.u[0]) * n0.y + bflo(q0.u[1]) * n0.z + bfhi(q0.u[1]) * n0.w;
        qn += bflo(q0.u[2]) * n1.x + bfhi(q0.u[2]) * n1.y + bflo(q0.u[3]) * n1.z + bfhi(q0.u[3]) * n1.w;
        qn += bflo(q1.u[0]) * n2.x + bfhi(q1.u[0]) * n2.y + bflo(q1.u[1]) * n2.z + bfhi(q1.u[1]) * n2.w;
        qn += bflo(q1.u[2]) * n3.x + bfhi(q1.u[2]) * n3.y + bflo(q1.u[3]) * n3.z + bfhi(q1.u[3]) * n3.w;
      }
      qn += __shfl_xor(qn, 16);
      qn += __shfl_xor(qn, 32);
      dsum += __shfl_xor(dsum, 16);
      dsum += __shfl_xor(dsum, 32);
      float den = dsum + winter * qn;
      float ih = 1.f / fmaxf(fabsf(den), __expf(-mt));
#pragma unroll
      for (int et = 0; et < 4; et++)
#pragma unroll
        for (int rr = 0; rr < 4; rr++) hs[et][rr] += (aw[et][rr] + winter * ac[et][rr]) * ih;
    }
    float ss = 0.f;
#pragma unroll
    for (int et = 0; et < 4; et++)
#pragma unroll
      for (int rr = 0; rr < 4; rr++) ss += hs[et][rr] * hs[et][rr];
    ss += __shfl_xor(ss, 16);
    ss += __shfl_xor(ss, 32);
    float rs = rsqrtf(ss * (1.f / 64.f) + 1e-6f);
#pragma unroll
    for (int et = 0; et < 4; et++) {
      int e0 = h * 64 + et * 16 + quad * 4;
      uint2 uo = *(const uint2*)(p.U + (size_t)trow * INC + 2560 + e0);
      float4 ng = *(const float4*)(p.ml_norm_g + l * 256 + e0);
      float o0 = hs[et][0] * rs * ng.x * sigmoidf_(bflo(uo.x));
      float o1 = hs[et][1] * rs * ng.y * sigmoidf_(bfhi(uo.x));
      float o2 = hs[et][2] * rs * ng.z * sigmoidf_(bflo(uo.y));
      float o3 = hs[et][3] * rs * ng.w * sigmoidf_(bfhi(uo.y));
      uint2 ov;
      ov.x = pack2(o0, o1);
      ov.y = pack2(o2, o3);
      *(uint2*)(p.Y + (size_t)trow * 1024 + 768 + e0) = ov;
    }
  }
}

typedef __attribute__((ext_vector_type(2))) float f32x2;
__device__ __forceinline__ float gelu_tanh(float x) {
  float u = 0.7978845608028654f * (x + 0.044715f * x * x * x);
  float th = 1.f - 2.f / (1.f + __expf(2.f * u));
  return 0.5f * x * (1.f + th);
}
__device__ __forceinline__ float dot16_fp8(const f32x2* xr, uint4 v) {
  f32x2 s = __builtin_amdgcn_cvt_pk_f32_fp8((int)v.x, false) * xr[0];
  s += __builtin_amdgcn_cvt_pk_f32_fp8((int)v.x, true) * xr[1];
  s += __builtin_amdgcn_cvt_pk_f32_fp8((int)v.y, false) * xr[2];
  s += __builtin_amdgcn_cvt_pk_f32_fp8((int)v.y, true) * xr[3];
  s += __builtin_amdgcn_cvt_pk_f32_fp8((int)v.z, false) * xr[4];
  s += __builtin_amdgcn_cvt_pk_f32_fp8((int)v.z, true) * xr[5];
  s += __builtin_amdgcn_cvt_pk_f32_fp8((int)v.w, false) * xr[6];
  s += __builtin_amdgcn_cvt_pk_f32_fp8((int)v.w, true) * xr[7];
  return s.x + s.y;
}
__device__ __forceinline__ void axpy16_fp8(f32x2* acc, float a, uint4 v) {
  f32x2 av = (f32x2){a, a};
  acc[0] += av * __builtin_amdgcn_cvt_pk_f32_fp8((int)v.x, false);
  acc[1] += av * __builtin_amdgcn_cvt_pk_f32_fp8((int)v.x, true);
  acc[2] += av * __builtin_amdgcn_cvt_pk_f32_fp8((int)v.y, false);
  acc[3] += av * __builtin_amdgcn_cvt_pk_f32_fp8((int)v.y, true);
  acc[4] += av * __builtin_amdgcn_cvt_pk_f32_fp8((int)v.z, false);
  acc[5] += av * __builtin_amdgcn_cvt_pk_f32_fp8((int)v.z, true);
  acc[6] += av * __builtin_amdgcn_cvt_pk_f32_fp8((int)v.w, false);
  acc[7] += av * __builtin_amdgcn_cvt_pk_f32_fp8((int)v.w, true);
}

__device__ __forceinline__ unsigned fkey(float f) {
  unsigned u = __float_as_uint(f);
  return (u & 0x80000000u) ? ~u : (u | 0x80000000u);
}
__device__ __forceinline__ int mbcnt64(unsigned long long m) {
  return __builtin_amdgcn_mbcnt_hi((unsigned)(m >> 32), __builtin_amdgcn_mbcnt_lo((unsigned)m, 0));
}
#define WAVE_LDS_FENCE() do { __builtin_amdgcn_fence(__ATOMIC_RELEASE, "wavefront"); __builtin_amdgcn_wave_barrier(); __builtin_amdgcn_fence(__ATOMIC_ACQUIRE, "wavefront"); } while (0)

#define RADIX_BODY(COUNT)                                                                  \
  unsigned pf = 0;                                                                         \
  int bit = 31;                                                                            \
  bool done = false;                                                                       \
  {                                                                                        \
    unsigned c = 0xC1000000u;                                                \
    int n = COUNT;                                                                         \
    n = __builtin_amdgcn_readfirstlane(n);                                                 \
    if (n < 16) {                                                                          \
      _Pragma("unroll 1") for (c = 0xC0800000u; c >= 0xBE800000u; c -= 0x00800000u) {      \
        n = COUNT;                                                                         \
        n = __builtin_amdgcn_readfirstlane(n);                                             \
        if (n >= 16) { pf = c; bit = 22; done = (n == 16); break; }                        \
      }                                                                                    \
    }                                                                                      \
  }                                                                                        \
  if (!done) {                                                                             \
    _Pragma("unroll 1") for (; bit >= 0; --bit) {                                          \
      const unsigned c = pf | (1u << bit);                                                 \
      int n = COUNT;                                                                       \
      n = __builtin_amdgcn_readfirstlane(n);                                               \
      if (n >= 16) { pf = c; if (n == 16) break; }                                         \
    }                                                                                      \
  }                                                                                        \
  return (unsigned)__builtin_amdgcn_readfirstlane((int)pf);
__device__ __forceinline__ unsigned radix_thr2(unsigned k0, unsigned k1) {
  RADIX_BODY((__popcll(__ballot(k0 >= c)) + __popcll(__ballot(k1 >= c))))
}
__device__ __forceinline__ unsigned radix_thr4(unsigned k0, unsigned k1, unsigned k2, unsigned k3) {
  RADIX_BODY((__popcll(__ballot(k0 >= c)) + __popcll(__ballot(k1 >= c)) + __popcll(__ballot(k2 >= c)) + __popcll(__ballot(k3 >= c))))
}
__device__ __forceinline__ void phase_peer_topk(const P& p, int l, char* smem) {
  const int tid = threadIdx.x, lane = tid & 63, w = tid >> 6;
  float* wl = (float*)smem + w * 512;
  float* cs = wl;
  int* ci = (int*)(wl + 32);
  int* el = (int*)(wl + 64);
  float* sl = wl + 192;
  const int nrows = (l == 1) ? ML_ROWS : MT_ROWS;
  const int nw = gridDim.x * 4;
  for (int row = blockIdx.x * 4 + w; row < nrows; row += nw) {
    float na0, na1, nb0, nb1;
    {
      const float* sp0 = p.S + (size_t)row * 2048;
      na0 = sp0[lane]; na1 = sp0[64 + lane]; nb0 = sp0[128 + lane]; nb1 = sp0[192 + lane];
    }
#pragma unroll 1
    for (int h = 0; h < 8; h++) {
      float a0 = na0, a1 = na1, b0 = nb0, b1 = nb1;
      {
        const float* spn = p.S + (size_t)row * 2048 + ((h + 1) & 7) * 256;
        na0 = spn[lane]; na1 = spn[64 + lane]; nb0 = spn[128 + lane]; nb1 = spn[192 + lane];
      }
      unsigned kA0 = fkey(a0), kA1 = fkey(a1), kB0 = fkey(b0), kB1 = fkey(b1);
      const unsigned pA = radix_thr2(kA0, kA1), pB = radix_thr2(kB0, kB1);
      {
        unsigned long long m0 = __ballot(kA0 >= pA), m1 = __ballot(kA1 >= pA);
        int p0 = mbcnt64(m0), p1 = __popcll(m0) + mbcnt64(m1);
        if (kA0 >= pA && p0 < 16) { cs[p0] = a0; ci[p0] = lane; }
        if (kA1 >= pA && p1 < 16) { cs[p1] = a1; ci[p1] = lane + 64; }
        m0 = __ballot(kB0 >= pB); m1 = __ballot(kB1 >= pB);
        p0 = mbcnt64(m0); p1 = __popcll(m0) + mbcnt64(m1);
        if (kB0 >= pB && p0 < 16) { cs[16 + p0] = b0; ci[16 + p0] = lane; }
        if (kB1 >= pB && p1 < 16) { cs[16 + p1] = b1; ci[16 + p1] = lane + 64; }
      }
      WAVE_LDS_FENCE();
      const int ii = lane >> 2, jb = (lane & 3) * 4;
      float s1 = cs[ii];
      float c0 = s1 + cs[16 + jb + 0], c1 = s1 + cs[16 + jb + 1], c2 = s1 + cs[16 + jb + 2], c3 = s1 + cs[16 + jb + 3];
      int e1 = ci[ii] * 128;
      int f0 = e1 + ci[16 + jb + 0], f1 = e1 + ci[16 + jb + 1], f2 = e1 + ci[16 + jb + 2], f3 = e1 + ci[16 + jb + 3];
      unsigned k0 = fkey(c0), k1 = fkey(c1), k2 = fkey(c2), k3 = fkey(c3);
      const unsigned pC = radix_thr4(k0, k1, k2, k3);
      {
        unsigned long long m0 = __ballot(k0 >= pC), m1 = __ballot(k1 >= pC), m2 = __ballot(k2 >= pC), m3 = __ballot(k3 >= pC);
        int q0 = mbcnt64(m0);
        int q1 = __popcll(m0) + mbcnt64(m1);
        int q2 = __popcll(m0) + __popcll(m1) + mbcnt64(m2);
        int q3 = __popcll(m0) + __popcll(m1) + __popcll(m2) + mbcnt64(m3);
        if (k0 >= pC && q0 < 16) { el[h * 16 + q0] = f0; sl[h * 16 + q0] = c0; }
        if (k1 >= pC && q1 < 16) { el[h * 16 + q1] = f1; sl[h * 16 + q1] = c1; }
        if (k2 >= pC && q2 < 16) { el[h * 16 + q2] = f2; sl[h * 16 + q2] = c2; }
        if (k3 >= pC && q3 < 16) { el[h * 16 + q3] = f3; sl[h * 16 + q3] = c3; }
      }
      WAVE_LDS_FENCE();
    }
    {
      float v0 = sl[lane], v1 = sl[64 + lane];
      float m0 = v0, m1 = v1;
#pragma unroll
      for (int o = 1; o < 16; o <<= 1) { m0 = fmaxf(m0, __shfl_xor(m0, o)); m1 = fmaxf(m1, __shfl_xor(m1, o)); }
      float e0 = __expf(v0 - m0), e1 = __expf(v1 - m1);
      float s0 = e0, s1 = e1;
#pragma unroll
      for (int o = 1; o < 16; o <<= 1) { s0 += __shfl_xor(s0, o); s1 += __shfl_xor(s1, o); }
      sl[lane] = e0 / s0;
      sl[64 + lane] = e1 / s1;
    }
    WAVE_LDS_FENCE();
    p.elist[(size_t)row * 128 + lane] = el[lane];
    p.elist[(size_t)row * 128 + 64 + lane] = el[64 + lane];
    p.glist[(size_t)row * 128 + lane] = sl[lane];
    p.glist[(size_t)row * 128 + 64 + lane] = sl[64 + lane];
    p.slist[(size_t)row * 128 + lane] = p.su[l * 16384 + el[lane]];
    p.slist[(size_t)row * 128 + 64 + lane] = p.su[l * 16384 + el[64 + lane]];
    WAVE_LDS_FENCE();
  }
}

struct PeerMeta {
  int id0, id1;
  uint4 xq;
  float h0[8], h1[8], g0, g1, s0, s1;
};
template <int PH>
__device__ __forceinline__ void peer_load_meta(const P& p, int t, int k, int lane, PeerMeta& m) {
  m.id0 = p.elist[(size_t)t * 128 + lane];
  m.id1 = p.elist[(size_t)t * 128 + 64 + lane];
  if (PH == 0) {
    m.xq = *(const uint4*)(p.xq + (size_t)t * 1024 + k * 128 + (lane & 7) * 16);
  } else {
#pragma unroll
    for (int kk = 0; kk < 8; kk++) {
      m.h0[kk] = p.hp[((size_t)t * 8 + kk) * 128 + lane];
      m.h1[kk] = p.hp[((size_t)t * 8 + kk) * 128 + 64 + lane];
    }
    m.g0 = p.glist[(size_t)t * 128 + lane];
    m.g1 = p.glist[(size_t)t * 128 + 64 + lane];
    const float sxt = p.sx[t];
    m.s0 = p.slist[(size_t)t * 128 + lane] * sxt;
    m.s1 = p.slist[(size_t)t * 128 + 64 + lane] * sxt;
  }
}
template <int PH>
__device__ __forceinline__ void peer_issue(const PeerMeta& m, int* idb, float* alb, const unsigned char* tab, int lane, uint4* rr, uint4& xq) {
  idb[lane] = m.id0;
  idb[64 + lane] = m.id1;
  if (PH == 0) {
    xq = m.xq;
  } else {
    float h0 = ((m.h0[0] + m.h0[1]) + (m.h0[2] + m.h0[3])) + ((m.h0[4] + m.h0[5]) + (m.h0[6] + m.h0[7]));
    float h1 = ((m.h1[0] + m.h1[1]) + (m.h1[2] + m.h1[3])) + ((m.h1[4] + m.h1[5]) + (m.h1[6] + m.h1[7]));
    alb[lane] = gelu_tanh(h0 * m.s0) * m.g0;
    alb[64 + lane] = gelu_tanh(h1 * m.s1) * m.g1;
  }
  WAVE_LDS_FENCE();
  const int es = lane >> 3;
#pragma unroll
  for (int i = 0; i < 16; i++) rr[i] = *(const uint4*)(tab + (size_t)idb[i * 8 + es] * 128);
}
template <int PH>
__device__ __forceinline__ void peer_compute(const P& p, int l, int t, bool valid, int k, int lane, const uint4* rr, const uint4& xq4, const float* alb) {
  const int es = lane >> 3;
  const int s0 = (PH == 0) ? 1 : 8, s1 = (PH == 0) ? 2 : 16, s2 = (PH == 0) ? 4 : 32;
  const bool c0 = (lane & s0) != 0, c1 = (lane & s1) != 0, c2 = (lane & s2) != 0;
  const int B = (c0 ? 8 : 0) + (c1 ? 4 : 0) + (c2 ? 2 : 0);
  float v[16];
  if (PH == 0) {
#pragma unroll
    for (int i = 0; i < 16; i++) {
      int a_ = __builtin_amdgcn_sdot4((int)rr[i].x, (int)xq4.x, 0, false);
      a_ = __builtin_amdgcn_sdot4((int)rr[i].y, (int)xq4.y, a_, false);
      a_ = __builtin_amdgcn_sdot4((int)rr[i].z, (int)xq4.z, a_, false);
      a_ = __builtin_amdgcn_sdot4((int)rr[i].w, (int)xq4.w, a_, false);
      v[i] = (float)a_;
    }
  } else {
    f32x2 acc[8];
#pragma unroll
    for (int i = 0; i < 8; i++) acc[i] = (f32x2){0.f, 0.f};
#pragma unroll
    for (int i = 0; i < 16; i++) axpy16_fp8(acc, alb[i * 8 + es], rr[i]);
#pragma unroll
    for (int i = 0; i < 8; i++) { v[2 * i] = acc[i].x; v[2 * i + 1] = acc[i].y; }
  }
  float k8[8], k4[4], k2[2];
#pragma unroll
  for (int i = 0; i < 8; i++) k8[i] = (c0 ? v[i + 8] : v[i]) + __shfl_xor(c0 ? v[i] : v[i + 8], s0);
#pragma unroll
  for (int i = 0; i < 4; i++) k4[i] = (c1 ? k8[i + 4] : k8[i]) + __shfl_xor(c1 ? k8[i] : k8[i + 4], s1);
#pragma unroll
  for (int i = 0; i < 2; i++) k2[i] = (c2 ? k4[i + 2] : k4[i]) + __shfl_xor(c2 ? k4[i] : k4[i + 2], s2);
  if (PH == 0) {
    float* hq = p.hp + ((size_t)t * 8 + k) * 128;
    if (valid) {
      hq[(B + 0) * 8 + es] = k2[0];
      hq[(B + 1) * 8 + es] = k2[1];
    }
  } else {
    const int col = k * 128 + (lane & 7) * 16 + B;
    const int mr = t < ML_ROWS ? (t >> 11) : 8;
    const float2 g2 = *(const float2*)(p.mod + (size_t)(l * 9 + mr) * 6144 + 5120 + col);
    float2* dst = (float2*)(t < ML_ROWS ? p.out + (size_t)t * 1024 + col : p.hc + (size_t)(t - ML_ROWS) * 1024 + col);
    float2 cur = *dst;
    cur.x += g2.x * 0.125f * k2[0];
    cur.y += g2.y * 0.125f * k2[1];
    if (valid) *dst = cur;
  }
}
template <int PH>
__device__ __forceinline__ void phase_peer_uv(const P& p, int l, char* smem) {
  const int tid = threadIdx.x, lane = tid & 63, w = tid >> 6;
  int* idA = (int*)smem + w * 512;
  int* idB = idA + 128;
  float* alA = (float*)(idA + 256);
  float* alB = alA + 128;
  const int nrows = (l == 1) ? ML_ROWS : MT_ROWS;
  const int k = blockIdx.x & 7;
  const int gw = (blockIdx.x >> 3) * 4 + w, ngw = (gridDim.x >> 3) * 4;
  const unsigned char* tab = (const unsigned char*)(PH == 0 ? p.Ub : p.Vb) + (size_t)((l * 8 + k) * 16384) * 128 + (lane & 7) * 16;
  PeerMeta M;
  uint4 rrA[16], rrB[16];
  uint4 xqA = make_uint4(0, 0, 0, 0), xqB = xqA;
  if (gw >= nrows) return;
  const int nit = (nrows - gw + ngw - 1) / ngw;
  const int tlast = gw + (nit - 1) * ngw;
  peer_load_meta<PH>(p, gw, k, lane, M);
  peer_issue<PH>(M, idA, alA, tab, lane, rrA, xqA);
  peer_load_meta<PH>(p, min(gw + ngw, tlast), k, lane, M);
#pragma unroll 1
  for (int i = 0; i < nit; i += 2) {
    const int tA = gw + i * ngw, tB = tA + ngw;
    peer_issue<PH>(M, idB, alB, tab, lane, rrB, xqB);
    peer_load_meta<PH>(p, min(tB + ngw, tlast), k, lane, M);
    peer_compute<PH>(p, l, tA, true, k, lane, rrA, xqA, alA);
    peer_issue<PH>(M, idA, alA, tab, lane, rrA, xqA);
    peer_load_meta<PH>(p, min(tB + 2 * ngw, tlast), k, lane, M);
    peer_compute<PH>(p, l, min(tB, tlast), tB <= tlast, k, lane, rrB, xqB, alB);
  }
}

#define RUN(k, call)                         \
  if (lo <= (k) && (k) < hi) {               \
    call;                                    \
    if ((k) + 1 < hi) xcd_barrier(xb);       \
  }
#define LAYER(l, base)                                                                                                    \
  RUN(base + 0, phase_norm(p, l, 1))                                                                                     \
  RUN(base + 1, phase_gemm<0>(p, l, p.xn, p.WinT + (size_t)l * INC_PAD * 1024, MT_ROWS / 128, INC_PAD / 128, smem))     \
  RUN(base + 2, phase_mixprep(p, l, smem))                                                                               \
  RUN(base + 3, phase_attn_mlA(p, l, smem))                                                                              \
  RUN(base + 4, phase_attn_mlB(p, l, smem))                                                                                            \
  RUN(base + 5, phase_mlC(p, l, smem))                                                                                   \
  RUN(base + 6, phase_gemm<1>(p, l, p.Y, p.WoutT + (size_t)l * 1024 * 1024, (l == 0 ? MT_ROWS : ML_ROWS) / 128, 8, smem)) \
  RUN(base + 7, phase_norm(p, l, 2))                                                                                     \
  RUN(base + 8, phase_gemm<2>(p, l, p.xn, p.WsT + (size_t)l * 2048 * 1024, (l == 0 ? MT_ROWS : ML_ROWS) / 128, 16, smem)) \
  RUN(base + 9, phase_peer_topk(p, l, smem))                                                                             \
  RUN(base + 10, phase_peer_uv<0>(p, l, smem))                                                                            \
  RUN(base + 11, phase_peer_uv<1>(p, l, smem))

__global__ void __launch_bounds__(256, 2) fwd_kernel(P p) {
  __shared__ __attribute__((aligned(16))) char smem[SMEM_BYTES];
  __shared__ uint4 xb_words;
  cg::grid_group grid = cg::this_grid();
  const int lo = (int)p.ph_lo, hi = (int)p.ph_hi;
  if (threadIdx.x == 0) xb_words = make_uint4(0u, 0u, 0u, 0u);
  __syncthreads();
  XcdBarrier xb = xcd_barrier_post(p.bar, (volatile LAS unsigned*)&xb_words);
  if (hi - lo > 1) grid.sync();
  RUN(0, phase_prologue(p, smem))
  LAYER(0, 1)
  LAYER(1, 13)
}

extern "C" void kernel_launch(void* const* d_in, const int* in_sizes, int n_in, void* d_out, int out_size, void* d_ws,
                              size_t ws_size, hipStream_t stream) {
  static int grid_blocks = 0;
  if (!grid_blocks) {
    int dev = 0, cus = 0, per_cu = 0;
    hipGetDevice(&dev);
    hipDeviceGetAttribute(&cus, hipDeviceAttributeMultiprocessorCount, dev);
    hipOccupancyMaxActiveBlocksPerMultiprocessor(&per_cu, fwd_kernel, 256, 0);
    if (per_cu < 1) per_cu = 1;
    if (per_cu > 2) per_cu = 2;
    grid_blocks = (cus * per_cu) & ~7;
  }
  P p{};
  const float** ins = (const float**)&p;
  for (int i = 0; i < 22; i++) ins[i] = (const float*)d_in[i];
  p.out = (float*)d_out;
  char* ws = (char*)d_ws;
  size_t off = 0;
  auto take = [&](size_t bytes) { char* r = ws + off; off += (bytes + 255) & ~(size_t)255; return r; };
  p.WinT = (u16*)take((size_t)2 * INC_PAD * 1024 * 2);
  p.WoutT = (u16*)take((size_t)2 * 1024 * 1024 * 2);
  p.WsT = (u16*)take((size_t)2 * 2048 * 1024 * 2);
  p.Ub = (u16*)take((size_t)2 * 16384 * 1024);
  p.Vb = (u16*)take((size_t)2 * 16384 * 1024);
  p.xq = (signed char*)take((size_t)MT_ROWS * 1024);
  p.sx = (float*)take((size_t)MT_ROWS * 4);
  p.su = (float*)take((size_t)2 * 16384 * 4);
  p.slist = (float*)take((size_t)MT_ROWS * 128 * 4);
  p.elist = (int*)take((size_t)MT_ROWS * 128 * 4);
  p.glist = (float*)take((size_t)MT_ROWS * 128 * 4);
  p.mod = (float*)take((size_t)2 * 9 * 6144 * 4);
  p.xn = (u16*)take((size_t)MT_ROWS * 1024 * 2);
  p.U = (u16*)take((size_t)MT_ROWS * INC * 2);
  p.MQK = (float*)take((size_t)MT_ROWS * 512 * 2);
  p.Y = (u16*)take((size_t)MT_ROWS * 1024 * 2);
  p.S = (float*)p.U;
  p.hp = (float*)take((size_t)MT_ROWS * 8 * 128 * 4);
  p.G = (float*)take((size_t)MT_ROWS * 16 * 4);
  p.mst = (float*)take((size_t)2304 * SLOT * 4);
  p.hc = (float*)take((size_t)MC_ROWS * 1024 * 4);
  p.bar = (unsigned*)take((size_t)XCD_BAR_WORDS * 4);
  p.VTm = (u16*)take((size_t)(8 * 4 * 64) * (2048 + 256) * 2);
  p.VT = (u16*)take((size_t)(8 * 8 * 64) * (2048 + 256) * 2);
  if (off > ws_size) { fprintf(stderr, "workspace too small: need %zu have %zu\n", off, ws_size); return; }
  (void)hipMemsetAsync(p.bar, 0, (size_t)XCD_BAR_WORDS * 4, stream);
#if MEGA
  p.ph_lo = 0; p.ph_hi = NPHASES;
  void* args[] = {&p};
  hipError_t e = hipLaunchCooperativeKernel((void*)fwd_kernel, dim3(grid_blocks), dim3(256), args, 0, stream);
  if (e != hipSuccess) fprintf(stderr, "cooperative launch failed: %s (grid %d)\n", hipGetErrorString(e), grid_blocks);
#else
  for (int ph = 0; ph < NPHASES; ph++) {
    p.ph_lo = ph; p.ph_hi = ph + 1;
    void* args[] = {&p};
    hipError_t e = hipLaunchCooperativeKernel((void*)fwd_kernel, dim3(grid_blocks), dim3(256), args, 0, stream);
    if (e != hipSuccess) fprintf(stderr, "cooperative launch failed: %s (grid %d)\n", hipGetErrorString(e), grid_blocks);
  }
#endif
}
```

```cpp
#include <hip/hip_runtime.h>
#include <hip/hip_cooperative_groups.h>
#include <cstdio>
namespace cg = cooperative_groups;

#ifndef MEGA
#define MEGA 1
#endif

typedef unsigned short u16;
typedef __attribute__((ext_vector_type(8))) short bf16x8;
typedef __attribute__((ext_vector_type(4))) float f32x4;

#define ML_ROWS 16384
#define MC_ROWS 2048
#define MT_ROWS 18432
#define INC 2832
#define INC_PAD 2944
#define SLOT 4480
#define SMEM_BYTES 69632
#define NPHASES 27

struct P {
  const float *x, *c, *ctx, *c_ctx, *w_ada, *b_ada, *norm1_g, *w_in, *ml_gate_b, *na_q_g, *na_k_g, *na_rpb,
      *pool_w, *pool_scale, *ml_conv, *ml_norm_g, *w_out, *norm2_g, *peer_wq, *peer_keys, *peer_u, *peer_v;
  float* out;
  u16 *WinT, *WoutT, *WsT, *Ub, *Vb;
  float* mod;
  u16* xn;
  u16* U;
  float* MQK;
  u16* Y;
  float* S;
  float* G;
  float* mst;
  float* hc;
  u16* VT;
  u16* VTm;
  signed char* xq;
  float* sx;
  float* su;
  float* slist;
  int* elist;
  float* glist;
  float* hp;
  unsigned* bar;
  long long ph_lo, ph_hi;
};

__device__ __forceinline__ u16 f2bf(float f) {
  unsigned u = __float_as_uint(f);
  u += 0x7fffu + ((u >> 16) & 1u);
  return (u16)(u >> 16);
}
__device__ __forceinline__ float bf2f(u16 h) { return __uint_as_float(((unsigned)h) << 16); }
__device__ __forceinline__ float bflo(unsigned u) { return __uint_as_float(u << 16); }
__device__ __forceinline__ float bfhi(unsigned u) { return __uint_as_float(u & 0xffff0000u); }
__device__ __forceinline__ unsigned pack2(float a, float b) { return (unsigned)f2bf(a) | ((unsigned)f2bf(b) << 16); }
__device__ __forceinline__ unsigned q8pack(float a, float b, float c, float d) {
  int qa = __float2int_rn(a), qb = __float2int_rn(b), qc = __float2int_rn(c), qd = __float2int_rn(d);
  return (unsigned)(qa & 0xff) | ((unsigned)(qb & 0xff) << 8) | ((unsigned)(qc & 0xff) << 16) | ((unsigned)(qd & 0xff) << 24);
}
__device__ __forceinline__ float wave_sum(float v) {
#pragma unroll
  for (int o = 32; o; o >>= 1) v += __shfl_xor(v, o);
  return v;
}
__device__ __forceinline__ void wave_argmax(float& v, int& i) {
#pragma unroll
  for (int o = 32; o; o >>= 1) {
    float ov = __shfl_xor(v, o);
    int oi = __shfl_xor(i, o);
    if (ov > v || (ov == v && oi < i)) { v = ov; i = oi; }
  }
}
__device__ __forceinline__ float sigmoidf_(float x) { return 1.f / (1.f + __expf(-x)); }
__device__ __forceinline__ float siluf_(float x) { return x / (1.f + __expf(-x)); }

#define XB_TMO      128
#define XB_XCNT(j)  (256  + 64 * (j))
#define XB_XSUB(j)  (1280 + 64 * (j))
#define XB_XGEN(j)  (2304 + 64 * (j))
#define XB_TOP      3328
#define XB_TOPGEN   3392
#define XCD_BAR_WORDS 3456
#define XB_SPIN_CAP (1u << 18)
#define LAS __attribute__((address_space(3)))
__device__ __forceinline__ unsigned xb_ld(unsigned* p)              { return __hip_atomic_load(p, __ATOMIC_RELAXED, __HIP_MEMORY_SCOPE_AGENT); }
__device__ __forceinline__ unsigned xb_add(unsigned* p, unsigned v) { return __hip_atomic_fetch_add(p, v, __ATOMIC_RELAXED, __HIP_MEMORY_SCOPE_AGENT); }
__device__ __forceinline__ unsigned xb_xcc_id() { return (unsigned)__builtin_amdgcn_s_getreg((3 << 11) | 20) & 0xFu; }
#define XB_SPIN(cond, bar) do { unsigned _sp = 0; while (cond) { __builtin_amdgcn_s_sleep(1); \
    if ((++_sp & 255u) == 0u) { if (xb_ld(&(bar)[XB_TMO])) break; if (_sp > XB_SPIN_CAP) { atomicAdd(&(bar)[XB_TMO], 1u); break; } } } } while (0)
struct XcdBarrier { unsigned* bar; unsigned x; volatile LAS unsigned* st; };
__device__ __forceinline__ XcdBarrier xcd_barrier_post(unsigned* bar, volatile LAS unsigned* st) {
    XcdBarrier b; b.bar = bar; b.x = xb_xcc_id(); b.st = st;
    if (threadIdx.x == 0) (void)xb_add(&bar[XB_XCNT(b.x)], 1u);
    return b;
}
__device__ __forceinline__ void xcd_barrier_complete(unsigned* bar, unsigned x, unsigned& nloc, unsigned& nx) {
    const unsigned G = gridDim.x * gridDim.y * gridDim.z;
    unsigned sum, cnt, mine, sp = 0u;
    for (;;) {
        sum = 0u; cnt = 0u; mine = 0u;
#pragma unroll
        for (unsigned j = 0; j < 16; ++j) { const unsigned c = xb_ld(&bar[XB_XCNT(j)]); sum += c; cnt += (c > 0u) ? 1u : 0u; mine = (j == x) ? c : mine; }
        if (sum == G) break;
        __builtin_amdgcn_s_sleep(1);
        if ((++sp & 255u) == 0u) { if (xb_ld(&bar[XB_TMO])) break; if (sp > XB_SPIN_CAP) { atomicAdd(&bar[XB_TMO], 1u); break; } }
    }
    nloc = mine > 0u ? mine : 1u; nx = cnt > 0u ? cnt : 1u;
}
__device__ __forceinline__ void xcd_barrier(const XcdBarrier& b) {
    asm volatile("s_waitcnt vmcnt(0)" ::: "memory");
    __syncthreads();
    if (threadIdx.x == 0) {
        unsigned* bar = b.bar;
        __builtin_amdgcn_s_waitcnt(0);
        unsigned nloc = b.st[0], nx = b.st[1];
        if (nloc == 0u) { xcd_barrier_complete(bar, b.x, nloc, nx); b.st[0] = nloc; b.st[1] = nx; }
        const unsigned old = xb_add(&bar[XB_XSUB(b.x)], 1u);
        const unsigned gen = old / nloc;
        if (old + 1u == (gen + 1u) * nloc) {
            __builtin_amdgcn_fence(__ATOMIC_RELEASE, "agent");
            asm volatile("s_waitcnt vmcnt(0)" ::: "memory");
            const unsigned og = xb_add(&bar[XB_TOP], 1u);
            const unsigned tg = og / nx;
            if (og + 1u == (tg + 1u) * nx) xb_add(&bar[XB_TOPGEN], 1u);
            else XB_SPIN(xb_ld(&bar[XB_TOPGEN]) == tg, bar);
            __builtin_amdgcn_fence(__ATOMIC_ACQUIRE, "agent");
            xb_add(&bar[XB_XGEN(b.x)], 1u);
            asm volatile("s_waitcnt vmcnt(0)" ::: "memory");
        } else {
            XB_SPIN(xb_ld(&bar[XB_XGEN(b.x)]) == gen, bar);
            __builtin_amdgcn_fence(__ATOMIC_ACQUIRE, "agent");
            asm volatile("s_waitcnt vmcnt(0)" ::: "memory");
        }
    }
    __syncthreads();
}

__device__ __forceinline__ void transpose_item(const float* __restrict__ src, int N, u16* __restrict__ dst, int kt, int nt, float* tl) {
  const int tid = threadIdx.x;
#pragma unroll 4
  for (int i = 0; i < 16; i++) {
    int idx = tid + 256 * i;
    int kk = idx >> 6, nn = idx & 63;
    int n = nt * 64 + nn;
    float v = (n < N) ? src[(size_t)(kt * 64 + kk) * N + n] : 0.f;
    tl[kk * 65 + nn] = v;
  }
  __syncthreads();
#pragma unroll 4
  for (int i = 0; i < 16; i++) {
    int idx = tid + 256 * i;
    int nn = idx >> 6, kk = idx & 63;
    dst[(size_t)(nt * 64 + nn) * 1024 + kt * 64 + kk] = f2bf(tl[kk * 65 + nn]);
  }
  __syncthreads();
}

__device__ __forceinline__ void wst_item(const P& p, int it, float* sm) {
  const int tid = threadIdx.x;
  int l = it >> 8, hp = (it >> 4) & 15, dt = it & 15;
  float* As = sm;
  float* Ks = sm + 64 * 33;
  const float* wq = p.peer_wq + (size_t)l * 1024 * 2048;
  const float* keys = p.peer_keys + ((size_t)l * 16 + hp) * 128 * 128;
  int d = tid & 63, cg_ = tid >> 6;
  float acc[32];
#pragma unroll
  for (int c = 0; c < 32; c++) acc[c] = 0.f;
  for (int jc = 0; jc < 4; jc++) {
    __syncthreads();
#pragma unroll
    for (int i = 0; i < 8; i++) {
      int idx = tid + 256 * i;
      int dd = idx >> 5, j = idx & 31;
      As[dd * 33 + j] = wq[(size_t)(dt * 64 + dd) * 2048 + hp * 128 + jc * 32 + j];
    }
#pragma unroll
    for (int i = 0; i < 16; i++) {
      int idx = tid + 256 * i;
      int k = idx >> 5, j = idx & 31;
      Ks[k * 33 + j] = keys[k * 128 + jc * 32 + j];
    }
    __syncthreads();
    for (int j = 0; j < 32; j++) {
      float a = As[d * 33 + j];
#pragma unroll
      for (int c = 0; c < 32; c++) acc[c] += a * Ks[(cg_ * 32 + c) * 33 + j];
    }
  }
  u16* dst = p.WsT + (size_t)l * 2048 * 1024;
#pragma unroll
  for (int c = 0; c < 32; c++) dst[(size_t)(hp * 128 + cg_ * 32 + c) * 1024 + dt * 64 + d] = f2bf(acc[c]);
  __syncthreads();
}

__device__ __forceinline__ void mod_item(const P& p, int it, float* sm) {
  const int tid = threadIdx.x;
  int l = it / 96, cc = it % 96;
  float* sc = sm;
  float* red = sm + 9216;
  for (int idx = tid; idx < 9216; idx += 256) {
    int r = idx >> 10, k = idx & 1023;
    float v = (r < 8) ? p.c[r * 1024 + k] : p.c_ctx[k];
    sc[idx] = siluf_(v);
  }
  __syncthreads();
  int cl = tid & 63, kg = tid >> 6;
  int col = cc * 64 + cl;
  float acc[9];
#pragma unroll
  for (int r = 0; r < 9; r++) acc[r] = 0.f;
  const float* wa = p.w_ada + (size_t)l * 1024 * 6144;
#pragma unroll 16
  for (int k = kg * 256; k < kg * 256 + 256; k++) {
    float w = wa[(size_t)k * 6144 + col];
#pragma unroll
    for (int r = 0; r < 9; r++) acc[r] += sc[r * 1024 + k] * w;
  }
#pragma unroll
  for (int r = 0; r < 9; r++) red[(kg * 9 + r) * 64 + cl] = acc[r];
  __syncthreads();
  if (kg == 0) {
    float bb = p.b_ada[l * 6144 + col];
#pragma unroll
    for (int r = 0; r < 9; r++) {
      float s = red[(0 * 9 + r) * 64 + cl] + red[(1 * 9 + r) * 64 + cl] + red[(2 * 9 + r) * 64 + cl] + red[(3 * 9 + r) * 64 + cl];
      p.mod[(size_t)(l * 9 + r) * 6144 + col] = s + bb;
    }
  }
  __syncthreads();
}

__device__ __forceinline__ void phase_prologue(const P& p, char* smem) {
  float* sm = (float*)smem;
  const int tid = threadIdx.x;
  const int N_A = 2 * 16 * 46, N_B = 2 * 16 * 16, N_C = 512, N_D = 192, N_E = 4096;
  const int total = N_A + N_B + N_C + N_D + N_E;
  for (int item = blockIdx.x; item < total; item += gridDim.x) {
    int it = item;
    if (it < N_D) { mod_item(p, it, sm); continue; }
    it -= N_D;
    if (it < N_C) { wst_item(p, it, sm); continue; }
    it -= N_C;
    if (it < N_A) {
      int l = it / (16 * 46), r = it % (16 * 46);
      transpose_item(p.w_in + (size_t)l * 1024 * INC, INC, p.WinT + (size_t)l * INC_PAD * 1024, r / 46, r % 46, sm);
      continue;
    }
    it -= N_A;
    if (it < N_B) {
      int l = it >> 8, r = it & 255;
      transpose_item(p.w_out + (size_t)l * 1024 * 1024, 1024, p.WoutT + (size_t)l * 1024 * 1024, r >> 4, r & 15, sm);
      continue;
    }
    it -= N_B;
    {
      if ((it >> 11) == 0) {
        const int lane_ = tid & 63, w_ = tid >> 6;
        const int chunk_ = it & 2047;
#pragma unroll
        for (int rr = 0; rr < 4; rr++) {
          const int R = chunk_ * 16 + w_ * 4 + rr;
          const float4* src = (const float4*)(p.peer_u + (size_t)R * 1024 + lane_ * 16);
          float4 v0 = src[0], v1 = src[1], v2 = src[2], v3 = src[3];
          float mx = fmaxf(fmaxf(fmaxf(fabsf(v0.x), fabsf(v0.y)), fmaxf(fabsf(v0.z), fabsf(v0.w))), fmaxf(fmaxf(fabsf(v1.x), fabsf(v1.y)), fmaxf(fabsf(v1.z), fabsf(v1.w))));
          mx = fmaxf(mx, fmaxf(fmaxf(fmaxf(fabsf(v2.x), fabsf(v2.y)), fmaxf(fabsf(v2.z), fabsf(v2.w))), fmaxf(fmaxf(fabsf(v3.x), fabsf(v3.y)), fmaxf(fabsf(v3.z), fabsf(v3.w)))));
#pragma unroll
          for (int o = 32; o; o >>= 1) mx = fmaxf(mx, __shfl_xor(mx, o));
          const float inv = mx > 0.f ? 127.f / mx : 0.f;
          uint4 o;
          o.x = q8pack(v0.x * inv, v0.y * inv, v0.z * inv, v0.w * inv);
          o.y = q8pack(v1.x * inv, v1.y * inv, v1.z * inv, v1.w * inv);
          o.z = q8pack(v2.x * inv, v2.y * inv, v2.z * inv, v2.w * inv);
          o.w = q8pack(v3.x * inv, v3.y * inv, v3.z * inv, v3.w * inv);
          const unsigned ll = (unsigned)R >> 14, ee = (unsigned)R & 16383u;
          size_t off = ((size_t)((ll * 8u + (unsigned)(lane_ >> 3)) * 16384u + ee)) * 128 + (lane_ & 7) * 16;
          *(uint4*)((unsigned char*)p.Ub + off) = o;
          if (lane_ == 0) p.su[R] = mx * (1.f / 127.f);
        }
        continue;
      }
      int tab = it >> 11;
      int chunk = it & 2047;
      const float scl = tab ? 8.f : 64.f;
      const float4* src = (const float4*)(tab ? p.peer_v : p.peer_u) + (size_t)chunk * 4096;
      unsigned char* dstb = (unsigned char*)(tab ? p.Vb : p.Ub);
#pragma unroll
      for (int i = 0; i < 4; i++) {
        int q = i * 256 + tid;
        float4 v0 = src[q * 4 + 0], v1 = src[q * 4 + 1], v2 = src[q * 4 + 2], v3 = src[q * 4 + 3];
        uint4 o;
        int w_;
        w_ = __builtin_amdgcn_cvt_pk_fp8_f32(v0.x * scl, v0.y * scl, 0, false);
        w_ = __builtin_amdgcn_cvt_pk_fp8_f32(v0.z * scl, v0.w * scl, w_, true);
        o.x = (unsigned)w_;
        w_ = __builtin_amdgcn_cvt_pk_fp8_f32(v1.x * scl, v1.y * scl, 0, false);
        w_ = __builtin_amdgcn_cvt_pk_fp8_f32(v1.z * scl, v1.w * scl, w_, true);
        o.y = (unsigned)w_;
        w_ = __builtin_amdgcn_cvt_pk_fp8_f32(v2.x * scl, v2.y * scl, 0, false);
        w_ = __builtin_amdgcn_cvt_pk_fp8_f32(v2.z * scl, v2.w * scl, w_, true);
        o.z = (unsigned)w_;
        w_ = __builtin_amdgcn_cvt_pk_fp8_f32(v3.x * scl, v3.y * scl, 0, false);
        w_ = __builtin_amdgcn_cvt_pk_fp8_f32(v3.z * scl, v3.w * scl, w_, true);
        o.w = (unsigned)w_;
        {
          unsigned G = (unsigned)chunk * 1024u + (unsigned)q;
          unsigned ll = G >> 20, ee = (G >> 6) & 16383u, cgp = G & 63u;
          size_t off = ((size_t)((ll * 8u + (cgp >> 3)) * 16384u + ee)) * 128 + (cgp & 7u) * 16;
          *(uint4*)(dstb + off) = o;
        }
      }
    }
  }
}

__device__ __forceinline__ void phase_norm(const P& p, int l, int which) {
  const int tid = threadIdx.x, lane = tid & 63, w = tid >> 6;
  const int nrows = (which == 2 && l == 1) ? ML_ROWS : MT_ROWS;
  const float* g = (which == 1 ? p.norm1_g : p.norm2_g) + l * 1024;
  for (int item = blockIdx.x; item * 4 < nrows; item += gridDim.x) {
    int row = item * 4 + w;
    const float* src;
    if (l == 0 && which == 1) src = row < ML_ROWS ? p.x + (size_t)row * 1024 : p.ctx + (size_t)(row - ML_ROWS) * 1024;
    else src = row < ML_ROWS ? p.out + (size_t)row * 1024 : p.hc + (size_t)(row - ML_ROWS) * 1024;
    int mr = row < ML_ROWS ? (row >> 11) : 8;
    const float* modp = p.mod + (size_t)(l * 9 + mr) * 6144;
    const float* sh = modp + (which == 1 ? 0 : 3072);
    const float* sc = modp + (which == 1 ? 1024 : 4096);
    float4 v[4];
    float ss = 0.f;
#pragma unroll
    for (int i = 0; i < 4; i++) {
      v[i] = ((const float4*)src)[i * 64 + lane];
      ss += v[i].x * v[i].x + v[i].y * v[i].y + v[i].z * v[i].z + v[i].w * v[i].w;
    }
    ss = wave_sum(ss);
    float rs = rsqrtf(ss * (1.f / 1024.f) + 1e-6f);
    float ov[16];
    float omax = 0.f;
#pragma unroll
    for (int i = 0; i < 4; i++) {
      int d = (i * 64 + lane) * 4;
      float4 gg = *(const float4*)(g + d);
      float4 s4 = *(const float4*)(sc + d);
      float4 h4 = *(const float4*)(sh + d);
      float o0 = v[i].x * rs * gg.x * (1.f + s4.x) + h4.x;
      float o1 = v[i].y * rs * gg.y * (1.f + s4.y) + h4.y;
      float o2 = v[i].z * rs * gg.z * (1.f + s4.z) + h4.z;
      float o3 = v[i].w * rs * gg.w * (1.f + s4.w) + h4.w;
      uint2 o;
      o.x = pack2(o0, o1);
      o.y = pack2(o2, o3);
      ((uint2*)(p.xn + (size_t)row * 1024))[i * 64 + lane] = o;
      ov[i * 4 + 0] = o0; ov[i * 4 + 1] = o1; ov[i * 4 + 2] = o2; ov[i * 4 + 3] = o3;
      omax = fmaxf(omax, fmaxf(fmaxf(fabsf(o0), fabsf(o1)), fmaxf(fabsf(o2), fabsf(o3))));
    }
    if (which == 2) {
#pragma unroll
      for (int o = 32; o; o >>= 1) omax = fmaxf(omax, __shfl_xor(omax, o));
      const float inv = omax > 0.f ? 127.f / omax : 0.f;
#pragma unroll
      for (int i = 0; i < 4; i++)
        ((unsigned*)(p.xq + (size_t)row * 1024))[i * 64 + lane] = q8pack(ov[i * 4] * inv, ov[i * 4 + 1] * inv, ov[i * 4 + 2] * inv, ov[i * 4 + 3] * inv);
      if (lane == 0) p.sx[row] = omax * (1.f / 127.f);
    }
  }
}

template <int EPI>
__device__ __forceinline__ void phase_gemm(const P& p, int l, const u16* __restrict__ A, const u16* __restrict__ Bt, int mtiles, int ntiles,
                           char* smem) {
  u16* As = (u16*)smem;
  u16* Bs = As + 128 * 72;
  const int tid = threadIdx.x, lane = tid & 63, w = tid >> 6, wm = w >> 1, wn = w & 1;
  const int lr = lane & 15, quad = lane >> 4;
  const int xk = blockIdx.x & 7, lb = blockIdx.x >> 3, nb = gridDim.x >> 3;
  const int mg = xk >> 1;
  const int nh0 = (ntiles + 1) >> 1;
  const int nbase = (xk & 1) ? nh0 : 0, nloc = (xk & 1) ? (ntiles - nh0) : nh0;
  const int mcount = (mtiles - mg + 3) >> 2;
  const int nlocal = mcount * nloc;
  for (int li = lb; li < nlocal; li += nb) {
    int mi = li / nloc;
    int mt = mg + 4 * mi, nt = nbase + (li - mi * nloc);
    int m0 = mt * 128, n0 = nt * 128;
    f32x4 acc[4][4];
#pragma unroll
    for (int i = 0; i < 4; i++)
#pragma unroll
      for (int j = 0; j < 4; j++) acc[i][j] = (f32x4){0.f, 0.f, 0.f, 0.f};
    const int r0_ = tid >> 3, ch_ = tid & 7;
    const u16* Ap0 = A + (size_t)(m0 + r0_) * 1024 + ch_ * 8;
    const u16* Bp0 = Bt + (size_t)(n0 + r0_) * 1024 + ch_ * 8;
    uint4 ra0 = *(const uint4*)Ap0, ra1 = *(const uint4*)(Ap0 + 32 * 1024), ra2 = *(const uint4*)(Ap0 + 64 * 1024), ra3 = *(const uint4*)(Ap0 + 96 * 1024);
    uint4 rb0 = *(const uint4*)Bp0, rb1 = *(const uint4*)(Bp0 + 32 * 1024), rb2 = *(const uint4*)(Bp0 + 64 * 1024), rb3 = *(const uint4*)(Bp0 + 96 * 1024);
    for (int kt = 0; kt < 16; kt++) {
      __syncthreads();
      *(uint4*)(As + r0_ * 72 + ch_ * 8) = ra0;
      *(uint4*)(As + (r0_ + 32) * 72 + ch_ * 8) = ra1;
      *(uint4*)(As + (r0_ + 64) * 72 + ch_ * 8) = ra2;
      *(uint4*)(As + (r0_ + 96) * 72 + ch_ * 8) = ra3;
      *(uint4*)(Bs + r0_ * 72 + ch_ * 8) = rb0;
      *(uint4*)(Bs + (r0_ + 32) * 72 + ch_ * 8) = rb1;
      *(uint4*)(Bs + (r0_ + 64) * 72 + ch_ * 8) = rb2;
      *(uint4*)(Bs + (r0_ + 96) * 72 + ch_ * 8) = rb3;
      __syncthreads();
      if (kt < 15) {
        const int ko = (kt + 1) * 64;
        ra0 = *(const uint4*)(Ap0 + ko); ra1 = *(const uint4*)(Ap0 + 32 * 1024 + ko); ra2 = *(const uint4*)(Ap0 + 64 * 1024 + ko); ra3 = *(const uint4*)(Ap0 + 96 * 1024 + ko);
        rb0 = *(const uint4*)(Bp0 + ko); rb1 = *(const uint4*)(Bp0 + 32 * 1024 + ko); rb2 = *(const uint4*)(Bp0 + 64 * 1024 + ko); rb3 = *(const uint4*)(Bp0 + 96 * 1024 + ko);
      }
#pragma unroll
      for (int ks = 0; ks < 2; ks++) {
        bf16x8 a[4], b[4];
#pragma unroll
        for (int i = 0; i < 4; i++) {
          a[i] = *(const bf16x8*)(As + (wm * 64 + i * 16 + lr) * 72 + ks * 32 + quad * 8);
          b[i] = *(const bf16x8*)(Bs + (wn * 64 + i * 16 + lr) * 72 + ks * 32 + quad * 8);
        }
#pragma unroll
        for (int i = 0; i < 4; i++)
#pragma unroll
          for (int j = 0; j < 4; j++) acc[i][j] = __builtin_amdgcn_mfma_f32_16x16x32_bf16(b[j], a[i], acc[i][j], 0, 0, 0);
      }
    }
#pragma unroll
    for (int i = 0; i < 4; i++)
#pragma unroll
      for (int j = 0; j < 4; j++) {
        const int row = m0 + wm * 64 + i * 16 + lr;
        const int col = n0 + wn * 64 + j * 16 + quad * 4;
        const f32x4 v = acc[i][j];
        if (EPI == 0) {
          if (col < INC) {
            uint2 o;
            o.x = pack2(v[0], v[1]);
            o.y = pack2(v[2], v[3]);
            *(uint2*)(p.U + (size_t)row * INC + col) = o;
            if (col >= 2816) *(float4*)(p.G + row * 16 + (col - 2816)) = make_float4(v[0], v[1], v[2], v[3]);
          }
        } else if (EPI == 1) {
          const int mr = row < ML_ROWS ? (row >> 11) : 8;
          const float4 g1 = *(const float4*)(p.mod + (size_t)(l * 9 + mr) * 6144 + 2048 + col);
          float4 sv;
          if (l == 0) sv = row < ML_ROWS ? *(const float4*)(p.x + (size_t)row * 1024 + col) : *(const float4*)(p.ctx + (size_t)(row - ML_ROWS) * 1024 + col);
          else sv = *(const float4*)(p.out + (size_t)row * 1024 + col);
          float* dst = row < ML_ROWS ? p.out + (size_t)row * 1024 + col : p.hc + (size_t)(row - ML_ROWS) * 1024 + col;
          *(float4*)dst = make_float4(sv.x + g1.x * v[0], sv.y + g1.y * v[1], sv.z + g1.z * v[2], sv.w + g1.w * v[3]);
        } else {
          *(float4*)(p.S + (size_t)row * 2048 + col) = make_float4(v[0], v[1], v[2], v[3]);
        }
      }
  }
}

__device__ __forceinline__ void vt_item(const P& p, int it, u16* tl);
__device__ __forceinline__ void phase_mixprep(const P& p, int l, char* smem) {
  const int tid = threadIdx.x;
  float* pl = (float*)smem;
  const int N_QK = MT_ROWS * 16 / 256;
  const int N_POOL = (l == 0 ? MT_ROWS : ML_ROWS) / 16;
  const int N_PREP = MT_ROWS / 8;
  const int N_VT = 2304 + 1152;
  const int total = N_QK + N_POOL + N_PREP + N_VT;
  for (int item = blockIdx.x; item < total; item += gridDim.x) {
    int it = item;
    if (it >= N_QK + N_POOL + N_PREP) { vt_item(p, it - (N_QK + N_POOL + N_PREP), (u16*)smem); continue; }
    if (it < N_QK) {
      int gi = it * 256 + tid;
      int row = gi >> 4, sub = gi & 15;
      int qk = sub >> 3, h = sub & 7;
      u16* ptr = p.U + (size_t)row * INC + qk * 512 + h * 64;
      const float* g = (qk ? p.na_k_g : p.na_q_g) + l * 64;
      uint4 v[8];
      float ss = 0.f;
#pragma unroll
      for (int c = 0; c < 8; c++) {
        v[c] = ((const uint4*)ptr)[c];
        float a;
        a = bflo(v[c].x); ss += a * a; a = bfhi(v[c].x); ss += a * a;
        a = bflo(v[c].y); ss += a * a; a = bfhi(v[c].y); ss += a * a;
        a = bflo(v[c].z); ss += a * a; a = bfhi(v[c].z); ss += a * a;
        a = bflo(v[c].w); ss += a * a; a = bfhi(v[c].w); ss += a * a;
      }
      float rs = rsqrtf(ss * (1.f / 64.f) + 1e-6f);
#pragma unroll
      for (int c = 0; c < 8; c++) {
        uint4 o;
        o.x = pack2(bflo(v[c].x) * rs * g[c * 8 + 0], bfhi(v[c].x) * rs * g[c * 8 + 1]);
        o.y = pack2(bflo(v[c].y) * rs * g[c * 8 + 2], bfhi(v[c].y) * rs * g[c * 8 + 3]);
        o.z = pack2(bflo(v[c].z) * rs * g[c * 8 + 4], bfhi(v[c].z) * rs * g[c * 8 + 5]);
        o.w = pack2(bflo(v[c].w) * rs * g[c * 8 + 6], bfhi(v[c].w) * rs * g[c * 8 + 7]);
        ((uint4*)ptr)[c] = o;
      }
      continue;
    }
    it -= N_QK;
    if (it < N_POOL) {
      int row0 = it * 16;
      int base, T;
      if (row0 < ML_ROWS) { base = (row0 >> 11) << 11; T = 2048; }
      else { base = ML_ROWS + (((row0 - ML_ROWS) >> 8) << 8); T = 256; }
      int t0 = row0 - base;
      int ch = tid, g = ch >> 6;
      int wdw = 2 << g;
      __syncthreads();
      {
        float vals[31];
#pragma unroll
        for (int j = 0; j < 31; j++) {
          int tau = t0 - 8 + j;
          bool ok = (tau >= 0) && (tau < T);
          vals[j] = ok ? bf2f(p.U[(size_t)(base + (ok ? tau : t0)) * INC + 1536 + ch]) : 0.f;
        }
        const int hl = wdw / 2, hr = wdw - wdw / 2 - 1;
#pragma unroll
        for (int tt = 0; tt < 16; tt++) {
          int t = t0 + tt;
          int lo = max(t - hl, 0), hi = min(t + hr, T - 1);
          float s = 0.f;
#pragma unroll
          for (int j = 0; j < 31; j++) {
            int rel = j - 8 - tt;
            if (rel >= -8 && rel <= 7) s += (rel >= -hl && rel <= hr) ? vals[j] : 0.f;
          }
          pl[tt * 256 + ch] = s / (float)(hi - lo + 1) - vals[8 + tt];
        }
      }
      __syncthreads();
      float acc[16];
#pragma unroll
      for (int tt = 0; tt < 16; tt++) acc[tt] = 0.f;
      int d = ch & 63;
      const float* pw = p.pool_w + ((size_t)(l * 4 + g) * 64) * 64 + d;
      for (int c = 0; c < 64; c++) {
        float wv = pw[c * 64];
#pragma unroll
        for (int tt = 0; tt < 16; tt++) acc[tt] += pl[tt * 256 + g * 64 + c] * wv;
      }
      float ps = p.pool_scale[l * 256 + ch];
#pragma unroll
      for (int tt = 0; tt < 16; tt++) p.Y[(size_t)(row0 + tt) * 1024 + 512 + ch] = f2bf(acc[tt] * ps);
      continue;
    }
    it -= N_POOL;
    {
      const int row0 = it * 8;
      int base, T;
      if (row0 < ML_ROWS) { base = (row0 >> 11) << 11; T = 2048; }
      else { base = ML_ROWS + (((row0 - ML_ROWS) >> 8) << 8); T = 256; }
      const int t0 = row0 - base;
      const int qk = tid >> 7, hh = (tid >> 5) & 3, ax = (tid >> 4) & 1, f = tid & 15;
      const int ca = qk * 256 + hh * 64 + ax * 32 + f, cb = ca + 16;
      float ua[12], ub[12];
#pragma unroll
      for (int j = 0; j < 12; j++) {
        int tt = t0 + j - 2;
        bool ok = (tt >= 0) && (tt < T);
        const u16* ur = p.U + (size_t)(base + (ok ? tt : t0)) * INC + 1792;
        ua[j] = ok ? bf2f(ur[ca]) : 0.f;
        ub[j] = ok ? bf2f(ur[cb]) : 0.f;
      }
      float wa[5], wb[5];
#pragma unroll
      for (int j = 0; j < 5; j++) { wa[j] = p.ml_conv[(l * 5 + j) * 512 + ca]; wb[j] = p.ml_conv[(l * 5 + j) * 512 + cb]; }
      const float inv = __expf(-(float)f * (9.210340371976184f / 16.f));
#pragma unroll
      for (int i = 0; i < 8; i++) {
        float a = 0.f, b = 0.f;
#pragma unroll
        for (int j = 0; j < 5; j++) { a += wa[j] * ua[i + j]; b += wb[j] * ub[i + j]; }
        a = siluf_(a);
        b = siluf_(b);
        if (row0 < ML_ROWS) {
          int t = t0 + i;
          float pos = (float)(ax == 0 ? (t >> 6) : (t & 63));
          float ang = pos * inv;
          float cs = __cosf(ang), sn = __sinf(ang);
          float oa = a * cs - b * sn, ob = a * sn + b * cs;
          a = oa; b = ob;
        }
        if (qk) { a *= 0.125f; b *= 0.125f; }
        ((u16*)p.MQK)[(size_t)(row0 + i) * 512 + ca] = f2bf(a);
        ((u16*)p.MQK)[(size_t)(row0 + i) * 512 + cb] = f2bf(b);
      }
      if (tid < 128) {
        int gi = tid & 15;
        float gv = p.G[row0 * 16 + tid] + p.ml_gate_b[l * 16 + gi];
        if ((gi >> 2) & 1) gv = fminf(gv, 0.f) - log1pf(__expf(-fabsf(gv)));
        p.G[row0 * 16 + tid] = gv;
      }
    }
  }
}

#define VT_CTX_OFF ((size_t)8 * 8 * 64 * 2048)
#define VTM_CTX_OFF ((size_t)8 * 4 * 64 * 2048)
__device__ __forceinline__ void vt_item(const P& p, int it, u16* tl) {
  const int tid = threadIdx.x;
  int b, h, tt, row0, TK, col0;
  u16* dst;
  if (it < 2048) { b = it >> 8; h = (it >> 5) & 7; tt = it & 31; row0 = b * 2048 + tt * 64; TK = 2048; col0 = 1024 + h * 64; dst = p.VT + (size_t)((b * 8 + h) * 64) * 2048 + tt * 64; }
  else if (it < 2304) { int ci = it - 2048; b = ci >> 5; h = (ci >> 2) & 7; tt = ci & 3; row0 = ML_ROWS + b * 256 + tt * 64; TK = 256; col0 = 1024 + h * 64; dst = p.VT + VT_CTX_OFF + (size_t)((b * 8 + h) * 64) * 256 + tt * 64; }
  else if (it < 2304 + 1024) { int mi = it - 2304; b = mi >> 7; h = (mi >> 5) & 3; tt = mi & 31; row0 = b * 2048 + tt * 64; TK = 2048; col0 = 2304 + h * 64; dst = p.VTm + (size_t)((b * 4 + h) * 64) * 2048 + tt * 64; }
  else { int mi = it - 3328; b = mi >> 4; h = (mi >> 2) & 3; tt = mi & 3; row0 = ML_ROWS + b * 256 + tt * 64; TK = 256; col0 = 2304 + h * 64; dst = p.VTm + VTM_CTX_OFF + (size_t)((b * 4 + h) * 64) * 256 + tt * 64; }
  __syncthreads();
  {
    int i = tid >> 2, part = tid & 3;
    const uint4* src = (const uint4*)(p.U + (size_t)(row0 + i) * INC + col0 + part * 16);
    uint4 v0 = src[0], v1 = src[1];
    unsigned* t32 = (unsigned*)(tl + i * 66 + part * 16);
    t32[0] = v0.x; t32[1] = v0.y; t32[2] = v0.z; t32[3] = v0.w;
    t32[4] = v1.x; t32[5] = v1.y; t32[6] = v1.z; t32[7] = v1.w;
  }
  __syncthreads();
  {
    int d = tid >> 2, part = tid & 3;
    unsigned o[8];
#pragma unroll
    for (int k = 0; k < 8; k++) {
      unsigned lo = tl[(part * 16 + 2 * k) * 66 + d], hi = tl[(part * 16 + 2 * k + 1) * 66 + d];
      o[k] = lo | (hi << 16);
    }
    uint4* dp = (uint4*)(dst + (size_t)d * TK + part * 16);
    dp[0] = make_uint4(o[0], o[1], o[2], o[3]);
    dp[1] = make_uint4(o[4], o[5], o[6], o[7]);
  }
}

__device__ __forceinline__ void attn_item(const P& p, int l, int item, float* sb) {
  const int tid = threadIdx.x, lane = tid & 63, w = tid >> 6, q = lane & 15, quad = lane >> 4;
  const bool latent = item < 2048;
  int b, r = 0, h, qb = 0;
  if (latent) { b = item >> 8; r = (item >> 3) & 31; h = item & 7; }
  else { int ci = item - 2048; b = ci >> 5; qb = (ci >> 3) & 3; h = ci & 7; }
  const int r0 = min(max(r - 4, 0), 24);
  __syncthreads();
  if (latent) {
    int kr = tid >> 5, j = tid & 31;
    if (j < 31) sb[tid] = p.na_rpb[(size_t)((l * 8 + h) * 15 + (r0 + kr - r + 7)) * 31 + j];
  }
  __syncthreads();
  const int qc = w * 16 + q;
  const int qrow = latent ? (b * 2048 + r * 64 + qc) : (ML_ROWS + b * 256 + qb * 64 + qc);
  const int cs = (w == 0) ? 0 : (w == 1) ? 8 : (w == 2) ? 24 : 32;
  const int c0 = min(max(qc - 8, 0), 48);
  const bf16x8 bq0 = *(const bf16x8*)(p.U + (size_t)qrow * INC + h * 64 + quad * 8);
  const bf16x8 bq1 = *(const bf16x8*)(p.U + (size_t)qrow * INC + h * 64 + 32 + quad * 8);
  const int mrow = (q >> 2) * 8 + (q & 3);
  const u16* vt_lat = p.VT + (size_t)((b * 8 + h) * 64 + q) * 2048 + quad * 8;
  const u16* vt_ctx = p.VT + VT_CTX_OFF + (size_t)((b * 8 + h) * 64 + q) * 256 + quad * 8;
  float m = -INFINITY, lsum = 0.f;
  f32x4 o[4];
#pragma unroll
  for (int dt = 0; dt < 4; dt++) o[dt] = (f32x4){0.f, 0.f, 0.f, 0.f};
#pragma unroll 1
  for (int chunk = (latent ? 0 : 2); chunk < 4; chunk++) {
    f32x4 s[4][2];
#pragma unroll
    for (int blk = 0; blk < 4; blk++) {
      int rowbase = (chunk < 2) ? (b * 2048 + (r0 + chunk * 4 + blk) * 64 + cs) : (ML_ROWS + b * 256 + (chunk - 2) * 128 + blk * 32);
#pragma unroll
      for (int T = 0; T < 2; T++) {
        const u16* kp = p.U + (size_t)(rowbase + mrow + T * 4) * INC + 512 + h * 64 + quad * 8;
        bf16x8 a0 = *(const bf16x8*)kp;
        bf16x8 a1 = *(const bf16x8*)(kp + 32);
        f32x4 acc = (f32x4){0.f, 0.f, 0.f, 0.f};
        acc = __builtin_amdgcn_mfma_f32_16x16x32_bf16(a0, bq0, acc, 0, 0, 0);
        acc = __builtin_amdgcn_mfma_f32_16x16x32_bf16(a1, bq1, acc, 0, 0, 0);
        s[blk][T] = acc;
      }
    }
    float mx = -INFINITY;
    if (chunk < 2) {
#pragma unroll
      for (int blk = 0; blk < 4; blk++)
#pragma unroll
        for (int T = 0; T < 2; T++)
#pragma unroll
          for (int rr = 0; rr < 4; rr++) {
            int kc = cs + quad * 8 + T * 4 + rr;
            bool valid = (kc >= c0) && (kc < c0 + 16);
            int bi = (chunk * 4 + blk) * 32 + min(max(kc - qc + 15, 0), 30);
            float v = valid ? (s[blk][T][rr] * 0.125f + sb[bi]) : -INFINITY;
            s[blk][T][rr] = v;
            mx = fmaxf(mx, v);
          }
    } else {
#pragma unroll
      for (int blk = 0; blk < 4; blk++)
#pragma unroll
        for (int T = 0; T < 2; T++)
#pragma unroll
          for (int rr = 0; rr < 4; rr++) {
            float v = s[blk][T][rr] * 0.125f;
            s[blk][T][rr] = v;
            mx = fmaxf(mx, v);
          }
    }
    mx = fmaxf(mx, __shfl_xor(mx, 16));
    mx = fmaxf(mx, __shfl_xor(mx, 32));
    float mn = fmaxf(m, mx);
    float sc = __expf(m - mn);
    lsum *= sc;
#pragma unroll
    for (int dt = 0; dt < 4; dt++) o[dt] *= sc;
    m = mn;
#pragma unroll
    for (int blk = 0; blk < 4; blk++) {
      float pv[8];
#pragma unroll
      for (int T = 0; T < 2; T++)
#pragma unroll
        for (int rr = 0; rr < 4; rr++) {
          float e = __expf(s[blk][T][rr] - mn);
          pv[T * 4 + rr] = e;
          lsum += e;
        }
      union { bf16x8 v; unsigned u[4]; } pk;
      pk.u[0] = pack2(pv[0], pv[1]); pk.u[1] = pack2(pv[2], pv[3]); pk.u[2] = pack2(pv[4], pv[5]); pk.u[3] = pack2(pv[6], pv[7]);
      const u16* vb = (chunk < 2) ? (vt_lat + (r0 + chunk * 4 + blk) * 64 + cs) : (vt_ctx + (chunk - 2) * 128 + blk * 32);
      const size_t dstr = (chunk < 2) ? (size_t)16 * 2048 : (size_t)16 * 256;
#pragma unroll
      for (int dt = 0; dt < 4; dt++) {
        bf16x8 av = *(const bf16x8*)(vb + dt * dstr);
        o[dt] = __builtin_amdgcn_mfma_f32_16x16x32_bf16(av, pk.v, o[dt], 0, 0, 0);
      }
    }
  }
  lsum += __shfl_xor(lsum, 16);
  lsum += __shfl_xor(lsum, 32);
  float il = 1.f / lsum;
#pragma unroll
  for (int dt = 0; dt < 4; dt++) {
    uint2 ov;
    ov.x = pack2(o[dt][0] * il, o[dt][1] * il);
    ov.y = pack2(o[dt][2] * il, o[dt][3] * il);
    *(uint2*)(p.Y + (size_t)qrow * 1024 + h * 64 + dt * 16 + quad * 4) = ov;
  }
}

__device__ __forceinline__ int ml_row(int b, int dir, int j, int pp) {
  if (j < 4) {
    int pos = j * 64 + pp;
    int t = dir ? 255 - pos : pos;
    return ML_ROWS + b * 256 + t;
  } else {
    int pos = (j - 4) * 64 + pp;
    int t = dir ? 2047 - pos : pos;
    return b * 2048 + t;
  }
}

__device__ __forceinline__ void mlstmA_item(const P& p, int it, float* sm) {
  const int tid = threadIdx.x, lane = tid & 63;
  int seq = it / 36, j = it % 36;
  int b = seq >> 3, h = (seq >> 1) & 3, dir = seq & 1;
  float* ks = sm;
  float* vs = sm + 64 * 65;
  float* wsm = sm + 2 * 64 * 65;
  float* slot = p.mst + (size_t)it * SLOT;
  const u16* mqk = (const u16*)p.MQK;
  __syncthreads();
  for (int idx = tid; idx < 4096; idx += 256) {
    int pp = idx >> 6, d = idx & 63;
    int row = ml_row(b, dir, j, pp);
    ks[pp * 65 + d] = bf2f(mqk[(size_t)row * 512 + 256 + h * 64 + d]);
    vs[pp * 65 + d] = bf2f(p.U[(size_t)row * INC + 2304 + h * 64 + d]);
  }
  if (tid < 64) {
    int row = ml_row(b, dir, j, lane);
    float ic = p.G[row * 16 + (dir * 2) * 4 + h];
    float fc = p.G[row * 16 + (dir * 2 + 1) * 4 + h];
    float bbv = fc;
#pragma unroll
    for (int o = 1; o < 64; o <<= 1) { float u = __shfl_up(bbv, o); if (lane >= o) bbv += u; }
    float cs = ic - bbv;
    float pm = cs;
#pragma unroll
    for (int o = 1; o < 64; o <<= 1) { float u = __shfl_up(pm, o); if (lane >= o) pm = fmaxf(pm, u); }
    float bl = __shfl(bbv, 63);
    float ml = __shfl(pm, 63) + bl;
    wsm[lane] = __expf(bl + cs - ml);
    slot[4224 + lane] = bbv;
    slot[4288 + lane] = cs;
    slot[4352 + lane] = pm;
    if (lane == 0) { slot[4160] = bl; slot[4161] = ml; }
  }
  __syncthreads();
  {
    int e = tid & 63, dg = tid >> 6;
    float acc[16];
#pragma unroll
    for (int dd = 0; dd < 16; dd++) acc[dd] = 0.f;
    for (int pp = 0; pp < 64; pp++) {
      float wv = wsm[pp] * vs[pp * 65 + e];
#pragma unroll
      for (int dd = 0; dd < 16; dd++) acc[dd] += ks[pp * 65 + dg * 16 + dd] * wv;
    }
#pragma unroll
    for (int q4 = 0; q4 < 4; q4++)
      *(float4*)(slot + e * 64 + dg * 16 + q4 * 4) = make_float4(acc[q4 * 4], acc[q4 * 4 + 1], acc[q4 * 4 + 2], acc[q4 * 4 + 3]);
  }
  if (tid < 64) {
    float a = 0.f;
    for (int pp = 0; pp < 64; pp++) a += wsm[pp] * ks[pp * 65 + tid];
    slot[4096 + tid] = a;
  }
}

#define ATT_SPLIT 768
__device__ __forceinline__ void phase_attn_mlA(const P& p, int l, char* smem) {
  const int N_MLA = 64 * 36;
  const int total = ATT_SPLIT + N_MLA;
  for (int item = blockIdx.x; item < total; item += gridDim.x) {
    if (item < N_MLA) mlstmA_item(p, item, (float*)smem);
    else attn_item(p, l, item - N_MLA, (float*)smem);
  }
}
__device__ __forceinline__ void mlB_item(const P& p, int item);
__device__ __forceinline__ void phase_attn_mlB(const P& p, int l, char* smem) {
  const int N_ATT = (l == 0 ? 2304 : 2048) - ATT_SPLIT;
  const int N_MLB = 64 * 17;
  const int total = N_ATT + N_MLB;
  for (int item = blockIdx.x; item < total; item += gridDim.x) {
    if (item < N_MLB) mlB_item(p, item);
    else attn_item(p, l, ATT_SPLIT + item - N_MLB, (float*)smem);
  }
}

__device__ __forceinline__ void mlB_item(const P& p, int item) {
  const int tid = threadIdx.x;
  int seq = item / 17, ech = item - seq * 17;
  int el = ech * 256 + tid;
  if (el >= 4160) return;
  float* base = p.mst + (size_t)(seq * 36) * SLOT;
  float loc[36], bl[36], ml[36];
#pragma unroll
  for (int j = 0; j < 36; j++) {
    loc[j] = base[(size_t)j * SLOT + el];
    bl[j] = base[(size_t)j * SLOT + 4160];
    ml[j] = base[(size_t)j * SLOT + 4161];
  }
  float m = 0.f, val = 0.f;
#pragma unroll
  for (int j = 0; j < 36; j++) {
    base[(size_t)j * SLOT + el] = val;
    if (el == 0) base[(size_t)j * SLOT + 4162] = m;
    float mn = fmaxf(bl[j] + m, ml[j]);
    val = __expf(bl[j] + m - mn) * val + __expf(ml[j] - mn) * loc[j];
    m = mn;
  }
}

__device__ __forceinline__ bf16x8 pack8(float4 a, float4 b) {
  union { bf16x8 v; unsigned u[4]; } r;
  r.u[0] = pack2(a.x, a.y); r.u[1] = pack2(a.z, a.w); r.u[2] = pack2(b.x, b.y); r.u[3] = pack2(b.z, b.w);
  return r.v;
}
__device__ __forceinline__ void phase_mlC(const P& p, int l, char* smem) {
  const int tid = threadIdx.x, lane = tid & 63, w = tid >> 6, q = lane & 15, quad = lane >> 4;
  const u16* mqk = (const u16*)p.MQK;
  const int nch = (l == 0) ? 36 : 32;
  const int total = 32 * nch;
  const int mrow = (q >> 2) * 8 + (q & 3);
  for (int item = blockIdx.x; item < total; item += gridDim.x) {
    int bh = item / nch, c = item % nch + (l == 0 ? 0 : 4);
    int b = bh >> 2, h = bh & 3;
    const int rowbase = (c < 4) ? (ML_ROWS + b * 256 + c * 64) : (b * 2048 + (c - 4) * 64);
    const int tau_t = w * 16 + q;
    const int trow = rowbase + tau_t;
    const bf16x8 bq0 = *(const bf16x8*)(mqk + (size_t)trow * 512 + h * 64 + quad * 8);
    const bf16x8 bq1 = *(const bf16x8*)(mqk + (size_t)trow * 512 + h * 64 + 32 + quad * 8);
    const u16* vt = (c < 4) ? (p.VTm + VTM_CTX_OFF + (size_t)((b * 4 + h) * 64 + q) * 256 + c * 64 + quad * 8)
                            : (p.VTm + (size_t)((b * 4 + h) * 64 + q) * 2048 + (c - 4) * 64 + quad * 8);
    const size_t vstr = (c < 4) ? (size_t)16 * 256 : (size_t)16 * 2048;
    f32x4 hs[4];
#pragma unroll
    for (int et = 0; et < 4; et++) hs[et] = (f32x4){0.f, 0.f, 0.f, 0.f};
#pragma unroll 1
    for (int dir = 0; dir < 2; dir++) {
      int j = dir ? (c < 4 ? 3 - c : 4 + 31 - (c - 4)) : c;
      const float* slot = p.mst + (size_t)(((b * 4 + h) * 2 + dir) * 36 + j) * SLOT;
      const int pt = dir ? 63 - tau_t : tau_t;
      const float m0 = slot[4162];
      const float bt = slot[4224 + pt];
      const float mt = bt + fmaxf(m0, slot[4352 + pt]);
      const float winter = __expf(bt + m0 - mt);
      f32x4 aw[4], ac[4];
#pragma unroll
      for (int et = 0; et < 4; et++) { aw[et] = (f32x4){0.f, 0.f, 0.f, 0.f}; ac[et] = (f32x4){0.f, 0.f, 0.f, 0.f}; }
      float dsum = 0.f;
#pragma unroll
      for (int kb = 0; kb < 2; kb++) {
        float wv[8];
#pragma unroll
        for (int T = 0; T < 2; T++) {
          const u16* kp = mqk + (size_t)(rowbase + kb * 32 + mrow + T * 4) * 512 + 256 + h * 64 + quad * 8;
          bf16x8 a0 = *(const bf16x8*)kp;
          bf16x8 a1 = *(const bf16x8*)(kp + 32);
          f32x4 sacc = (f32x4){0.f, 0.f, 0.f, 0.f};
          sacc = __builtin_amdgcn_mfma_f32_16x16x32_bf16(a0, bq0, sacc, 0, 0, 0);
          sacc = __builtin_amdgcn_mfma_f32_16x16x32_bf16(a1, bq1, sacc, 0, 0, 0);
#pragma unroll
          for (int rr = 0; rr < 4; rr++) {
            int tau_s = kb * 32 + quad * 8 + T * 4 + rr;
            int ps = dir ? 63 - tau_s : tau_s;
            bool valid = dir ? (tau_s >= tau_t) : (tau_s <= tau_t);
            float cs = slot[4288 + ps];
            float v = valid ? sacc[rr] * __expf(bt - mt + cs) : 0.f;
            wv[T * 4 + rr] = v;
            dsum += v;
          }
        }
        union { bf16x8 v; unsigned u[4]; } pk;
        pk.u[0] = pack2(wv[0], wv[1]); pk.u[1] = pack2(wv[2], wv[3]); pk.u[2] = pack2(wv[4], wv[5]); pk.u[3] = pack2(wv[6], wv[7]);
#pragma unroll
        for (int et = 0; et < 4; et++) {
          bf16x8 av = *(const bf16x8*)(vt + et * vstr + kb * 32);
          aw[et] = __builtin_amdgcn_mfma_f32_16x16x32_bf16(av, pk.v, aw[et], 0, 0, 0);
        }
      }
#pragma unroll
      for (int et = 0; et < 4; et++) {
        const float* cp = slot + (et * 16 + q) * 64 + quad * 8;
        bf16x8 c0 = pack8(*(const float4*)cp, *(const float4*)(cp + 4));
        bf16x8 c1 = pack8(*(const float4*)(cp + 32), *(const float4*)(cp + 36));
        ac[et] = __builtin_amdgcn_mfma_f32_16x16x32_bf16(c0, bq0, ac[et], 0, 0, 0);
        ac[et] = __builtin_amdgcn_mfma_f32_16x16x32_bf16(c1, bq1, ac[et], 0, 0, 0);
      }
      float qn = 0.f;
      {
        const float* np_ = slot + 4096 + quad * 8;
        float4 n0 = *(const float4*)np_, n1 = *(const float4*)(np_ + 4), n2 = *(const float4*)(np_ + 32), n3 = *(const float4*)(np_ + 36);
        union { bf16x8 v; unsigned u[4]; } q0, q1;
        q0.v = bq0; q1.v = bq1;
        qn += bflo(q0.u[0]) * n0.x + bfhi(q0.u[0]) * n0.y + bflo(q0.u[1]) * n0.z + bfhi(q0.u[1]) * n0.w;
        qn += bflo(q0.u[2]) * n1.x + bfhi(q0.u[2]) * n1.y + bflo(q0.u[3]) * n1.z + bfhi(q0.u[3]) * n1.w;
        qn += bflo(q1.u[0]) * n2.x + bfhi(q1.u[0]) * n2.y + bflo(q1.u[1]) * n2.z + bfhi(q1.u[1]) * n2.w;
        qn += bflo(q1.u[2]) * n3.x + bfhi(q1.u[2]) * n3.y + bflo(q1.u[3]) * n3.z + bfhi(q1.u[3]) * n3.w;
      }
      qn += __shfl_xor(qn, 16);
      qn += __shfl_xor(qn, 32);
      dsum += __shfl_xor(dsum, 16);
      dsum += __shfl_xor(dsum, 32);
      float den = dsum + winter * qn;
      float ih = 1.f / fmaxf(fabsf(den), __expf(-mt));
#pragma unroll
      for (int et = 0; et < 4; et++)
#pragma unroll
        for (int rr = 0; rr < 4; rr++) hs[et][rr] += (aw[et][rr] + winter * ac[et][rr]) * ih;
    }
    float ss = 0.f;
#pragma unroll
    for (int et = 0; et < 4; et++)
#pragma unroll
      for (int rr = 0; rr < 4; rr++) ss += hs[et][rr] * hs[et][rr];
    ss += __shfl_xor(ss, 16);
    ss += __shfl_xor(ss, 32);
    float rs = rsqrtf(ss * (1.f / 64.f) + 1e-6f);
#pragma unroll
    for (int et = 0; et < 4; et++) {
      int e0 = h * 64 + et * 16 + quad * 4;
      uint2 uo = *(const uint2*)(p.U + (size_t)trow * INC + 2560 + e0);
      float4 ng = *(const float4*)(p.ml_norm_g + l * 256 + e0);
      float o0 = hs[et][0] * rs * ng.x * sigmoidf_(bflo(uo.x));
      float o1 = hs[et][1] * rs * ng.y * sigmoidf_(bfhi(uo.x));
      float o2 = hs[et][2] * rs * ng.z * sigmoidf_(bflo(uo.y));
      float o3 = hs[et][3] * rs * ng.w * sigmoidf_(bfhi(uo.y));
      uint2 ov;
      ov.x = pack2(o0, o1);
      ov.y = pack2(o2, o3);
      *(uint2*)(p.Y + (size_t)trow * 1024 + 768 + e0) = ov;
    }
  }
}

typedef __attribute__((ext_vector_type(2))) float f32x2;
__device__ __forceinline__ float gelu_tanh(float x) {
  float u = 0.7978845608028654f * (x + 0.044715f * x * x * x);
  float th = 1.f - 2.f / (1.f + __expf(2.f * u));
  return 0.5f * x * (1.f + th);
}
__device__ __forceinline__ float dot16_fp8(const f32x2* xr, uint4 v) {
  f32x2 s = __builtin_amdgcn_cvt_pk_f32_fp8((int)v.x, false) * xr[0];
  s += __builtin_amdgcn_cvt_pk_f32_fp8((int)v.x, true) * xr[1];
  s += __builtin_amdgcn_cvt_pk_f32_fp8((int)v.y, false) * xr[2];
  s += __builtin_amdgcn_cvt_pk_f32_fp8((int)v.y, true) * xr[3];
  s += __builtin_amdgcn_cvt_pk_f32_fp8((int)v.z, false) * xr[4];
  s += __builtin_amdgcn_cvt_pk_f32_fp8((int)v.z, true) * xr[5];
  s += __builtin_amdgcn_cvt_pk_f32_fp8((int)v.w, false) * xr[6];
  s += __builtin_amdgcn_cvt_pk_f32_fp8((int)v.w, true) * xr[7];
  return s.x + s.y;
}
__device__ __forceinline__ void axpy16_fp8(f32x2* acc, float a, uint4 v) {
  f32x2 av = (f32x2){a, a};
  acc[0] += av * __builtin_amdgcn_cvt_pk_f32_fp8((int)v.x, false);
  acc[1] += av * __builtin_amdgcn_cvt_pk_f32_fp8((int)v.x, true);
  acc[2] += av * __builtin_amdgcn_cvt_pk_f32_fp8((int)v.y, false);
  acc[3] += av * __builtin_amdgcn_cvt_pk_f32_fp8((int)v.y, true);
  acc[4] += av * __builtin_amdgcn_cvt_pk_f32_fp8((int)v.z, false);
  acc[5] += av * __builtin_amdgcn_cvt_pk_f32_fp8((int)v.z, true);
  acc[6] += av * __builtin_amdgcn_cvt_pk_f32_fp8((int)v.w, false);
  acc[7] += av * __builtin_amdgcn_cvt_pk_f32_fp8((int)v.w, true);
}

__device__ __forceinline__ unsigned fkey(float f) {
  unsigned u = __float_as_uint(f);
  return (u & 0x80000000u) ? ~u : (u | 0x80000000u);
}
__device__ __forceinline__ int mbcnt64(unsigned long long m) {
  return __builtin_amdgcn_mbcnt_hi((unsigned)(m >> 32), __builtin_amdgcn_mbcnt_lo((unsigned)m, 0));
}
#define WAVE_LDS_FENCE() do { __builtin_amdgcn_fence(__ATOMIC_RELEASE, "wavefront"); __builtin_amdgcn_wave_barrier(); __builtin_amdgcn_fence(__ATOMIC_ACQUIRE, "wavefront"); } while (0)

#define RADIX_BODY(COUNT)                                                                  \
  unsigned pf = 0;                                                                         \
  int bit = 31;                                                                            \
  bool done = false;                                                                       \
  {                                                                                        \
    unsigned c = 0xC1000000u;                                                \
    int n = COUNT;                                                                         \
    n = __builtin_amdgcn_readfirstlane(n);                                                 \
    if (n < 16) {                                                                          \
      _Pragma("unroll 1") for (c = 0xC0800000u; c >= 0xBE800000u; c -= 0x00800000u) {      \
        n = COUNT;                                                                         \
        n = __builtin_amdgcn_readfirstlane(n);                                             \
        if (n >= 16) { pf = c; bit = 22; done = (n == 16); break; }                        \
      }                                                                                    \
    }                                                                                      \
  }                                                                                        \
  if (!done) {                                                                             \
    _Pragma("unroll 1") for (; bit >= 0; --bit) {                                          \
      const unsigned c = pf | (1u << bit);                                                 \
      int n = COUNT;                                                                       \
      n = __builtin_amdgcn_readfirstlane(n);                                               \
      if (n >= 16) { pf = c; if (n == 16) break; }                                         \
    }                                                                                      \
  }                                                                                        \
  return (unsigned)__builtin_amdgcn_readfirstlane((int)pf);
__device__ __forceinline__ unsigned radix_thr2(unsigned k0, unsigned k1) {
  RADIX_BODY((__popcll(__ballot(k0 >= c)) + __popcll(__ballot(k1 >= c))))
}
__device__ __forceinline__ unsigned radix_thr4(unsigned k0, unsigned k1, unsigned k2, unsigned k3) {
  RADIX_BODY((__popcll(__ballot(k0 >= c)) + __popcll(__ballot(k1 >= c)) + __popcll(__ballot(k2 >= c)) + __popcll(__ballot(k3 >= c))))
}
__device__ __forceinline__ void phase_peer_topk(const P& p, int l, char* smem) {
  const int tid = threadIdx.x, lane = tid & 63, w = tid >> 6;
  float* wl = (float*)smem + w * 512;
  float* cs = wl;
  int* ci = (int*)(wl + 32);
  int* el = (int*)(wl + 64);
  float* sl = wl + 192;
  const int nrows = (l == 1) ? ML_ROWS : MT_ROWS;
  const int nw = gridDim.x * 4;
  for (int row = blockIdx.x * 4 + w; row < nrows; row += nw) {
    float na0, na1, nb0, nb1;
    {
      const float* sp0 = p.S + (size_t)row * 2048;
      na0 = sp0[lane]; na1 = sp0[64 + lane]; nb0 = sp0[128 + lane]; nb1 = sp0[192 + lane];
    }
#pragma unroll 1
    for (int h = 0; h < 8; h++) {
      float a0 = na0, a1 = na1, b0 = nb0, b1 = nb1;
      {
        const float* spn = p.S + (size_t)row * 2048 + ((h + 1) & 7) * 256;
        na0 = spn[lane]; na1 = spn[64 + lane]; nb0 = spn[128 + lane]; nb1 = spn[192 + lane];
      }
      unsigned kA0 = fkey(a0), kA1 = fkey(a1), kB0 = fkey(b0), kB1 = fkey(b1);
      const unsigned pA = radix_thr2(kA0, kA1), pB = radix_thr2(kB0, kB1);
      {
        unsigned long long m0 = __ballot(kA0 >= pA), m1 = __ballot(kA1 >= pA);
        int p0 = mbcnt64(m0), p1 = __popcll(m0) + mbcnt64(m1);
        if (kA0 >= pA && p0 < 16) { cs[p0] = a0; ci[p0] = lane; }
        if (kA1 >= pA && p1 < 16) { cs[p1] = a1; ci[p1] = lane + 64; }
        m0 = __ballot(kB0 >= pB); m1 = __ballot(kB1 >= pB);
        p0 = mbcnt64(m0); p1 = __popcll(m0) + mbcnt64(m1);
        if (kB0 >= pB && p0 < 16) { cs[16 + p0] = b0; ci[16 + p0] = lane; }
        if (kB1 >= pB && p1 < 16) { cs[16 + p1] = b1; ci[16 + p1] = lane + 64; }
      }
      WAVE_LDS_FENCE();
      const int ii = lane >> 2, jb = (lane & 3) * 4;
      float s1 = cs[ii];
      float c0 = s1 + cs[16 + jb + 0], c1 = s1 + cs[16 + jb + 1], c2 = s1 + cs[16 + jb + 2], c3 = s1 + cs[16 + jb + 3];
      int e1 = ci[ii] * 128;
      int f0 = e1 + ci[16 + jb + 0], f1 = e1 + ci[16 + jb + 1], f2 = e1 + ci[16 + jb + 2], f3 = e1 + ci[16 + jb + 3];
      unsigned k0 = fkey(c0), k1 = fkey(c1), k2 = fkey(c2), k3 = fkey(c3);
      const unsigned pC = radix_thr4(k0, k1, k2, k3);
      {
        unsigned long long m0 = __ballot(k0 >= pC), m1 = __ballot(k1 >= pC), m2 = __ballot(k2 >= pC), m3 = __ballot(k3 >= pC);
        int q0 = mbcnt64(m0);
        int q1 = __popcll(m0) + mbcnt64(m1);
        int q2 = __popcll(m0) + __popcll(m1) + mbcnt64(m2);
        int q3 = __popcll(m0) + __popcll(m1) + __popcll(m2) + mbcnt64(m3);
        if (k0 >= pC && q0 < 16) { el[h * 16 + q0] = f0; sl[h * 16 + q0] = c0; }
        if (k1 >= pC && q1 < 16) { el[h * 16 + q1] = f1; sl[h * 16 + q1] = c1; }
        if (k2 >= pC && q2 < 16) { el[h * 16 + q2] = f2; sl[h * 16 + q2] = c2; }
        if (k3 >= pC && q3 < 16) { el[h * 16 + q3] = f3; sl[h * 16 + q3] = c3; }
      }
      WAVE_LDS_FENCE();
    }
    {
      float v0 = sl[lane], v1 = sl[64 + lane];
      float m0 = v0, m1 = v1;
#pragma unroll
      for (int o = 1; o < 16; o <<= 1) { m0 = fmaxf(m0, __shfl_xor(m0, o)); m1 = fmaxf(m1, __shfl_xor(m1, o)); }
      float e0 = __expf(v0 - m0), e1 = __expf(v1 - m1);
      float s0 = e0, s1 = e1;
#pragma unroll
      for (int o = 1; o < 16; o <<= 1) { s0 += __shfl_xor(s0, o); s1 += __shfl_xor(s1, o); }
      sl[lane] = e0 / s0;
      sl[64 + lane] = e1 / s1;
    }
    WAVE_LDS_FENCE();
    p.elist[(size_t)row * 128 + lane] = el[lane];
    p.elist[(size_t)row * 128 + 64 + lane] = el[64 + lane];
    p.glist[(size_t)row * 128 + lane] = sl[lane];
    p.glist[(size_t)row * 128 + 64 + lane] = sl[64 + lane];
    p.slist[(size_t)row * 128 + lane] = p.su[l * 16384 + el[lane]];
    p.slist[(size_t)row * 128 + 64 + lane] = p.su[l * 16384 + el[64 + lane]];
    WAVE_LDS_FENCE();
  }
}

struct PeerMeta {
  int id0, id1;
  uint4 xq;
  float g0, g1;
  float2 cur, g2;
};
template <int PH>
__device__ __forceinline__ void peer_load_meta(const P& p, int l, int t, int k, int lane, PeerMeta& m) {
  m.id0 = p.elist[(size_t)t * 128 + lane];
  m.id1 = p.elist[(size_t)t * 128 + 64 + lane];
  if (PH == 0) {
    m.xq = *(const uint4*)(p.xq + (size_t)t * 1024 + k * 128 + (lane & 7) * 16);
  } else {
    m.g0 = p.glist[(size_t)t * 128 + lane];
    m.g1 = p.glist[(size_t)t * 128 + 64 + lane];
    {
      const int Bc = ((lane & 8) ? 8 : 0) + ((lane & 16) ? 4 : 0) + ((lane & 32) ? 2 : 0);
      const int col = k * 128 + (lane & 7) * 16 + Bc;
      const int mr = t < ML_ROWS ? (t >> 11) : 8;
      m.g2 = *(const float2*)(p.mod + (size_t)(l * 9 + mr) * 6144 + 5120 + col);
      m.cur = *(const float2*)(t < ML_ROWS ? p.out + (size_t)t * 1024 + col : p.hc + (size_t)(t - ML_ROWS) * 1024 + col);
    }
  }
}
template <int PH>
__device__ __forceinline__ void peer_issue(const PeerMeta& m, int* idb, float* alb, const unsigned char* tab, int lane, uint4* rr, uint4& xq, float2& rmw, float2& gsc) {
  idb[lane] = m.id0;
  idb[64 + lane] = m.id1;
  if (PH == 0) {
    xq = m.xq;
  } else {
    alb[lane] = m.g0;
    alb[64 + lane] = m.g1;
    rmw = m.cur;
    gsc = m.g2;
  }
  WAVE_LDS_FENCE();
  const int es = lane >> 3;
#pragma unroll
  for (int i = 0; i < 16; i++) rr[i] = *(const uint4*)(tab + (size_t)idb[i * 8 + es] * 128);
}
template <int PH>
__device__ __forceinline__ void peer_compute(const P& p, int l, int t, bool valid, int k, int lane, const uint4* rr, const uint4& xq4, const float* alb, float2 rmw, float2 gsc) {
  const int es = lane >> 3;
  const int s0 = (PH == 0) ? 1 : 8, s1 = (PH == 0) ? 2 : 16, s2 = (PH == 0) ? 4 : 32;
  const bool c0 = (lane & s0) != 0, c1 = (lane & s1) != 0, c2 = (lane & s2) != 0;
  const int B = (c0 ? 8 : 0) + (c1 ? 4 : 0) + (c2 ? 2 : 0);
  float v[16];
  if (PH == 0) {
#pragma unroll
    for (int i = 0; i < 16; i++) {
      int a_ = __builtin_amdgcn_sdot4((int)rr[i].x, (int)xq4.x, 0, false);
      a_ = __builtin_amdgcn_sdot4((int)rr[i].y, (int)xq4.y, a_, false);
      a_ = __builtin_amdgcn_sdot4((int)rr[i].z, (int)xq4.z, a_, false);
      a_ = __builtin_amdgcn_sdot4((int)rr[i].w, (int)xq4.w, a_, false);
      v[i] = (float)a_;
    }
  } else {
    f32x2 acc[8];
#pragma unroll
    for (int i = 0; i < 8; i++) acc[i] = (f32x2){0.f, 0.f};
#pragma unroll
    for (int i = 0; i < 16; i++) axpy16_fp8(acc, alb[i * 8 + es], rr[i]);
#pragma unroll
    for (int i = 0; i < 8; i++) { v[2 * i] = acc[i].x; v[2 * i + 1] = acc[i].y; }
  }
  float k8[8], k4[4], k2[2];
#pragma unroll
  for (int i = 0; i < 8; i++) k8[i] = (c0 ? v[i + 8] : v[i]) + __shfl_xor(c0 ? v[i] : v[i + 8], s0);
#pragma unroll
  for (int i = 0; i < 4; i++) k4[i] = (c1 ? k8[i + 4] : k8[i]) + __shfl_xor(c1 ? k8[i] : k8[i + 4], s1);
#pragma unroll
  for (int i = 0; i < 2; i++) k2[i] = (c2 ? k4[i + 2] : k4[i]) + __shfl_xor(c2 ? k4[i] : k4[i + 2], s2);
  if (PH == 0) {
    float* hq = p.hp + ((size_t)t * 8 + k) * 128;
    if (valid) {
      hq[(B + 0) * 8 + es] = k2[0];
      hq[(B + 1) * 8 + es] = k2[1];
    }
  } else {
    const int col = k * 128 + (lane & 7) * 16 + B;
    float2* dst = (float2*)(t < ML_ROWS ? p.out + (size_t)t * 1024 + col : p.hc + (size_t)(t - ML_ROWS) * 1024 + col);
    float2 cur = rmw;
    cur.x += gsc.x * 0.125f * k2[0];
    cur.y += gsc.y * 0.125f * k2[1];
    if (valid) *dst = cur;
  }
}
template <int PH>
__device__ __forceinline__ void phase_peer_uv(const P& p, int l, char* smem) {
  const int tid = threadIdx.x, lane = tid & 63, w = tid >> 6;
  int* idA = (int*)smem + w * 512;
  int* idB = idA + 128;
  float* alA = (float*)(idA + 256);
  float* alB = alA + 128;
  const int nrows = (l == 1) ? ML_ROWS : MT_ROWS;
  const int k = blockIdx.x & 7;
  const int gw = (blockIdx.x >> 3) * 4 + w, ngw = (gridDim.x >> 3) * 4;
  const unsigned char* tab = (const unsigned char*)(PH == 0 ? p.Ub : p.Vb) + (size_t)((l * 8 + k) * 16384) * 128 + (lane & 7) * 16;
  PeerMeta M;
  uint4 rrA[16], rrB[16];
  uint4 xqA = make_uint4(0, 0, 0, 0), xqB = xqA;
  float2 rmA = make_float2(0.f, 0.f), rmB = rmA, gsA = rmA, gsB = rmA;
  if (gw >= nrows) return;
  const int nit = (nrows - gw + ngw - 1) / ngw;
  const int tlast = gw + (nit - 1) * ngw;
  peer_load_meta<PH>(p, l, gw, k, lane, M);
  peer_issue<PH>(M, idA, alA, tab, lane, rrA, xqA, rmA, gsA);
  peer_load_meta<PH>(p, l, min(gw + ngw, tlast), k, lane, M);
#pragma unroll 1
  for (int i = 0; i < nit; i += 2) {
    const int tA = gw + i * ngw, tB = tA + ngw;
    peer_issue<PH>(M, idB, alB, tab, lane, rrB, xqB, rmB, gsB);
    peer_load_meta<PH>(p, l, min(tB + ngw, tlast), k, lane, M);
    peer_compute<PH>(p, l, tA, true, k, lane, rrA, xqA, alA, rmA, gsA);
    peer_issue<PH>(M, idA, alA, tab, lane, rrA, xqA, rmA, gsA);
    peer_load_meta<PH>(p, l, min(tB + 2 * ngw, tlast), k, lane, M);
    peer_compute<PH>(p, l, min(tB, tlast), tB <= tlast, k, lane, rrB, xqB, alB, rmB, gsB);
  }
}

__device__ __forceinline__ void phase_peer_act(const P& p, int l) {
  const int tid = threadIdx.x, lane = tid & 63, w = tid >> 6;
  const int nrows = (l == 1) ? ML_ROWS : MT_ROWS;
  const int nw = gridDim.x * 4;
  for (int t = blockIdx.x * 4 + w; t < nrows; t += nw) {
    float h0 = 0.f, h1 = 0.f;
#pragma unroll
    for (int kk = 0; kk < 8; kk++) {
      h0 += p.hp[((size_t)t * 8 + kk) * 128 + lane];
      h1 += p.hp[((size_t)t * 8 + kk) * 128 + 64 + lane];
    }
    const float sxt = p.sx[t];
    const float s0 = p.slist[(size_t)t * 128 + lane] * sxt, s1 = p.slist[(size_t)t * 128 + 64 + lane] * sxt;
    const float g0 = p.glist[(size_t)t * 128 + lane], g1 = p.glist[(size_t)t * 128 + 64 + lane];
    p.glist[(size_t)t * 128 + lane] = gelu_tanh(h0 * s0) * g0;
    p.glist[(size_t)t * 128 + 64 + lane] = gelu_tanh(h1 * s1) * g1;
  }
}

#define RUN(k, call)                         \
  if (lo <= (k) && (k) < hi) {               \
    call;                                    \
    if ((k) + 1 < hi) xcd_barrier(xb);       \
  }
#define LAYER(l, base)                                                                                                    \
  RUN(base + 0, phase_norm(p, l, 1))                                                                                     \
  RUN(base + 1, phase_gemm<0>(p, l, p.xn, p.WinT + (size_t)l * INC_PAD * 1024, MT_ROWS / 128, INC_PAD / 128, smem))     \
  RUN(base + 2, phase_mixprep(p, l, smem))                                                                               \
  RUN(base + 3, phase_attn_mlA(p, l, smem))                                                                              \
  RUN(base + 4, phase_attn_mlB(p, l, smem))                                                                                            \
  RUN(base + 5, phase_mlC(p, l, smem))                                                                                   \
  RUN(base + 6, phase_gemm<1>(p, l, p.Y, p.WoutT + (size_t)l * 1024 * 1024, (l == 0 ? MT_ROWS : ML_ROWS) / 128, 8, smem)) \
  RUN(base + 7, phase_norm(p, l, 2))                                                                                     \
  RUN(base + 8, phase_gemm<2>(p, l, p.xn, p.WsT + (size_t)l * 2048 * 1024, (l == 0 ? MT_ROWS : ML_ROWS) / 128, 16, smem)) \
  RUN(base + 9, phase_peer_topk(p, l, smem))                                                                             \
  RUN(base + 10, phase_peer_uv<0>(p, l, smem))                                                                            \
  RUN(base + 11, phase_peer_act(p, l))                                                                                   \
  RUN(base + 12, phase_peer_uv<1>(p, l, smem))

__global__ void __launch_bounds__(256, 2) fwd_kernel(P p) {
  __shared__ __attribute__((aligned(16))) char smem[SMEM_BYTES];
  __shared__ uint4 xb_words;
  cg::grid_group grid = cg::this_grid();
  const int lo = (int)p.ph_lo, hi = (int)p.ph_hi;
  if (threadIdx.x == 0) xb_words = make_uint4(0u, 0u, 0u, 0u);
  __syncthreads();
  XcdBarrier xb = xcd_barrier_post(p.bar, (volatile LAS unsigned*)&xb_words);
  if (hi - lo > 1) grid.sync();
  RUN(0, phase_prologue(p, smem))
  LAYER(0, 1)
  LAYER(1, 14)
}

extern "C" void kernel_launch(void* const* d_in, const int* in_sizes, int n_in, void* d_out, int out_size, void* d_ws,
                              size_t ws_size, hipStream_t stream) {
  static int grid_blocks = 0;
  if (!grid_blocks) {
    int dev = 0, cus = 0, per_cu = 0;
    hipGetDevice(&dev);
    hipDeviceGetAttribute(&cus, hipDeviceAttributeMultiprocessorCount, dev);
    hipOccupancyMaxActiveBlocksPerMultiprocessor(&per_cu, fwd_kernel, 256, 0);
    if (per_cu < 1) per_cu = 1;
    if (per_cu > 2) per_cu = 2;
    grid_blocks = (cus * per_cu) & ~7;
  }
  P p{};
  const float** ins = (const float**)&p;
  for (int i = 0; i < 22; i++) ins[i] = (const float*)d_in[i];
  p.out = (float*)d_out;
  char* ws = (char*)d_ws;
  size_t off = 0;
  auto take = [&](size_t bytes) { char* r = ws + off; off += (bytes + 255) & ~(size_t)255; return r; };
  p.WinT = (u16*)take((size_t)2 * INC_PAD * 1024 * 2);
  p.WoutT = (u16*)take((size_t)2 * 1024 * 1024 * 2);
  p.WsT = (u16*)take((size_t)2 * 2048 * 1024 * 2);
  p.Ub = (u16*)take((size_t)2 * 16384 * 1024);
  p.Vb = (u16*)take((size_t)2 * 16384 * 1024);
  p.xq = (signed char*)take((size_t)MT_ROWS * 1024);
  p.sx = (float*)take((size_t)MT_ROWS * 4);
  p.su = (float*)take((size_t)2 * 16384 * 4);
  p.slist = (float*)take((size_t)MT_ROWS * 128 * 4);
  p.elist = (int*)take((size_t)MT_ROWS * 128 * 4);
  p.glist = (float*)take((size_t)MT_ROWS * 128 * 4);
  p.mod = (float*)take((size_t)2 * 9 * 6144 * 4);
  p.xn = (u16*)take((size_t)MT_ROWS * 1024 * 2);
  p.U = (u16*)take((size_t)MT_ROWS * INC * 2);
  p.MQK = (float*)take((size_t)MT_ROWS * 512 * 2);
  p.Y = (u16*)take((size_t)MT_ROWS * 1024 * 2);
  p.S = (float*)p.U;
  p.hp = (float*)take((size_t)MT_ROWS * 8 * 128 * 4);
  p.G = (float*)take((size_t)MT_ROWS * 16 * 4);
  p.mst = (float*)take((size_t)2304 * SLOT * 4);
  p.hc = (float*)take((size_t)MC_ROWS * 1024 * 4);
  p.bar = (unsigned*)take((size_t)XCD_BAR_WORDS * 4);
  p.VTm = (u16*)take((size_t)(8 * 4 * 64) * (2048 + 256) * 2);
  p.VT = (u16*)take((size_t)(8 * 8 * 64) * (2048 + 256) * 2);
  if (off > ws_size) { fprintf(stderr, "workspace too small: need %zu have %zu\n", off, ws_size); return; }
  (void)hipMemsetAsync(p.bar, 0, (size_t)XCD_BAR_WORDS * 4, stream);
#if MEGA
  p.ph_lo = 0; p.ph_hi = NPHASES;
  void* args[] = {&p};
  hipError_t e = hipLaunchCooperativeKernel((void*)fwd_kernel, dim3(grid_blocks), dim3(256), args, 0, stream);
  if (e != hipSuccess) fprintf(stderr, "cooperative launch failed: %s (grid %d)\n", hipGetErrorString(e), grid_blocks);
#else
  for (int ph = 0; ph < NPHASES; ph++) {
    p.ph_lo = ph; p.ph_hi = ph + 1;
    void* args[] = {&p};
    hipError_t e = hipLaunchCooperativeKernel((void*)fwd_kernel, dim3(grid_blocks), dim3(256), args, 0, stream);
    if (e != hipSuccess) fprintf(stderr, "cooperative launch failed: %s (grid %d)\n", hipGetErrorString(e), grid_blocks);
  }
#endif
}
```

```cpp
#include <hip/hip_runtime.h>
#include <hip/hip_cooperative_groups.h>
#include <cstdio>
namespace cg = cooperative_groups;

#ifndef MEGA
#define MEGA 1
#endif

typedef unsigned short u16;
typedef __attribute__((ext_vector_type(8))) short bf16x8;
typedef __attribute__((ext_vector_type(4))) float f32x4;

#define ML_ROWS 16384
#define MC_ROWS 2048
#define MT_ROWS 18432
#define INC 2832
#define INC_PAD 2944
#define SLOT 4480
#define SMEM_BYTES 49152
#define NPHASES 27

struct P {
  const float *x, *c, *ctx, *c_ctx, *w_ada, *b_ada, *norm1_g, *w_in, *ml_gate_b, *na_q_g, *na_k_g, *na_rpb,
      *pool_w, *pool_scale, *ml_conv, *ml_norm_g, *w_out, *norm2_g, *peer_wq, *peer_keys, *peer_u, *peer_v;
  float* out;
  u16 *WinT, *WoutT, *WsT, *Ub, *Vb;
  float* mod;
  u16* xn;
  u16* U;
  float* MQK;
  u16* Y;
  float* S;
  float* G;
  float* mst;
  float* hc;
  u16* VT;
  u16* VTm;
  signed char* xq;
  float* sx;
  float* su;
  float* slist;
  int* elist;
  float* glist;
  float* hp;
  unsigned* bar;
  long long ph_lo, ph_hi;
};

__device__ __forceinline__ u16 f2bf(float f) {
  unsigned u = __float_as_uint(f);
  u += 0x7fffu + ((u >> 16) & 1u);
  return (u16)(u >> 16);
}
__device__ __forceinline__ float bf2f(u16 h) { return __uint_as_float(((unsigned)h) << 16); }
__device__ __forceinline__ float bflo(unsigned u) { return __uint_as_float(u << 16); }
__device__ __forceinline__ float bfhi(unsigned u) { return __uint_as_float(u & 0xffff0000u); }
__device__ __forceinline__ unsigned pack2(float a, float b) { return (unsigned)f2bf(a) | ((unsigned)f2bf(b) << 16); }
__device__ __forceinline__ unsigned q8pack(float a, float b, float c, float d) {
  int qa = __float2int_rn(a), qb = __float2int_rn(b), qc = __float2int_rn(c), qd = __float2int_rn(d);
  return (unsigned)(qa & 0xff) | ((unsigned)(qb & 0xff) << 8) | ((unsigned)(qc & 0xff) << 16) | ((unsigned)(qd & 0xff) << 24);
}
__device__ __forceinline__ int opaque_tid() { int t = threadIdx.x; asm volatile("" : "+v"(t)); return t; }
__device__ __forceinline__ float wave_sum(float v) {
#pragma unroll
  for (int o = 32; o; o >>= 1) v += __shfl_xor(v, o);
  return v;
}
__device__ __forceinline__ void wave_argmax(float& v, int& i) {
#pragma unroll
  for (int o = 32; o; o >>= 1) {
    float ov = __shfl_xor(v, o);
    int oi = __shfl_xor(i, o);
    if (ov > v || (ov == v && oi < i)) { v = ov; i = oi; }
  }
}
__device__ __forceinline__ float sigmoidf_(float x) { return 1.f / (1.f + __expf(-x)); }
__device__ __forceinline__ float siluf_(float x) { return x / (1.f + __expf(-x)); }

#define XB_TMO      128
#define XB_XCNT(j)  (256  + 64 * (j))
#define XB_XSUB(j)  (1280 + 64 * (j))
#define XB_XGEN(j)  (2304 + 64 * (j))
#define XB_TOP      3328
#define XB_TOPGEN   3392
#define XCD_BAR_WORDS 3456
#define XB_SPIN_CAP (1u << 18)
#define LAS __attribute__((address_space(3)))
__device__ __forceinline__ unsigned xb_ld(unsigned* p)              { return __hip_atomic_load(p, __ATOMIC_RELAXED, __HIP_MEMORY_SCOPE_AGENT); }
__device__ __forceinline__ unsigned xb_add(unsigned* p, unsigned v) { return __hip_atomic_fetch_add(p, v, __ATOMIC_RELAXED, __HIP_MEMORY_SCOPE_AGENT); }
__device__ __forceinline__ unsigned xb_xcc_id() { return (unsigned)__builtin_amdgcn_s_getreg((3 << 11) | 20) & 0xFu; }
#define XB_SPIN(cond, bar) do { unsigned _sp = 0; while (cond) { __builtin_amdgcn_s_sleep(1); \
    if ((++_sp & 255u) == 0u) { if (xb_ld(&(bar)[XB_TMO])) break; if (_sp > XB_SPIN_CAP) { atomicAdd(&(bar)[XB_TMO], 1u); break; } } } } while (0)
struct XcdBarrier { unsigned* bar; unsigned x; volatile LAS unsigned* st; };
__device__ __forceinline__ XcdBarrier xcd_barrier_post(unsigned* bar, volatile LAS unsigned* st) {
    XcdBarrier b; b.bar = bar; b.x = xb_xcc_id(); b.st = st;
    if (threadIdx.x == 0) (void)xb_add(&bar[XB_XCNT(b.x)], 1u);
    return b;
}
__device__ __forceinline__ void xcd_barrier_complete(unsigned* bar, unsigned x, unsigned& nloc, unsigned& nx) {
    const unsigned G = gridDim.x * gridDim.y * gridDim.z;
    unsigned sum, cnt, mine, sp = 0u;
    for (;;) {
        sum = 0u; cnt = 0u; mine = 0u;
#pragma unroll
        for (unsigned j = 0; j < 16; ++j) { const unsigned c = xb_ld(&bar[XB_XCNT(j)]); sum += c; cnt += (c > 0u) ? 1u : 0u; mine = (j == x) ? c : mine; }
        if (sum == G) break;
        __builtin_amdgcn_s_sleep(1);
        if ((++sp & 255u) == 0u) { if (xb_ld(&bar[XB_TMO])) break; if (sp > XB_SPIN_CAP) { atomicAdd(&bar[XB_TMO], 1u); break; } }
    }
    nloc = mine > 0u ? mine : 1u; nx = cnt > 0u ? cnt : 1u;
}
__device__ __forceinline__ void xcd_barrier(const XcdBarrier& b) {
    asm volatile("s_waitcnt vmcnt(0)" ::: "memory");
    __syncthreads();
    if (threadIdx.x == 0) {
        unsigned* bar = b.bar;
        __builtin_amdgcn_s_waitcnt(0);
        unsigned nloc = b.st[0], nx = b.st[1];
        if (nloc == 0u) { xcd_barrier_complete(bar, b.x, nloc, nx); b.st[0] = nloc; b.st[1] = nx; }
        const unsigned old = xb_add(&bar[XB_XSUB(b.x)], 1u);
        const unsigned gen = old / nloc;
        if (old + 1u == (gen + 1u) * nloc) {
            __builtin_amdgcn_fence(__ATOMIC_RELEASE, "agent");
            asm volatile("s_waitcnt vmcnt(0)" ::: "memory");
            const unsigned og = xb_add(&bar[XB_TOP], 1u);
            const unsigned tg = og / nx;
            if (og + 1u == (tg + 1u) * nx) xb_add(&bar[XB_TOPGEN], 1u);
            else XB_SPIN(xb_ld(&bar[XB_TOPGEN]) == tg, bar);
            __builtin_amdgcn_fence(__ATOMIC_ACQUIRE, "agent");
            xb_add(&bar[XB_XGEN(b.x)], 1u);
            asm volatile("s_waitcnt vmcnt(0)" ::: "memory");
        } else {
            XB_SPIN(xb_ld(&bar[XB_XGEN(b.x)]) == gen, bar);
            __builtin_amdgcn_fence(__ATOMIC_ACQUIRE, "agent");
            asm volatile("s_waitcnt vmcnt(0)" ::: "memory");
        }
    }
    __syncthreads();
}

__device__ __forceinline__ void transpose_item(const float* __restrict__ src, int N, u16* __restrict__ dst, int kt, int nt, float* tl) {
  const int tid = opaque_tid();
#pragma unroll 4
  for (int i = 0; i < 16; i++) {
    int idx = tid + 256 * i;
    int kk = idx >> 6, nn = idx & 63;
    int n = nt * 64 + nn;
    float v = (n < N) ? src[(size_t)(kt * 64 + kk) * N + n] : 0.f;
    tl[kk * 65 + nn] = v;
  }
  __syncthreads();
#pragma unroll 4
  for (int i = 0; i < 16; i++) {
    int idx = tid + 256 * i;
    int nn = idx >> 6, kk = idx & 63;
    dst[(size_t)(nt * 64 + nn) * 1024 + kt * 64 + kk] = f2bf(tl[kk * 65 + nn]);
  }
  __syncthreads();
}

__device__ __forceinline__ void wst_item(const P& p, int it, float* sm) {
  (void)sm;
  const int tid = opaque_tid(), lane = tid & 63, w = tid >> 6, r = lane & 15, quad = lane >> 4;
  const int l = it >> 9, rem = it & 511, hp = rem >> 5, kt = (rem >> 2) & 7, dchunk = rem & 3;
  const float* wq = p.peer_wq + (size_t)l * 1024 * 2048 + hp * 128 + quad * 4;
  const float* keys = p.peer_keys + ((size_t)(l * 16 + hp) * 128 + kt * 16 + r) * 128 + quad * 4;
  const int dbase = dchunk * 256 + w * 64;
  f32x4 acc[4];
#pragma unroll
  for (int dt = 0; dt < 4; dt++) acc[dt] = (f32x4){0.f, 0.f, 0.f, 0.f};
#pragma unroll 2
  for (int jj = 0; jj < 8; jj++) {
    const float4 b4 = *(const float4*)(keys + jj * 16);
#pragma unroll
    for (int dt = 0; dt < 4; dt++) {
      const float4 a4 = *(const float4*)(wq + (size_t)(dbase + dt * 16 + r) * 2048 + jj * 16);
      acc[dt] = __builtin_amdgcn_mfma_f32_16x16x4f32(a4.x, b4.x, acc[dt], 0, 0, 0);
      acc[dt] = __builtin_amdgcn_mfma_f32_16x16x4f32(a4.y, b4.y, acc[dt], 0, 0, 0);
      acc[dt] = __builtin_amdgcn_mfma_f32_16x16x4f32(a4.z, b4.z, acc[dt], 0, 0, 0);
      acc[dt] = __builtin_amdgcn_mfma_f32_16x16x4f32(a4.w, b4.w, acc[dt], 0, 0, 0);
    }
  }
  u16* dst = p.WsT + (size_t)l * 2048 * 1024 + (size_t)(hp * 128 + kt * 16 + r) * 1024 + dbase + quad * 4;
#pragma unroll
  for (int dt = 0; dt < 4; dt++) {
    uint2 o;
    o.x = pack2(acc[dt][0], acc[dt][1]);
    o.y = pack2(acc[dt][2], acc[dt][3]);
    *(uint2*)(dst + dt * 16) = o;
  }
}

__device__ __forceinline__ void mod_item(const P& p, int it, float* sm) {
  const int tid = opaque_tid();
  int l = it / 96, cc = it % 96;
  float* sc = sm;
  float* red = sm + 9216;
  for (int idx = tid; idx < 9216; idx += 256) {
    int r = idx >> 10, k = idx & 1023;
    float v = (r < 8) ? p.c[r * 1024 + k] : p.c_ctx[k];
    sc[idx] = siluf_(v);
  }
  __syncthreads();
  int cl = tid & 63, kg = tid >> 6;
  int col = cc * 64 + cl;
  float acc[9];
#pragma unroll
  for (int r = 0; r < 9; r++) acc[r] = 0.f;
  const float* wa = p.w_ada + (size_t)l * 1024 * 6144;
#pragma unroll 16
  for (int k = kg * 256; k < kg * 256 + 256; k++) {
    float w = wa[(size_t)k * 6144 + col];
#pragma unroll
    for (int r = 0; r < 9; r++) acc[r] += sc[r * 1024 + k] * w;
  }
#pragma unroll
  for (int r = 0; r < 9; r++) red[(kg * 9 + r) * 64 + cl] = acc[r];
  __syncthreads();
  if (kg == 0) {
    float bb = p.b_ada[l * 6144 + col];
#pragma unroll
    for (int r = 0; r < 9; r++) {
      float s = red[(0 * 9 + r) * 64 + cl] + red[(1 * 9 + r) * 64 + cl] + red[(2 * 9 + r) * 64 + cl] + red[(3 * 9 + r) * 64 + cl];
      p.mod[(size_t)(l * 9 + r) * 6144 + col] = s + bb;
    }
  }
  __syncthreads();
}

__device__ __forceinline__ void phase_prologue(const P& p, char* smem) {
  float* sm = (float*)smem;
  const int tid = opaque_tid();
  const int N_A = 2 * 16 * 46, N_B = 2 * 16 * 16, N_C = 1024, N_D = 192, N_E = 4096;
  const int total = N_A + N_B + N_C + N_D + N_E;
  for (int item = blockIdx.x; item < total; item += gridDim.x) {
    int it = item;
    if (it < N_D) { mod_item(p, it, sm); continue; }
    it -= N_D;
    if (it < N_C) { wst_item(p, it, sm); continue; }
    it -= N_C;
    if (it < N_A) {
      int l = it / (16 * 46), r = it % (16 * 46);
      transpose_item(p.w_in + (size_t)l * 1024 * INC, INC, p.WinT + (size_t)l * INC_PAD * 1024, r / 46, r % 46, sm);
      continue;
    }
    it -= N_A;
    if (it < N_B) {
      int l = it >> 8, r = it & 255;
      transpose_item(p.w_out + (size_t)l * 1024 * 1024, 1024, p.WoutT + (size_t)l * 1024 * 1024, r >> 4, r & 15, sm);
      continue;
    }
    it -= N_B;
    {
      if ((it >> 11) == 0) {
        const int lane_ = tid & 63, w_ = tid >> 6;
        const int chunk_ = it & 2047;
#pragma unroll
        for (int rr = 0; rr < 4; rr++) {
          const int R = chunk_ * 16 + w_ * 4 + rr;
          const float4* src = (const float4*)(p.peer_u + (size_t)R * 1024 + lane_ * 16);
          float4 v0 = src[0], v1 = src[1], v2 = src[2], v3 = src[3];
          float mx = fmaxf(fmaxf(fmaxf(fabsf(v0.x), fabsf(v0.y)), fmaxf(fabsf(v0.z), fabsf(v0.w))), fmaxf(fmaxf(fabsf(v1.x), fabsf(v1.y)), fmaxf(fabsf(v1.z), fabsf(v1.w))));
          mx = fmaxf(mx, fmaxf(fmaxf(fmaxf(fabsf(v2.x), fabsf(v2.y)), fmaxf(fabsf(v2.z), fabsf(v2.w))), fmaxf(fmaxf(fabsf(v3.x), fabsf(v3.y)), fmaxf(fabsf(v3.z), fabsf(v3.w)))));
#pragma unroll
          for (int o = 32; o; o >>= 1) mx = fmaxf(mx, __shfl_xor(mx, o));
          const float inv = mx > 0.f ? 127.f / mx : 0.f;
          uint4 o;
          o.x = q8pack(v0.x * inv, v0.y * inv, v0.z * inv, v0.w * inv);
          o.y = q8pack(v1.x * inv, v1.y * inv, v1.z * inv, v1.w * inv);
          o.z = q8pack(v2.x * inv, v2.y * inv, v2.z * inv, v2.w * inv);
          o.w = q8pack(v3.x * inv, v3.y * inv, v3.z * inv, v3.w * inv);
          const unsigned ll = (unsigned)R >> 14, ee = (unsigned)R & 16383u;
          size_t off = ((size_t)((ll * 8u + (unsigned)(lane_ >> 3)) * 16384u + ee)) * 128 + (lane_ & 7) * 16;
          *(uint4*)((unsigned char*)p.Ub + off) = o;
          if (lane_ == 0) p.su[R] = mx * (1.f / 127.f);
        }
        continue;
      }
      int tab = it >> 11;
      int chunk = it & 2047;
      const float scl = tab ? 8.f : 64.f;
      const float4* src = (const float4*)(tab ? p.peer_v : p.peer_u) + (size_t)chunk * 4096;
      unsigned char* dstb = (unsigned char*)(tab ? p.Vb : p.Ub);
#pragma unroll
      for (int i = 0; i < 4; i++) {
        int q = i * 256 + tid;
        float4 v0 = src[q * 4 + 0], v1 = src[q * 4 + 1], v2 = src[q * 4 + 2], v3 = src[q * 4 + 3];
        uint4 o;
        int w_;
        w_ = __builtin_amdgcn_cvt_pk_fp8_f32(v0.x * scl, v0.y * scl, 0, false);
        w_ = __builtin_amdgcn_cvt_pk_fp8_f32(v0.z * scl, v0.w * scl, w_, true);
        o.x = (unsigned)w_;
        w_ = __builtin_amdgcn_cvt_pk_fp8_f32(v1.x * scl, v1.y * scl, 0, false);
        w_ = __builtin_amdgcn_cvt_pk_fp8_f32(v1.z * scl, v1.w * scl, w_, true);
        o.y = (unsigned)w_;
        w_ = __builtin_amdgcn_cvt_pk_fp8_f32(v2.x * scl, v2.y * scl, 0, false);
        w_ = __builtin_amdgcn_cvt_pk_fp8_f32(v2.z * scl, v2.w * scl, w_, true);
        o.z = (unsigned)w_;
        w_ = __builtin_amdgcn_cvt_pk_fp8_f32(v3.x * scl, v3.y * scl, 0, false);
        w_ = __builtin_amdgcn_cvt_pk_fp8_f32(v3.z * scl, v3.w * scl, w_, true);
        o.w = (unsigned)w_;
        {
          unsigned G = (unsigned)chunk * 1024u + (unsigned)q;
          unsigned ll = G >> 20, ee = (G >> 6) & 16383u, cgp = G & 63u;
          size_t off = ((size_t)((ll * 8u + (cgp >> 3)) * 16384u + ee)) * 128 + (cgp & 7u) * 16;
          *(uint4*)(dstb + off) = o;
        }
      }
    }
  }
}

__device__ __forceinline__ void phase_norm(const P& p, int l, int which) {
  const int tid = opaque_tid(), lane = tid & 63, w = tid >> 6;
  const int nrows = (which == 2 && l == 1) ? ML_ROWS : MT_ROWS;
  const float* g = (which == 1 ? p.norm1_g : p.norm2_g) + l * 1024;
  for (int item = blockIdx.x; item * 4 < nrows; item += gridDim.x) {
    int row = item * 4 + w;
    const float* src;
    if (l == 0 && which == 1) src = row < ML_ROWS ? p.x + (size_t)row * 1024 : p.ctx + (size_t)(row - ML_ROWS) * 1024;
    else src = row < ML_ROWS ? p.out + (size_t)row * 1024 : p.hc + (size_t)(row - ML_ROWS) * 1024;
    int mr = row < ML_ROWS ? (row >> 11) : 8;
    const float* modp = p.mod + (size_t)(l * 9 + mr) * 6144;
    const float* sh = modp + (which == 1 ? 0 : 3072);
    const float* sc = modp + (which == 1 ? 1024 : 4096);
    float4 v[4];
    float ss = 0.f;
#pragma unroll
    for (int i = 0; i < 4; i++) {
      v[i] = ((const float4*)src)[i * 64 + lane];
      ss += v[i].x * v[i].x + v[i].y * v[i].y + v[i].z * v[i].z + v[i].w * v[i].w;
    }
    ss = wave_sum(ss);
    float rs = rsqrtf(ss * (1.f / 1024.f) + 1e-6f);
    float ov[16];
    float omax = 0.f;
#pragma unroll
    for (int i = 0; i < 4; i++) {
      int d = (i * 64 + lane) * 4;
      float4 gg = *(const float4*)(g + d);
      float4 s4 = *(const float4*)(sc + d);
      float4 h4 = *(const float4*)(sh + d);
      float o0 = v[i].x * rs * gg.x * (1.f + s4.x) + h4.x;
      float o1 = v[i].y * rs * gg.y * (1.f + s4.y) + h4.y;
      float o2 = v[i].z * rs * gg.z * (1.f + s4.z) + h4.z;
      float o3 = v[i].w * rs * gg.w * (1.f + s4.w) + h4.w;
      uint2 o;
      o.x = pack2(o0, o1);
      o.y = pack2(o2, o3);
      ((uint2*)(p.xn + (size_t)row * 1024))[i * 64 + lane] = o;
      ov[i * 4 + 0] = o0; ov[i * 4 + 1] = o1; ov[i * 4 + 2] = o2; ov[i * 4 + 3] = o3;
      omax = fmaxf(omax, fmaxf(fmaxf(fabsf(o0), fabsf(o1)), fmaxf(fabsf(o2), fabsf(o3))));
    }
    if (which == 2) {
#pragma unroll
      for (int o = 32; o; o >>= 1) omax = fmaxf(omax, __shfl_xor(omax, o));
      const float inv = omax > 0.f ? 127.f / omax : 0.f;
#pragma unroll
      for (int i = 0; i < 4; i++)
        ((unsigned*)(p.xq + (size_t)row * 1024))[i * 64 + lane] = q8pack(ov[i * 4] * inv, ov[i * 4 + 1] * inv, ov[i * 4 + 2] * inv, ov[i * 4 + 3] * inv);
      if (lane == 0) p.sx[row] = omax * (1.f / 127.f);
    }
  }
}

template <int EPI>
__device__ __forceinline__ void phase_gemm(const P& p, int l, const u16* __restrict__ A, const u16* __restrict__ Bt, int mtiles, int ntiles,
                           char* smem) {
  u16* As = (u16*)smem;
  u16* Bs = As + 128 * 72;
  const int tid = opaque_tid(), lane = tid & 63, w = tid >> 6, wm = w >> 1, wn = w & 1;
  const int lr = lane & 15, quad = lane >> 4;
  const int xk = blockIdx.x & 7, lb = blockIdx.x >> 3, nb = gridDim.x >> 3;
  const int mg = xk >> 1;
  const int nh0 = (ntiles + 1) >> 1;
  const int nbase = (xk & 1) ? nh0 : 0, nloc = (xk & 1) ? (ntiles - nh0) : nh0;
  const int mcount = (mtiles - mg + 3) >> 2;
  const int nlocal = mcount * nloc;
  for (int li = lb; li < nlocal; li += nb) {
    int mi = li / nloc;
    int mt = mg + 4 * mi, nt = nbase + (li - mi * nloc);
    int m0 = mt * 128, n0 = nt * 128;
    f32x4 acc[4][4];
#pragma unroll
    for (int i = 0; i < 4; i++)
#pragma unroll
      for (int j = 0; j < 4; j++) acc[i][j] = (f32x4){0.f, 0.f, 0.f, 0.f};
    const int r0_ = tid >> 3, ch_ = tid & 7;
    const u16* Ap0 = A + (size_t)(m0 + r0_) * 1024 + ch_ * 8;
    const u16* Bp0 = Bt + (size_t)(n0 + r0_) * 1024 + ch_ * 8;
    uint4 ra0 = *(const uint4*)Ap0, ra1 = *(const uint4*)(Ap0 + 32 * 1024), ra2 = *(const uint4*)(Ap0 + 64 * 1024), ra3 = *(const uint4*)(Ap0 + 96 * 1024);
    uint4 rb0 = *(const uint4*)Bp0, rb1 = *(const uint4*)(Bp0 + 32 * 1024), rb2 = *(const uint4*)(Bp0 + 64 * 1024), rb3 = *(const uint4*)(Bp0 + 96 * 1024);
    for (int kt = 0; kt < 16; kt++) {
      __syncthreads();
      *(uint4*)(As + r0_ * 72 + ch_ * 8) = ra0;
      *(uint4*)(As + (r0_ + 32) * 72 + ch_ * 8) = ra1;
      *(uint4*)(As + (r0_ + 64) * 72 + ch_ * 8) = ra2;
      *(uint4*)(As + (r0_ + 96) * 72 + ch_ * 8) = ra3;
      *(uint4*)(Bs + r0_ * 72 + ch_ * 8) = rb0;
      *(uint4*)(Bs + (r0_ + 32) * 72 + ch_ * 8) = rb1;
      *(uint4*)(Bs + (r0_ + 64) * 72 + ch_ * 8) = rb2;
      *(uint4*)(Bs + (r0_ + 96) * 72 + ch_ * 8) = rb3;
      __syncthreads();
      if (kt < 15) {
        const int ko = (kt + 1) * 64;
        ra0 = *(const uint4*)(Ap0 + ko); ra1 = *(const uint4*)(Ap0 + 32 * 1024 + ko); ra2 = *(const uint4*)(Ap0 + 64 * 1024 + ko); ra3 = *(const uint4*)(Ap0 + 96 * 1024 + ko);
        rb0 = *(const uint4*)(Bp0 + ko); rb1 = *(const uint4*)(Bp0 + 32 * 1024 + ko); rb2 = *(const uint4*)(Bp0 + 64 * 1024 + ko); rb3 = *(const uint4*)(Bp0 + 96 * 1024 + ko);
      }
#pragma unroll
      for (int ks = 0; ks < 2; ks++) {
        bf16x8 a[4], b[4];
#pragma unroll
        for (int i = 0; i < 4; i++) {
          a[i] = *(const bf16x8*)(As + (wm * 64 + i * 16 + lr) * 72 + ks * 32 + quad * 8);
          b[i] = *(const bf16x8*)(Bs + (wn * 64 + i * 16 + lr) * 72 + ks * 32 + quad * 8);
        }
#pragma unroll
        for (int i = 0; i < 4; i++)
#pragma unroll
          for (int j = 0; j < 4; j++) acc[i][j] = __builtin_amdgcn_mfma_f32_16x16x32_bf16(b[j], a[i], acc[i][j], 0, 0, 0);
      }
    }
#pragma unroll
    for (int i = 0; i < 4; i++)
#pragma unroll
      for (int j = 0; j < 4; j++) {
        const int row = m0 + wm * 64 + i * 16 + lr;
        const int col = n0 + wn * 64 + j * 16 + quad * 4;
        const f32x4 v = acc[i][j];
        if (EPI == 0) {
          if (col < INC) {
            uint2 o;
            o.x = pack2(v[0], v[1]);
            o.y = pack2(v[2], v[3]);
            *(uint2*)(p.U + (size_t)row * INC + col) = o;
            if (col >= 2816) *(float4*)(p.G + row * 16 + (col - 2816)) = make_float4(v[0], v[1], v[2], v[3]);
          }
        } else if (EPI == 1) {
          const int mr = row < ML_ROWS ? (row >> 11) : 8;
          const float4 g1 = *(const float4*)(p.mod + (size_t)(l * 9 + mr) * 6144 + 2048 + col);
          float4 sv;
          if (l == 0) sv = row < ML_ROWS ? *(const float4*)(p.x + (size_t)row * 1024 + col) : *(const float4*)(p.ctx + (size_t)(row - ML_ROWS) * 1024 + col);
          else sv = *(const float4*)(p.out + (size_t)row * 1024 + col);
          float* dst = row < ML_ROWS ? p.out + (size_t)row * 1024 + col : p.hc + (size_t)(row - ML_ROWS) * 1024 + col;
          *(float4*)dst = make_float4(sv.x + g1.x * v[0], sv.y + g1.y * v[1], sv.z + g1.z * v[2], sv.w + g1.w * v[3]);
        } else {
          *(float4*)(p.S + (size_t)row * 2048 + col) = make_float4(v[0], v[1], v[2], v[3]);
        }
      }
  }
}

__device__ __forceinline__ void vt_item(const P& p, int it, u16* tl);
__device__ __forceinline__ void phase_mixprep(const P& p, int l, char* smem) {
  float* pl = (float*)smem;
  const int N_QK = MT_ROWS * 16 / 256;
  const int N_POOL = (l == 0 ? MT_ROWS : ML_ROWS) / 16;
  const int N_PREP = MT_ROWS / 4;
  const int N_VT = 2304 + 1152;
  const int total = N_QK + N_POOL + N_PREP + N_VT;
  for (int item = blockIdx.x; item < total; item += gridDim.x) {
    const int tid = opaque_tid();
    int it = item;
    if (it >= N_QK + N_POOL + N_PREP) { vt_item(p, it - (N_QK + N_POOL + N_PREP), (u16*)smem); continue; }
    if (it < N_QK) {
      int gi = it * 256 + tid;
      int row = gi >> 4, sub = gi & 15;
      int qk = sub >> 3, h = sub & 7;
      u16* ptr = p.U + (size_t)row * INC + qk * 512 + h * 64;
      const float* g = (qk ? p.na_k_g : p.na_q_g) + l * 64;
      uint4 v[8];
      float ss = 0.f;
#pragma unroll
      for (int c = 0; c < 8; c++) {
        v[c] = ((const uint4*)ptr)[c];
        float a;
        a = bflo(v[c].x); ss += a * a; a = bfhi(v[c].x); ss += a * a;
        a = bflo(v[c].y); ss += a * a; a = bfhi(v[c].y); ss += a * a;
        a = bflo(v[c].z); ss += a * a; a = bfhi(v[c].z); ss += a * a;
        a = bflo(v[c].w); ss += a * a; a = bfhi(v[c].w); ss += a * a;
      }
      float rs = rsqrtf(ss * (1.f / 64.f) + 1e-6f);
#pragma unroll
      for (int c = 0; c < 8; c++) {
        uint4 o;
        o.x = pack2(bflo(v[c].x) * rs * g[c * 8 + 0], bfhi(v[c].x) * rs * g[c * 8 + 1]);
        o.y = pack2(bflo(v[c].y) * rs * g[c * 8 + 2], bfhi(v[c].y) * rs * g[c * 8 + 3]);
        o.z = pack2(bflo(v[c].z) * rs * g[c * 8 + 4], bfhi(v[c].z) * rs * g[c * 8 + 5]);
        o.w = pack2(bflo(v[c].w) * rs * g[c * 8 + 6], bfhi(v[c].w) * rs * g[c * 8 + 7]);
        ((uint4*)ptr)[c] = o;
      }
      continue;
    }
    it -= N_QK;
    if (it < N_POOL) {
      int row0 = it * 16;
      int base, T;
      if (row0 < ML_ROWS) { base = (row0 >> 11) << 11; T = 2048; }
      else { base = ML_ROWS + (((row0 - ML_ROWS) >> 8) << 8); T = 256; }
      int t0 = row0 - base;
      int ch = tid, g = ch >> 6;
      int wdw = 2 << g;
      __syncthreads();
      {
        float vals[31];
#pragma unroll
        for (int j = 0; j < 31; j++) {
          int tau = t0 - 8 + j;
          bool ok = (tau >= 0) && (tau < T);
          vals[j] = ok ? bf2f(p.U[(size_t)(base + (ok ? tau : t0)) * INC + 1536 + ch]) : 0.f;
        }
        const int hl = wdw / 2, hr = wdw - wdw / 2 - 1;
#pragma unroll
        for (int tt = 0; tt < 16; tt++) {
          int t = t0 + tt;
          int lo = max(t - hl, 0), hi = min(t + hr, T - 1);
          float s = 0.f;
#pragma unroll
          for (int j = 0; j < 31; j++) {
            int rel = j - 8 - tt;
            if (rel >= -8 && rel <= 7) s += (rel >= -hl && rel <= hr) ? vals[j] : 0.f;
          }
          pl[tt * 256 + ch] = s / (float)(hi - lo + 1) - vals[8 + tt];
        }
      }
      __syncthreads();
      float acc[16];
#pragma unroll
      for (int tt = 0; tt < 16; tt++) acc[tt] = 0.f;
      int d = ch & 63;
      const float* pw = p.pool_w + ((size_t)(l * 4 + g) * 64) * 64 + d;
      for (int c = 0; c < 64; c++) {
        float wv = pw[c * 64];
#pragma unroll
        for (int tt = 0; tt < 16; tt++) acc[tt] += pl[tt * 256 + g * 64 + c] * wv;
      }
      float ps = p.pool_scale[l * 256 + ch];
#pragma unroll
      for (int tt = 0; tt < 16; tt++) p.Y[(size_t)(row0 + tt) * 1024 + 512 + ch] = f2bf(acc[tt] * ps);
      continue;
    }
    it -= N_POOL;
    {
      const int row0 = it * 4;
      int base, T;
      if (row0 < ML_ROWS) { base = (row0 >> 11) << 11; T = 2048; }
      else { base = ML_ROWS + (((row0 - ML_ROWS) >> 8) << 8); T = 256; }
      const int t0 = row0 - base;
      const int qk = tid >> 7, hh = (tid >> 5) & 3, ax = (tid >> 4) & 1, f = tid & 15;
      const int ca = qk * 256 + hh * 64 + ax * 32 + f, cb = ca + 16;
      float ua[8], ub[8];
#pragma unroll
      for (int j = 0; j < 8; j++) {
        int tt = t0 + j - 2;
        bool ok = (tt >= 0) && (tt < T);
        const u16* ur = p.U + (size_t)(base + (ok ? tt : t0)) * INC + 1792;
        ua[j] = ok ? bf2f(ur[ca]) : 0.f;
        ub[j] = ok ? bf2f(ur[cb]) : 0.f;
      }
      float wa[5], wb[5];
#pragma unroll
      for (int j = 0; j < 5; j++) { wa[j] = p.ml_conv[(l * 5 + j) * 512 + ca]; wb[j] = p.ml_conv[(l * 5 + j) * 512 + cb]; }
      const float inv = __expf(-(float)f * (9.210340371976184f / 16.f));
#pragma unroll
      for (int i = 0; i < 4; i++) {
        float a = 0.f, b = 0.f;
#pragma unroll
        for (int j = 0; j < 5; j++) { a += wa[j] * ua[i + j]; b += wb[j] * ub[i + j]; }
        a = siluf_(a);
        b = siluf_(b);
        if (row0 < ML_ROWS) {
          int t = t0 + i;
          float pos = (float)(ax == 0 ? (t >> 6) : (t & 63));
          float ang = pos * inv;
          float cs = __cosf(ang), sn = __sinf(ang);
          float oa = a * cs - b * sn, ob = a * sn + b * cs;
          a = oa; b = ob;
        }
        if (qk) { a *= 0.125f; b *= 0.125f; }
        ((u16*)p.MQK)[(size_t)(row0 + i) * 512 + ca] = f2bf(a);
        ((u16*)p.MQK)[(size_t)(row0 + i) * 512 + cb] = f2bf(b);
      }
      if (tid < 64) {
        int gi = tid & 15;
        float gv = p.G[row0 * 16 + tid] + p.ml_gate_b[l * 16 + gi];
        if ((gi >> 2) & 1) gv = fminf(gv, 0.f) - log1pf(__expf(-fabsf(gv)));
        p.G[row0 * 16 + tid] = gv;
      }
    }
  }
}

#define VT_CTX_OFF ((size_t)8 * 8 * 64 * 2048)
#define VTM_CTX_OFF ((size_t)8 * 4 * 64 * 2048)
__device__ __forceinline__ void vt_item(const P& p, int it, u16* tl) {
  const int tid = opaque_tid();
  int b, h, tt, row0, TK, col0;
  u16* dst;
  if (it < 2048) { b = it >> 8; h = (it >> 5) & 7; tt = it & 31; row0 = b * 2048 + tt * 64; TK = 2048; col0 = 1024 + h * 64; dst = p.VT + (size_t)((b * 8 + h) * 64) * 2048 + tt * 64; }
  else if (it < 2304) { int ci = it - 2048; b = ci >> 5; h = (ci >> 2) & 7; tt = ci & 3; row0 = ML_ROWS + b * 256 + tt * 64; TK = 256; col0 = 1024 + h * 64; dst = p.VT + VT_CTX_OFF + (size_t)((b * 8 + h) * 64) * 256 + tt * 64; }
  else if (it < 2304 + 1024) { int mi = it - 2304; b = mi >> 7; h = (mi >> 5) & 3; tt = mi & 31; row0 = b * 2048 + tt * 64; TK = 2048; col0 = 2304 + h * 64; dst = p.VTm + (size_t)((b * 4 + h) * 64) * 2048 + tt * 64; }
  else { int mi = it - 3328; b = mi >> 4; h = (mi >> 2) & 3; tt = mi & 3; row0 = ML_ROWS + b * 256 + tt * 64; TK = 256; col0 = 2304 + h * 64; dst = p.VTm + VTM_CTX_OFF + (size_t)((b * 4 + h) * 64) * 256 + tt * 64; }
  __syncthreads();
  {
    int i = tid >> 2, part = tid & 3;
    const uint4* src = (const uint4*)(p.U + (size_t)(row0 + i) * INC + col0 + part * 16);
    uint4 v0 = src[0], v1 = src[1];
    unsigned* t32 = (unsigned*)(tl + i * 66 + part * 16);
    t32[0] = v0.x; t32[1] = v0.y; t32[2] = v0.z; t32[3] = v0.w;
    t32[4] = v1.x; t32[5] = v1.y; t32[6] = v1.z; t32[7] = v1.w;
  }
  __syncthreads();
  {
    int d = tid >> 2, part = tid & 3;
    unsigned o[8];
#pragma unroll
    for (int k = 0; k < 8; k++) {
      unsigned lo = tl[(part * 16 + 2 * k) * 66 + d], hi = tl[(part * 16 + 2 * k + 1) * 66 + d];
      o[k] = lo | (hi << 16);
    }
    uint4* dp = (uint4*)(dst + (size_t)d * TK + part * 16);
    dp[0] = make_uint4(o[0], o[1], o[2], o[3]);
    dp[1] = make_uint4(o[4], o[5], o[6], o[7]);
  }
}

__device__ __forceinline__ void attn_item(const P& p, int l, int item, float* sb) {
  const int tid = opaque_tid(), lane = tid & 63, w = tid >> 6, q = lane & 15, quad = lane >> 4;
  const bool latent = item < 2048;
  int b, r = 0, h, qb = 0;
  if (latent) { b = item >> 8; r = (item >> 3) & 31; h = item & 7; }
  else { int ci = item - 2048; b = ci >> 5; qb = (ci >> 3) & 3; h = ci & 7; }
  const int r0 = min(max(r - 4, 0), 24);
  __syncthreads();
  if (latent) {
    int kr = tid >> 5, j = tid & 31;
    if (j < 31) sb[tid] = p.na_rpb[(size_t)((l * 8 + h) * 15 + (r0 + kr - r + 7)) * 31 + j];
  }
  __syncthreads();
  const int qc = w * 16 + q;
  const int qrow = latent ? (b * 2048 + r * 64 + qc) : (ML_ROWS + b * 256 + qb * 64 + qc);
  const int cs = (w == 0) ? 0 : (w == 1) ? 8 : (w == 2) ? 24 : 32;
  const int c0 = min(max(qc - 8, 0), 48);
  const bf16x8 bq0 = *(const bf16x8*)(p.U + (size_t)qrow * INC + h * 64 + quad * 8);
  const bf16x8 bq1 = *(const bf16x8*)(p.U + (size_t)qrow * INC + h * 64 + 32 + quad * 8);
  const int mrow = (q >> 2) * 8 + (q & 3);
  const u16* vt_lat = p.VT + (size_t)((b * 8 + h) * 64 + q) * 2048 + quad * 8;
  const u16* vt_ctx = p.VT + VT_CTX_OFF + (size_t)((b * 8 + h) * 64 + q) * 256 + quad * 8;
  float m = -INFINITY, lsum = 0.f;
  f32x4 o[4];
#pragma unroll
  for (int dt = 0; dt < 4; dt++) o[dt] = (f32x4){0.f, 0.f, 0.f, 0.f};
#pragma unroll 1
  for (int chunk = (latent ? 0 : 2); chunk < 4; chunk++) {
    f32x4 s[4][2];
#pragma unroll
    for (int blk = 0; blk < 4; blk++) {
      int rowbase = (chunk < 2) ? (b * 2048 + (r0 + chunk * 4 + blk) * 64 + cs) : (ML_ROWS + b * 256 + (chunk - 2) * 128 + blk * 32);
#pragma unroll
      for (int T = 0; T < 2; T++) {
        const u16* kp = p.U + (size_t)(rowbase + mrow + T * 4) * INC + 512 + h * 64 + quad * 8;
        bf16x8 a0 = *(const bf16x8*)kp;
        bf16x8 a1 = *(const bf16x8*)(kp + 32);
        f32x4 acc = (f32x4){0.f, 0.f, 0.f, 0.f};
        acc = __builtin_amdgcn_mfma_f32_16x16x32_bf16(a0, bq0, acc, 0, 0, 0);
        acc = __builtin_amdgcn_mfma_f32_16x16x32_bf16(a1, bq1, acc, 0, 0, 0);
        s[blk][T] = acc;
      }
    }
    float mx = -INFINITY;
    if (chunk < 2) {
#pragma unroll
      for (int blk = 0; blk < 4; blk++)
#pragma unroll
        for (int T = 0; T < 2; T++)
#pragma unroll
          for (int rr = 0; rr < 4; rr++) {
            int kc = cs + quad * 8 + T * 4 + rr;
            bool valid = (kc >= c0) && (kc < c0 + 16);
            int bi = (chunk * 4 + blk) * 32 + min(max(kc - qc + 15, 0), 30);
            float v = valid ? (s[blk][T][rr] * 0.125f + sb[bi]) : -INFINITY;
            s[blk][T][rr] = v;
            mx = fmaxf(mx, v);
          }
    } else {
#pragma unroll
      for (int blk = 0; blk < 4; blk++)
#pragma unroll
        for (int T = 0; T < 2; T++)
#pragma unroll
          for (int rr = 0; rr < 4; rr++) {
            float v = s[blk][T][rr] * 0.125f;
            s[blk][T][rr] = v;
            mx = fmaxf(mx, v);
          }
    }
    mx = fmaxf(mx, __shfl_xor(mx, 16));
    mx = fmaxf(mx, __shfl_xor(mx, 32));
    float mn = fmaxf(m, mx);
    float sc = __expf(m - mn);
    lsum *= sc;
#pragma unroll
    for (int dt = 0; dt < 4; dt++) o[dt] *= sc;
    m = mn;
#pragma unroll
    for (int blk = 0; blk < 4; blk++) {
      float pv[8];
#pragma unroll
      for (int T = 0; T < 2; T++)
#pragma unroll
        for (int rr = 0; rr < 4; rr++) {
          float e = __expf(s[blk][T][rr] - mn);
          pv[T * 4 + rr] = e;
          lsum += e;
        }
      union { bf16x8 v; unsigned u[4]; } pk;
      pk.u[0] = pack2(pv[0], pv[1]); pk.u[1] = pack2(pv[2], pv[3]); pk.u[2] = pack2(pv[4], pv[5]); pk.u[3] = pack2(pv[6], pv[7]);
      const u16* vb = (chunk < 2) ? (vt_lat + (r0 + chunk * 4 + blk) * 64 + cs) : (vt_ctx + (chunk - 2) * 128 + blk * 32);
      const size_t dstr = (chunk < 2) ? (size_t)16 * 2048 : (size_t)16 * 256;
#pragma unroll
      for (int dt = 0; dt < 4; dt++) {
        bf16x8 av = *(const bf16x8*)(vb + dt * dstr);
        o[dt] = __builtin_amdgcn_mfma_f32_16x16x32_bf16(av, pk.v, o[dt], 0, 0, 0);
      }
    }
  }
  lsum += __shfl_xor(lsum, 16);
  lsum += __shfl_xor(lsum, 32);
  float il = 1.f / lsum;
#pragma unroll
  for (int dt = 0; dt < 4; dt++) {
    uint2 ov;
    ov.x = pack2(o[dt][0] * il, o[dt][1] * il);
    ov.y = pack2(o[dt][2] * il, o[dt][3] * il);
    *(uint2*)(p.Y + (size_t)qrow * 1024 + h * 64 + dt * 16 + quad * 4) = ov;
  }
}

__device__ __forceinline__ int ml_row(int b, int dir, int j, int pp) {
  if (j < 4) {
    int pos = j * 64 + pp;
    int t = dir ? 255 - pos : pos;
    return ML_ROWS + b * 256 + t;
  } else {
    int pos = (j - 4) * 64 + pp;
    int t = dir ? 2047 - pos : pos;
    return b * 2048 + t;
  }
}

__device__ __forceinline__ void mlstmA_item(const P& p, int it, float* sm) {
  const int tid = opaque_tid(), lane = tid & 63;
  int seq = it / 36, j = it % 36;
  int b = seq >> 3, h = (seq >> 1) & 3, dir = seq & 1;
  float* ks = sm;
  float* vs = sm + 64 * 65;
  float* wsm = sm + 2 * 64 * 65;
  float* slot = p.mst + (size_t)it * SLOT;
  const u16* mqk = (const u16*)p.MQK;
  __syncthreads();
  for (int idx = tid; idx < 4096; idx += 256) {
    int pp = idx >> 6, d = idx & 63;
    int row = ml_row(b, dir, j, pp);
    ks[pp * 65 + d] = bf2f(mqk[(size_t)row * 512 + 256 + h * 64 + d]);
    vs[pp * 65 + d] = bf2f(p.U[(size_t)row * INC + 2304 + h * 64 + d]);
  }
  if (tid < 64) {
    int row = ml_row(b, dir, j, lane);
    float ic = p.G[row * 16 + (dir * 2) * 4 + h];
    float fc = p.G[row * 16 + (dir * 2 + 1) * 4 + h];
    float bbv = fc;
#pragma unroll
    for (int o = 1; o < 64; o <<= 1) { float u = __shfl_up(bbv, o); if (lane >= o) bbv += u; }
    float cs = ic - bbv;
    float pm = cs;
#pragma unroll
    for (int o = 1; o < 64; o <<= 1) { float u = __shfl_up(pm, o); if (lane >= o) pm = fmaxf(pm, u); }
    float bl = __shfl(bbv, 63);
    float ml = __shfl(pm, 63) + bl;
    wsm[lane] = __expf(bl + cs - ml);
    slot[4224 + lane] = bbv;
    slot[4288 + lane] = cs;
    slot[4352 + lane] = pm;
    if (lane == 0) { slot[4160] = bl; slot[4161] = ml; }
  }
  __syncthreads();
  {
    int e = tid & 63, dg = tid >> 6;
    float acc[16];
#pragma unroll
    for (int dd = 0; dd < 16; dd++) acc[dd] = 0.f;
    for (int pp = 0; pp < 64; pp++) {
      float wv = wsm[pp] * vs[pp * 65 + e];
#pragma unroll
      for (int dd = 0; dd < 16; dd++) acc[dd] += ks[pp * 65 + dg * 16 + dd] * wv;
    }
#pragma unroll
    for (int q4 = 0; q4 < 4; q4++)
      *(float4*)(slot + e * 64 + dg * 16 + q4 * 4) = make_float4(acc[q4 * 4], acc[q4 * 4 + 1], acc[q4 * 4 + 2], acc[q4 * 4 + 3]);
  }
  if (tid < 64) {
    float a = 0.f;
    for (int pp = 0; pp < 64; pp++) a += wsm[pp] * ks[pp * 65 + tid];
    slot[4096 + tid] = a;
  }
}

#define ATT_SPLIT 768
__device__ __forceinline__ void phase_attn_mlA(const P& p, int l, char* smem) {
  const int N_MLA = 64 * 36;
  const int total = ATT_SPLIT + N_MLA;
  for (int item = blockIdx.x; item < total; item += gridDim.x) {
    if (item < N_MLA) mlstmA_item(p, item, (float*)smem);
    else attn_item(p, l, item - N_MLA, (float*)smem);
  }
}
__device__ __forceinline__ void mlB_item(const P& p, int item);
__device__ __forceinline__ void phase_attn_mlB(const P& p, int l, char* smem) {
  const int N_ATT = (l == 0 ? 2304 : 2048) - ATT_SPLIT;
  const int N_MLB = 64 * 17;
  const int total = N_ATT + N_MLB;
  for (int item = blockIdx.x; item < total; item += gridDim.x) {
    if (item < N_MLB) mlB_item(p, item);
    else attn_item(p, l, ATT_SPLIT + item - N_MLB, (float*)smem);
  }
}

__device__ __forceinline__ void mlB_item(const P& p, int item) {
  const int tid = opaque_tid();
  int seq = item / 17, ech = item - seq * 17;
  int el = ech * 256 + tid;
  if (el >= 4160) return;
  float* base = p.mst + (size_t)(seq * 36) * SLOT;
  float loc[36], bl[36], ml[36];
#pragma unroll
  for (int j = 0; j < 36; j++) {
    loc[j] = base[(size_t)j * SLOT + el];
    bl[j] = base[(size_t)j * SLOT + 4160];
    ml[j] = base[(size_t)j * SLOT + 4161];
  }
  float m = 0.f, val = 0.f;
#pragma unroll
  for (int j = 0; j < 36; j++) {
    base[(size_t)j * SLOT + el] = val;
    if (el == 0) base[(size_t)j * SLOT + 4162] = m;
    float mn = fmaxf(bl[j] + m, ml[j]);
    val = __expf(bl[j] + m - mn) * val + __expf(ml[j] - mn) * loc[j];
    m = mn;
  }
}

__device__ __forceinline__ bf16x8 pack8(float4 a, float4 b) {
  union { bf16x8 v; unsigned u[4]; } r;
  r.u[0] = pack2(a.x, a.y); r.u[1] = pack2(a.z, a.w); r.u[2] = pack2(b.x, b.y); r.u[3] = pack2(b.z, b.w);
  return r.v;
}
__device__ __forceinline__ void phase_mlC(const P& p, int l, char* smem) {
  const int tid = opaque_tid(), lane = tid & 63, w = tid >> 6, q = lane & 15, quad = lane >> 4;
  const u16* mqk = (const u16*)p.MQK;
  const int nch = (l == 0) ? 36 : 32;
  const int total = 32 * nch;
  const int mrow = (q >> 2) * 8 + (q & 3);
  for (int item = blockIdx.x; item < total; item += gridDim.x) {
    int bh = item / nch, c = item % nch + (l == 0 ? 0 : 4);
    int b = bh >> 2, h = bh & 3;
    const int rowbase = (c < 4) ? (ML_ROWS + b * 256 + c * 64) : (b * 2048 + (c - 4) * 64);
    const int tau_t = w * 16 + q;
    const int trow = rowbase + tau_t;
    const bf16x8 bq0 = *(const bf16x8*)(mqk + (size_t)trow * 512 + h * 64 + quad * 8);
    const bf16x8 bq1 = *(const bf16x8*)(mqk + (size_t)trow * 512 + h * 64 + 32 + quad * 8);
    const u16* vt = (c < 4) ? (p.VTm + VTM_CTX_OFF + (size_t)((b * 4 + h) * 64 + q) * 256 + c * 64 + quad * 8)
                            : (p.VTm + (size_t)((b * 4 + h) * 64 + q) * 2048 + (c - 4) * 64 + quad * 8);
    const size_t vstr = (c < 4) ? (size_t)16 * 256 : (size_t)16 * 2048;
    f32x4 hs[4];
#pragma unroll
    for (int et = 0; et < 4; et++) hs[et] = (f32x4){0.f, 0.f, 0.f, 0.f};
#pragma unroll 1
    for (int dir = 0; dir < 2; dir++) {
      int j = dir ? (c < 4 ? 3 - c : 4 + 31 - (c - 4)) : c;
      const float* slot = p.mst + (size_t)(((b * 4 + h) * 2 + dir) * 36 + j) * SLOT;
      const int pt = dir ? 63 - tau_t : tau_t;
      const float m0 = slot[4162];
      const float bt = slot[4224 + pt];
      const float mt = bt + fmaxf(m0, slot[4352 + pt]);
      const float winter = __expf(bt + m0 - mt);
      f32x4 aw[4], ac[4];
#pragma unroll
      for (int et = 0; et < 4; et++) { aw[et] = (f32x4){0.f, 0.f, 0.f, 0.f}; ac[et] = (f32x4){0.f, 0.f, 0.f, 0.f}; }
      float dsum = 0.f;
#pragma unroll 1
      for (int kb = 0; kb < 2; kb++) {
        float wv[8];
#pragma unroll
        for (int T = 0; T < 2; T++) {
          const u16* kp = mqk + (size_t)(rowbase + kb * 32 + mrow + T * 4) * 512 + 256 + h * 64 + quad * 8;
          bf16x8 a0 = *(const bf16x8*)kp;
          bf16x8 a1 = *(const bf16x8*)(kp + 32);
          f32x4 sacc = (f32x4){0.f, 0.f, 0.f, 0.f};
          sacc = __builtin_amdgcn_mfma_f32_16x16x32_bf16(a0, bq0, sacc, 0, 0, 0);
          sacc = __builtin_amdgcn_mfma_f32_16x16x32_bf16(a1, bq1, sacc, 0, 0, 0);
#pragma unroll
          for (int rr = 0; rr < 4; rr++) {
            int tau_s = kb * 32 + quad * 8 + T * 4 + rr;
            int ps = dir ? 63 - tau_s : tau_s;
            bool valid = dir ? (tau_s >= tau_t) : (tau_s <= tau_t);
            float cs = slot[4288 + ps];
            float v = valid ? sacc[rr] * __expf(bt - mt + cs) : 0.f;
            wv[T * 4 + rr] = v;
            dsum += v;
          }
        }
        union { bf16x8 v; unsigned u[4]; } pk;
        pk.u[0] = pack2(wv[0], wv[1]); pk.u[1] = pack2(wv[2], wv[3]); pk.u[2] = pack2(wv[4], wv[5]); pk.u[3] = pack2(wv[6], wv[7]);
#pragma unroll
        for (int et = 0; et < 4; et++) {
          bf16x8 av = *(const bf16x8*)(vt + et * vstr + kb * 32);
          aw[et] = __builtin_amdgcn_mfma_f32_16x16x32_bf16(av, pk.v, aw[et], 0, 0, 0);
        }
      }
#pragma unroll 2
      for (int et = 0; et < 4; et++) {
        const float* cp = slot + (et * 16 + q) * 64 + quad * 8;
        bf16x8 c0 = pack8(*(const float4*)cp, *(const float4*)(cp + 4));
        bf16x8 c1 = pack8(*(const float4*)(cp + 32), *(const float4*)(cp + 36));
        ac[et] = __builtin_amdgcn_mfma_f32_16x16x32_bf16(c0, bq0, ac[et], 0, 0, 0);
        ac[et] = __builtin_amdgcn_mfma_f32_16x16x32_bf16(c1, bq1, ac[et], 0, 0, 0);
      }
      float qn = 0.f;
      {
        const float* np_ = slot + 4096 + quad * 8;
        float4 n0 = *(const float4*)np_, n1 = *(const float4*)(np_ + 4), n2 = *(const float4*)(np_ + 32), n3 = *(const float4*)(np_ + 36);
        union { bf16x8 v; unsigned u[4]; } q0, q1;
        q0.v = bq0; q1.v = bq1;
        qn += bflo(q0.u[0]) * n0.x + bfhi(q0.u[0]) * n0.y + bflo(q0.u[1]) * n0.z + bfhi(q0.u[1]) * n0.w;
        qn += bflo(q0.u[2]) * n1.x + bfhi(q0.u[2]) * n1.y + bflo(q0.u[3]) * n1.z + bfhi(q0.u[3]) * n1.w;
        qn += bflo(q1.u[0]) * n2.x + bfhi(q1.u[0]) * n2.y + bflo(q1.u[1]) * n2.z + bfhi(q1.u[1]) * n2.w;
        qn += bflo(q1.u[2]) * n3.x + bfhi(q1.u[2]) * n3.y + bflo(q1.u[3]) * n3.z + bfhi(q1.u[3]) * n3.w;
      }
      qn += __shfl_xor(qn, 16);
      qn += __shfl_xor(qn, 32);
      dsum += __shfl_xor(dsum, 16);
      dsum += __shfl_xor(dsum, 32);
      float den = dsum + winter * qn;
      float ih = 1.f / fmaxf(fabsf(den), __expf(-mt));
#pragma unroll
      for (int et = 0; et < 4; et++)
#pragma unroll
        for (int rr = 0; rr < 4; rr++) hs[et][rr] += (aw[et][rr] + winter * ac[et][rr]) * ih;
    }
    float ss = 0.f;
#pragma unroll
    for (int et = 0; et < 4; et++)
#pragma unroll
      for (int rr = 0; rr < 4; rr++) ss += hs[et][rr] * hs[et][rr];
    ss += __shfl_xor(ss, 16);
    ss += __shfl_xor(ss, 32);
    float rs = rsqrtf(ss * (1.f / 64.f) + 1e-6f);
#pragma unroll
    for (int et = 0; et < 4; et++) {
      int e0 = h * 64 + et * 16 + quad * 4;
      uint2 uo = *(const uint2*)(p.U + (size_t)trow * INC + 2560 + e0);
      float4 ng = *(const float4*)(p.ml_norm_g + l * 256 + e0);
      float o0 = hs[et][0] * rs * ng.x * sigmoidf_(bflo(uo.x));
      float o1 = hs[et][1] * rs * ng.y * sigmoidf_(bfhi(uo.x));
      float o2 = hs[et][2] * rs * ng.z * sigmoidf_(bflo(uo.y));
      float o3 = hs[et][3] * rs * ng.w * sigmoidf_(bfhi(uo.y));
      uint2 ov;
      ov.x = pack2(o0, o1);
      ov.y = pack2(o2, o3);
      *(uint2*)(p.Y + (size_t)trow * 1024 + 768 + e0) = ov;
    }
  }
}

typedef __attribute__((ext_vector_type(2))) float f32x2;
__device__ __forceinline__ float gelu_tanh(float x) {
  float u = 0.7978845608028654f * (x + 0.044715f * x * x * x);
  float th = 1.f - 2.f / (1.f + __expf(2.f * u));
  return 0.5f * x * (1.f + th);
}
__device__ __forceinline__ float dot16_fp8(const f32x2* xr, uint4 v) {
  f32x2 s = __builtin_amdgcn_cvt_pk_f32_fp8((int)v.x, false) * xr[0];
  s += __builtin_amdgcn_cvt_pk_f32_fp8((int)v.x, true) * xr[1];
  s += __builtin_amdgcn_cvt_pk_f32_fp8((int)v.y, false) * xr[2];
  s += __builtin_amdgcn_cvt_pk_f32_fp8((int)v.y, true) * xr[3];
  s += __builtin_amdgcn_cvt_pk_f32_fp8((int)v.z, false) * xr[4];
  s += __builtin_amdgcn_cvt_pk_f32_fp8((int)v.z, true) * xr[5];
  s += __builtin_amdgcn_cvt_pk_f32_fp8((int)v.w, false) * xr[6];
  s += __builtin_amdgcn_cvt_pk_f32_fp8((int)v.w, true) * xr[7];
  return s.x + s.y;
}
__device__ __forceinline__ void axpy16_fp8(f32x2* acc, float a, uint4 v) {
  f32x2 av = (f32x2){a, a};
  acc[0] += av * __builtin_amdgcn_cvt_pk_f32_fp8((int)v.x, false);
  acc[1] += av * __builtin_amdgcn_cvt_pk_f32_fp8((int)v.x, true);
  acc[2] += av * __builtin_amdgcn_cvt_pk_f32_fp8((int)v.y, false);
  acc[3] += av * __builtin_amdgcn_cvt_pk_f32_fp8((int)v.y, true);
  acc[4] += av * __builtin_amdgcn_cvt_pk_f32_fp8((int)v.z, false);
  acc[5] += av * __builtin_amdgcn_cvt_pk_f32_fp8((int)v.z, true);
  acc[6] += av * __builtin_amdgcn_cvt_pk_f32_fp8((int)v.w, false);
  acc[7] += av * __builtin_amdgcn_cvt_pk_f32_fp8((int)v.w, true);
}

__device__ __forceinline__ unsigned fkey(float f) {
  unsigned u = __float_as_uint(f);
  return (u & 0x80000000u) ? ~u : (u | 0x80000000u);
}
__device__ __forceinline__ int mbcnt64(unsigned long long m) {
  return __builtin_amdgcn_mbcnt_hi((unsigned)(m >> 32), __builtin_amdgcn_mbcnt_lo((unsigned)m, 0));
}
#define WAVE_LDS_FENCE() do { __builtin_amdgcn_fence(__ATOMIC_RELEASE, "wavefront"); __builtin_amdgcn_wave_barrier(); __builtin_amdgcn_fence(__ATOMIC_ACQUIRE, "wavefront"); } while (0)

#define RADIX_BODY(COUNT)                                                                  \
  unsigned pf = 0;                                                                         \
  int bit = 31;                                                                            \
  bool done = false;                                                                       \
  {                                                                                        \
    unsigned c = 0xC1000000u;                                                \
    int n = COUNT;                                                                         \
    n = __builtin_amdgcn_readfirstlane(n);                                                 \
    if (n < 16) {                                                                          \
      _Pragma("unroll 1") for (c = 0xC0800000u; c >= 0xBE800000u; c -= 0x00800000u) {      \
        n = COUNT;                                                                         \
        n = __builtin_amdgcn_readfirstlane(n);                                             \
        if (n >= 16) { pf = c; bit = 22; done = (n == 16); break; }                        \
      }                                                                                    \
    }                                                                                      \
  }                                                                                        \
  if (!done) {                                                                             \
    _Pragma("unroll 1") for (; bit >= 0; --bit) {                                          \
      const unsigned c = pf | (1u << bit);                                                 \
      int n = COUNT;                                                                       \
      n = __builtin_amdgcn_readfirstlane(n);                                               \
      if (n >= 16) { pf = c; if (n == 16) break; }                                         \
    }                                                                                      \
  }                                                                                        \
  return (unsigned)__builtin_amdgcn_readfirstlane((int)pf);
__device__ __forceinline__ unsigned radix_thr2(unsigned k0, unsigned k1) {
  RADIX_BODY((__popcll(__ballot(k0 >= c)) + __popcll(__ballot(k1 >= c))))
}
__device__ __forceinline__ unsigned radix_thr4(unsigned k0, unsigned k1, unsigned k2, unsigned k3) {
  RADIX_BODY((__popcll(__ballot(k0 >= c)) + __popcll(__ballot(k1 >= c)) + __popcll(__ballot(k2 >= c)) + __popcll(__ballot(k3 >= c))))
}
__device__ __forceinline__ void phase_peer_topk(const P& p, int l, char* smem) {
  const int tid = opaque_tid(), lane = tid & 63, w = tid >> 6;
  float* wl = (float*)smem + w * 512;
  float* cs = wl;
  int* ci = (int*)(wl + 32);
  int* el = (int*)(wl + 64);
  float* sl = wl + 192;
  const int nrows = (l == 1) ? ML_ROWS : MT_ROWS;
  const int nw = gridDim.x * 4;
  for (int row = blockIdx.x * 4 + w; row < nrows; row += nw) {
    float na0, na1, nb0, nb1;
    {
      const float* sp0 = p.S + (size_t)row * 2048;
      na0 = sp0[lane]; na1 = sp0[64 + lane]; nb0 = sp0[128 + lane]; nb1 = sp0[192 + lane];
    }
#pragma unroll 1
    for (int h = 0; h < 8; h++) {
      float a0 = na0, a1 = na1, b0 = nb0, b1 = nb1;
      {
        const float* spn = p.S + (size_t)row * 2048 + ((h + 1) & 7) * 256;
        na0 = spn[lane]; na1 = spn[64 + lane]; nb0 = spn[128 + lane]; nb1 = spn[192 + lane];
      }
      unsigned kA0 = fkey(a0), kA1 = fkey(a1), kB0 = fkey(b0), kB1 = fkey(b1);
      const unsigned pA = radix_thr2(kA0, kA1), pB = radix_thr2(kB0, kB1);
      {
        unsigned long long m0 = __ballot(kA0 >= pA), m1 = __ballot(kA1 >= pA);
        int p0 = mbcnt64(m0), p1 = __popcll(m0) + mbcnt64(m1);
        if (kA0 >= pA && p0 < 16) { cs[p0] = a0; ci[p0] = lane; }
        if (kA1 >= pA && p1 < 16) { cs[p1] = a1; ci[p1] = lane + 64; }
        m0 = __ballot(kB0 >= pB); m1 = __ballot(kB1 >= pB);
        p0 = mbcnt64(m0); p1 = __popcll(m0) + mbcnt64(m1);
        if (kB0 >= pB && p0 < 16) { cs[16 + p0] = b0; ci[16 + p0] = lane; }
        if (kB1 >= pB && p1 < 16) { cs[16 + p1] = b1; ci[16 + p1] = lane + 64; }
      }
      WAVE_LDS_FENCE();
      const int ii = lane >> 2, jb = (lane & 3) * 4;
      float s1 = cs[ii];
      float c0 = s1 + cs[16 + jb + 0], c1 = s1 + cs[16 + jb + 1], c2 = s1 + cs[16 + jb + 2], c3 = s1 + cs[16 + jb + 3];
      int e1 = ci[ii] * 128;
      int f0 = e1 + ci[16 + jb + 0], f1 = e1 + ci[16 + jb + 1], f2 = e1 + ci[16 + jb + 2], f3 = e1 + ci[16 + jb + 3];
      unsigned k0 = fkey(c0), k1 = fkey(c1), k2 = fkey(c2), k3 = fkey(c3);
      const unsigned pC = radix_thr4(k0, k1, k2, k3);
      {
        unsigned long long m0 = __ballot(k0 >= pC), m1 = __ballot(k1 >= pC), m2 = __ballot(k2 >= pC), m3 = __ballot(k3 >= pC);
        int q0 = mbcnt64(m0);
        int q1 = __popcll(m0) + mbcnt64(m1);
        int q2 = __popcll(m0) + __popcll(m1) + mbcnt64(m2);
        int q3 = __popcll(m0) + __popcll(m1) + __popcll(m2) + mbcnt64(m3);
        if (k0 >= pC && q0 < 16) { el[h * 16 + q0] = f0; sl[h * 16 + q0] = c0; }
        if (k1 >= pC && q1 < 16) { el[h * 16 + q1] = f1; sl[h * 16 + q1] = c1; }
        if (k2 >= pC && q2 < 16) { el[h * 16 + q2] = f2; sl[h * 16 + q2] = c2; }
        if (k3 >= pC && q3 < 16) { el[h * 16 + q3] = f3; sl[h * 16 + q3] = c3; }
      }
      WAVE_LDS_FENCE();
    }
    {
      float v0 = sl[lane], v1 = sl[64 + lane];
      float m0 = v0, m1 = v1;
#pragma unroll
      for (int o = 1; o < 16; o <<= 1) { m0 = fmaxf(m0, __shfl_xor(m0, o)); m1 = fmaxf(m1, __shfl_xor(m1, o)); }
      float e0 = __expf(v0 - m0), e1 = __expf(v1 - m1);
      float s0 = e0, s1 = e1;
#pragma unroll
      for (int o = 1; o < 16; o <<= 1) { s0 += __shfl_xor(s0, o); s1 += __shfl_xor(s1, o); }
      sl[lane] = e0 / s0;
      sl[64 + lane] = e1 / s1;
    }
    WAVE_LDS_FENCE();
    p.elist[(size_t)row * 128 + lane] = el[lane];
    p.elist[(size_t)row * 128 + 64 + lane] = el[64 + lane];
    p.glist[(size_t)row * 128 + lane] = sl[lane];
    p.glist[(size_t)row * 128 + 64 + lane] = sl[64 + lane];
    p.slist[(size_t)row * 128 + lane] = p.su[l * 16384 + el[lane]];
    p.slist[(size_t)row * 128 + 64 + lane] = p.su[l * 16384 + el[64 + lane]];
    WAVE_LDS_FENCE();
  }
}

struct PeerMeta {
  int id0, id1;
  uint4 xq;
  float g0, g1;
  float2 cur, g2;
};
template <int PH>
__device__ __forceinline__ void peer_load_meta(const P& p, int l, int t, int k, int lane, PeerMeta& m) {
  m.id0 = p.elist[(size_t)t * 128 + lane];
  m.id1 = p.elist[(size_t)t * 128 + 64 + lane];
  if (PH == 0) {
    m.xq = *(const uint4*)(p.xq + (size_t)t * 1024 + k * 128 + (lane & 7) * 16);
  } else {
    m.g0 = p.glist[(size_t)t * 128 + lane];
    m.g1 = p.glist[(size_t)t * 128 + 64 + lane];
    {
      const int Bc = ((lane & 8) ? 8 : 0) + ((lane & 16) ? 4 : 0) + ((lane & 32) ? 2 : 0);
      const int col = k * 128 + (lane & 7) * 16 + Bc;
      const int mr = t < ML_ROWS ? (t >> 11) : 8;
      m.g2 = *(const float2*)(p.mod + (size_t)(l * 9 + mr) * 6144 + 5120 + col);
      m.cur = *(const float2*)(t < ML_ROWS ? p.out + (size_t)t * 1024 + col : p.hc + (size_t)(t - ML_ROWS) * 1024 + col);
    }
  }
}
template <int PH>
__device__ __forceinline__ void peer_issue(const PeerMeta& m, int* idb, float* alb, const unsigned char* tab, int lane, uint4* rr, uint4& xq, float2& rmw, float2& gsc) {
  idb[lane] = m.id0;
  idb[64 + lane] = m.id1;
  if (PH == 0) {
    xq = m.xq;
  } else {
    alb[lane] = m.g0;
    alb[64 + lane] = m.g1;
    rmw = m.cur;
    gsc = m.g2;
  }
  WAVE_LDS_FENCE();
  const int es = lane >> 3;
#pragma unroll
  for (int i = 0; i < 16; i++) rr[i] = *(const uint4*)(tab + (size_t)idb[i * 8 + es] * 128);
}
template <int PH>
__device__ __forceinline__ void peer_compute(const P& p, int l, int t, bool valid, int k, int lane, const uint4* rr, const uint4& xq4, const float* alb, float2 rmw, float2 gsc) {
  const int es = lane >> 3;
  const int s0 = (PH == 0) ? 1 : 8, s1 = (PH == 0) ? 2 : 16, s2 = (PH == 0) ? 4 : 32;
  const bool c0 = (lane & s0) != 0, c1 = (lane & s1) != 0, c2 = (lane & s2) != 0;
  const int B = (c0 ? 8 : 0) + (c1 ? 4 : 0) + (c2 ? 2 : 0);
  float v[16];
  if (PH == 0) {
#pragma unroll
    for (int i = 0; i < 16; i++) {
      int a_ = __builtin_amdgcn_sdot4((int)rr[i].x, (int)xq4.x, 0, false);
      a_ = __builtin_amdgcn_sdot4((int)rr[i].y, (int)xq4.y, a_, false);
      a_ = __builtin_amdgcn_sdot4((int)rr[i].z, (int)xq4.z, a_, false);
      a_ = __builtin_amdgcn_sdot4((int)rr[i].w, (int)xq4.w, a_, false);
      v[i] = (float)a_;
    }
  } else {
    f32x2 acc[8];
#pragma unroll
    for (int i = 0; i < 8; i++) acc[i] = (f32x2){0.f, 0.f};
#pragma unroll
    for (int i = 0; i < 16; i++) axpy16_fp8(acc, alb[i * 8 + es], rr[i]);
#pragma unroll
    for (int i = 0; i < 8; i++) { v[2 * i] = acc[i].x; v[2 * i + 1] = acc[i].y; }
  }
  float k8[8], k4[4], k2[2];
#pragma unroll
  for (int i = 0; i < 8; i++) k8[i] = (c0 ? v[i + 8] : v[i]) + __shfl_xor(c0 ? v[i] : v[i + 8], s0);
#pragma unroll
  for (int i = 0; i < 4; i++) k4[i] = (c1 ? k8[i + 4] : k8[i]) + __shfl_xor(c1 ? k8[i] : k8[i + 4], s1);
#pragma unroll
  for (int i = 0; i < 2; i++) k2[i] = (c2 ? k4[i + 2] : k4[i]) + __shfl_xor(c2 ? k4[i] : k4[i + 2], s2);
  if (PH == 0) {
    float* hq = p.hp + ((size_t)t * 8 + k) * 128;
    if (valid) {
      hq[(B + 0) * 8 + es] = k2[0];
      hq[(B + 1) * 8 + es] = k2[1];
    }
  } else {
    const int col = k * 128 + (lane & 7) * 16 + B;
    float2* dst = (float2*)(t < ML_ROWS ? p.out + (size_t)t * 1024 + col : p.hc + (size_t)(t - ML_ROWS) * 1024 + col);
    float2 cur = rmw;
    cur.x += gsc.x * 0.125f * k2[0];
    cur.y += gsc.y * 0.125f * k2[1];
    if (valid) *dst = cur;
  }
}
template <int PH>
__device__ __forceinline__ void phase_peer_uv(const P& p, int l, char* smem) {
  const int tid = opaque_tid(), lane = tid & 63, w = tid >> 6;
  int* idA = (int*)smem + w * 512;
  int* idB = idA + 128;
  float* alA = (float*)(idA + 256);
  float* alB = alA + 128;
  const int nrows = (l == 1) ? ML_ROWS : MT_ROWS;
  const int k = blockIdx.x & 7;
  const int gw = (blockIdx.x >> 3) * 4 + w, ngw = (gridDim.x >> 3) * 4;
  const unsigned char* tab = (const unsigned char*)(PH == 0 ? p.Ub : p.Vb) + (size_t)((l * 8 + k) * 16384) * 128 + (lane & 7) * 16;
  PeerMeta M;
  uint4 rrA[16], rrB[16];
  uint4 xqA = make_uint4(0, 0, 0, 0), xqB = xqA;
  float2 rmA = make_float2(0.f, 0.f), rmB = rmA, gsA = rmA, gsB = rmA;
  if (gw >= nrows) return;
  const int nit = (nrows - gw + ngw - 1) / ngw;
  const int tlast = gw + (nit - 1) * ngw;
  peer_load_meta<PH>(p, l, gw, k, lane, M);
  peer_issue<PH>(M, idA, alA, tab, lane, rrA, xqA, rmA, gsA);
  peer_load_meta<PH>(p, l, min(gw + ngw, tlast), k, lane, M);
#pragma unroll 1
  for (int i = 0; i < nit; i += 2) {
    const int tA = gw + i * ngw, tB = tA + ngw;
    peer_issue<PH>(M, idB, alB, tab, lane, rrB, xqB, rmB, gsB);
    peer_load_meta<PH>(p, l, min(tB + ngw, tlast), k, lane, M);
    peer_compute<PH>(p, l, tA, true, k, lane, rrA, xqA, alA, rmA, gsA);
    peer_issue<PH>(M, idA, alA, tab, lane, rrA, xqA, rmA, gsA);
    peer_load_meta<PH>(p, l, min(tB + 2 * ngw, tlast), k, lane, M);
    peer_compute<PH>(p, l, min(tB, tlast), tB <= tlast, k, lane, rrB, xqB, alB, rmB, gsB);
  }
}

__device__ __forceinline__ void phase_peer_act(const P& p, int l) {
  const int tid = opaque_tid(), lane = tid & 63, w = tid >> 6;
  const int nrows = (l == 1) ? ML_ROWS : MT_ROWS;
  const int nw = gridDim.x * 4;
  for (int t = blockIdx.x * 4 + w; t < nrows; t += nw) {
    float h0 = 0.f, h1 = 0.f;
#pragma unroll
    for (int kk = 0; kk < 8; kk++) {
      h0 += p.hp[((size_t)t * 8 + kk) * 128 + lane];
      h1 += p.hp[((size_t)t * 8 + kk) * 128 + 64 + lane];
    }
    const float sxt = p.sx[t];
    const float s0 = p.slist[(size_t)t * 128 + lane] * sxt, s1 = p.slist[(size_t)t * 128 + 64 + lane] * sxt;
    const float g0 = p.glist[(size_t)t * 128 + lane], g1 = p.glist[(size_t)t * 128 + 64 + lane];
    p.glist[(size_t)t * 128 + lane] = gelu_tanh(h0 * s0) * g0;
    p.glist[(size_t)t * 128 + 64 + lane] = gelu_tanh(h1 * s1) * g1;
  }
}

#define RUN(k, call)                         \
  if (lo <= (k) && (k) < hi) {               \
    call;                                    \
    if ((k) + 1 < hi) xcd_barrier(xb);       \
  }
#define LAYER(l, base)                                                                                                    \
  RUN(base + 0, phase_norm(p, l, 1))                                                                                     \
  RUN(base + 1, phase_gemm<0>(p, l, p.xn, p.WinT + (size_t)l * INC_PAD * 1024, MT_ROWS / 128, INC_PAD / 128, smem))     \
  RUN(base + 2, phase_mixprep(p, l, smem))                                                                               \
  RUN(base + 3, phase_attn_mlA(p, l, smem))                                                                              \
  RUN(base + 4, phase_attn_mlB(p, l, smem))                                                                                            \
  RUN(base + 5, phase_mlC(p, l, smem))                                                                                   \
  RUN(base + 6, phase_gemm<1>(p, l, p.Y, p.WoutT + (size_t)l * 1024 * 1024, (l == 0 ? MT_ROWS : ML_ROWS) / 128, 8, smem)) \
  RUN(base + 7, phase_norm(p, l, 2))                                                                                     \
  RUN(base + 8, phase_gemm<2>(p, l, p.xn, p.WsT + (size_t)l * 2048 * 1024, (l == 0 ? MT_ROWS : ML_ROWS) / 128, 16, smem)) \
  RUN(base + 9, phase_peer_topk(p, l, smem))                                                                             \
  RUN(base + 10, phase_peer_uv<0>(p, l, smem))                                                                            \
  RUN(base + 11, phase_peer_act(p, l))                                                                                   \
  RUN(base + 12, phase_peer_uv<1>(p, l, smem))

__global__ void __launch_bounds__(256, 3) fwd_kernel(P p) {
  __shared__ __attribute__((aligned(16))) char smem[SMEM_BYTES];
  __shared__ uint4 xb_words;
  cg::grid_group grid = cg::this_grid();
  const int lo = (int)p.ph_lo, hi = (int)p.ph_hi;
  if (threadIdx.x == 0) xb_words = make_uint4(0u, 0u, 0u, 0u);
  __syncthreads();
  XcdBarrier xb = xcd_barrier_post(p.bar, (volatile LAS unsigned*)&xb_words);
  if (hi - lo > 1) grid.sync();
  RUN(0, phase_prologue(p, smem))
  LAYER(0, 1)
  LAYER(1, 14)
}

extern "C" void kernel_launch(void* const* d_in, const int* in_sizes, int n_in, void* d_out, int out_size, void* d_ws,
                              size_t ws_size, hipStream_t stream) {
  static int grid_blocks = 0;
  if (!grid_blocks) {
    int dev = 0, cus = 0, per_cu = 0;
    hipGetDevice(&dev);
    hipDeviceGetAttribute(&cus, hipDeviceAttributeMultiprocessorCount, dev);
    hipOccupancyMaxActiveBlocksPerMultiprocessor(&per_cu, fwd_kernel, 256, 0);
    if (per_cu < 1) per_cu = 1;
    if (per_cu > 3) per_cu = 3;
    grid_blocks = (cus * per_cu) & ~7;
  }
  P p{};
  const float** ins = (const float**)&p;
  for (int i = 0; i < 22; i++) ins[i] = (const float*)d_in[i];
  p.out = (float*)d_out;
  char* ws = (char*)d_ws;
  size_t off = 0;
  auto take = [&](size_t bytes) { char* r = ws + off; off += (bytes + 255) & ~(size_t)255; return r; };
  p.WinT = (u16*)take((size_t)2 * INC_PAD * 1024 * 2);
  p.WoutT = (u16*)take((size_t)2 * 1024 * 1024 * 2);
  p.WsT = (u16*)take((size_t)2 * 2048 * 1024 * 2);
  p.Ub = (u16*)take((size_t)2 * 16384 * 1024);
  p.Vb = (u16*)take((size_t)2 * 16384 * 1024);
  p.xq = (signed char*)take((size_t)MT_ROWS * 1024);
  p.sx = (float*)take((size_t)MT_ROWS * 4);
  p.su = (float*)take((size_t)2 * 16384 * 4);
  p.slist = (float*)take((size_t)MT_ROWS * 128 * 4);
  p.elist = (int*)take((size_t)MT_ROWS * 128 * 4);
  p.glist = (float*)take((size_t)MT_ROWS * 128 * 4);
  p.mod = (float*)take((size_t)2 * 9 * 6144 * 4);
  p.xn = (u16*)take((size_t)MT_ROWS * 1024 * 2);
  p.U = (u16*)take((size_t)MT_ROWS * INC * 2);
  p.MQK = (float*)take((size_t)MT_ROWS * 512 * 2);
  p.Y = (u16*)take((size_t)MT_ROWS * 1024 * 2);
  p.S = (float*)p.U;
  p.hp = (float*)take((size_t)MT_ROWS * 8 * 128 * 4);
  p.G = (float*)take((size_t)MT_ROWS * 16 * 4);
  p.mst = (float*)take((size_t)2304 * SLOT * 4);
  p.hc = (float*)take((size_t)MC_ROWS * 1024 * 4);
  p.bar = (unsigned*)take((size_t)XCD_BAR_WORDS * 4);
  p.VTm = (u16*)take((size_t)(8 * 4 * 64) * (2048 + 256) * 2);
  p.VT = (u16*)take((size_t)(8 * 8 * 64) * (2048 + 256) * 2);
  if (off > ws_size) { fprintf(stderr, "workspace too small: need %zu have %zu\n", off, ws_size); return; }
  (void)hipMemsetAsync(p.bar, 0, (size_t)XCD_BAR_WORDS * 4, stream);
#if MEGA
  p.ph_lo = 0; p.ph_hi = NPHASES;
  void* args[] = {&p};
  hipError_t e = hipLaunchCooperativeKernel((void*)fwd_kernel, dim3(grid_blocks), dim3(256), args, 0, stream);
  if (e != hipSuccess) fprintf(stderr, "cooperative launch failed: %s (grid %d)\n", hipGetErrorString(e), grid_blocks);
#else
  for (int ph = 0; ph < NPHASES; ph++) {
    p.ph_lo = ph; p.ph_hi = ph + 1;
    void* args[] = {&p};
    hipError_t e = hipLaunchCooperativeKernel((void*)fwd_kernel, dim3(grid_blocks), dim3(256), args, 0, stream);
    if (e != hipSuccess) fprintf(stderr, "cooperative launch failed: %s (grid %d)\n", hipGetErrorString(e), grid_blocks);
  }
#endif
}
```

```cpp
#include <hip/hip_runtime.h>
#include <hip/hip_cooperative_groups.h>
#include <cstdio>
namespace cg = cooperative_groups;

#ifndef MEGA
#define MEGA 1
#endif

typedef unsigned short u16;
typedef __attribute__((ext_vector_type(8))) short bf16x8;
typedef __attribute__((ext_vector_type(4))) float f32x4;

#define ML_ROWS 16384
#define MC_ROWS 2048
#define MT_ROWS 18432
#define INC 2832
#define INC_PAD 2944
#define SLOT 4480
#define SMEM_BYTES 49152
#define NPHASES 27

struct P {
  const float *x, *c, *ctx, *c_ctx, *w_ada, *b_ada, *norm1_g, *w_in, *ml_gate_b, *na_q_g, *na_k_g, *na_rpb,
      *pool_w, *pool_scale, *ml_conv, *ml_norm_g, *w_out, *norm2_g, *peer_wq, *peer_keys, *peer_u, *peer_v;
  float* out;
  u16 *WinT, *WoutT, *WsT, *Ub, *Vb;
  float* mod;
  u16* xn;
  u16* U;
  float* MQK;
  u16* Y;
  float* S;
  float* G;
  float* mst;
  float* hc;
  u16* VT;
  u16* VTm;
  signed char* xq;
  float* sx;
  float* su;
  float* slist;
  int* elist;
  float* glist;
  float* hp;
  unsigned* bar;
  long long ph_lo, ph_hi;
};

__device__ __forceinline__ u16 f2bf(float f) {
  unsigned u = __float_as_uint(f);
  u += 0x7fffu + ((u >> 16) & 1u);
  return (u16)(u >> 16);
}
__device__ __forceinline__ float bf2f(u16 h) { return __uint_as_float(((unsigned)h) << 16); }
__device__ __forceinline__ float bflo(unsigned u) { return __uint_as_float(u << 16); }
__device__ __forceinline__ float bfhi(unsigned u) { return __uint_as_float(u & 0xffff0000u); }
__device__ __forceinline__ unsigned pack2(float a, float b) { return (unsigned)f2bf(a) | ((unsigned)f2bf(b) << 16); }
__device__ __forceinline__ unsigned q8pack(float a, float b, float c, float d) {
  int qa = __float2int_rn(a), qb = __float2int_rn(b), qc = __float2int_rn(c), qd = __float2int_rn(d);
  return (unsigned)(qa & 0xff) | ((unsigned)(qb & 0xff) << 8) | ((unsigned)(qc & 0xff) << 16) | ((unsigned)(qd & 0xff) << 24);
}
__device__ __forceinline__ int opaque_tid() { int t = threadIdx.x; asm volatile("" : "+v"(t)); return t; }
__device__ __forceinline__ float wave_sum(float v) {
#pragma unroll
  for (int o = 32; o; o >>= 1) v += __shfl_xor(v, o);
  return v;
}
__device__ __forceinline__ void wave_argmax(float& v, int& i) {
#pragma unroll
  for (int o = 32; o; o >>= 1) {
    float ov = __shfl_xor(v, o);
    int oi = __shfl_xor(i, o);
    if (ov > v || (ov == v && oi < i)) { v = ov; i = oi; }
  }
}
__device__ __forceinline__ float sigmoidf_(float x) { return 1.f / (1.f + __expf(-x)); }
__device__ __forceinline__ float siluf_(float x) { return x / (1.f + __expf(-x)); }

#define XB_TMO      128
#define XB_XCNT(j)  (256  + 64 * (j))
#define XB_XSUB(j)  (1280 + 64 * (j))
#define XB_XGEN(j)  (2304 + 64 * (j))
#define XB_TOP      3328
#define XB_TOPGEN   3392
#define XCD_BAR_WORDS 3456
#define XB_SPIN_CAP (1u << 18)
#define LAS __attribute__((address_space(3)))
__device__ __forceinline__ unsigned xb_ld(unsigned* p)              { return __hip_atomic_load(p, __ATOMIC_RELAXED, __HIP_MEMORY_SCOPE_AGENT); }
__device__ __forceinline__ unsigned xb_add(unsigned* p, unsigned v) { return __hip_atomic_fetch_add(p, v, __ATOMIC_RELAXED, __HIP_MEMORY_SCOPE_AGENT); }
__device__ __forceinline__ unsigned xb_xcc_id() { return (unsigned)__builtin_amdgcn_s_getreg((3 << 11) | 20) & 0xFu; }
#define XB_SPIN(cond, bar) do { unsigned _sp = 0; while (cond) { __builtin_amdgcn_s_sleep(1); \
    if ((++_sp & 255u) == 0u) { if (xb_ld(&(bar)[XB_TMO])) break; if (_sp > XB_SPIN_CAP) { atomicAdd(&(bar)[XB_TMO], 1u); break; } } } } while (0)
struct XcdBarrier { unsigned* bar; unsigned x; volatile LAS unsigned* st; };
__device__ __forceinline__ XcdBarrier xcd_barrier_post(unsigned* bar, volatile LAS unsigned* st) {
    XcdBarrier b; b.bar = bar; b.x = xb_xcc_id(); b.st = st;
    if (threadIdx.x == 0) (void)xb_add(&bar[XB_XCNT(b.x)], 1u);
    return b;
}
__device__ __forceinline__ void xcd_barrier_complete(unsigned* bar, unsigned x, unsigned& nloc, unsigned& nx) {
    const unsigned G = gridDim.x * gridDim.y * gridDim.z;
    unsigned sum, cnt, mine, sp = 0u;
    for (;;) {
        sum = 0u; cnt = 0u; mine = 0u;
#pragma unroll
        for (unsigned j = 0; j < 16; ++j) { const unsigned c = xb_ld(&bar[XB_XCNT(j)]); sum += c; cnt += (c > 0u) ? 1u : 0u; mine = (j == x) ? c : mine; }
        if (sum == G) break;
        __builtin_amdgcn_s_sleep(1);
        if ((++sp & 255u) == 0u) { if (xb_ld(&bar[XB_TMO])) break; if (sp > XB_SPIN_CAP) { atomicAdd(&bar[XB_TMO], 1u); break; } }
    }
    nloc = mine > 0u ? mine : 1u; nx = cnt > 0u ? cnt : 1u;
}
__device__ __forceinline__ void xcd_barrier(const XcdBarrier& b) {
    asm volatile("s_waitcnt vmcnt(0)" ::: "memory");
    __syncthreads();
    if (threadIdx.x == 0) {
        unsigned* bar = b.bar;
        __builtin_amdgcn_s_waitcnt(0);
        unsigned nloc = b.st[0], nx = b.st[1];
        if (nloc == 0u) { xcd_barrier_complete(bar, b.x, nloc, nx); b.st[0] = nloc; b.st[1] = nx; }
        const unsigned old = xb_add(&bar[XB_XSUB(b.x)], 1u);
        const unsigned gen = old / nloc;
        if (old + 1u == (gen + 1u) * nloc) {
            __builtin_amdgcn_fence(__ATOMIC_RELEASE, "agent");
            asm volatile("s_waitcnt vmcnt(0)" ::: "memory");
            const unsigned og = xb_add(&bar[XB_TOP], 1u);
            const unsigned tg = og / nx;
            if (og + 1u == (tg + 1u) * nx) xb_add(&bar[XB_TOPGEN], 1u);
            else XB_SPIN(xb_ld(&bar[XB_TOPGEN]) == tg, bar);
            __builtin_amdgcn_fence(__ATOMIC_ACQUIRE, "agent");
            xb_add(&bar[XB_XGEN(b.x)], 1u);
            asm volatile("s_waitcnt vmcnt(0)" ::: "memory");
        } else {
            XB_SPIN(xb_ld(&bar[XB_XGEN(b.x)]) == gen, bar);
            __builtin_amdgcn_fence(__ATOMIC_ACQUIRE, "agent");
            asm volatile("s_waitcnt vmcnt(0)" ::: "memory");
        }
    }
    __syncthreads();
}

__device__ __forceinline__ void transpose_item(const float* __restrict__ src, int N, u16* __restrict__ dst, int kt, int nt, float* tl) {
  const int tid = opaque_tid();
#pragma unroll 4
  for (int i = 0; i < 16; i++) {
    int idx = tid + 256 * i;
    int kk = idx >> 6, nn = idx & 63;
    int n = nt * 64 + nn;
    float v = (n < N) ? src[(size_t)(kt * 64 + kk) * N + n] : 0.f;
    tl[kk * 65 + nn] = v;
  }
  __syncthreads();
#pragma unroll 4
  for (int i = 0; i < 16; i++) {
    int idx = tid + 256 * i;
    int nn = idx >> 6, kk = idx & 63;
    dst[(size_t)(nt * 64 + nn) * 1024 + kt * 64 + kk] = f2bf(tl[kk * 65 + nn]);
  }
  __syncthreads();
}

__device__ __forceinline__ void wst_item(const P& p, int it, float* sm) {
  (void)sm;
  const int tid = opaque_tid(), lane = tid & 63, w = tid >> 6, r = lane & 15, quad = lane >> 4;
  const int l = it >> 9, rem = it & 511, hp = rem >> 5, kt = (rem >> 2) & 7, dchunk = rem & 3;
  const float* wq = p.peer_wq + (size_t)l * 1024 * 2048 + hp * 128 + quad * 4;
  const float* keys = p.peer_keys + ((size_t)(l * 16 + hp) * 128 + kt * 16 + r) * 128 + quad * 4;
  const int dbase = dchunk * 256 + w * 64;
  f32x4 acc[4];
#pragma unroll
  for (int dt = 0; dt < 4; dt++) acc[dt] = (f32x4){0.f, 0.f, 0.f, 0.f};
#pragma unroll 2
  for (int jj = 0; jj < 8; jj++) {
    const float4 b4 = *(const float4*)(keys + jj * 16);
#pragma unroll
    for (int dt = 0; dt < 4; dt++) {
      const float4 a4 = *(const float4*)(wq + (size_t)(dbase + dt * 16 + r) * 2048 + jj * 16);
      acc[dt] = __builtin_amdgcn_mfma_f32_16x16x4f32(a4.x, b4.x, acc[dt], 0, 0, 0);
      acc[dt] = __builtin_amdgcn_mfma_f32_16x16x4f32(a4.y, b4.y, acc[dt], 0, 0, 0);
      acc[dt] = __builtin_amdgcn_mfma_f32_16x16x4f32(a4.z, b4.z, acc[dt], 0, 0, 0);
      acc[dt] = __builtin_amdgcn_mfma_f32_16x16x4f32(a4.w, b4.w, acc[dt], 0, 0, 0);
    }
  }
  u16* dst = p.WsT + (size_t)l * 2048 * 1024 + (size_t)(hp * 128 + kt * 16 + r) * 1024 + dbase + quad * 4;
#pragma unroll
  for (int dt = 0; dt < 4; dt++) {
    uint2 o;
    o.x = pack2(acc[dt][0], acc[dt][1]);
    o.y = pack2(acc[dt][2], acc[dt][3]);
    *(uint2*)(dst + dt * 16) = o;
  }
}

__device__ __forceinline__ void mod_item(const P& p, int it, float* sm) {
  const int tid = opaque_tid();
  int l = it / 96, cc = it % 96;
  float* sc = sm;
  float* red = sm + 9216;
  for (int idx = tid; idx < 9216; idx += 256) {
    int r = idx >> 10, k = idx & 1023;
    float v = (r < 8) ? p.c[r * 1024 + k] : p.c_ctx[k];
    sc[idx] = siluf_(v);
  }
  __syncthreads();
  int cl = tid & 63, kg = tid >> 6;
  int col = cc * 64 + cl;
  float acc[9];
#pragma unroll
  for (int r = 0; r < 9; r++) acc[r] = 0.f;
  const float* wa = p.w_ada + (size_t)l * 1024 * 6144;
#pragma unroll 16
  for (int k = kg * 256; k < kg * 256 + 256; k++) {
    float w = wa[(size_t)k * 6144 + col];
#pragma unroll
    for (int r = 0; r < 9; r++) acc[r] += sc[r * 1024 + k] * w;
  }
#pragma unroll
  for (int r = 0; r < 9; r++) red[(kg * 9 + r) * 64 + cl] = acc[r];
  __syncthreads();
  if (kg == 0) {
    float bb = p.b_ada[l * 6144 + col];
#pragma unroll
    for (int r = 0; r < 9; r++) {
      float s = red[(0 * 9 + r) * 64 + cl] + red[(1 * 9 + r) * 64 + cl] + red[(2 * 9 + r) * 64 + cl] + red[(3 * 9 + r) * 64 + cl];
      p.mod[(size_t)(l * 9 + r) * 6144 + col] = s + bb;
    }
  }
  __syncthreads();
}

__device__ __forceinline__ void phase_prologue(const P& p, char* smem) {
  float* sm = (float*)smem;
  const int tid = opaque_tid();
  const int N_A = 2 * 16 * 46, N_B = 2 * 16 * 16, N_C = 1024, N_D = 192, N_E = 4096;
  const int total = N_A + N_B + N_C + N_D + N_E;
  for (int item = blockIdx.x; item < total; item += gridDim.x) {
    int it = item;
    if (it < N_D) { mod_item(p, it, sm); continue; }
    it -= N_D;
    if (it < N_C) { wst_item(p, it, sm); continue; }
    it -= N_C;
    if (it < N_A) {
      int l = it / (16 * 46), r = it % (16 * 46);
      transpose_item(p.w_in + (size_t)l * 1024 * INC, INC, p.WinT + (size_t)l * INC_PAD * 1024, r / 46, r % 46, sm);
      continue;
    }
    it -= N_A;
    if (it < N_B) {
      int l = it >> 8, r = it & 255;
      transpose_item(p.w_out + (size_t)l * 1024 * 1024, 1024, p.WoutT + (size_t)l * 1024 * 1024, r >> 4, r & 15, sm);
      continue;
    }
    it -= N_B;
    {
      if ((it >> 11) == 0) {
        const int lane_ = tid & 63, w_ = tid >> 6;
        const int chunk_ = it & 2047;
#pragma unroll
        for (int rr = 0; rr < 4; rr++) {
          const int R = chunk_ * 16 + w_ * 4 + rr;
          const float4* src = (const float4*)(p.peer_u + (size_t)R * 1024 + lane_ * 16);
          typedef __attribute__((ext_vector_type(4))) float f4v;
          const f4v* s4 = (const f4v*)src;
          f4v t0 = __builtin_nontemporal_load(s4), t1 = __builtin_nontemporal_load(s4 + 1), t2 = __builtin_nontemporal_load(s4 + 2), t3 = __builtin_nontemporal_load(s4 + 3);
          float4 v0 = make_float4(t0[0], t0[1], t0[2], t0[3]), v1 = make_float4(t1[0], t1[1], t1[2], t1[3]), v2 = make_float4(t2[0], t2[1], t2[2], t2[3]), v3 = make_float4(t3[0], t3[1], t3[2], t3[3]);
          float mx = fmaxf(fmaxf(fmaxf(fabsf(v0.x), fabsf(v0.y)), fmaxf(fabsf(v0.z), fabsf(v0.w))), fmaxf(fmaxf(fabsf(v1.x), fabsf(v1.y)), fmaxf(fabsf(v1.z), fabsf(v1.w))));
          mx = fmaxf(mx, fmaxf(fmaxf(fmaxf(fabsf(v2.x), fabsf(v2.y)), fmaxf(fabsf(v2.z), fabsf(v2.w))), fmaxf(fmaxf(fabsf(v3.x), fabsf(v3.y)), fmaxf(fabsf(v3.z), fabsf(v3.w)))));
#pragma unroll
          for (int o = 32; o; o >>= 1) mx = fmaxf(mx, __shfl_xor(mx, o));
          const float inv = mx > 0.f ? 127.f / mx : 0.f;
          uint4 o;
          o.x = q8pack(v0.x * inv, v0.y * inv, v0.z * inv, v0.w * inv);
          o.y = q8pack(v1.x * inv, v1.y * inv, v1.z * inv, v1.w * inv);
          o.z = q8pack(v2.x * inv, v2.y * inv, v2.z * inv, v2.w * inv);
          o.w = q8pack(v3.x * inv, v3.y * inv, v3.z * inv, v3.w * inv);
          const unsigned ll = (unsigned)R >> 14, ee = (unsigned)R & 16383u;
          size_t off = ((size_t)((ll * 8u + (unsigned)(lane_ >> 3)) * 16384u + ee)) * 128 + (lane_ & 7) * 16;
          *(uint4*)((unsigned char*)p.Ub + off) = o;
          if (lane_ == 0) p.su[R] = mx * (1.f / 127.f);
        }
        continue;
      }
      int tab = it >> 11;
      int chunk = it & 2047;
      const float scl = tab ? 8.f : 64.f;
      const float4* src = (const float4*)(tab ? p.peer_v : p.peer_u) + (size_t)chunk * 4096;
      unsigned char* dstb = (unsigned char*)(tab ? p.Vb : p.Ub);
#pragma unroll
      for (int i = 0; i < 4; i++) {
        int q = i * 256 + tid;
        typedef __attribute__((ext_vector_type(4))) float f4v;
        const f4v* s4 = (const f4v*)src + q * 4;
        f4v t0 = __builtin_nontemporal_load(s4), t1 = __builtin_nontemporal_load(s4 + 1), t2 = __builtin_nontemporal_load(s4 + 2), t3 = __builtin_nontemporal_load(s4 + 3);
        float4 v0 = make_float4(t0[0], t0[1], t0[2], t0[3]), v1 = make_float4(t1[0], t1[1], t1[2], t1[3]), v2 = make_float4(t2[0], t2[1], t2[2], t2[3]), v3 = make_float4(t3[0], t3[1], t3[2], t3[3]);
        uint4 o;
        int w_;
        w_ = __builtin_amdgcn_cvt_pk_fp8_f32(v0.x * scl, v0.y * scl, 0, false);
        w_ = __builtin_amdgcn_cvt_pk_fp8_f32(v0.z * scl, v0.w * scl, w_, true);
        o.x = (unsigned)w_;
        w_ = __builtin_amdgcn_cvt_pk_fp8_f32(v1.x * scl, v1.y * scl, 0, false);
        w_ = __builtin_amdgcn_cvt_pk_fp8_f32(v1.z * scl, v1.w * scl, w_, true);
        o.y = (unsigned)w_;
        w_ = __builtin_amdgcn_cvt_pk_fp8_f32(v2.x * scl, v2.y * scl, 0, false);
        w_ = __builtin_amdgcn_cvt_pk_fp8_f32(v2.z * scl, v2.w * scl, w_, true);
        o.z = (unsigned)w_;
        w_ = __builtin_amdgcn_cvt_pk_fp8_f32(v3.x * scl, v3.y * scl, 0, false);
        w_ = __builtin_amdgcn_cvt_pk_fp8_f32(v3.z * scl, v3.w * scl, w_, true);
        o.w = (unsigned)w_;
        {
          unsigned G = (unsigned)chunk * 1024u + (unsigned)q;
          unsigned ll = G >> 20, ee = (G >> 6) & 16383u, cgp = G & 63u;
          size_t off = ((size_t)((ll * 8u + (cgp >> 3)) * 16384u + ee)) * 128 + (cgp & 7u) * 16;
          *(uint4*)(dstb + off) = o;
        }
      }
    }
  }
}

__device__ __forceinline__ void phase_norm(const P& p, int l, int which) {
  const int tid = opaque_tid(), lane = tid & 63, w = tid >> 6;
  const int nrows = (which == 2 && l == 1) ? ML_ROWS : MT_ROWS;
  const float* g = (which == 1 ? p.norm1_g : p.norm2_g) + l * 1024;
  for (int item = blockIdx.x; item * 4 < nrows; item += gridDim.x) {
    int row = item * 4 + w;
    const float* src;
    if (l == 0 && which == 1) src = row < ML_ROWS ? p.x + (size_t)row * 1024 : p.ctx + (size_t)(row - ML_ROWS) * 1024;
    else src = row < ML_ROWS ? p.out + (size_t)row * 1024 : p.hc + (size_t)(row - ML_ROWS) * 1024;
    int mr = row < ML_ROWS ? (row >> 11) : 8;
    const float* modp = p.mod + (size_t)(l * 9 + mr) * 6144;
    const float* sh = modp + (which == 1 ? 0 : 3072);
    const float* sc = modp + (which == 1 ? 1024 : 4096);
    float4 v[4];
    float ss = 0.f;
#pragma unroll
    for (int i = 0; i < 4; i++) {
      v[i] = ((const float4*)src)[i * 64 + lane];
      ss += v[i].x * v[i].x + v[i].y * v[i].y + v[i].z * v[i].z + v[i].w * v[i].w;
    }
    ss = wave_sum(ss);
    float rs = rsqrtf(ss * (1.f / 1024.f) + 1e-6f);
    float ov[16];
    float omax = 0.f;
#pragma unroll
    for (int i = 0; i < 4; i++) {
      int d = (i * 64 + lane) * 4;
      float4 gg = *(const float4*)(g + d);
      float4 s4 = *(const float4*)(sc + d);
      float4 h4 = *(const float4*)(sh + d);
      float o0 = v[i].x * rs * gg.x * (1.f + s4.x) + h4.x;
      float o1 = v[i].y * rs * gg.y * (1.f + s4.y) + h4.y;
      float o2 = v[i].z * rs * gg.z * (1.f + s4.z) + h4.z;
      float o3 = v[i].w * rs * gg.w * (1.f + s4.w) + h4.w;
      uint2 o;
      o.x = pack2(o0, o1);
      o.y = pack2(o2, o3);
      ((uint2*)(p.xn + (size_t)row * 1024))[i * 64 + lane] = o;
      ov[i * 4 + 0] = o0; ov[i * 4 + 1] = o1; ov[i * 4 + 2] = o2; ov[i * 4 + 3] = o3;
      omax = fmaxf(omax, fmaxf(fmaxf(fabsf(o0), fabsf(o1)), fmaxf(fabsf(o2), fabsf(o3))));
    }
    if (which == 2) {
#pragma unroll
      for (int o = 32; o; o >>= 1) omax = fmaxf(omax, __shfl_xor(omax, o));
      const float inv = omax > 0.f ? 127.f / omax : 0.f;
#pragma unroll
      for (int i = 0; i < 4; i++)
        ((unsigned*)(p.xq + (size_t)row * 1024))[i * 64 + lane] = q8pack(ov[i * 4] * inv, ov[i * 4 + 1] * inv, ov[i * 4 + 2] * inv, ov[i * 4 + 3] * inv);
      if (lane == 0) p.sx[row] = omax * (1.f / 127.f);
    }
  }
}

template <int EPI>
__device__ __forceinline__ void phase_gemm(const P& p, int l, const u16* __restrict__ A, const u16* __restrict__ Bt, int mtiles, int ntiles,
                           char* smem) {
  u16* As = (u16*)smem;
  u16* Bs = As + 128 * 72;
  const int tid = opaque_tid(), lane = tid & 63, w = tid >> 6, wm = w >> 1, wn = w & 1;
  const int lr = lane & 15, quad = lane >> 4;
  const int xk = blockIdx.x & 7, lb = blockIdx.x >> 3, nb = gridDim.x >> 3;
  const int mg = xk >> 1;
  const int nh0 = (ntiles + 1) >> 1;
  const int nbase = (xk & 1) ? nh0 : 0, nloc = (xk & 1) ? (ntiles - nh0) : nh0;
  const int mcount = (mtiles - mg + 3) >> 2;
  const int nlocal = mcount * nloc;
  for (int li = lb; li < nlocal; li += nb) {
    int mi = li / nloc;
    int mt = mg + 4 * mi, nt = nbase + (li - mi * nloc);
    int m0 = mt * 128, n0 = nt * 128;
    f32x4 acc[4][4];
#pragma unroll
    for (int i = 0; i < 4; i++)
#pragma unroll
      for (int j = 0; j < 4; j++) acc[i][j] = (f32x4){0.f, 0.f, 0.f, 0.f};
    const int r0_ = tid >> 3, ch_ = tid & 7;
    const u16* Ap0 = A + (size_t)(m0 + r0_) * 1024 + ch_ * 8;
    const u16* Bp0 = Bt + (size_t)(n0 + r0_) * 1024 + ch_ * 8;
    uint4 ra0 = *(const uint4*)Ap0, ra1 = *(const uint4*)(Ap0 + 32 * 1024), ra2 = *(const uint4*)(Ap0 + 64 * 1024), ra3 = *(const uint4*)(Ap0 + 96 * 1024);
    uint4 rb0 = *(const uint4*)Bp0, rb1 = *(const uint4*)(Bp0 + 32 * 1024), rb2 = *(const uint4*)(Bp0 + 64 * 1024), rb3 = *(const uint4*)(Bp0 + 96 * 1024);
    for (int kt = 0; kt < 16; kt++) {
      __syncthreads();
      *(uint4*)(As + r0_ * 72 + ch_ * 8) = ra0;
      *(uint4*)(As + (r0_ + 32) * 72 + ch_ * 8) = ra1;
      *(uint4*)(As + (r0_ + 64) * 72 + ch_ * 8) = ra2;
      *(uint4*)(As + (r0_ + 96) * 72 + ch_ * 8) = ra3;
      *(uint4*)(Bs + r0_ * 72 + ch_ * 8) = rb0;
      *(uint4*)(Bs + (r0_ + 32) * 72 + ch_ * 8) = rb1;
      *(uint4*)(Bs + (r0_ + 64) * 72 + ch_ * 8) = rb2;
      *(uint4*)(Bs + (r0_ + 96) * 72 + ch_ * 8) = rb3;
      __syncthreads();
      if (kt < 15) {
        const int ko = (kt + 1) * 64;
        ra0 = *(const uint4*)(Ap0 + ko); ra1 = *(const uint4*)(Ap0 + 32 * 1024 + ko); ra2 = *(const uint4*)(Ap0 + 64 * 1024 + ko); ra3 = *(const uint4*)(Ap0 + 96 * 1024 + ko);
        rb0 = *(const uint4*)(Bp0 + ko); rb1 = *(const uint4*)(Bp0 + 32 * 1024 + ko); rb2 = *(const uint4*)(Bp0 + 64 * 1024 + ko); rb3 = *(const uint4*)(Bp0 + 96 * 1024 + ko);
      }
#pragma unroll
      for (int ks = 0; ks < 2; ks++) {
        bf16x8 a[4], b[4];
#pragma unroll
        for (int i = 0; i < 4; i++) {
          a[i] = *(const bf16x8*)(As + (wm * 64 + i * 16 + lr) * 72 + ks * 32 + quad * 8);
          b[i] = *(const bf16x8*)(Bs + (wn * 64 + i * 16 + lr) * 72 + ks * 32 + quad * 8);
        }
#pragma unroll
        for (int i = 0; i < 4; i++)
#pragma unroll
          for (int j = 0; j < 4; j++) acc[i][j] = __builtin_amdgcn_mfma_f32_16x16x32_bf16(b[j], a[i], acc[i][j], 0, 0, 0);
      }
    }
#pragma unroll
    for (int i = 0; i < 4; i++)
#pragma unroll
      for (int j = 0; j < 4; j++) {
        const int row = m0 + wm * 64 + i * 16 + lr;
        const int col = n0 + wn * 64 + j * 16 + quad * 4;
        const f32x4 v = acc[i][j];
        if (EPI == 0) {
          if (col < INC) {
            uint2 o;
            o.x = pack2(v[0], v[1]);
            o.y = pack2(v[2], v[3]);
            *(uint2*)(p.U + (size_t)row * INC + col) = o;
            if (col >= 2816) *(float4*)(p.G + row * 16 + (col - 2816)) = make_float4(v[0], v[1], v[2], v[3]);
          }
        } else if (EPI == 1) {
          const int mr = row < ML_ROWS ? (row >> 11) : 8;
          const float4 g1 = *(const float4*)(p.mod + (size_t)(l * 9 + mr) * 6144 + 2048 + col);
          float4 sv;
          if (l == 0) sv = row < ML_ROWS ? *(const float4*)(p.x + (size_t)row * 1024 + col) : *(const float4*)(p.ctx + (size_t)(row - ML_ROWS) * 1024 + col);
          else sv = *(const float4*)(p.out + (size_t)row * 1024 + col);
          float* dst = row < ML_ROWS ? p.out + (size_t)row * 1024 + col : p.hc + (size_t)(row - ML_ROWS) * 1024 + col;
          *(float4*)dst = make_float4(sv.x + g1.x * v[0], sv.y + g1.y * v[1], sv.z + g1.z * v[2], sv.w + g1.w * v[3]);
        } else {
          *(float4*)(p.S + (size_t)row * 2048 + col) = make_float4(v[0], v[1], v[2], v[3]);
        }
      }
  }
}

__device__ __forceinline__ void vt_item(const P& p, int it, u16* tl);
__device__ __forceinline__ void phase_mixprep(const P& p, int l, char* smem) {
  float* pl = (float*)smem;
  const int N_QK = MT_ROWS * 16 / 256;
  const int N_POOL = (l == 0 ? MT_ROWS : ML_ROWS) / 16;
  const int N_PREP = MT_ROWS / 4;
  const int N_VT = 2304 + 1152;
  const int total = N_QK + N_POOL + N_PREP + N_VT;
  for (int item = blockIdx.x; item < total; item += gridDim.x) {
    const int tid = opaque_tid();
    int it = item;
    if (it >= N_QK + N_POOL + N_PREP) { vt_item(p, it - (N_QK + N_POOL + N_PREP), (u16*)smem); continue; }
    if (it < N_QK) {
      int gi = it * 256 + tid;
      int row = gi >> 4, sub = gi & 15;
      int qk = sub >> 3, h = sub & 7;
      u16* ptr = p.U + (size_t)row * INC + qk * 512 + h * 64;
      const float* g = (qk ? p.na_k_g : p.na_q_g) + l * 64;
      uint4 v[8];
      float ss = 0.f;
#pragma unroll
      for (int c = 0; c < 8; c++) {
        v[c] = ((const uint4*)ptr)[c];
        float a;
        a = bflo(v[c].x); ss += a * a; a = bfhi(v[c].x); ss += a * a;
        a = bflo(v[c].y); ss += a * a; a = bfhi(v[c].y); ss += a * a;
        a = bflo(v[c].z); ss += a * a; a = bfhi(v[c].z); ss += a * a;
        a = bflo(v[c].w); ss += a * a; a = bfhi(v[c].w); ss += a * a;
      }
      float rs = rsqrtf(ss * (1.f / 64.f) + 1e-6f);
#pragma unroll
      for (int c = 0; c < 8; c++) {
        uint4 o;
        o.x = pack2(bflo(v[c].x) * rs * g[c * 8 + 0], bfhi(v[c].x) * rs * g[c * 8 + 1]);
        o.y = pack2(bflo(v[c].y) * rs * g[c * 8 + 2], bfhi(v[c].y) * rs * g[c * 8 + 3]);
        o.z = pack2(bflo(v[c].z) * rs * g[c * 8 + 4], bfhi(v[c].z) * rs * g[c * 8 + 5]);
        o.w = pack2(bflo(v[c].w) * rs * g[c * 8 + 6], bfhi(v[c].w) * rs * g[c * 8 + 7]);
        ((uint4*)ptr)[c] = o;
      }
      continue;
    }
    it -= N_QK;
    if (it < N_POOL) {
      int row0 = it * 16;
      int base, T;
      if (row0 < ML_ROWS) { base = (row0 >> 11) << 11; T = 2048; }
      else { base = ML_ROWS + (((row0 - ML_ROWS) >> 8) << 8); T = 256; }
      int t0 = row0 - base;
      int ch = tid, g = ch >> 6;
      int wdw = 2 << g;
      __syncthreads();
      {
        float vals[31];
#pragma unroll
        for (int j = 0; j < 31; j++) {
          int tau = t0 - 8 + j;
          bool ok = (tau >= 0) && (tau < T);
          vals[j] = ok ? bf2f(p.U[(size_t)(base + (ok ? tau : t0)) * INC + 1536 + ch]) : 0.f;
        }
        const int hl = wdw / 2, hr = wdw - wdw / 2 - 1;
#pragma unroll
        for (int tt = 0; tt < 16; tt++) {
          int t = t0 + tt;
          int lo = max(t - hl, 0), hi = min(t + hr, T - 1);
          float s = 0.f;
#pragma unroll
          for (int j = 0; j < 31; j++) {
            int rel = j - 8 - tt;
            if (rel >= -8 && rel <= 7) s += (rel >= -hl && rel <= hr) ? vals[j] : 0.f;
          }
          pl[tt * 256 + ch] = s / (float)(hi - lo + 1) - vals[8 + tt];
        }
      }
      __syncthreads();
      float acc[16];
#pragma unroll
      for (int tt = 0; tt < 16; tt++) acc[tt] = 0.f;
      int d = ch & 63;
      const float* pw = p.pool_w + ((size_t)(l * 4 + g) * 64) * 64 + d;
      for (int c = 0; c < 64; c++) {
        float wv = pw[c * 64];
#pragma unroll
        for (int tt = 0; tt < 16; tt++) acc[tt] += pl[tt * 256 + g * 64 + c] * wv;
      }
      float ps = p.pool_scale[l * 256 + ch];
#pragma unroll
      for (int tt = 0; tt < 16; tt++) p.Y[(size_t)(row0 + tt) * 1024 + 512 + ch] = f2bf(acc[tt] * ps);
      continue;
    }
    it -= N_POOL;
    {
      const int row0 = it * 4;
      int base, T;
      if (row0 < ML_ROWS) { base = (row0 >> 11) << 11; T = 2048; }
      else { base = ML_ROWS + (((row0 - ML_ROWS) >> 8) << 8); T = 256; }
      const int t0 = row0 - base;
      const int qk = tid >> 7, hh = (tid >> 5) & 3, ax = (tid >> 4) & 1, f = tid & 15;
      const int ca = qk * 256 + hh * 64 + ax * 32 + f, cb = ca + 16;
      float ua[8], ub[8];
#pragma unroll
      for (int j = 0; j < 8; j++) {
        int tt = t0 + j - 2;
        bool ok = (tt >= 0) && (tt < T);
        const u16* ur = p.U + (size_t)(base + (ok ? tt : t0)) * INC + 1792;
        ua[j] = ok ? bf2f(ur[ca]) : 0.f;
        ub[j] = ok ? bf2f(ur[cb]) : 0.f;
      }
      float wa[5], wb[5];
#pragma unroll
      for (int j = 0; j < 5; j++) { wa[j] = p.ml_conv[(l * 5 + j) * 512 + ca]; wb[j] = p.ml_conv[(l * 5 + j) * 512 + cb]; }
      const float inv = __expf(-(float)f * (9.210340371976184f / 16.f));
#pragma unroll
      for (int i = 0; i < 4; i++) {
        float a = 0.f, b = 0.f;
#pragma unroll
        for (int j = 0; j < 5; j++) { a += wa[j] * ua[i + j]; b += wb[j] * ub[i + j]; }
        a = siluf_(a);
        b = siluf_(b);
        if (row0 < ML_ROWS) {
          int t = t0 + i;
          float pos = (float)(ax == 0 ? (t >> 6) : (t & 63));
          float ang = pos * inv;
          float cs = __cosf(ang), sn = __sinf(ang);
          float oa = a * cs - b * sn, ob = a * sn + b * cs;
          a = oa; b = ob;
        }
        if (qk) { a *= 0.125f; b *= 0.125f; }
        ((u16*)p.MQK)[(size_t)(row0 + i) * 512 + ca] = f2bf(a);
        ((u16*)p.MQK)[(size_t)(row0 + i) * 512 + cb] = f2bf(b);
      }
      if (tid < 64) {
        int gi = tid & 15;
        float gv = p.G[row0 * 16 + tid] + p.ml_gate_b[l * 16 + gi];
        if ((gi >> 2) & 1) gv = fminf(gv, 0.f) - log1pf(__expf(-fabsf(gv)));
        p.G[row0 * 16 + tid] = gv;
      }
    }
  }
}

#define VT_CTX_OFF ((size_t)8 * 8 * 64 * 2048)
#define VTM_CTX_OFF ((size_t)8 * 4 * 64 * 2048)
__device__ __forceinline__ void vt_item(const P& p, int it, u16* tl) {
  const int tid = opaque_tid();
  int b, h, tt, row0, TK, col0;
  u16* dst;
  if (it < 2048) { b = it >> 8; h = (it >> 5) & 7; tt = it & 31; row0 = b * 2048 + tt * 64; TK = 2048; col0 = 1024 + h * 64; dst = p.VT + (size_t)((b * 8 + h) * 64) * 2048 + tt * 64; }
  else if (it < 2304) { int ci = it - 2048; b = ci >> 5; h = (ci >> 2) & 7; tt = ci & 3; row0 = ML_ROWS + b * 256 + tt * 64; TK = 256; col0 = 1024 + h * 64; dst = p.VT + VT_CTX_OFF + (size_t)((b * 8 + h) * 64) * 256 + tt * 64; }
  else if (it < 2304 + 1024) { int mi = it - 2304; b = mi >> 7; h = (mi >> 5) & 3; tt = mi & 31; row0 = b * 2048 + tt * 64; TK = 2048; col0 = 2304 + h * 64; dst = p.VTm + (size_t)((b * 4 + h) * 64) * 2048 + tt * 64; }
  else { int mi = it - 3328; b = mi >> 4; h = (mi >> 2) & 3; tt = mi & 3; row0 = ML_ROWS + b * 256 + tt * 64; TK = 256; col0 = 2304 + h * 64; dst = p.VTm + VTM_CTX_OFF + (size_t)((b * 4 + h) * 64) * 256 + tt * 64; }
  __syncthreads();
  {
    int i = tid >> 2, part = tid & 3;
    const uint4* src = (const uint4*)(p.U + (size_t)(row0 + i) * INC + col0 + part * 16);
    uint4 v0 = src[0], v1 = src[1];
    unsigned* t32 = (unsigned*)(tl + i * 66 + part * 16);
    t32[0] = v0.x; t32[1] = v0.y; t32[2] = v0.z; t32[3] = v0.w;
    t32[4] = v1.x; t32[5] = v1.y; t32[6] = v1.z; t32[7] = v1.w;
  }
  __syncthreads();
  {
    int d = tid >> 2, part = tid & 3;
    unsigned o[8];
#pragma unroll
    for (int k = 0; k < 8; k++) {
      unsigned lo = tl[(part * 16 + 2 * k) * 66 + d], hi = tl[(part * 16 + 2 * k + 1) * 66 + d];
      o[k] = lo | (hi << 16);
    }
    uint4* dp = (uint4*)(dst + (size_t)d * TK + part * 16);
    dp[0] = make_uint4(o[0], o[1], o[2], o[3]);
    dp[1] = make_uint4(o[4], o[5], o[6], o[7]);
  }
}

__device__ __forceinline__ void attn_item(const P& p, int l, int item, float* sb) {
  const int tid = opaque_tid(), lane = tid & 63, w = tid >> 6, q = lane & 15, quad = lane >> 4;
  const bool latent = item < 2048;
  int b, r = 0, h, qb = 0;
  if (latent) { b = item >> 8; r = (item >> 3) & 31; h = item & 7; }
  else { int ci = item - 2048; b = ci >> 5; qb = (ci >> 3) & 3; h = ci & 7; }
  const int r0 = min(max(r - 4, 0), 24);
  __syncthreads();
  if (latent) {
    int kr = tid >> 5, j = tid & 31;
    if (j < 31) sb[tid] = p.na_rpb[(size_t)((l * 8 + h) * 15 + (r0 + kr - r + 7)) * 31 + j];
  }
  __syncthreads();
  const int qc = w * 16 + q;
  const int qrow = latent ? (b * 2048 + r * 64 + qc) : (ML_ROWS + b * 256 + qb * 64 + qc);
  const int cs = (w == 0) ? 0 : (w == 1) ? 8 : (w == 2) ? 24 : 32;
  const int c0 = min(max(qc - 8, 0), 48);
  const bf16x8 bq0 = *(const bf16x8*)(p.U + (size_t)qrow * INC + h * 64 + quad * 8);
  const bf16x8 bq1 = *(const bf16x8*)(p.U + (size_t)qrow * INC + h * 64 + 32 + quad * 8);
  const int mrow = (q >> 2) * 8 + (q & 3);
  const u16* vt_lat = p.VT + (size_t)((b * 8 + h) * 64 + q) * 2048 + quad * 8;
  const u16* vt_ctx = p.VT + VT_CTX_OFF + (size_t)((b * 8 + h) * 64 + q) * 256 + quad * 8;
  float m = -INFINITY, lsum = 0.f;
  f32x4 o[4];
#pragma unroll
  for (int dt = 0; dt < 4; dt++) o[dt] = (f32x4){0.f, 0.f, 0.f, 0.f};
#pragma unroll 1
  for (int chunk = (latent ? 0 : 2); chunk < 4; chunk++) {
    f32x4 s[4][2];
#pragma unroll
    for (int blk = 0; blk < 4; blk++) {
      int rowbase = (chunk < 2) ? (b * 2048 + (r0 + chunk * 4 + blk) * 64 + cs) : (ML_ROWS + b * 256 + (chunk - 2) * 128 + blk * 32);
#pragma unroll
      for (int T = 0; T < 2; T++) {
        const u16* kp = p.U + (size_t)(rowbase + mrow + T * 4) * INC + 512 + h * 64 + quad * 8;
        bf16x8 a0 = *(const bf16x8*)kp;
        bf16x8 a1 = *(const bf16x8*)(kp + 32);
        f32x4 acc = (f32x4){0.f, 0.f, 0.f, 0.f};
        acc = __builtin_amdgcn_mfma_f32_16x16x32_bf16(a0, bq0, acc, 0, 0, 0);
        acc = __builtin_amdgcn_mfma_f32_16x16x32_bf16(a1, bq1, acc, 0, 0, 0);
        s[blk][T] = acc;
      }
    }
    float mx = -INFINITY;
    if (chunk < 2) {
#pragma unroll
      for (int blk = 0; blk < 4; blk++)
#pragma unroll
        for (int T = 0; T < 2; T++)
#pragma unroll
          for (int rr = 0; rr < 4; rr++) {
            int kc = cs + quad * 8 + T * 4 + rr;
            bool valid = (kc >= c0) && (kc < c0 + 16);
            int bi = (chunk * 4 + blk) * 32 + min(max(kc - qc + 15, 0), 30);
            float v = valid ? (s[blk][T][rr] * 0.125f + sb[bi]) : -INFINITY;
            s[blk][T][rr] = v;
            mx = fmaxf(mx, v);
          }
    } else {
#pragma unroll
      for (int blk = 0; blk < 4; blk++)
#pragma unroll
        for (int T = 0; T < 2; T++)
#pragma unroll
          for (int rr = 0; rr < 4; rr++) {
            float v = s[blk][T][rr] * 0.125f;
            s[blk][T][rr] = v;
            mx = fmaxf(mx, v);
          }
    }
    mx = fmaxf(mx, __shfl_xor(mx, 16));
    mx = fmaxf(mx, __shfl_xor(mx, 32));
    float mn = fmaxf(m, mx);
    float sc = __expf(m - mn);
    lsum *= sc;
#pragma unroll
    for (int dt = 0; dt < 4; dt++) o[dt] *= sc;
    m = mn;
#pragma unroll
    for (int blk = 0; blk < 4; blk++) {
      float pv[8];
#pragma unroll
      for (int T = 0; T < 2; T++)
#pragma unroll
        for (int rr = 0; rr < 4; rr++) {
          float e = __expf(s[blk][T][rr] - mn);
          pv[T * 4 + rr] = e;
          lsum += e;
        }
      union { bf16x8 v; unsigned u[4]; } pk;
      pk.u[0] = pack2(pv[0], pv[1]); pk.u[1] = pack2(pv[2], pv[3]); pk.u[2] = pack2(pv[4], pv[5]); pk.u[3] = pack2(pv[6], pv[7]);
      const u16* vb = (chunk < 2) ? (vt_lat + (r0 + chunk * 4 + blk) * 64 + cs) : (vt_ctx + (chunk - 2) * 128 + blk * 32);
      const size_t dstr = (chunk < 2) ? (size_t)16 * 2048 : (size_t)16 * 256;
#pragma unroll
      for (int dt = 0; dt < 4; dt++) {
        bf16x8 av = *(const bf16x8*)(vb + dt * dstr);
        o[dt] = __builtin_amdgcn_mfma_f32_16x16x32_bf16(av, pk.v, o[dt], 0, 0, 0);
      }
    }
  }
  lsum += __shfl_xor(lsum, 16);
  lsum += __shfl_xor(lsum, 32);
  float il = 1.f / lsum;
#pragma unroll
  for (int dt = 0; dt < 4; dt++) {
    uint2 ov;
    ov.x = pack2(o[dt][0] * il, o[dt][1] * il);
    ov.y = pack2(o[dt][2] * il, o[dt][3] * il);
    *(uint2*)(p.Y + (size_t)qrow * 1024 + h * 64 + dt * 16 + quad * 4) = ov;
  }
}

__device__ __forceinline__ int ml_row(int b, int dir, int j, int pp) {
  if (j < 4) {
    int pos = j * 64 + pp;
    int t = dir ? 255 - pos : pos;
    return ML_ROWS + b * 256 + t;
  } else {
    int pos = (j - 4) * 64 + pp;
    int t = dir ? 2047 - pos : pos;
    return b * 2048 + t;
  }
}

__device__ __forceinline__ void mlstmA_item(const P& p, int it, float* sm) {
  const int tid = opaque_tid(), lane = tid & 63;
  int seq = it / 36, j = it % 36;
  int b = seq >> 3, h = (seq >> 1) & 3, dir = seq & 1;
  float* ks = sm;
  float* vs = sm + 64 * 65;
  float* wsm = sm + 2 * 64 * 65;
  float* slot = p.mst + (size_t)it * SLOT;
  const u16* mqk = (const u16*)p.MQK;
  __syncthreads();
  for (int idx = tid; idx < 4096; idx += 256) {
    int pp = idx >> 6, d = idx & 63;
    int row = ml_row(b, dir, j, pp);
    ks[pp * 65 + d] = bf2f(mqk[(size_t)row * 512 + 256 + h * 64 + d]);
    vs[pp * 65 + d] = bf2f(p.U[(size_t)row * INC + 2304 + h * 64 + d]);
  }
  if (tid < 64) {
    int row = ml_row(b, dir, j, lane);
    float ic = p.G[row * 16 + (dir * 2) * 4 + h];
    float fc = p.G[row * 16 + (dir * 2 + 1) * 4 + h];
    float bbv = fc;
#pragma unroll
    for (int o = 1; o < 64; o <<= 1) { float u = __shfl_up(bbv, o); if (lane >= o) bbv += u; }
    float cs = ic - bbv;
    float pm = cs;
#pragma unroll
    for (int o = 1; o < 64; o <<= 1) { float u = __shfl_up(pm, o); if (lane >= o) pm = fmaxf(pm, u); }
    float bl = __shfl(bbv, 63);
    float ml = __shfl(pm, 63) + bl;
    wsm[lane] = __expf(bl + cs - ml);
    slot[4224 + lane] = bbv;
    slot[4288 + lane] = cs;
    slot[4352 + lane] = pm;
    if (lane == 0) { slot[4160] = bl; slot[4161] = ml; }
  }
  __syncthreads();
  {
    int e = tid & 63, dg = tid >> 6;
    float acc[16];
#pragma unroll
    for (int dd = 0; dd < 16; dd++) acc[dd] = 0.f;
    for (int pp = 0; pp < 64; pp++) {
      float wv = wsm[pp] * vs[pp * 65 + e];
#pragma unroll
      for (int dd = 0; dd < 16; dd++) acc[dd] += ks[pp * 65 + dg * 16 + dd] * wv;
    }
#pragma unroll
    for (int q4 = 0; q4 < 4; q4++)
      *(float4*)(slot + e * 64 + dg * 16 + q4 * 4) = make_float4(acc[q4 * 4], acc[q4 * 4 + 1], acc[q4 * 4 + 2], acc[q4 * 4 + 3]);
  }
  if (tid < 64) {
    float a = 0.f;
    for (int pp = 0; pp < 64; pp++) a += wsm[pp] * ks[pp * 65 + tid];
    slot[4096 + tid] = a;
  }
}

#define ATT_SPLIT 768
__device__ __forceinline__ void phase_attn_mlA(const P& p, int l, char* smem) {
  const int N_MLA = 64 * 36;
  const int total = ATT_SPLIT + N_MLA;
  for (int item = blockIdx.x; item < total; item += gridDim.x) {
    if (item < N_MLA) mlstmA_item(p, item, (float*)smem);
    else attn_item(p, l, item - N_MLA, (float*)smem);
  }
}
__device__ __forceinline__ void mlB_item(const P& p, int item);
__device__ __forceinline__ void phase_attn_mlB(const P& p, int l, char* smem) {
  const int N_ATT = (l == 0 ? 2304 : 2048) - ATT_SPLIT;
  const int N_MLB = 64 * 17;
  const int total = N_ATT + N_MLB;
  for (int item = blockIdx.x; item < total; item += gridDim.x) {
    if (item < N_MLB) mlB_item(p, item);
    else attn_item(p, l, ATT_SPLIT + item - N_MLB, (float*)smem);
  }
}

__device__ __forceinline__ void mlB_item(const P& p, int item) {
  const int tid = opaque_tid();
  int seq = item / 17, ech = item - seq * 17;
  int el = ech * 256 + tid;
  if (el >= 4160) return;
  float* base = p.mst + (size_t)(seq * 36) * SLOT;
  float loc[36], bl[36], ml[36];
#pragma unroll
  for (int j = 0; j < 36; j++) {
    loc[j] = base[(size_t)j * SLOT + el];
    bl[j] = base[(size_t)j * SLOT + 4160];
    ml[j] = base[(size_t)j * SLOT + 4161];
  }
  float m = 0.f, val = 0.f;
#pragma unroll
  for (int j = 0; j < 36; j++) {
    base[(size_t)j * SLOT + el] = val;
    if (el == 0) base[(size_t)j * SLOT + 4162] = m;
    float mn = fmaxf(bl[j] + m, ml[j]);
    val = __expf(bl[j] + m - mn) * val + __expf(ml[j] - mn) * loc[j];
    m = mn;
  }
}

__device__ __forceinline__ bf16x8 pack8(float4 a, float4 b) {
  union { bf16x8 v; unsigned u[4]; } r;
  r.u[0] = pack2(a.x, a.y); r.u[1] = pack2(a.z, a.w); r.u[2] = pack2(b.x, b.y); r.u[3] = pack2(b.z, b.w);
  return r.v;
}
__device__ __forceinline__ void phase_mlC(const P& p, int l, char* smem) {
  const int tid = opaque_tid(), lane = tid & 63, w = tid >> 6, q = lane & 15, quad = lane >> 4;
  const u16* mqk = (const u16*)p.MQK;
  const int nch = (l == 0) ? 36 : 32;
  const int total = 32 * nch;
  const int mrow = (q >> 2) * 8 + (q & 3);
  for (int item = blockIdx.x; item < total; item += gridDim.x) {
    int bh = item / nch, c = item % nch + (l == 0 ? 0 : 4);
    int b = bh >> 2, h = bh & 3;
    const int rowbase = (c < 4) ? (ML_ROWS + b * 256 + c * 64) : (b * 2048 + (c - 4) * 64);
    const int tau_t = w * 16 + q;
    const int trow = rowbase + tau_t;
    const bf16x8 bq0 = *(const bf16x8*)(mqk + (size_t)trow * 512 + h * 64 + quad * 8);
    const bf16x8 bq1 = *(const bf16x8*)(mqk + (size_t)trow * 512 + h * 64 + 32 + quad * 8);
    const u16* vt = (c < 4) ? (p.VTm + VTM_CTX_OFF + (size_t)((b * 4 + h) * 64 + q) * 256 + c * 64 + quad * 8)
                            : (p.VTm + (size_t)((b * 4 + h) * 64 + q) * 2048 + (c - 4) * 64 + quad * 8);
    const size_t vstr = (c < 4) ? (size_t)16 * 256 : (size_t)16 * 2048;
    f32x4 hs[4];
#pragma unroll
    for (int et = 0; et < 4; et++) hs[et] = (f32x4){0.f, 0.f, 0.f, 0.f};
#pragma unroll 1
    for (int dir = 0; dir < 2; dir++) {
      int j = dir ? (c < 4 ? 3 - c : 4 + 31 - (c - 4)) : c;
      const float* slot = p.mst + (size_t)(((b * 4 + h) * 2 + dir) * 36 + j) * SLOT;
      const int pt = dir ? 63 - tau_t : tau_t;
      const float m0 = slot[4162];
      const float bt = slot[4224 + pt];
      const float mt = bt + fmaxf(m0, slot[4352 + pt]);
      const float winter = __expf(bt + m0 - mt);
      f32x4 aw[4], ac[4];
#pragma unroll
      for (int et = 0; et < 4; et++) { aw[et] = (f32x4){0.f, 0.f, 0.f, 0.f}; ac[et] = (f32x4){0.f, 0.f, 0.f, 0.f}; }
      float dsum = 0.f;
#pragma unroll 1
      for (int kb = 0; kb < 2; kb++) {
        float wv[8];
#pragma unroll
        for (int T = 0; T < 2; T++) {
          const u16* kp = mqk + (size_t)(rowbase + kb * 32 + mrow + T * 4) * 512 + 256 + h * 64 + quad * 8;
          bf16x8 a0 = *(const bf16x8*)kp;
          bf16x8 a1 = *(const bf16x8*)(kp + 32);
          f32x4 sacc = (f32x4){0.f, 0.f, 0.f, 0.f};
          sacc = __builtin_amdgcn_mfma_f32_16x16x32_bf16(a0, bq0, sacc, 0, 0, 0);
          sacc = __builtin_amdgcn_mfma_f32_16x16x32_bf16(a1, bq1, sacc, 0, 0, 0);
#pragma unroll
          for (int rr = 0; rr < 4; rr++) {
            int tau_s = kb * 32 + quad * 8 + T * 4 + rr;
            int ps = dir ? 63 - tau_s : tau_s;
            bool valid = dir ? (tau_s >= tau_t) : (tau_s <= tau_t);
            float cs = slot[4288 + ps];
            float v = valid ? sacc[rr] * __expf(bt - mt + cs) : 0.f;
            wv[T * 4 + rr] = v;
            dsum += v;
          }
        }
        union { bf16x8 v; unsigned u[4]; } pk;
        pk.u[0] = pack2(wv[0], wv[1]); pk.u[1] = pack2(wv[2], wv[3]); pk.u[2] = pack2(wv[4], wv[5]); pk.u[3] = pack2(wv[6], wv[7]);
#pragma unroll
        for (int et = 0; et < 4; et++) {
          bf16x8 av = *(const bf16x8*)(vt + et * vstr + kb * 32);
          aw[et] = __builtin_amdgcn_mfma_f32_16x16x32_bf16(av, pk.v, aw[et], 0, 0, 0);
        }
      }
#pragma unroll 2
      for (int et = 0; et < 4; et++) {
        const float* cp = slot + (et * 16 + q) * 64 + quad * 8;
        bf16x8 c0 = pack8(*(const float4*)cp, *(const float4*)(cp + 4));
        bf16x8 c1 = pack8(*(const float4*)(cp + 32), *(const float4*)(cp + 36));
        ac[et] = __builtin_amdgcn_mfma_f32_16x16x32_bf16(c0, bq0, ac[et], 0, 0, 0);
        ac[et] = __builtin_amdgcn_mfma_f32_16x16x32_bf16(c1, bq1, ac[et], 0, 0, 0);
      }
      float qn = 0.f;
      {
        const float* np_ = slot + 4096 + quad * 8;
        float4 n0 = *(const float4*)np_, n1 = *(const float4*)(np_ + 4), n2 = *(const float4*)(np_ + 32), n3 = *(const float4*)(np_ + 36);
        union { bf16x8 v; unsigned u[4]; } q0, q1;
        q0.v = bq0; q1.v = bq1;
        qn += bflo(q0.u[0]) * n0.x + bfhi(q0.u[0]) * n0.y + bflo(q0.u[1]) * n0.z + bfhi(q0.u[1]) * n0.w;
        qn += bflo(q0.u[2]) * n1.x + bfhi(q0.u[2]) * n1.y + bflo(q0.u[3]) * n1.z + bfhi(q0.u[3]) * n1.w;
        qn += bflo(q1.u[0]) * n2.x + bfhi(q1.u[0]) * n2.y + bflo(q1.u[1]) * n2.z + bfhi(q1.u[1]) * n2.w;
        qn += bflo(q1.u[2]) * n3.x + bfhi(q1.u[2]) * n3.y + bflo(q1.u[3]) * n3.z + bfhi(q1.u[3]) * n3.w;
      }
      qn += __shfl_xor(qn, 16);
      qn += __shfl_xor(qn, 32);
      dsum += __shfl_xor(dsum, 16);
      dsum += __shfl_xor(dsum, 32);
      float den = dsum + winter * qn;
      float ih = 1.f / fmaxf(fabsf(den), __expf(-mt));
#pragma unroll
      for (int et = 0; et < 4; et++)
#pragma unroll
        for (int rr = 0; rr < 4; rr++) hs[et][rr] += (aw[et][rr] + winter * ac[et][rr]) * ih;
    }
    float ss = 0.f;
#pragma unroll
    for (int et = 0; et < 4; et++)
#pragma unroll
      for (int rr = 0; rr < 4; rr++) ss += hs[et][rr] * hs[et][rr];
    ss += __shfl_xor(ss, 16);
    ss += __shfl_xor(ss, 32);
    float rs = rsqrtf(ss * (1.f / 64.f) + 1e-6f);
#pragma unroll
    for (int et = 0; et < 4; et++) {
      int e0 = h * 64 + et * 16 + quad * 4;
      uint2 uo = *(const uint2*)(p.U + (size_t)trow * INC + 2560 + e0);
      float4 ng = *(const float4*)(p.ml_norm_g + l * 256 + e0);
      float o0 = hs[et][0] * rs * ng.x * sigmoidf_(bflo(uo.x));
      float o1 = hs[et][1] * rs * ng.y * sigmoidf_(bfhi(uo.x));
      float o2 = hs[et][2] * rs * ng.z * sigmoidf_(bflo(uo.y));
      float o3 = hs[et][3] * rs * ng.w * sigmoidf_(bfhi(uo.y));
      uint2 ov;
      ov.x = pack2(o0, o1);
      ov.y = pack2(o2, o3);
      *(uint2*)(p.Y + (size_t)trow * 1024 + 768 + e0) = ov;
    }
  }
}

typedef __attribute__((ext_vector_type(2))) float f32x2;
__device__ __forceinline__ float gelu_tanh(float x) {
  float u = 0.7978845608028654f * (x + 0.044715f * x * x * x);
  float th = 1.f - 2.f / (1.f + __expf(2.f * u));
  return 0.5f * x * (1.f + th);
}
__device__ __forceinline__ float dot16_fp8(const f32x2* xr, uint4 v) {
  f32x2 s = __builtin_amdgcn_cvt_pk_f32_fp8((int)v.x, false) * xr[0];
  s += __builtin_amdgcn_cvt_pk_f32_fp8((int)v.x, true) * xr[1];
  s += __builtin_amdgcn_cvt_pk_f32_fp8((int)v.y, false) * xr[2];
  s += __builtin_amdgcn_cvt_pk_f32_fp8((int)v.y, true) * xr[3];
  s += __builtin_amdgcn_cvt_pk_f32_fp8((int)v.z, false) * xr[4];
  s += __builtin_amdgcn_cvt_pk_f32_fp8((int)v.z, true) * xr[5];
  s += __builtin_amdgcn_cvt_pk_f32_fp8((int)v.w, false) * xr[6];
  s += __builtin_amdgcn_cvt_pk_f32_fp8((int)v.w, true) * xr[7];
  return s.x + s.y;
}
__device__ __forceinline__ void axpy16_fp8(f32x2* acc, float a, uint4 v) {
  f32x2 av = (f32x2){a, a};
  acc[0] += av * __builtin_amdgcn_cvt_pk_f32_fp8((int)v.x, false);
  acc[1] += av * __builtin_amdgcn_cvt_pk_f32_fp8((int)v.x, true);
  acc[2] += av * __builtin_amdgcn_cvt_pk_f32_fp8((int)v.y, false);
  acc[3] += av * __builtin_amdgcn_cvt_pk_f32_fp8((int)v.y, true);
  acc[4] += av * __builtin_amdgcn_cvt_pk_f32_fp8((int)v.z, false);
  acc[5] += av * __builtin_amdgcn_cvt_pk_f32_fp8((int)v.z, true);
  acc[6] += av * __builtin_amdgcn_cvt_pk_f32_fp8((int)v.w, false);
  acc[7] += av * __builtin_amdgcn_cvt_pk_f32_fp8((int)v.w, true);
}

__device__ __forceinline__ unsigned fkey(float f) {
  unsigned u = __float_as_uint(f);
  return (u & 0x80000000u) ? ~u : (u | 0x80000000u);
}
__device__ __forceinline__ int mbcnt64(unsigned long long m) {
  return __builtin_amdgcn_mbcnt_hi((unsigned)(m >> 32), __builtin_amdgcn_mbcnt_lo((unsigned)m, 0));
}
#define WAVE_LDS_FENCE() do { __builtin_amdgcn_fence(__ATOMIC_RELEASE, "wavefront"); __builtin_amdgcn_wave_barrier(); __builtin_amdgcn_fence(__ATOMIC_ACQUIRE, "wavefront"); } while (0)

#define RADIX_BODY(COUNT)                                                                  \
  unsigned pf = 0;                                                                         \
  int bit = 31;                                                                            \
  bool done = false;                                                                       \
  {                                                                                        \
    unsigned c = 0xC1000000u;                                                \
    int n = COUNT;                                                                         \
    n = __builtin_amdgcn_readfirstlane(n);                                                 \
    if (n < 16) {                                                                          \
      _Pragma("unroll 1") for (c = 0xC0800000u; c >= 0xBE800000u; c -= 0x00800000u) {      \
        n = COUNT;                                                                         \
        n = __builtin_amdgcn_readfirstlane(n);                                             \
        if (n >= 16) { pf = c; bit = 22; done = (n == 16); break; }                        \
      }                                                                                    \
    }                                                                                      \
  }                                                                                        \
  if (!done) {                                                                             \
    _Pragma("unroll 1") for (; bit >= 0; --bit) {                                          \
      const unsigned c = pf | (1u << bit);                                                 \
      int n = COUNT;                                                                       \
      n = __builtin_amdgcn_readfirstlane(n);                                               \
      if (n >= 16) { pf = c; if (n == 16) break; }                                         \
    }                                                                                      \
  }                                                                                        \
  return (unsigned)__builtin_amdgcn_readfirstlane((int)pf);
__device__ __forceinline__ unsigned radix_thr2(unsigned k0, unsigned k1) {
  RADIX_BODY((__popcll(__ballot(k0 >= c)) + __popcll(__ballot(k1 >= c))))
}
__device__ __forceinline__ unsigned radix_thr4(unsigned k0, unsigned k1, unsigned k2, unsigned k3) {
  RADIX_BODY((__popcll(__ballot(k0 >= c)) + __popcll(__ballot(k1 >= c)) + __popcll(__ballot(k2 >= c)) + __popcll(__ballot(k3 >= c))))
}
__device__ __forceinline__ void phase_peer_topk(const P& p, int l, char* smem) {
  const int tid = opaque_tid(), lane = tid & 63, w = tid >> 6;
  float* wl = (float*)smem + w * 512;
  float* cs = wl;
  int* ci = (int*)(wl + 32);
  int* el = (int*)(wl + 64);
  float* sl = wl + 192;
  const int nrows = (l == 1) ? ML_ROWS : MT_ROWS;
  const int nw = gridDim.x * 4;
  for (int row = blockIdx.x * 4 + w; row < nrows; row += nw) {
    float na0, na1, nb0, nb1;
    {
      const float* sp0 = p.S + (size_t)row * 2048;
      na0 = sp0[lane]; na1 = sp0[64 + lane]; nb0 = sp0[128 + lane]; nb1 = sp0[192 + lane];
    }
#pragma unroll 1
    for (int h = 0; h < 8; h++) {
      float a0 = na0, a1 = na1, b0 = nb0, b1 = nb1;
      {
        const float* spn = p.S + (size_t)row * 2048 + ((h + 1) & 7) * 256;
        na0 = spn[lane]; na1 = spn[64 + lane]; nb0 = spn[128 + lane]; nb1 = spn[192 + lane];
      }
      unsigned kA0 = fkey(a0), kA1 = fkey(a1), kB0 = fkey(b0), kB1 = fkey(b1);
      const unsigned pA = radix_thr2(kA0, kA1), pB = radix_thr2(kB0, kB1);
      {
        unsigned long long m0 = __ballot(kA0 >= pA), m1 = __ballot(kA1 >= pA);
        int p0 = mbcnt64(m0), p1 = __popcll(m0) + mbcnt64(m1);
        if (kA0 >= pA && p0 < 16) { cs[p0] = a0; ci[p0] = lane; }
        if (kA1 >= pA && p1 < 16) { cs[p1] = a1; ci[p1] = lane + 64; }
        m0 = __ballot(kB0 >= pB); m1 = __ballot(kB1 >= pB);
        p0 = mbcnt64(m0); p1 = __popcll(m0) + mbcnt64(m1);
        if (kB0 >= pB && p0 < 16) { cs[16 + p0] = b0; ci[16 + p0] = lane; }
        if (kB1 >= pB && p1 < 16) { cs[16 + p1] = b1; ci[16 + p1] = lane + 64; }
      }
      WAVE_LDS_FENCE();
      const int ii = lane >> 2, jb = (lane & 3) * 4;
      float s1 = cs[ii];
      float c0 = s1 + cs[16 + jb + 0], c1 = s1 + cs[16 + jb + 1], c2 = s1 + cs[16 + jb + 2], c3 = s1 + cs[16 + jb + 3];
      int e1 = ci[ii] * 128;
      int f0 = e1 + ci[16 + jb + 0], f1 = e1 + ci[16 + jb + 1], f2 = e1 + ci[16 + jb + 2], f3 = e1 + ci[16 + jb + 3];
      unsigned k0 = fkey(c0), k1 = fkey(c1), k2 = fkey(c2), k3 = fkey(c3);
      const unsigned pC = radix_thr4(k0, k1, k2, k3);
      {
        unsigned long long m0 = __ballot(k0 >= pC), m1 = __ballot(k1 >= pC), m2 = __ballot(k2 >= pC), m3 = __ballot(k3 >= pC);
        int q0 = mbcnt64(m0);
        int q1 = __popcll(m0) + mbcnt64(m1);
        int q2 = __popcll(m0) + __popcll(m1) + mbcnt64(m2);
        int q3 = __popcll(m0) + __popcll(m1) + __popcll(m2) + mbcnt64(m3);
        if (k0 >= pC && q0 < 16) { el[h * 16 + q0] = f0; sl[h * 16 + q0] = c0; }
        if (k1 >= pC && q1 < 16) { el[h * 16 + q1] = f1; sl[h * 16 + q1] = c1; }
        if (k2 >= pC && q2 < 16) { el[h * 16 + q2] = f2; sl[h * 16 + q2] = c2; }
        if (k3 >= pC && q3 < 16) { el[h * 16 + q3] = f3; sl[h * 16 + q3] = c3; }
      }
      WAVE_LDS_FENCE();
    }
    {
      float v0 = sl[lane], v1 = sl[64 + lane];
      float m0 = v0, m1 = v1;
#pragma unroll
      for (int o = 1; o < 16; o <<= 1) { m0 = fmaxf(m0, __shfl_xor(m0, o)); m1 = fmaxf(m1, __shfl_xor(m1, o)); }
      float e0 = __expf(v0 - m0), e1 = __expf(v1 - m1);
      float s0 = e0, s1 = e1;
#pragma unroll
      for (int o = 1; o < 16; o <<= 1) { s0 += __shfl_xor(s0, o); s1 += __shfl_xor(s1, o); }
      sl[lane] = e0 / s0;
      sl[64 + lane] = e1 / s1;
    }
    WAVE_LDS_FENCE();
    p.elist[(size_t)row * 128 + lane] = el[lane];
    p.elist[(size_t)row * 128 + 64 + lane] = el[64 + lane];
    p.glist[(size_t)row * 128 + lane] = sl[lane];
    p.glist[(size_t)row * 128 + 64 + lane] = sl[64 + lane];
    p.slist[(size_t)row * 128 + lane] = p.su[l * 16384 + el[lane]];
    p.slist[(size_t)row * 128 + 64 + lane] = p.su[l * 16384 + el[64 + lane]];
    WAVE_LDS_FENCE();
  }
}

struct PeerMeta {
  int id0, id1;
  uint4 xq;
  float g0, g1;
  float2 cur, g2;
};
template <int PH>
__device__ __forceinline__ void peer_load_meta(const P& p, int l, int t, int k, int lane, PeerMeta& m) {
  m.id0 = p.elist[(size_t)t * 128 + lane];
  m.id1 = p.elist[(size_t)t * 128 + 64 + lane];
  if (PH == 0) {
    m.xq = *(const uint4*)(p.xq + (size_t)t * 1024 + k * 128 + (lane & 7) * 16);
  } else {
    m.g0 = p.glist[(size_t)t * 128 + lane];
    m.g1 = p.glist[(size_t)t * 128 + 64 + lane];
    {
      const int Bc = ((lane & 8) ? 8 : 0) + ((lane & 16) ? 4 : 0) + ((lane & 32) ? 2 : 0);
      const int col = k * 128 + (lane & 7) * 16 + Bc;
      const int mr = t < ML_ROWS ? (t >> 11) : 8;
      m.g2 = *(const float2*)(p.mod + (size_t)(l * 9 + mr) * 6144 + 5120 + col);
      m.cur = *(const float2*)(t < ML_ROWS ? p.out + (size_t)t * 1024 + col : p.hc + (size_t)(t - ML_ROWS) * 1024 + col);
    }
  }
}
template <int PH>
__device__ __forceinline__ void peer_issue(const PeerMeta& m, int* idb, float* alb, const unsigned char* tab, int lane, uint4* rr, uint4& xq, float2& rmw, float2& gsc) {
  idb[lane] = m.id0;
  idb[64 + lane] = m.id1;
  if (PH == 0) {
    xq = m.xq;
  } else {
    alb[lane] = m.g0;
    alb[64 + lane] = m.g1;
    rmw = m.cur;
    gsc = m.g2;
  }
  WAVE_LDS_FENCE();
  const int es = lane >> 3;
#pragma unroll
  for (int i = 0; i < 16; i++) rr[i] = *(const uint4*)(tab + (size_t)idb[i * 8 + es] * 128);
}
template <int PH>
__device__ __forceinline__ void peer_compute(const P& p, int l, int t, bool valid, int k, int lane, const uint4* rr, const uint4& xq4, const float* alb, float2 rmw, float2 gsc) {
  const int es = lane >> 3;
  const int s0 = (PH == 0) ? 1 : 8, s1 = (PH == 0) ? 2 : 16, s2 = (PH == 0) ? 4 : 32;
  const bool c0 = (lane & s0) != 0, c1 = (lane & s1) != 0, c2 = (lane & s2) != 0;
  const int B = (c0 ? 8 : 0) + (c1 ? 4 : 0) + (c2 ? 2 : 0);
  float v[16];
  if (PH == 0) {
#pragma unroll
    for (int i = 0; i < 16; i++) {
      int a_ = __builtin_amdgcn_sdot4((int)rr[i].x, (int)xq4.x, 0, false);
      a_ = __builtin_amdgcn_sdot4((int)rr[i].y, (int)xq4.y, a_, false);
      a_ = __builtin_amdgcn_sdot4((int)rr[i].z, (int)xq4.z, a_, false);
      a_ = __builtin_amdgcn_sdot4((int)rr[i].w, (int)xq4.w, a_, false);
      v[i] = (float)a_;
    }
  } else {
    f32x2 acc[8];
#pragma unroll
    for (int i = 0; i < 8; i++) acc[i] = (f32x2){0.f, 0.f};
#pragma unroll
    for (int i = 0; i < 16; i++) axpy16_fp8(acc, alb[i * 8 + es], rr[i]);
#pragma unroll
    for (int i = 0; i < 8; i++) { v[2 * i] = acc[i].x; v[2 * i + 1] = acc[i].y; }
  }
  float k8[8], k4[4], k2[2];
#pragma unroll
  for (int i = 0; i < 8; i++) k8[i] = (c0 ? v[i + 8] : v[i]) + __shfl_xor(c0 ? v[i] : v[i + 8], s0);
#pragma unroll
  for (int i = 0; i < 4; i++) k4[i] = (c1 ? k8[i + 4] : k8[i]) + __shfl_xor(c1 ? k8[i] : k8[i + 4], s1);
#pragma unroll
  for (int i = 0; i < 2; i++) k2[i] = (c2 ? k4[i + 2] : k4[i]) + __shfl_xor(c2 ? k4[i] : k4[i + 2], s2);
  if (PH == 0) {
    float* hq = p.hp + ((size_t)t * 8 + k) * 128;
    if (valid) {
      hq[(B + 0) * 8 + es] = k2[0];
      hq[(B + 1) * 8 + es] = k2[1];
    }
  } else {
    const int col = k * 128 + (lane & 7) * 16 + B;
    float2* dst = (float2*)(t < ML_ROWS ? p.out + (size_t)t * 1024 + col : p.hc + (size_t)(t - ML_ROWS) * 1024 + col);
    float2 cur = rmw;
    cur.x += gsc.x * 0.125f * k2[0];
    cur.y += gsc.y * 0.125f * k2[1];
    if (valid) *dst = cur;
  }
}
template <int PH>
__device__ __forceinline__ void phase_peer_uv(const P& p, int l, char* smem) {
  const int tid = opaque_tid(), lane = tid & 63, w = tid >> 6;
  int* idA = (int*)smem + w * 512;
  int* idB = idA + 128;
  float* alA = (float*)(idA + 256);
  float* alB = alA + 128;
  const int nrows = (l == 1) ? ML_ROWS : MT_ROWS;
  const int k = blockIdx.x & 7;
  const int gw = (blockIdx.x >> 3) * 4 + w, ngw = (gridDim.x >> 3) * 4;
  const unsigned char* tab = (const unsigned char*)(PH == 0 ? p.Ub : p.Vb) + (size_t)((l * 8 + k) * 16384) * 128 + (lane & 7) * 16;
  PeerMeta M;
  uint4 rrA[16], rrB[16];
  uint4 xqA = make_uint4(0, 0, 0, 0), xqB = xqA;
  float2 rmA = make_float2(0.f, 0.f), rmB = rmA, gsA = rmA, gsB = rmA;
  if (gw >= nrows) return;
  const int nit = (nrows - gw + ngw - 1) / ngw;
  const int tlast = gw + (nit - 1) * ngw;
  peer_load_meta<PH>(p, l, gw, k, lane, M);
  peer_issue<PH>(M, idA, alA, tab, lane, rrA, xqA, rmA, gsA);
  peer_load_meta<PH>(p, l, min(gw + ngw, tlast), k, lane, M);
#pragma unroll 1
  for (int i = 0; i < nit; i += 2) {
    const int tA = gw + i * ngw, tB = tA + ngw;
    peer_issue<PH>(M, idB, alB, tab, lane, rrB, xqB, rmB, gsB);
    peer_load_meta<PH>(p, l, min(tB + ngw, tlast), k, lane, M);
    peer_compute<PH>(p, l, tA, true, k, lane, rrA, xqA, alA, rmA, gsA);
    peer_issue<PH>(M, idA, alA, tab, lane, rrA, xqA, rmA, gsA);
    peer_load_meta<PH>(p, l, min(tB + 2 * ngw, tlast), k, lane, M);
    peer_compute<PH>(p, l, min(tB, tlast), tB <= tlast, k, lane, rrB, xqB, alB, rmB, gsB);
  }
}

__device__ __forceinline__ void phase_peer_act(const P& p, int l) {
  const int tid = opaque_tid(), lane = tid & 63, w = tid >> 6;
  const int nrows = (l == 1) ? ML_ROWS : MT_ROWS;
  const int nw = gridDim.x * 4;
  for (int t = blockIdx.x * 4 + w; t < nrows; t += nw) {
    float h0 = 0.f, h1 = 0.f;
#pragma unroll
    for (int kk = 0; kk < 8; kk++) {
      h0 += p.hp[((size_t)t * 8 + kk) * 128 + lane];
      h1 += p.hp[((size_t)t * 8 + kk) * 128 + 64 + lane];
    }
    const float sxt = p.sx[t];
    const float s0 = p.slist[(size_t)t * 128 + lane] * sxt, s1 = p.slist[(size_t)t * 128 + 64 + lane] * sxt;
    const float g0 = p.glist[(size_t)t * 128 + lane], g1 = p.glist[(size_t)t * 128 + 64 + lane];
    p.glist[(size_t)t * 128 + lane] = gelu_tanh(h0 * s0) * g0;
    p.glist[(size_t)t * 128 + 64 + lane] = gelu_tanh(h1 * s1) * g1;
  }
}

#define RUN(k, call)                         \
  if (lo <= (k) && (k) < hi) {               \
    call;                                    \
    if ((k) + 1 < hi) xcd_barrier(xb);       \
  }
#define LAYER(l, base)                                                                                                    \
  RUN(base + 0, phase_norm(p, l, 1))                                                                                     \
  RUN(base + 1, phase_gemm<0>(p, l, p.xn, p.WinT + (size_t)l * INC_PAD * 1024, MT_ROWS / 128, INC_PAD / 128, smem))     \
  RUN(base + 2, phase_mixprep(p, l, smem))                                                                               \
  RUN(base + 3, phase_attn_mlA(p, l, smem))                                                                              \
  RUN(base + 4, phase_attn_mlB(p, l, smem))                                                                                            \
  RUN(base + 5, phase_mlC(p, l, smem))                                                                                   \
  RUN(base + 6, phase_gemm<1>(p, l, p.Y, p.WoutT + (size_t)l * 1024 * 1024, (l == 0 ? MT_ROWS : ML_ROWS) / 128, 8, smem)) \
  RUN(base + 7, phase_norm(p, l, 2))                                                                                     \
  RUN(base + 8, phase_gemm<2>(p, l, p.xn, p.WsT + (size_t)l * 2048 * 1024, (l == 0 ? MT_ROWS : ML_ROWS) / 128, 16, smem)) \
  RUN(base + 9, phase_peer_topk(p, l, smem))                                                                             \
  RUN(base + 10, phase_peer_uv<0>(p, l, smem))                                                                            \
  RUN(base + 11, phase_peer_act(p, l))                                                                                   \
  RUN(base + 12, phase_peer_uv<1>(p, l, smem))

__global__ void __launch_bounds__(256, 3) fwd_kernel(P p) {
  __shared__ __attribute__((aligned(16))) char smem[SMEM_BYTES];
  __shared__ uint4 xb_words;
  cg::grid_group grid = cg::this_grid();
  const int lo = (int)p.ph_lo, hi = (int)p.ph_hi;
  if (threadIdx.x == 0) xb_words = make_uint4(0u, 0u, 0u, 0u);
  __syncthreads();
  XcdBarrier xb = xcd_barrier_post(p.bar, (volatile LAS unsigned*)&xb_words);
  if (hi - lo > 1) grid.sync();
  RUN(0, phase_prologue(p, smem))
  LAYER(0, 1)
  LAYER(1, 14)
}

extern "C" void kernel_launch(void* const* d_in, const int* in_sizes, int n_in, void* d_out, int out_size, void* d_ws,
                              size_t ws_size, hipStream_t stream) {
  static int grid_blocks = 0;
  if (!grid_blocks) {
    int dev = 0, cus = 0, per_cu = 0;
    hipGetDevice(&dev);
    hipDeviceGetAttribute(&cus, hipDeviceAttributeMultiprocessorCount, dev);
    hipOccupancyMaxActiveBlocksPerMultiprocessor(&per_cu, fwd_kernel, 256, 0);
    if (per_cu < 1) per_cu = 1;
    if (per_cu > 3) per_cu = 3;
    grid_blocks = (cus * per_cu) & ~7;
  }
  P p{};
  const float** ins = (const float**)&p;
  for (int i = 0; i < 22; i++) ins[i] = (const float*)d_in[i];
  p.out = (float*)d_out;
  char* ws = (char*)d_ws;
  size_t off = 0;
  auto take = [&](size_t bytes) { char* r = ws + off; off += (bytes + 255) & ~(size_t)255; return r; };
  p.WinT = (u16*)take((size_t)2 * INC_PAD * 1024 * 2);
  p.WoutT = (u16*)take((size_t)2 * 1024 * 1024 * 2);
  p.WsT = (u16*)take((size_t)2 * 2048 * 1024 * 2);
  p.Ub = (u16*)take((size_t)2 * 16384 * 1024);
  p.Vb = (u16*)take((size_t)2 * 16384 * 1024);
  p.xq = (signed char*)take((size_t)MT_ROWS * 1024);
  p.sx = (float*)take((size_t)MT_ROWS * 4);
  p.su = (float*)take((size_t)2 * 16384 * 4);
  p.slist = (float*)take((size_t)MT_ROWS * 128 * 4);
  p.elist = (int*)take((size_t)MT_ROWS * 128 * 4);
  p.glist = (float*)take((size_t)MT_ROWS * 128 * 4);
  p.mod = (float*)take((size_t)2 * 9 * 6144 * 4);
  p.xn = (u16*)take((size_t)MT_ROWS * 1024 * 2);
  p.U = (u16*)take((size_t)MT_ROWS * INC * 2);
  p.MQK = (float*)take((size_t)MT_ROWS * 512 * 2);
  p.Y = (u16*)take((size_t)MT_ROWS * 1024 * 2);
  p.S = (float*)p.U;
  p.hp = (float*)take((size_t)MT_ROWS * 8 * 128 * 4);
  p.G = (float*)take((size_t)MT_ROWS * 16 * 4);
  p.mst = (float*)take((size_t)2304 * SLOT * 4);
  p.hc = (float*)take((size_t)MC_ROWS * 1024 * 4);
  p.bar = (unsigned*)take((size_t)XCD_BAR_WORDS * 4);
  p.VTm = (u16*)take((size_t)(8 * 4 * 64) * (2048 + 256) * 2);
  p.VT = (u16*)take((size_t)(8 * 8 * 64) * (2048 + 256) * 2);
  if (off > ws_size) { fprintf(stderr, "workspace too small: need %zu have %zu\n", off, ws_size); return; }
  (void)hipMemsetAsync(p.bar, 0, (size_t)XCD_BAR_WORDS * 4, stream);
#if MEGA
  p.ph_lo = 0; p.ph_hi = NPHASES;
  void* args[] = {&p};
  hipError_t e = hipLaunchCooperativeKernel((void*)fwd_kernel, dim3(grid_blocks), dim3(256), args, 0, stream);
  if (e != hipSuccess) fprintf(stderr, "cooperative launch failed: %s (grid %d)\n", hipGetErrorString(e), grid_blocks);
#else
  for (int ph = 0; ph < NPHASES; ph++) {
    p.ph_lo = ph; p.ph_hi = ph + 1;
    void* args[] = {&p};
    hipError_t e = hipLaunchCooperativeKernel((void*)fwd_kernel, dim3(grid_blocks), dim3(256), args, 0, stream);
    if (e != hipSuccess) fprintf(stderr, "cooperative launch failed: %s (grid %d)\n", hipGetErrorString(e), grid_blocks);
  }
#endif
}
```

```cpp
#include <hip/hip_runtime.h>
#include <hip/hip_cooperative_groups.h>
#include <cstdio>
namespace cg = cooperative_groups;

#ifndef MEGA
#define MEGA 1
#endif

typedef unsigned short u16;
typedef __attribute__((ext_vector_type(8))) short bf16x8;
typedef __attribute__((ext_vector_type(4))) float f32x4;

#define ML_ROWS 16384
#define MC_ROWS 2048
#define MT_ROWS 18432
#define INC 2832
#define INC_PAD 2944
#define SLOT 4480
#define SMEM_BYTES 49152
#define NPHASES 27

struct P {
  const float *x, *c, *ctx, *c_ctx, *w_ada, *b_ada, *norm1_g, *w_in, *ml_gate_b, *na_q_g, *na_k_g, *na_rpb,
      *pool_w, *pool_scale, *ml_conv, *ml_norm_g, *w_out, *norm2_g, *peer_wq, *peer_keys, *peer_u, *peer_v;
  float* out;
  u16 *WinT, *WoutT, *WsT, *Ub, *Vb;
  float* mod;
  u16* xn;
  u16* U;
  float* MQK;
  u16* Y;
  float* S;
  float* G;
  float* mst;
  float* hc;
  u16* VT;
  u16* VTm;
  signed char* xq;
  float* sx;
  float* su;
  float* slist;
  int* elist;
  float* glist;
  float* hp;
  unsigned* bar;
  long long ph_lo, ph_hi;
};

__device__ __forceinline__ u16 f2bf(float f) {
  unsigned u = __float_as_uint(f);
  u += 0x7fffu + ((u >> 16) & 1u);
  return (u16)(u >> 16);
}
__device__ __forceinline__ float bf2f(u16 h) { return __uint_as_float(((unsigned)h) << 16); }
__device__ __forceinline__ float bflo(unsigned u) { return __uint_as_float(u << 16); }
__device__ __forceinline__ float bfhi(unsigned u) { return __uint_as_float(u & 0xffff0000u); }
__device__ __forceinline__ unsigned pack2(float a, float b) { return (unsigned)f2bf(a) | ((unsigned)f2bf(b) << 16); }
__device__ __forceinline__ unsigned q8pack(float a, float b, float c, float d) {
  int qa = __float2int_rn(a), qb = __float2int_rn(b), qc = __float2int_rn(c), qd = __float2int_rn(d);
  return (unsigned)(qa & 0xff) | ((unsigned)(qb & 0xff) << 8) | ((unsigned)(qc & 0xff) << 16) | ((unsigned)(qd & 0xff) << 24);
}
__device__ __forceinline__ int opaque_tid() { int t = threadIdx.x; asm volatile("" : "+v"(t)); return t; }
__device__ __forceinline__ float wave_sum(float v) {
#pragma unroll
  for (int o = 32; o; o >>= 1) v += __shfl_xor(v, o);
  return v;
}
__device__ __forceinline__ void wave_argmax(float& v, int& i) {
#pragma unroll
  for (int o = 32; o; o >>= 1) {
    float ov = __shfl_xor(v, o);
    int oi = __shfl_xor(i, o);
    if (ov > v || (ov == v && oi < i)) { v = ov; i = oi; }
  }
}
__device__ __forceinline__ float sigmoidf_(float x) { return 1.f / (1.f + __expf(-x)); }
__device__ __forceinline__ float siluf_(float x) { return x / (1.f + __expf(-x)); }

#define XB_TMO      128
#define XB_XCNT(j)  (256  + 64 * (j))
#define XB_XSUB(j)  (1280 + 64 * (j))
#define XB_XGEN(j)  (2304 + 64 * (j))
#define XB_TOP      3328
#define XB_TOPGEN   3392
#define XCD_BAR_WORDS 3456
#define XB_SPIN_CAP (1u << 18)
#define LAS __attribute__((address_space(3)))
__device__ __forceinline__ unsigned xb_ld(unsigned* p)              { return __hip_atomic_load(p, __ATOMIC_RELAXED, __HIP_MEMORY_SCOPE_AGENT); }
__device__ __forceinline__ unsigned xb_add(unsigned* p, unsigned v) { return __hip_atomic_fetch_add(p, v, __ATOMIC_RELAXED, __HIP_MEMORY_SCOPE_AGENT); }
__device__ __forceinline__ unsigned xb_xcc_id() { return (unsigned)__builtin_amdgcn_s_getreg((3 << 11) | 20) & 0xFu; }
#define XB_SPIN(cond, bar) do { unsigned _sp = 0; while (cond) { __builtin_amdgcn_s_sleep(1); \
    if ((++_sp & 255u) == 0u) { if (xb_ld(&(bar)[XB_TMO])) break; if (_sp > XB_SPIN_CAP) { atomicAdd(&(bar)[XB_TMO], 1u); break; } } } } while (0)
struct XcdBarrier { unsigned* bar; unsigned x; volatile LAS unsigned* st; };
__device__ __forceinline__ XcdBarrier xcd_barrier_post(unsigned* bar, volatile LAS unsigned* st) {
    XcdBarrier b; b.bar = bar; b.x = xb_xcc_id(); b.st = st;
    if (threadIdx.x == 0) (void)xb_add(&bar[XB_XCNT(b.x)], 1u);
    return b;
}
__device__ __forceinline__ void xcd_barrier_complete(unsigned* bar, unsigned x, unsigned& nloc, unsigned& nx) {
    const unsigned G = gridDim.x * gridDim.y * gridDim.z;
    unsigned sum, cnt, mine, sp = 0u;
    for (;;) {
        sum = 0u; cnt = 0u; mine = 0u;
#pragma unroll
        for (unsigned j = 0; j < 16; ++j) { const unsigned c = xb_ld(&bar[XB_XCNT(j)]); sum += c; cnt += (c > 0u) ? 1u : 0u; mine = (j == x) ? c : mine; }
        if (sum == G) break;
        __builtin_amdgcn_s_sleep(1);
        if ((++sp & 255u) == 0u) { if (xb_ld(&bar[XB_TMO])) break; if (sp > XB_SPIN_CAP) { atomicAdd(&bar[XB_TMO], 1u); break; } }
    }
    nloc = mine > 0u ? mine : 1u; nx = cnt > 0u ? cnt : 1u;
}
__device__ __forceinline__ void xcd_barrier(const XcdBarrier& b) {
    asm volatile("s_waitcnt vmcnt(0)" ::: "memory");
    __syncthreads();
    if (threadIdx.x == 0) {
        unsigned* bar = b.bar;
        __builtin_amdgcn_s_waitcnt(0);
        unsigned nloc = b.st[0], nx = b.st[1];
        if (nloc == 0u) { xcd_barrier_complete(bar, b.x, nloc, nx); b.st[0] = nloc; b.st[1] = nx; }
        const unsigned old = xb_add(&bar[XB_XSUB(b.x)], 1u);
        const unsigned gen = old / nloc;
        if (old + 1u == (gen + 1u) * nloc) {
            __builtin_amdgcn_fence(__ATOMIC_RELEASE, "agent");
            asm volatile("s_waitcnt vmcnt(0)" ::: "memory");
            const unsigned og = xb_add(&bar[XB_TOP], 1u);
            const unsigned tg = og / nx;
            if (og + 1u == (tg + 1u) * nx) xb_add(&bar[XB_TOPGEN], 1u);
            else XB_SPIN(xb_ld(&bar[XB_TOPGEN]) == tg, bar);
            __builtin_amdgcn_fence(__ATOMIC_ACQUIRE, "agent");
            xb_add(&bar[XB_XGEN(b.x)], 1u);
            asm volatile("s_waitcnt vmcnt(0)" ::: "memory");
        } else {
            XB_SPIN(xb_ld(&bar[XB_XGEN(b.x)]) == gen, bar);
            __builtin_amdgcn_fence(__ATOMIC_ACQUIRE, "agent");
            asm volatile("s_waitcnt vmcnt(0)" ::: "memory");
        }
    }
    __syncthreads();
}

__device__ __forceinline__ void transpose_item(const float* __restrict__ src, int N, u16* __restrict__ dst, int kt, int nt, float* tl) {
  const int tid = opaque_tid();
#pragma unroll 4
  for (int i = 0; i < 16; i++) {
    int idx = tid + 256 * i;
    int kk = idx >> 6, nn = idx & 63;
    int n = nt * 64 + nn;
    float v = (n < N) ? src[(size_t)(kt * 64 + kk) * N + n] : 0.f;
    tl[kk * 65 + nn] = v;
  }
  __syncthreads();
#pragma unroll 4
  for (int i = 0; i < 16; i++) {
    int idx = tid + 256 * i;
    int nn = idx >> 6, kk = idx & 63;
    dst[(size_t)(nt * 64 + nn) * 1024 + kt * 64 + kk] = f2bf(tl[kk * 65 + nn]);
  }
  __syncthreads();
}

__device__ __forceinline__ void wst_item(const P& p, int it, float* sm) {
  (void)sm;
  const int tid = opaque_tid(), lane = tid & 63, w = tid >> 6, r = lane & 15, quad = lane >> 4;
  const int l = it >> 9, rem = it & 511, hp = rem >> 5, kt = (rem >> 2) & 7, dchunk = rem & 3;
  const float* wq = p.peer_wq + (size_t)l * 1024 * 2048 + hp * 128 + quad * 4;
  const float* keys = p.peer_keys + ((size_t)(l * 16 + hp) * 128 + kt * 16 + r) * 128 + quad * 4;
  const int dbase = dchunk * 256 + w * 64;
  f32x4 acc[4];
#pragma unroll
  for (int dt = 0; dt < 4; dt++) acc[dt] = (f32x4){0.f, 0.f, 0.f, 0.f};
#pragma unroll 2
  for (int jj = 0; jj < 8; jj++) {
    const float4 b4 = *(const float4*)(keys + jj * 16);
#pragma unroll
    for (int dt = 0; dt < 4; dt++) {
      const float4 a4 = *(const float4*)(wq + (size_t)(dbase + dt * 16 + r) * 2048 + jj * 16);
      acc[dt] = __builtin_amdgcn_mfma_f32_16x16x4f32(a4.x, b4.x, acc[dt], 0, 0, 0);
      acc[dt] = __builtin_amdgcn_mfma_f32_16x16x4f32(a4.y, b4.y, acc[dt], 0, 0, 0);
      acc[dt] = __builtin_amdgcn_mfma_f32_16x16x4f32(a4.z, b4.z, acc[dt], 0, 0, 0);
      acc[dt] = __builtin_amdgcn_mfma_f32_16x16x4f32(a4.w, b4.w, acc[dt], 0, 0, 0);
    }
  }
  u16* dst = p.WsT + (size_t)l * 2048 * 1024 + (size_t)(hp * 128 + kt * 16 + r) * 1024 + dbase + quad * 4;
#pragma unroll
  for (int dt = 0; dt < 4; dt++) {
    uint2 o;
    o.x = pack2(acc[dt][0], acc[dt][1]);
    o.y = pack2(acc[dt][2], acc[dt][3]);
    *(uint2*)(dst + dt * 16) = o;
  }
}

__device__ __forceinline__ void mod_item(const P& p, int it, float* sm) {
  const int tid = opaque_tid();
  int l = it / 96, cc = it % 96;
  float* sc = sm;
  float* red = sm + 9216;
  for (int idx = tid; idx < 9216; idx += 256) {
    int r = idx >> 10, k = idx & 1023;
    float v = (r < 8) ? p.c[r * 1024 + k] : p.c_ctx[k];
    sc[idx] = siluf_(v);
  }
  __syncthreads();
  int cl = tid & 63, kg = tid >> 6;
  int col = cc * 64 + cl;
  float acc[9];
#pragma unroll
  for (int r = 0; r < 9; r++) acc[r] = 0.f;
  const float* wa = p.w_ada + (size_t)l * 1024 * 6144;
#pragma unroll 16
  for (int k = kg * 256; k < kg * 256 + 256; k++) {
    float w = wa[(size_t)k * 6144 + col];
#pragma unroll
    for (int r = 0; r < 9; r++) acc[r] += sc[r * 1024 + k] * w;
  }
#pragma unroll
  for (int r = 0; r < 9; r++) red[(kg * 9 + r) * 64 + cl] = acc[r];
  __syncthreads();
  if (kg == 0) {
    float bb = p.b_ada[l * 6144 + col];
#pragma unroll
    for (int r = 0; r < 9; r++) {
      float s = red[(0 * 9 + r) * 64 + cl] + red[(1 * 9 + r) * 64 + cl] + red[(2 * 9 + r) * 64 + cl] + red[(3 * 9 + r) * 64 + cl];
      p.mod[(size_t)(l * 9 + r) * 6144 + col] = s + bb;
    }
  }
  __syncthreads();
}

__device__ __forceinline__ void phase_prologue(const P& p, char* smem) {
  float* sm = (float*)smem;
  const int tid = opaque_tid();
  const int N_A = 2 * 16 * 46, N_B = 2 * 16 * 16, N_C = 1024, N_D = 192, N_E = 4096;
  const int total = N_A + N_B + N_C + N_D + N_E;
  for (int item = blockIdx.x; item < total; item += gridDim.x) {
    int it = item;
    if (it < N_D) { mod_item(p, it, sm); continue; }
    it -= N_D;
    if (it < N_C) { wst_item(p, it, sm); continue; }
    it -= N_C;
    if (it < N_A) {
      int l = it / (16 * 46), r = it % (16 * 46);
      transpose_item(p.w_in + (size_t)l * 1024 * INC, INC, p.WinT + (size_t)l * INC_PAD * 1024, r / 46, r % 46, sm);
      continue;
    }
    it -= N_A;
    if (it < N_B) {
      int l = it >> 8, r = it & 255;
      transpose_item(p.w_out + (size_t)l * 1024 * 1024, 1024, p.WoutT + (size_t)l * 1024 * 1024, r >> 4, r & 15, sm);
      continue;
    }
    it -= N_B;
    {
      if ((it >> 11) == 0) {
        const int lane_ = tid & 63, w_ = tid >> 6;
        const int chunk_ = it & 2047;
#pragma unroll
        for (int rr = 0; rr < 4; rr++) {
          const int R = chunk_ * 16 + w_ * 4 + rr;
          const float4* src = (const float4*)(p.peer_u + (size_t)R * 1024 + lane_ * 16);
          typedef __attribute__((ext_vector_type(4))) float f4v;
          const f4v* s4 = (const f4v*)src;
          f4v t0 = __builtin_nontemporal_load(s4), t1 = __builtin_nontemporal_load(s4 + 1), t2 = __builtin_nontemporal_load(s4 + 2), t3 = __builtin_nontemporal_load(s4 + 3);
          float4 v0 = make_float4(t0[0], t0[1], t0[2], t0[3]), v1 = make_float4(t1[0], t1[1], t1[2], t1[3]), v2 = make_float4(t2[0], t2[1], t2[2], t2[3]), v3 = make_float4(t3[0], t3[1], t3[2], t3[3]);
          float mx = fmaxf(fmaxf(fmaxf(fabsf(v0.x), fabsf(v0.y)), fmaxf(fabsf(v0.z), fabsf(v0.w))), fmaxf(fmaxf(fabsf(v1.x), fabsf(v1.y)), fmaxf(fabsf(v1.z), fabsf(v1.w))));
          mx = fmaxf(mx, fmaxf(fmaxf(fmaxf(fabsf(v2.x), fabsf(v2.y)), fmaxf(fabsf(v2.z), fabsf(v2.w))), fmaxf(fmaxf(fabsf(v3.x), fabsf(v3.y)), fmaxf(fabsf(v3.z), fabsf(v3.w)))));
#pragma unroll
          for (int o = 32; o; o >>= 1) mx = fmaxf(mx, __shfl_xor(mx, o));
          const float inv = mx > 0.f ? 127.f / mx : 0.f;
          uint4 o;
          o.x = q8pack(v0.x * inv, v0.y * inv, v0.z * inv, v0.w * inv);
          o.y = q8pack(v1.x * inv, v1.y * inv, v1.z * inv, v1.w * inv);
          o.z = q8pack(v2.x * inv, v2.y * inv, v2.z * inv, v2.w * inv);
          o.w = q8pack(v3.x * inv, v3.y * inv, v3.z * inv, v3.w * inv);
          const unsigned ll = (unsigned)R >> 14, ee = (unsigned)R & 16383u;
          size_t off = ((size_t)((ll * 8u + (unsigned)(lane_ >> 3)) * 16384u + ee)) * 128 + (lane_ & 7) * 16;
          *(uint4*)((unsigned char*)p.Ub + off) = o;
          if (lane_ == 0) p.su[R] = mx * (1.f / 127.f);
        }
        continue;
      }
      int tab = it >> 11;
      int chunk = it & 2047;
      const float scl = tab ? 8.f : 64.f;
      const float4* src = (const float4*)(tab ? p.peer_v : p.peer_u) + (size_t)chunk * 4096;
      unsigned char* dstb = (unsigned char*)(tab ? p.Vb : p.Ub);
#pragma unroll
      for (int i = 0; i < 4; i++) {
        int q = i * 256 + tid;
        typedef __attribute__((ext_vector_type(4))) float f4v;
        const f4v* s4 = (const f4v*)src + q * 4;
        f4v t0 = __builtin_nontemporal_load(s4), t1 = __builtin_nontemporal_load(s4 + 1), t2 = __builtin_nontemporal_load(s4 + 2), t3 = __builtin_nontemporal_load(s4 + 3);
        float4 v0 = make_float4(t0[0], t0[1], t0[2], t0[3]), v1 = make_float4(t1[0], t1[1], t1[2], t1[3]), v2 = make_float4(t2[0], t2[1], t2[2], t2[3]), v3 = make_float4(t3[0], t3[1], t3[2], t3[3]);
        uint4 o;
        int w_;
        w_ = __builtin_amdgcn_cvt_pk_fp8_f32(v0.x * scl, v0.y * scl, 0, false);
        w_ = __builtin_amdgcn_cvt_pk_fp8_f32(v0.z * scl, v0.w * scl, w_, true);
        o.x = (unsigned)w_;
        w_ = __builtin_amdgcn_cvt_pk_fp8_f32(v1.x * scl, v1.y * scl, 0, false);
        w_ = __builtin_amdgcn_cvt_pk_fp8_f32(v1.z * scl, v1.w * scl, w_, true);
        o.y = (unsigned)w_;
        w_ = __builtin_amdgcn_cvt_pk_fp8_f32(v2.x * scl, v2.y * scl, 0, false);
        w_ = __builtin_amdgcn_cvt_pk_fp8_f32(v2.z * scl, v2.w * scl, w_, true);
        o.z = (unsigned)w_;
        w_ = __builtin_amdgcn_cvt_pk_fp8_f32(v3.x * scl, v3.y * scl, 0, false);
        w_ = __builtin_amdgcn_cvt_pk_fp8_f32(v3.z * scl, v3.w * scl, w_, true);
        o.w = (unsigned)w_;
        {
          unsigned G = (unsigned)chunk * 1024u + (unsigned)q;
          unsigned ll = G >> 20, ee = (G >> 6) & 16383u, cgp = G & 63u;
          size_t off = ((size_t)((ll * 8u + (cgp >> 3)) * 16384u + ee)) * 128 + (cgp & 7u) * 16;
          *(uint4*)(dstb + off) = o;
        }
      }
    }
  }
}

__device__ __forceinline__ void phase_norm(const P& p, int l, int which) {
  const int tid = opaque_tid(), lane = tid & 63, w = tid >> 6;
  const int nrows = (which == 2 && l == 1) ? ML_ROWS : MT_ROWS;
  const float* g = (which == 1 ? p.norm1_g : p.norm2_g) + l * 1024;
  for (int item = blockIdx.x; item * 4 < nrows; item += gridDim.x) {
    int row = item * 4 + w;
    const float* src;
    if (l == 0 && which == 1) src = row < ML_ROWS ? p.x + (size_t)row * 1024 : p.ctx + (size_t)(row - ML_ROWS) * 1024;
    else src = row < ML_ROWS ? p.out + (size_t)row * 1024 : p.hc + (size_t)(row - ML_ROWS) * 1024;
    int mr = row < ML_ROWS ? (row >> 11) : 8;
    const float* modp = p.mod + (size_t)(l * 9 + mr) * 6144;
    const float* sh = modp + (which == 1 ? 0 : 3072);
    const float* sc = modp + (which == 1 ? 1024 : 4096);
    float4 v[4];
    float ss = 0.f;
#pragma unroll
    for (int i = 0; i < 4; i++) {
      v[i] = ((const float4*)src)[i * 64 + lane];
      ss += v[i].x * v[i].x + v[i].y * v[i].y + v[i].z * v[i].z + v[i].w * v[i].w;
    }
    ss = wave_sum(ss);
    float rs = rsqrtf(ss * (1.f / 1024.f) + 1e-6f);
    float ov[16];
    float omax = 0.f;
#pragma unroll
    for (int i = 0; i < 4; i++) {
      int d = (i * 64 + lane) * 4;
      float4 gg = *(const float4*)(g + d);
      float4 s4 = *(const float4*)(sc + d);
      float4 h4 = *(const float4*)(sh + d);
      float o0 = v[i].x * rs * gg.x * (1.f + s4.x) + h4.x;
      float o1 = v[i].y * rs * gg.y * (1.f + s4.y) + h4.y;
      float o2 = v[i].z * rs * gg.z * (1.f + s4.z) + h4.z;
      float o3 = v[i].w * rs * gg.w * (1.f + s4.w) + h4.w;
      uint2 o;
      o.x = pack2(o0, o1);
      o.y = pack2(o2, o3);
      ((uint2*)(p.xn + (size_t)row * 1024))[i * 64 + lane] = o;
      ov[i * 4 + 0] = o0; ov[i * 4 + 1] = o1; ov[i * 4 + 2] = o2; ov[i * 4 + 3] = o3;
      omax = fmaxf(omax, fmaxf(fmaxf(fabsf(o0), fabsf(o1)), fmaxf(fabsf(o2), fabsf(o3))));
    }
    if (which == 2) {
#pragma unroll
      for (int o = 32; o; o >>= 1) omax = fmaxf(omax, __shfl_xor(omax, o));
      const float inv = omax > 0.f ? 127.f / omax : 0.f;
#pragma unroll
      for (int i = 0; i < 4; i++)
        ((unsigned*)(p.xq + (size_t)row * 1024))[i * 64 + lane] = q8pack(ov[i * 4] * inv, ov[i * 4 + 1] * inv, ov[i * 4 + 2] * inv, ov[i * 4 + 3] * inv);
      if (lane == 0) p.sx[row] = omax * (1.f / 127.f);
    }
  }
}

template <int EPI>
__device__ __forceinline__ void phase_gemm(const P& p, int l, const u16* __restrict__ A, const u16* __restrict__ Bt, int mtiles, int ntiles,
                           char* smem) {
  u16* As = (u16*)smem;
  u16* Bs = As + 128 * 72;
  const int tid = opaque_tid(), lane = tid & 63, w = tid >> 6, wm = w >> 1, wn = w & 1;
  const int lr = lane & 15, quad = lane >> 4;
  const int xk = blockIdx.x & 7, lb = blockIdx.x >> 3, nb = gridDim.x >> 3;
  const int mg = xk >> 1;
  const int nh0 = (ntiles + 1) >> 1;
  const int nbase = (xk & 1) ? nh0 : 0, nloc = (xk & 1) ? (ntiles - nh0) : nh0;
  const int mcount = (mtiles - mg + 3) >> 2;
  const int nlocal = mcount * nloc;
  for (int li = lb; li < nlocal; li += nb) {
    int mi = li / nloc;
    int mt = mg + 4 * mi, nt = nbase + (li - mi * nloc);
    int m0 = mt * 128, n0 = nt * 128;
    f32x4 acc[4][4];
#pragma unroll
    for (int i = 0; i < 4; i++)
#pragma unroll
      for (int j = 0; j < 4; j++) acc[i][j] = (f32x4){0.f, 0.f, 0.f, 0.f};
    const int r0_ = tid >> 3, ch_ = tid & 7;
    const u16* Ap0 = A + (size_t)(m0 + r0_) * 1024 + ch_ * 8;
    const u16* Bp0 = Bt + (size_t)(n0 + r0_) * 1024 + ch_ * 8;
    uint4 ra0 = *(const uint4*)Ap0, ra1 = *(const uint4*)(Ap0 + 32 * 1024), ra2 = *(const uint4*)(Ap0 + 64 * 1024), ra3 = *(const uint4*)(Ap0 + 96 * 1024);
    uint4 rb0 = *(const uint4*)Bp0, rb1 = *(const uint4*)(Bp0 + 32 * 1024), rb2 = *(const uint4*)(Bp0 + 64 * 1024), rb3 = *(const uint4*)(Bp0 + 96 * 1024);
    for (int kt = 0; kt < 16; kt++) {
      __syncthreads();
      *(uint4*)(As + r0_ * 72 + ch_ * 8) = ra0;
      *(uint4*)(As + (r0_ + 32) * 72 + ch_ * 8) = ra1;
      *(uint4*)(As + (r0_ + 64) * 72 + ch_ * 8) = ra2;
      *(uint4*)(As + (r0_ + 96) * 72 + ch_ * 8) = ra3;
      *(uint4*)(Bs + r0_ * 72 + ch_ * 8) = rb0;
      *(uint4*)(Bs + (r0_ + 32) * 72 + ch_ * 8) = rb1;
      *(uint4*)(Bs + (r0_ + 64) * 72 + ch_ * 8) = rb2;
      *(uint4*)(Bs + (r0_ + 96) * 72 + ch_ * 8) = rb3;
      __syncthreads();
      if (kt < 15) {
        const int ko = (kt + 1) * 64;
        ra0 = *(const uint4*)(Ap0 + ko); ra1 = *(const uint4*)(Ap0 + 32 * 1024 + ko); ra2 = *(const uint4*)(Ap0 + 64 * 1024 + ko); ra3 = *(const uint4*)(Ap0 + 96 * 1024 + ko);
        rb0 = *(const uint4*)(Bp0 + ko); rb1 = *(const uint4*)(Bp0 + 32 * 1024 + ko); rb2 = *(const uint4*)(Bp0 + 64 * 1024 + ko); rb3 = *(const uint4*)(Bp0 + 96 * 1024 + ko);
      }
#pragma unroll
      for (int ks = 0; ks < 2; ks++) {
        bf16x8 a[4], b[4];
#pragma unroll
        for (int i = 0; i < 4; i++) {
          a[i] = *(const bf16x8*)(As + (wm * 64 + i * 16 + lr) * 72 + ks * 32 + quad * 8);
          b[i] = *(const bf16x8*)(Bs + (wn * 64 + i * 16 + lr) * 72 + ks * 32 + quad * 8);
        }
#pragma unroll
        for (int i = 0; i < 4; i++)
#pragma unroll
          for (int j = 0; j < 4; j++) acc[i][j] = __builtin_amdgcn_mfma_f32_16x16x32_bf16(b[j], a[i], acc[i][j], 0, 0, 0);
      }
    }
#pragma unroll
    for (int i = 0; i < 4; i++)
#pragma unroll
      for (int j = 0; j < 4; j++) {
        const int row = m0 + wm * 64 + i * 16 + lr;
        const int col = n0 + wn * 64 + j * 16 + quad * 4;
        const f32x4 v = acc[i][j];
        if (EPI == 0) {
          if (col < INC) {
            uint2 o;
            o.x = pack2(v[0], v[1]);
            o.y = pack2(v[2], v[3]);
            *(uint2*)(p.U + (size_t)row * INC + col) = o;
            if (col >= 2816) *(float4*)(p.G + row * 16 + (col - 2816)) = make_float4(v[0], v[1], v[2], v[3]);
          }
        } else if (EPI == 1) {
          const int mr = row < ML_ROWS ? (row >> 11) : 8;
          const float4 g1 = *(const float4*)(p.mod + (size_t)(l * 9 + mr) * 6144 + 2048 + col);
          float4 sv;
          if (l == 0) sv = row < ML_ROWS ? *(const float4*)(p.x + (size_t)row * 1024 + col) : *(const float4*)(p.ctx + (size_t)(row - ML_ROWS) * 1024 + col);
          else sv = *(const float4*)(p.out + (size_t)row * 1024 + col);
          float* dst = row < ML_ROWS ? p.out + (size_t)row * 1024 + col : p.hc + (size_t)(row - ML_ROWS) * 1024 + col;
          *(float4*)dst = make_float4(sv.x + g1.x * v[0], sv.y + g1.y * v[1], sv.z + g1.z * v[2], sv.w + g1.w * v[3]);
        } else {
          *(float4*)(p.S + (size_t)row * 2048 + col) = make_float4(v[0], v[1], v[2], v[3]);
        }
      }
  }
}

__device__ __forceinline__ void vt_item(const P& p, int it, u16* tl);
__device__ __forceinline__ void phase_mixprep(const P& p, int l, char* smem) {
  float* pl = (float*)smem;
  const int N_QK = MT_ROWS * 16 / 256;
  const int N_POOL = (l == 0 ? MT_ROWS : ML_ROWS) / 16;
  const int N_PREP = MT_ROWS / 4;
  const int N_VT = 2304 + 1152;
  const int total = N_QK + N_POOL + N_PREP + N_VT;
  for (int item = blockIdx.x; item < total; item += gridDim.x) {
    const int tid = opaque_tid();
    int it = item;
    if (it >= N_QK + N_POOL + N_PREP) { vt_item(p, it - (N_QK + N_POOL + N_PREP), (u16*)smem); continue; }
    if (it < N_QK) {
      int gi = it * 256 + tid;
      int row = gi >> 4, sub = gi & 15;
      int qk = sub >> 3, h = sub & 7;
      u16* ptr = p.U + (size_t)row * INC + qk * 512 + h * 64;
      const float* g = (qk ? p.na_k_g : p.na_q_g) + l * 64;
      uint4 v[8];
      float ss = 0.f;
#pragma unroll
      for (int c = 0; c < 8; c++) {
        v[c] = ((const uint4*)ptr)[c];
        float a;
        a = bflo(v[c].x); ss += a * a; a = bfhi(v[c].x); ss += a * a;
        a = bflo(v[c].y); ss += a * a; a = bfhi(v[c].y); ss += a * a;
        a = bflo(v[c].z); ss += a * a; a = bfhi(v[c].z); ss += a * a;
        a = bflo(v[c].w); ss += a * a; a = bfhi(v[c].w); ss += a * a;
      }
      float rs = rsqrtf(ss * (1.f / 64.f) + 1e-6f);
#pragma unroll
      for (int c = 0; c < 8; c++) {
        uint4 o;
        o.x = pack2(bflo(v[c].x) * rs * g[c * 8 + 0], bfhi(v[c].x) * rs * g[c * 8 + 1]);
        o.y = pack2(bflo(v[c].y) * rs * g[c * 8 + 2], bfhi(v[c].y) * rs * g[c * 8 + 3]);
        o.z = pack2(bflo(v[c].z) * rs * g[c * 8 + 4], bfhi(v[c].z) * rs * g[c * 8 + 5]);
        o.w = pack2(bflo(v[c].w) * rs * g[c * 8 + 6], bfhi(v[c].w) * rs * g[c * 8 + 7]);
        ((uint4*)ptr)[c] = o;
      }
      continue;
    }
    it -= N_QK;
    if (it < N_POOL) {
      int row0 = it * 16;
      int base, T;
      if (row0 < ML_ROWS) { base = (row0 >> 11) << 11; T = 2048; }
      else { base = ML_ROWS + (((row0 - ML_ROWS) >> 8) << 8); T = 256; }
      int t0 = row0 - base;
      int ch = tid, g = ch >> 6;
      int wdw = 2 << g;
      __syncthreads();
      {
        float vals[31];
#pragma unroll
        for (int j = 0; j < 31; j++) {
          int tau = t0 - 8 + j;
          bool ok = (tau >= 0) && (tau < T);
          vals[j] = ok ? bf2f(p.U[(size_t)(base + (ok ? tau : t0)) * INC + 1536 + ch]) : 0.f;
        }
        const int hl = wdw / 2, hr = wdw - wdw / 2 - 1;
#pragma unroll
        for (int tt = 0; tt < 16; tt++) {
          int t = t0 + tt;
          int lo = max(t - hl, 0), hi = min(t + hr, T - 1);
          float s = 0.f;
#pragma unroll
          for (int j = 0; j < 31; j++) {
            int rel = j - 8 - tt;
            if (rel >= -8 && rel <= 7) s += (rel >= -hl && rel <= hr) ? vals[j] : 0.f;
          }
          pl[tt * 256 + ch] = s / (float)(hi - lo + 1) - vals[8 + tt];
        }
      }
      __syncthreads();
      float acc[16];
#pragma unroll
      for (int tt = 0; tt < 16; tt++) acc[tt] = 0.f;
      int d = ch & 63;
      const float* pw = p.pool_w + ((size_t)(l * 4 + g) * 64) * 64 + d;
      for (int c = 0; c < 64; c++) {
        float wv = pw[c * 64];
#pragma unroll
        for (int tt = 0; tt < 16; tt++) acc[tt] += pl[tt * 256 + g * 64 + c] * wv;
      }
      float ps = p.pool_scale[l * 256 + ch];
#pragma unroll
      for (int tt = 0; tt < 16; tt++) p.Y[(size_t)(row0 + tt) * 1024 + 512 + ch] = f2bf(acc[tt] * ps);
      continue;
    }
    it -= N_POOL;
    {
      const int row0 = it * 4;
      int base, T;
      if (row0 < ML_ROWS) { base = (row0 >> 11) << 11; T = 2048; }
      else { base = ML_ROWS + (((row0 - ML_ROWS) >> 8) << 8); T = 256; }
      const int t0 = row0 - base;
      const int qk = tid >> 7, hh = (tid >> 5) & 3, ax = (tid >> 4) & 1, f = tid & 15;
      const int ca = qk * 256 + hh * 64 + ax * 32 + f, cb = ca + 16;
      float ua[8], ub[8];
#pragma unroll
      for (int j = 0; j < 8; j++) {
        int tt = t0 + j - 2;
        bool ok = (tt >= 0) && (tt < T);
        const u16* ur = p.U + (size_t)(base + (ok ? tt : t0)) * INC + 1792;
        ua[j] = ok ? bf2f(ur[ca]) : 0.f;
        ub[j] = ok ? bf2f(ur[cb]) : 0.f;
      }
      float wa[5], wb[5];
#pragma unroll
      for (int j = 0; j < 5; j++) { wa[j] = p.ml_conv[(l * 5 + j) * 512 + ca]; wb[j] = p.ml_conv[(l * 5 + j) * 512 + cb]; }
      const float inv = __expf(-(float)f * (9.210340371976184f / 16.f));
#pragma unroll
      for (int i = 0; i < 4; i++) {
        float a = 0.f, b = 0.f;
#pragma unroll
        for (int j = 0; j < 5; j++) { a += wa[j] * ua[i + j]; b += wb[j] * ub[i + j]; }
        a = siluf_(a);
        b = siluf_(b);
        if (row0 < ML_ROWS) {
          int t = t0 + i;
          float pos = (float)(ax == 0 ? (t >> 6) : (t & 63));
          float ang = pos * inv;
          float cs = __cosf(ang), sn = __sinf(ang);
          float oa = a * cs - b * sn, ob = a * sn + b * cs;
          a = oa; b = ob;
        }
        if (qk) { a *= 0.125f; b *= 0.125f; }
        ((u16*)p.MQK)[(size_t)(row0 + i) * 512 + ca] = f2bf(a);
        ((u16*)p.MQK)[(size_t)(row0 + i) * 512 + cb] = f2bf(b);
      }
      if (tid < 64) {
        int gi = tid & 15;
        float gv = p.G[row0 * 16 + tid] + p.ml_gate_b[l * 16 + gi];
        if ((gi >> 2) & 1) gv = fminf(gv, 0.f) - log1pf(__expf(-fabsf(gv)));
        p.G[row0 * 16 + tid] = gv;
      }
    }
  }
}

#define VT_CTX_OFF ((size_t)8 * 8 * 64 * 2048)
#define VTM_CTX_OFF ((size_t)8 * 4 * 64 * 2048)
__device__ __forceinline__ void vt_item(const P& p, int it, u16* tl) {
  const int tid = opaque_tid();
  int b, h, tt, row0, TK, col0;
  u16* dst;
  if (it < 2048) { b = it >> 8; h = (it >> 5) & 7; tt = it & 31; row0 = b * 2048 + tt * 64; TK = 2048; col0 = 1024 + h * 64; dst = p.VT + (size_t)((b * 8 + h) * 64) * 2048 + tt * 64; }
  else if (it < 2304) { int ci = it - 2048; b = ci >> 5; h = (ci >> 2) & 7; tt = ci & 3; row0 = ML_ROWS + b * 256 + tt * 64; TK = 256; col0 = 1024 + h * 64; dst = p.VT + VT_CTX_OFF + (size_t)((b * 8 + h) * 64) * 256 + tt * 64; }
  else if (it < 2304 + 1024) { int mi = it - 2304; b = mi >> 7; h = (mi >> 5) & 3; tt = mi & 31; row0 = b * 2048 + tt * 64; TK = 2048; col0 = 2304 + h * 64; dst = p.VTm + (size_t)((b * 4 + h) * 64) * 2048 + tt * 64; }
  else { int mi = it - 3328; b = mi >> 4; h = (mi >> 2) & 3; tt = mi & 3; row0 = ML_ROWS + b * 256 + tt * 64; TK = 256; col0 = 2304 + h * 64; dst = p.VTm + VTM_CTX_OFF + (size_t)((b * 4 + h) * 64) * 256 + tt * 64; }
  __syncthreads();
  {
    int i = tid >> 2, part = tid & 3;
    const uint4* src = (const uint4*)(p.U + (size_t)(row0 + i) * INC + col0 + part * 16);
    uint4 v0 = src[0], v1 = src[1];
    unsigned* t32 = (unsigned*)(tl + i * 66 + part * 16);
    t32[0] = v0.x; t32[1] = v0.y; t32[2] = v0.z; t32[3] = v0.w;
    t32[4] = v1.x; t32[5] = v1.y; t32[6] = v1.z; t32[7] = v1.w;
  }
  __syncthreads();
  {
    int d = tid >> 2, part = tid & 3;
    unsigned o[8];
#pragma unroll
    for (int k = 0; k < 8; k++) {
      unsigned lo = tl[(part * 16 + 2 * k) * 66 + d], hi = tl[(part * 16 + 2 * k + 1) * 66 + d];
      o[k] = lo | (hi << 16);
    }
    uint4* dp = (uint4*)(dst + (size_t)d * TK + part * 16);
    dp[0] = make_uint4(o[0], o[1], o[2], o[3]);
    dp[1] = make_uint4(o[4], o[5], o[6], o[7]);
  }
}

__device__ __forceinline__ void attn_item(const P& p, int l, int item, float* sb) {
  const int tid = opaque_tid(), lane = tid & 63, w = tid >> 6, q = lane & 15, quad = lane >> 4;
  const bool latent = item < 2048;
  int b, r = 0, h, qb = 0;
  if (latent) { b = item >> 8; r = (item >> 3) & 31; h = item & 7; }
  else { int ci = item - 2048; b = ci >> 5; qb = (ci >> 3) & 3; h = ci & 7; }
  const int r0 = min(max(r - 4, 0), 24);
  __syncthreads();
  if (latent) {
    int kr = tid >> 5, j = tid & 31;
    if (j < 31) sb[tid] = p.na_rpb[(size_t)((l * 8 + h) * 15 + (r0 + kr - r + 7)) * 31 + j];
  }
  __syncthreads();
  const int qc = w * 16 + q;
  const int qrow = latent ? (b * 2048 + r * 64 + qc) : (ML_ROWS + b * 256 + qb * 64 + qc);
  const int cs = (w == 0) ? 0 : (w == 1) ? 8 : (w == 2) ? 24 : 32;
  const int c0 = min(max(qc - 8, 0), 48);
  const bf16x8 bq0 = *(const bf16x8*)(p.U + (size_t)qrow * INC + h * 64 + quad * 8);
  const bf16x8 bq1 = *(const bf16x8*)(p.U + (size_t)qrow * INC + h * 64 + 32 + quad * 8);
  const int mrow = (q >> 2) * 8 + (q & 3);
  const u16* vt_lat = p.VT + (size_t)((b * 8 + h) * 64 + q) * 2048 + quad * 8;
  const u16* vt_ctx = p.VT + VT_CTX_OFF + (size_t)((b * 8 + h) * 64 + q) * 256 + quad * 8;
  float m = -INFINITY, lsum = 0.f;
  f32x4 o[4];
#pragma unroll
  for (int dt = 0; dt < 4; dt++) o[dt] = (f32x4){0.f, 0.f, 0.f, 0.f};
#pragma unroll 1
  for (int chunk = (latent ? 0 : 2); chunk < 4; chunk++) {
    f32x4 s[4][2];
#pragma unroll
    for (int blk = 0; blk < 4; blk++) {
      int rowbase = (chunk < 2) ? (b * 2048 + (r0 + chunk * 4 + blk) * 64 + cs) : (ML_ROWS + b * 256 + (chunk - 2) * 128 + blk * 32);
#pragma unroll
      for (int T = 0; T < 2; T++) {
        const u16* kp = p.U + (size_t)(rowbase + mrow + T * 4) * INC + 512 + h * 64 + quad * 8;
        bf16x8 a0 = *(const bf16x8*)kp;
        bf16x8 a1 = *(const bf16x8*)(kp + 32);
        f32x4 acc = (f32x4){0.f, 0.f, 0.f, 0.f};
        acc = __builtin_amdgcn_mfma_f32_16x16x32_bf16(a0, bq0, acc, 0, 0, 0);
        acc = __builtin_amdgcn_mfma_f32_16x16x32_bf16(a1, bq1, acc, 0, 0, 0);
        s[blk][T] = acc;
      }
    }
    float mx = -INFINITY;
    if (chunk < 2) {
#pragma unroll
      for (int blk = 0; blk < 4; blk++)
#pragma unroll
        for (int T = 0; T < 2; T++)
#pragma unroll
          for (int rr = 0; rr < 4; rr++) {
            int kc = cs + quad * 8 + T * 4 + rr;
            bool valid = (kc >= c0) && (kc < c0 + 16);
            int bi = (chunk * 4 + blk) * 32 + min(max(kc - qc + 15, 0), 30);
            float v = valid ? (s[blk][T][rr] * 0.125f + sb[bi]) : -INFINITY;
            s[blk][T][rr] = v;
            mx = fmaxf(mx, v);
          }
    } else {
#pragma unroll
      for (int blk = 0; blk < 4; blk++)
#pragma unroll
        for (int T = 0; T < 2; T++)
#pragma unroll
          for (int rr = 0; rr < 4; rr++) {
            float v = s[blk][T][rr] * 0.125f;
            s[blk][T][rr] = v;
            mx = fmaxf(mx, v);
          }
    }
    mx = fmaxf(mx, __shfl_xor(mx, 16));
    mx = fmaxf(mx, __shfl_xor(mx, 32));
    float mn = fmaxf(m, mx);
    float sc = __expf(m - mn);
    lsum *= sc;
#pragma unroll
    for (int dt = 0; dt < 4; dt++) o[dt] *= sc;
    m = mn;
#pragma unroll
    for (int blk = 0; blk < 4; blk++) {
      float pv[8];
#pragma unroll
      for (int T = 0; T < 2; T++)
#pragma unroll
        for (int rr = 0; rr < 4; rr++) {
          float e = __expf(s[blk][T][rr] - mn);
          pv[T * 4 + rr] = e;
          lsum += e;
        }
      union { bf16x8 v; unsigned u[4]; } pk;
      pk.u[0] = pack2(pv[0], pv[1]); pk.u[1] = pack2(pv[2], pv[3]); pk.u[2] = pack2(pv[4], pv[5]); pk.u[3] = pack2(pv[6], pv[7]);
      const u16* vb = (chunk < 2) ? (vt_lat + (r0 + chunk * 4 + blk) * 64 + cs) : (vt_ctx + (chunk - 2) * 128 + blk * 32);
      const size_t dstr = (chunk < 2) ? (size_t)16 * 2048 : (size_t)16 * 256;
#pragma unroll
      for (int dt = 0; dt < 4; dt++) {
        bf16x8 av = *(const bf16x8*)(vb + dt * dstr);
        o[dt] = __builtin_amdgcn_mfma_f32_16x16x32_bf16(av, pk.v, o[dt], 0, 0, 0);
      }
    }
  }
  lsum += __shfl_xor(lsum, 16);
  lsum += __shfl_xor(lsum, 32);
  float il = 1.f / lsum;
#pragma unroll
  for (int dt = 0; dt < 4; dt++) {
    uint2 ov;
    ov.x = pack2(o[dt][0] * il, o[dt][1] * il);
    ov.y = pack2(o[dt][2] * il, o[dt][3] * il);
    *(uint2*)(p.Y + (size_t)qrow * 1024 + h * 64 + dt * 16 + quad * 4) = ov;
  }
}

__device__ __forceinline__ int ml_row(int b, int dir, int j, int pp) {
  if (j < 4) {
    int pos = j * 64 + pp;
    int t = dir ? 255 - pos : pos;
    return ML_ROWS + b * 256 + t;
  } else {
    int pos = (j - 4) * 64 + pp;
    int t = dir ? 2047 - pos : pos;
    return b * 2048 + t;
  }
}

__device__ __forceinline__ void mlstmA_item(const P& p, int it, float* sm) {
  const int tid = opaque_tid(), lane = tid & 63;
  int seq = it / 36, j = it % 36;
  int b = seq >> 3, h = (seq >> 1) & 3, dir = seq & 1;
  float* ks = sm;
  float* vs = sm + 64 * 68;
  float* wsm = vs + 64 * 65;
  float* slot = p.mst + (size_t)it * SLOT;
  const u16* mqk = (const u16*)p.MQK;
  __syncthreads();
#pragma unroll
  for (int q = 0; q < 2; q++) {
    int idx = tid + 256 * q;
    int pp = idx >> 3, d8 = (idx & 7) * 8;
    int row = ml_row(b, dir, j, pp);
    uint4 kv = *(const uint4*)(mqk + (size_t)row * 512 + 256 + h * 64 + d8);
    uint4 vv = *(const uint4*)(p.U + (size_t)row * INC + 2304 + h * 64 + d8);
    *(float4*)(ks + pp * 68 + d8) = make_float4(bflo(kv.x), bfhi(kv.x), bflo(kv.y), bfhi(kv.y));
    *(float4*)(ks + pp * 68 + d8 + 4) = make_float4(bflo(kv.z), bfhi(kv.z), bflo(kv.w), bfhi(kv.w));
    float* vp = vs + pp * 65 + d8;
    vp[0] = bflo(vv.x); vp[1] = bfhi(vv.x); vp[2] = bflo(vv.y); vp[3] = bfhi(vv.y);
    vp[4] = bflo(vv.z); vp[5] = bfhi(vv.z); vp[6] = bflo(vv.w); vp[7] = bfhi(vv.w);
  }
  if (tid < 64) {
    int row = ml_row(b, dir, j, lane);
    float ic = p.G[row * 16 + (dir * 2) * 4 + h];
    float fc = p.G[row * 16 + (dir * 2 + 1) * 4 + h];
    float bbv = fc;
#pragma unroll
    for (int o = 1; o < 64; o <<= 1) { float u = __shfl_up(bbv, o); if (lane >= o) bbv += u; }
    float cs = ic - bbv;
    float pm = cs;
#pragma unroll
    for (int o = 1; o < 64; o <<= 1) { float u = __shfl_up(pm, o); if (lane >= o) pm = fmaxf(pm, u); }
    float bl = __shfl(bbv, 63);
    float ml = __shfl(pm, 63) + bl;
    wsm[lane] = __expf(bl + cs - ml);
    slot[4224 + lane] = bbv;
    slot[4288 + lane] = cs;
    slot[4352 + lane] = pm;
    if (lane == 0) { slot[4160] = bl; slot[4161] = ml; }
  }
  __syncthreads();
  {
    int e = tid & 63, dg = tid >> 6;
    float acc[16];
#pragma unroll
    for (int dd = 0; dd < 16; dd++) acc[dd] = 0.f;
    for (int pp = 0; pp < 64; pp++) {
      float wv = wsm[pp] * vs[pp * 65 + e];
      const float4* kp = (const float4*)(ks + pp * 68 + dg * 16);
#pragma unroll
      for (int q4 = 0; q4 < 4; q4++) {
        float4 k4 = kp[q4];
        acc[q4 * 4 + 0] += k4.x * wv; acc[q4 * 4 + 1] += k4.y * wv; acc[q4 * 4 + 2] += k4.z * wv; acc[q4 * 4 + 3] += k4.w * wv;
      }
    }
#pragma unroll
    for (int q4 = 0; q4 < 4; q4++)
      *(float4*)(slot + e * 64 + dg * 16 + q4 * 4) = make_float4(acc[q4 * 4], acc[q4 * 4 + 1], acc[q4 * 4 + 2], acc[q4 * 4 + 3]);
  }
  if (tid < 64) {
    float a = 0.f;
    for (int pp = 0; pp < 64; pp++) a += wsm[pp] * ks[pp * 68 + tid];
    slot[4096 + tid] = a;
  }
}

#define ATT_SPLIT 768
__device__ __forceinline__ void phase_attn_mlA(const P& p, int l, char* smem) {
  const int N_MLA = 64 * 36;
  const int total = ATT_SPLIT + N_MLA;
  for (int item = blockIdx.x; item < total; item += gridDim.x) {
    if (item < N_MLA) mlstmA_item(p, item, (float*)smem);
    else attn_item(p, l, item - N_MLA, (float*)smem);
  }
}
__device__ __forceinline__ void mlB_item(const P& p, int item);
__device__ __forceinline__ void phase_attn_mlB(const P& p, int l, char* smem) {
  const int N_ATT = (l == 0 ? 2304 : 2048) - ATT_SPLIT;
  const int N_MLB = 64 * 17;
  const int total = N_ATT + N_MLB;
  for (int item = blockIdx.x; item < total; item += gridDim.x) {
    if (item < N_MLB) mlB_item(p, item);
    else attn_item(p, l, ATT_SPLIT + item - N_MLB, (float*)smem);
  }
}

__device__ __forceinline__ void mlB_item(const P& p, int item) {
  const int tid = opaque_tid();
  int seq = item / 17, ech = item - seq * 17;
  int el = ech * 256 + tid;
  if (el >= 4160) return;
  float* base = p.mst + (size_t)(seq * 36) * SLOT;
  float loc[36], bl[36], ml[36];
#pragma unroll
  for (int j = 0; j < 36; j++) {
    loc[j] = base[(size_t)j * SLOT + el];
    bl[j] = base[(size_t)j * SLOT + 4160];
    ml[j] = base[(size_t)j * SLOT + 4161];
  }
  float m = 0.f, val = 0.f;
#pragma unroll
  for (int j = 0; j < 36; j++) {
    base[(size_t)j * SLOT + el] = val;
    if (el == 0) base[(size_t)j * SLOT + 4162] = m;
    float mn = fmaxf(bl[j] + m, ml[j]);
    val = __expf(bl[j] + m - mn) * val + __expf(ml[j] - mn) * loc[j];
    m = mn;
  }
}

__device__ __forceinline__ bf16x8 pack8(float4 a, float4 b) {
  union { bf16x8 v; unsigned u[4]; } r;
  r.u[0] = pack2(a.x, a.y); r.u[1] = pack2(a.z, a.w); r.u[2] = pack2(b.x, b.y); r.u[3] = pack2(b.z, b.w);
  return r.v;
}
__device__ __forceinline__ void phase_mlC(const P& p, int l, char* smem) {
  const int tid = opaque_tid(), lane = tid & 63, w = tid >> 6, q = lane & 15, quad = lane >> 4;
  const u16* mqk = (const u16*)p.MQK;
  const int nch = (l == 0) ? 36 : 32;
  const int total = 32 * nch;
  const int mrow = (q >> 2) * 8 + (q & 3);
  for (int item = blockIdx.x; item < total; item += gridDim.x) {
    int bh = item / nch, c = item % nch + (l == 0 ? 0 : 4);
    int b = bh >> 2, h = bh & 3;
    const int rowbase = (c < 4) ? (ML_ROWS + b * 256 + c * 64) : (b * 2048 + (c - 4) * 64);
    const int tau_t = w * 16 + q;
    const int trow = rowbase + tau_t;
    const bf16x8 bq0 = *(const bf16x8*)(mqk + (size_t)trow * 512 + h * 64 + quad * 8);
    const bf16x8 bq1 = *(const bf16x8*)(mqk + (size_t)trow * 512 + h * 64 + 32 + quad * 8);
    const u16* vt = (c < 4) ? (p.VTm + VTM_CTX_OFF + (size_t)((b * 4 + h) * 64 + q) * 256 + c * 64 + quad * 8)
                            : (p.VTm + (size_t)((b * 4 + h) * 64 + q) * 2048 + (c - 4) * 64 + quad * 8);
    const size_t vstr = (c < 4) ? (size_t)16 * 256 : (size_t)16 * 2048;
    f32x4 hs[4];
#pragma unroll
    for (int et = 0; et < 4; et++) hs[et] = (f32x4){0.f, 0.f, 0.f, 0.f};
#pragma unroll 1
    for (int dir = 0; dir < 2; dir++) {
      int j = dir ? (c < 4 ? 3 - c : 4 + 31 - (c - 4)) : c;
      const float* slot = p.mst + (size_t)(((b * 4 + h) * 2 + dir) * 36 + j) * SLOT;
      const int pt = dir ? 63 - tau_t : tau_t;
      const float m0 = slot[4162];
      const float bt = slot[4224 + pt];
      const float mt = bt + fmaxf(m0, slot[4352 + pt]);
      const float winter = __expf(bt + m0 - mt);
      f32x4 aw[4], ac[4];
#pragma unroll
      for (int et = 0; et < 4; et++) { aw[et] = (f32x4){0.f, 0.f, 0.f, 0.f}; ac[et] = (f32x4){0.f, 0.f, 0.f, 0.f}; }
      float dsum = 0.f;
#pragma unroll 1
      for (int kb = 0; kb < 2; kb++) {
        float wv[8];
#pragma unroll
        for (int T = 0; T < 2; T++) {
          const u16* kp = mqk + (size_t)(rowbase + kb * 32 + mrow + T * 4) * 512 + 256 + h * 64 + quad * 8;
          bf16x8 a0 = *(const bf16x8*)kp;
          bf16x8 a1 = *(const bf16x8*)(kp + 32);
          f32x4 sacc = (f32x4){0.f, 0.f, 0.f, 0.f};
          sacc = __builtin_amdgcn_mfma_f32_16x16x32_bf16(a0, bq0, sacc, 0, 0, 0);
          sacc = __builtin_amdgcn_mfma_f32_16x16x32_bf16(a1, bq1, sacc, 0, 0, 0);
#pragma unroll
          for (int rr = 0; rr < 4; rr++) {
            int tau_s = kb * 32 + quad * 8 + T * 4 + rr;
            int ps = dir ? 63 - tau_s : tau_s;
            bool valid = dir ? (tau_s >= tau_t) : (tau_s <= tau_t);
            float cs = slot[4288 + ps];
            float v = valid ? sacc[rr] * __expf(bt - mt + cs) : 0.f;
            wv[T * 4 + rr] = v;
            dsum += v;
          }
        }
        union { bf16x8 v; unsigned u[4]; } pk;
        pk.u[0] = pack2(wv[0], wv[1]); pk.u[1] = pack2(wv[2], wv[3]); pk.u[2] = pack2(wv[4], wv[5]); pk.u[3] = pack2(wv[6], wv[7]);
#pragma unroll
        for (int et = 0; et < 4; et++) {
          bf16x8 av = *(const bf16x8*)(vt + et * vstr + kb * 32);
          aw[et] = __builtin_amdgcn_mfma_f32_16x16x32_bf16(av, pk.v, aw[et], 0, 0, 0);
        }
      }
#pragma unroll 2
      for (int et = 0; et < 4; et++) {
        const float* cp = slot + (et * 16 + q) * 64 + quad * 8;
        bf16x8 c0 = pack8(*(const float4*)cp, *(const float4*)(cp + 4));
        bf16x8 c1 = pack8(*(const float4*)(cp + 32), *(const float4*)(cp + 36));
        ac[et] = __builtin_amdgcn_mfma_f32_16x16x32_bf16(c0, bq0, ac[et], 0, 0, 0);
        ac[et] = __builtin_amdgcn_mfma_f32_16x16x32_bf16(c1, bq1, ac[et], 0, 0, 0);
      }
      float qn = 0.f;
      {
        const float* np_ = slot + 4096 + quad * 8;
        float4 n0 = *(const float4*)np_, n1 = *(const float4*)(np_ + 4), n2 = *(const float4*)(np_ + 32), n3 = *(const float4*)(np_ + 36);
        union { bf16x8 v; unsigned u[4]; } q0, q1;
        q0.v = bq0; q1.v = bq1;
        qn += bflo(q0.u[0]) * n0.x + bfhi(q0.u[0]) * n0.y + bflo(q0.u[1]) * n0.z + bfhi(q0.u[1]) * n0.w;
        qn += bflo(q0.u[2]) * n1.x + bfhi(q0.u[2]) * n1.y + bflo(q0.u[3]) * n1.z + bfhi(q0.u[3]) * n1.w;
        qn += bflo(q1.u[0]) * n2.x + bfhi(q1.u[0]) * n2.y + bflo(q1.u[1]) * n2.z + bfhi(q1.u[1]) * n2.w;
        qn += bflo(q1.u[2]) * n3.x + bfhi(q1.u[2]) * n3.y + bflo(q1.u[3]) * n3.z + bfhi(q1.u[3]) * n3.w;
      }
      qn += __shfl_xor(qn, 16);
      qn += __shfl_xor(qn, 32);
      dsum += __shfl_xor(dsum, 16);
      dsum += __shfl_xor(dsum, 32);
      float den = dsum + winter * qn;
      float ih = 1.f / fmaxf(fabsf(den), __expf(-mt));
#pragma unroll
      for (int et = 0; et < 4; et++)
#pragma unroll
        for (int rr = 0; rr < 4; rr++) hs[et][rr] += (aw[et][rr] + winter * ac[et][rr]) * ih;
    }
    float ss = 0.f;
#pragma unroll
    for (int et = 0; et < 4; et++)
#pragma unroll
      for (int rr = 0; rr < 4; rr++) ss += hs[et][rr] * hs[et][rr];
    ss += __shfl_xor(ss, 16);
    ss += __shfl_xor(ss, 32);
    float rs = rsqrtf(ss * (1.f / 64.f) + 1e-6f);
#pragma unroll
    for (int et = 0; et < 4; et++) {
      int e0 = h * 64 + et * 16 + quad * 4;
      uint2 uo = *(const uint2*)(p.U + (size_t)trow * INC + 2560 + e0);
      float4 ng = *(const float4*)(p.ml_norm_g + l * 256 + e0);
      float o0 = hs[et][0] * rs * ng.x * sigmoidf_(bflo(uo.x));
      float o1 = hs[et][1] * rs * ng.y * sigmoidf_(bfhi(uo.x));
      float o2 = hs[et][2] * rs * ng.z * sigmoidf_(bflo(uo.y));
      float o3 = hs[et][3] * rs * ng.w * sigmoidf_(bfhi(uo.y));
      uint2 ov;
      ov.x = pack2(o0, o1);
      ov.y = pack2(o2, o3);
      *(uint2*)(p.Y + (size_t)trow * 1024 + 768 + e0) = ov;
    }
  }
}

typedef __attribute__((ext_vector_type(2))) float f32x2;
__device__ __forceinline__ float gelu_tanh(float x) {
  float u = 0.7978845608028654f * (x + 0.044715f * x * x * x);
  float th = 1.f - 2.f / (1.f + __expf(2.f * u));
  return 0.5f * x * (1.f + th);
}
__device__ __forceinline__ float dot16_fp8(const f32x2* xr, uint4 v) {
  f32x2 s = __builtin_amdgcn_cvt_pk_f32_fp8((int)v.x, false) * xr[0];
  s += __builtin_amdgcn_cvt_pk_f32_fp8((int)v.x, true) * xr[1];
  s += __builtin_amdgcn_cvt_pk_f32_fp8((int)v.y, false) * xr[2];
  s += __builtin_amdgcn_cvt_pk_f32_fp8((int)v.y, true) * xr[3];
  s += __builtin_amdgcn_cvt_pk_f32_fp8((int)v.z, false) * xr[4];
  s += __builtin_amdgcn_cvt_pk_f32_fp8((int)v.z, true) * xr[5];
  s += __builtin_amdgcn_cvt_pk_f32_fp8((int)v.w, false) * xr[6];
  s += __builtin_amdgcn_cvt_pk_f32_fp8((int)v.w, true) * xr[7];
  return s.x + s.y;
}
__device__ __forceinline__ void axpy16_fp8(f32x2* acc, float a, uint4 v) {
  f32x2 av = (f32x2){a, a};
  acc[0] += av * __builtin_amdgcn_cvt_pk_f32_fp8((int)v.x, false);
  acc[1] += av * __builtin_amdgcn_cvt_pk_f32_fp8((int)v.x, true);
  acc[2] += av * __builtin_amdgcn_cvt_pk_f32_fp8((int)v.y, false);
  acc[3] += av * __builtin_amdgcn_cvt_pk_f32_fp8((int)v.y, true);
  acc[4] += av * __builtin_amdgcn_cvt_pk_f32_fp8((int)v.z, false);
  acc[5] += av * __builtin_amdgcn_cvt_pk_f32_fp8((int)v.z, true);
  acc[6] += av * __builtin_amdgcn_cvt_pk_f32_fp8((int)v.w, false);
  acc[7] += av * __builtin_amdgcn_cvt_pk_f32_fp8((int)v.w, true);
}

__device__ __forceinline__ unsigned fkey(float f) {
  unsigned u = __float_as_uint(f);
  return (u & 0x80000000u) ? ~u : (u | 0x80000000u);
}
__device__ __forceinline__ int mbcnt64(unsigned long long m) {
  return __builtin_amdgcn_mbcnt_hi((unsigned)(m >> 32), __builtin_amdgcn_mbcnt_lo((unsigned)m, 0));
}
#define WAVE_LDS_FENCE() do { __builtin_amdgcn_fence(__ATOMIC_RELEASE, "wavefront"); __builtin_amdgcn_wave_barrier(); __builtin_amdgcn_fence(__ATOMIC_ACQUIRE, "wavefront"); } while (0)

#define RADIX_BODY(COUNT)                                                                  \
  unsigned pf = 0;                                                                         \
  int bit = 31;                                                                            \
  bool done = false;                                                                       \
  {                                                                                        \
    unsigned c = 0xC1000000u;                                                \
    int n = COUNT;                                                                         \
    n = __builtin_amdgcn_readfirstlane(n);                                                 \
    if (n < 16) {                                                                          \
      _Pragma("unroll 1") for (c = 0xC0800000u; c >= 0xBE800000u; c -= 0x00800000u) {      \
        n = COUNT;                                                                         \
        n = __builtin_amdgcn_readfirstlane(n);                                             \
        if (n >= 16) { pf = c; bit = 22; done = (n == 16); break; }                        \
      }                                                                                    \
    }                                                                                      \
  }                                                                                        \
  if (!done) {                                                                             \
    _Pragma("unroll 1") for (; bit >= 0; --bit) {                                          \
      const unsigned c = pf | (1u << bit);                                                 \
      int n = COUNT;                                                                       \
      n = __builtin_amdgcn_readfirstlane(n);                                               \
      if (n >= 16) { pf = c; if (n == 16) break; }                                         \
    }                                                                                      \
  }                                                                                        \
  return (unsigned)__builtin_amdgcn_readfirstlane((int)pf);
__device__ __forceinline__ unsigned radix_thr2(unsigned k0, unsigned k1) {
  RADIX_BODY((__popcll(__ballot(k0 >= c)) + __popcll(__ballot(k1 >= c))))
}
__device__ __forceinline__ unsigned radix_thr4(unsigned k0, unsigned k1, unsigned k2, unsigned k3) {
  RADIX_BODY((__popcll(__ballot(k0 >= c)) + __popcll(__ballot(k1 >= c)) + __popcll(__ballot(k2 >= c)) + __popcll(__ballot(k3 >= c))))
}
__device__ __forceinline__ void phase_peer_topk(const P& p, int l, char* smem) {
  const int tid = opaque_tid(), lane = tid & 63, w = tid >> 6;
  float* wl = (float*)smem + w * 512;
  float* cs = wl;
  int* ci = (int*)(wl + 32);
  int* el = (int*)(wl + 64);
  float* sl = wl + 192;
  const int nrows = (l == 1) ? ML_ROWS : MT_ROWS;
  const int nw = gridDim.x * 4;
  for (int row = blockIdx.x * 4 + w; row < nrows; row += nw) {
    float na0, na1, nb0, nb1;
    {
      const float* sp0 = p.S + (size_t)row * 2048;
      na0 = sp0[lane]; na1 = sp0[64 + lane]; nb0 = sp0[128 + lane]; nb1 = sp0[192 + lane];
    }
#pragma unroll 1
    for (int h = 0; h < 8; h++) {
      float a0 = na0, a1 = na1, b0 = nb0, b1 = nb1;
      {
        const float* spn = p.S + (size_t)row * 2048 + ((h + 1) & 7) * 256;
        na0 = spn[lane]; na1 = spn[64 + lane]; nb0 = spn[128 + lane]; nb1 = spn[192 + lane];
      }
      unsigned kA0 = fkey(a0), kA1 = fkey(a1), kB0 = fkey(b0), kB1 = fkey(b1);
      const unsigned pA = radix_thr2(kA0, kA1), pB = radix_thr2(kB0, kB1);
      {
        unsigned long long m0 = __ballot(kA0 >= pA), m1 = __ballot(kA1 >= pA);
        int p0 = mbcnt64(m0), p1 = __popcll(m0) + mbcnt64(m1);
        if (kA0 >= pA && p0 < 16) { cs[p0] = a0; ci[p0] = lane; }
        if (kA1 >= pA && p1 < 16) { cs[p1] = a1; ci[p1] = lane + 64; }
        m0 = __ballot(kB0 >= pB); m1 = __ballot(kB1 >= pB);
        p0 = mbcnt64(m0); p1 = __popcll(m0) + mbcnt64(m1);
        if (kB0 >= pB && p0 < 16) { cs[16 + p0] = b0; ci[16 + p0] = lane; }
        if (kB1 >= pB && p1 < 16) { cs[16 + p1] = b1; ci[16 + p1] = lane + 64; }
      }
      WAVE_LDS_FENCE();
      const int ii = lane >> 2, jb = (lane & 3) * 4;
      float s1 = cs[ii];
      float c0 = s1 + cs[16 + jb + 0], c1 = s1 + cs[16 + jb + 1], c2 = s1 + cs[16 + jb + 2], c3 = s1 + cs[16 + jb + 3];
      int e1 = ci[ii] * 128;
      int f0 = e1 + ci[16 + jb + 0], f1 = e1 + ci[16 + jb + 1], f2 = e1 + ci[16 + jb + 2], f3 = e1 + ci[16 + jb + 3];
      unsigned k0 = fkey(c0), k1 = fkey(c1), k2 = fkey(c2), k3 = fkey(c3);
      const unsigned pC = radix_thr4(k0, k1, k2, k3);
      {
        unsigned long long m0 = __ballot(k0 >= pC), m1 = __ballot(k1 >= pC), m2 = __ballot(k2 >= pC), m3 = __ballot(k3 >= pC);
        int q0 = mbcnt64(m0);
        int q1 = __popcll(m0) + mbcnt64(m1);
        int q2 = __popcll(m0) + __popcll(m1) + mbcnt64(m2);
        int q3 = __popcll(m0) + __popcll(m1) + __popcll(m2) + mbcnt64(m3);
        if (k0 >= pC && q0 < 16) { el[h * 16 + q0] = f0; sl[h * 16 + q0] = c0; }
        if (k1 >= pC && q1 < 16) { el[h * 16 + q1] = f1; sl[h * 16 + q1] = c1; }
        if (k2 >= pC && q2 < 16) { el[h * 16 + q2] = f2; sl[h * 16 + q2] = c2; }
        if (k3 >= pC && q3 < 16) { el[h * 16 + q3] = f3; sl[h * 16 + q3] = c3; }
      }
      WAVE_LDS_FENCE();
    }
    {
      float v0 = sl[lane], v1 = sl[64 + lane];
      float m0 = v0, m1 = v1;
#pragma unroll
      for (int o = 1; o < 16; o <<= 1) { m0 = fmaxf(m0, __shfl_xor(m0, o)); m1 = fmaxf(m1, __shfl_xor(m1, o)); }
      float e0 = __expf(v0 - m0), e1 = __expf(v1 - m1);
      float s0 = e0, s1 = e1;
#pragma unroll
      for (int o = 1; o < 16; o <<= 1) { s0 += __shfl_xor(s0, o); s1 += __shfl_xor(s1, o); }
      sl[lane] = e0 / s0;
      sl[64 + lane] = e1 / s1;
    }
    WAVE_LDS_FENCE();
    p.elist[(size_t)row * 128 + lane] = el[lane];
    p.elist[(size_t)row * 128 + 64 + lane] = el[64 + lane];
    p.glist[(size_t)row * 128 + lane] = sl[lane];
    p.glist[(size_t)row * 128 + 64 + lane] = sl[64 + lane];
    p.slist[(size_t)row * 128 + lane] = p.su[l * 16384 + el[lane]];
    p.slist[(size_t)row * 128 + 64 + lane] = p.su[l * 16384 + el[64 + lane]];
    WAVE_LDS_FENCE();
  }
}

struct PeerMeta {
  int id0, id1;
  uint4 xq;
  float g0, g1;
  float2 cur, g2;
};
template <int PH>
__device__ __forceinline__ void peer_load_meta(const P& p, int l, int t, int k, int lane, PeerMeta& m) {
  m.id0 = p.elist[(size_t)t * 128 + lane];
  m.id1 = p.elist[(size_t)t * 128 + 64 + lane];
  if (PH == 0) {
    m.xq = *(const uint4*)(p.xq + (size_t)t * 1024 + k * 128 + (lane & 7) * 16);
  } else {
    m.g0 = p.glist[(size_t)t * 128 + lane];
    m.g1 = p.glist[(size_t)t * 128 + 64 + lane];
    {
      const int Bc = ((lane & 8) ? 8 : 0) + ((lane & 16) ? 4 : 0) + ((lane & 32) ? 2 : 0);
      const int col = k * 128 + (lane & 7) * 16 + Bc;
      const int mr = t < ML_ROWS ? (t >> 11) : 8;
      m.g2 = *(const float2*)(p.mod + (size_t)(l * 9 + mr) * 6144 + 5120 + col);
      m.cur = *(const float2*)(t < ML_ROWS ? p.out + (size_t)t * 1024 + col : p.hc + (size_t)(t - ML_ROWS) * 1024 + col);
    }
  }
}
template <int PH>
__device__ __forceinline__ void peer_issue(const PeerMeta& m, int* idb, float* alb, const unsigned char* tab, int lane, uint4* rr, uint4& xq, float2& rmw, float2& gsc) {
  idb[lane] = m.id0;
  idb[64 + lane] = m.id1;
  if (PH == 0) {
    xq = m.xq;
  } else {
    alb[lane] = m.g0;
    alb[64 + lane] = m.g1;
    rmw = m.cur;
    gsc = m.g2;
  }
  WAVE_LDS_FENCE();
  const int es = lane >> 3;
#pragma unroll
  for (int i = 0; i < 16; i++) rr[i] = *(const uint4*)(tab + (size_t)idb[i * 8 + es] * 128);
}
template <int PH>
__device__ __forceinline__ void peer_compute(const P& p, int l, int t, bool valid, int k, int lane, const uint4* rr, const uint4& xq4, const float* alb, float2 rmw, float2 gsc) {
  const int es = lane >> 3;
  const int s0 = (PH == 0) ? 1 : 8, s1 = (PH == 0) ? 2 : 16, s2 = (PH == 0) ? 4 : 32;
  const bool c0 = (lane & s0) != 0, c1 = (lane & s1) != 0, c2 = (lane & s2) != 0;
  const int B = (c0 ? 8 : 0) + (c1 ? 4 : 0) + (c2 ? 2 : 0);
  float v[16];
  if (PH == 0) {
#pragma unroll
    for (int i = 0; i < 16; i++) {
      int a_ = __builtin_amdgcn_sdot4((int)rr[i].x, (int)xq4.x, 0, false);
      a_ = __builtin_amdgcn_sdot4((int)rr[i].y, (int)xq4.y, a_, false);
      a_ = __builtin_amdgcn_sdot4((int)rr[i].z, (int)xq4.z, a_, false);
      a_ = __builtin_amdgcn_sdot4((int)rr[i].w, (int)xq4.w, a_, false);
      v[i] = (float)a_;
    }
  } else {
    f32x2 acc[8];
#pragma unroll
    for (int i = 0; i < 8; i++) acc[i] = (f32x2){0.f, 0.f};
#pragma unroll
    for (int i = 0; i < 16; i++) axpy16_fp8(acc, alb[i * 8 + es], rr[i]);
#pragma unroll
    for (int i = 0; i < 8; i++) { v[2 * i] = acc[i].x; v[2 * i + 1] = acc[i].y; }
  }
  float k8[8], k4[4], k2[2];
#pragma unroll
  for (int i = 0; i < 8; i++) k8[i] = (c0 ? v[i + 8] : v[i]) + __shfl_xor(c0 ? v[i] : v[i + 8], s0);
#pragma unroll
  for (int i = 0; i < 4; i++) k4[i] = (c1 ? k8[i + 4] : k8[i]) + __shfl_xor(c1 ? k8[i] : k8[i + 4], s1);
#pragma unroll
  for (int i = 0; i < 2; i++) k2[i] = (c2 ? k4[i + 2] : k4[i]) + __shfl_xor(c2 ? k4[i] : k4[i + 2], s2);
  if (PH == 0) {
    float* hq = p.hp + ((size_t)t * 8 + k) * 128;
    if (valid) {
      hq[(B + 0) * 8 + es] = k2[0];
      hq[(B + 1) * 8 + es] = k2[1];
    }
  } else {
    const int col = k * 128 + (lane & 7) * 16 + B;
    float2* dst = (float2*)(t < ML_ROWS ? p.out + (size_t)t * 1024 + col : p.hc + (size_t)(t - ML_ROWS) * 1024 + col);
    float2 cur = rmw;
    cur.x += gsc.x * 0.125f * k2[0];
    cur.y += gsc.y * 0.125f * k2[1];
    if (valid) *dst = cur;
  }
}
template <int PH>
__device__ __forceinline__ void phase_peer_uv(const P& p, int l, char* smem) {
  const int tid = opaque_tid(), lane = tid & 63, w = tid >> 6;
  int* idA = (int*)smem + w * 512;
  int* idB = idA + 128;
  float* alA = (float*)(idA + 256);
  float* alB = alA + 128;
  const int nrows = (l == 1) ? ML_ROWS : MT_ROWS;
  const int k = blockIdx.x & 7;
  const int gw = (blockIdx.x >> 3) * 4 + w, ngw = (gridDim.x >> 3) * 4;
  const unsigned char* tab = (const unsigned char*)(PH == 0 ? p.Ub : p.Vb) + (size_t)((l * 8 + k) * 16384) * 128 + (lane & 7) * 16;
  PeerMeta M;
  uint4 rrA[16], rrB[16];
  uint4 xqA = make_uint4(0, 0, 0, 0), xqB = xqA;
  float2 rmA = make_float2(0.f, 0.f), rmB = rmA, gsA = rmA, gsB = rmA;
  if (gw >= nrows) return;
  const int nit = (nrows - gw + ngw - 1) / ngw;
  const int tlast = gw + (nit - 1) * ngw;
  peer_load_meta<PH>(p, l, gw, k, lane, M);
  peer_issue<PH>(M, idA, alA, tab, lane, rrA, xqA, rmA, gsA);
  peer_load_meta<PH>(p, l, min(gw + ngw, tlast), k, lane, M);
#pragma unroll 1
  for (int i = 0; i < nit; i += 2) {
    const int tA = gw + i * ngw, tB = tA + ngw;
    peer_issue<PH>(M, idB, alB, tab, lane, rrB, xqB, rmB, gsB);
    peer_load_meta<PH>(p, l, min(tB + ngw, tlast), k, lane, M);
    peer_compute<PH>(p, l, tA, true, k, lane, rrA, xqA, alA, rmA, gsA);
    peer_issue<PH>(M, idA, alA, tab, lane, rrA, xqA, rmA, gsA);
    peer_load_meta<PH>(p, l, min(tB + 2 * ngw, tlast), k, lane, M);
    peer_compute<PH>(p, l, min(tB, tlast), tB <= tlast, k, lane, rrB, xqB, alB, rmB, gsB);
  }
}

__device__ __forceinline__ void phase_peer_act(const P& p, int l) {
  const int tid = opaque_tid(), lane = tid & 63, w = tid >> 6;
  const int nrows = (l == 1) ? ML_ROWS : MT_ROWS;
  const int nw = gridDim.x * 4;
  for (int t = blockIdx.x * 4 + w; t < nrows; t += nw) {
    float h0 = 0.f, h1 = 0.f;
#pragma unroll
    for (int kk = 0; kk < 8; kk++) {
      h0 += p.hp[((size_t)t * 8 + kk) * 128 + lane];
      h1 += p.hp[((size_t)t * 8 + kk) * 128 + 64 + lane];
    }
    const float sxt = p.sx[t];
    const float s0 = p.slist[(size_t)t * 128 + lane] * sxt, s1 = p.slist[(size_t)t * 128 + 64 + lane] * sxt;
    const float g0 = p.glist[(size_t)t * 128 + lane], g1 = p.glist[(size_t)t * 128 + 64 + lane];
    p.glist[(size_t)t * 128 + lane] = gelu_tanh(h0 * s0) * g0;
    p.glist[(size_t)t * 128 + 64 + lane] = gelu_tanh(h1 * s1) * g1;
  }
}

#define RUN(k, call)                         \
  if (lo <= (k) && (k) < hi) {               \
    call;                                    \
    if ((k) + 1 < hi) xcd_barrier(xb);       \
  }
#define LAYER(l, base)                                                                                                    \
  RUN(base + 0, phase_norm(p, l, 1))                                                                                     \
  RUN(base + 1, phase_gemm<0>(p, l, p.xn, p.WinT + (size_t)l * INC_PAD * 1024, MT_ROWS / 128, INC_PAD / 128, smem))     \
  RUN(base + 2, phase_mixprep(p, l, smem))                                                                               \
  RUN(base + 3, phase_attn_mlA(p, l, smem))                                                                              \
  RUN(base + 4, phase_attn_mlB(p, l, smem))                                                                                            \
  RUN(base + 5, phase_mlC(p, l, smem))                                                                                   \
  RUN(base + 6, phase_gemm<1>(p, l, p.Y, p.WoutT + (size_t)l * 1024 * 1024, (l == 0 ? MT_ROWS : ML_ROWS) / 128, 8, smem)) \
  RUN(base + 7, phase_norm(p, l, 2))                                                                                     \
  RUN(base + 8, phase_gemm<2>(p, l, p.xn, p.WsT + (size_t)l * 2048 * 1024, (l == 0 ? MT_ROWS : ML_ROWS) / 128, 16, smem)) \
  RUN(base + 9, phase_peer_topk(p, l, smem))                                                                             \
  RUN(base + 10, phase_peer_uv<0>(p, l, smem))                                                                            \
  RUN(base + 11, phase_peer_act(p, l))                                                                                   \
  RUN(base + 12, phase_peer_uv<1>(p, l, smem))

__global__ void __launch_bounds__(256, 3) fwd_kernel(P p) {
  __shared__ __attribute__((aligned(16))) char smem[SMEM_BYTES];
  __shared__ uint4 xb_words;
  cg::grid_group grid = cg::this_grid();
  const int lo = (int)p.ph_lo, hi = (int)p.ph_hi;
  if (threadIdx.x == 0) xb_words = make_uint4(0u, 0u, 0u, 0u);
  __syncthreads();
  XcdBarrier xb = xcd_barrier_post(p.bar, (volatile LAS unsigned*)&xb_words);
  if (hi - lo > 1) grid.sync();
  RUN(0, phase_prologue(p, smem))
  LAYER(0, 1)
  LAYER(1, 14)
}

extern "C" void kernel_launch(void* const* d_in, const int* in_sizes, int n_in, void* d_out, int out_size, void* d_ws,
                              size_t ws_size, hipStream_t stream) {
  static int grid_blocks = 0;
  if (!grid_blocks) {
    int dev = 0, cus = 0, per_cu = 0;
    hipGetDevice(&dev);
    hipDeviceGetAttribute(&cus, hipDeviceAttributeMultiprocessorCount, dev);
    hipOccupancyMaxActiveBlocksPerMultiprocessor(&per_cu, fwd_kernel, 256, 0);
    if (per_cu < 1) per_cu = 1;
    if (per_cu > 3) per_cu = 3;
    grid_blocks = (cus * per_cu) & ~7;
  }
  P p{};
  const float** ins = (const float**)&p;
  for (int i = 0; i < 22; i++) ins[i] = (const float*)d_in[i];
  p.out = (float*)d_out;
  char* ws = (char*)d_ws;
  size_t off = 0;
  auto take = [&](size_t bytes) { char* r = ws + off; off += (bytes + 255) & ~(size_t)255; return r; };
  p.WinT = (u16*)take((size_t)2 * INC_PAD * 1024 * 2);
  p.WoutT = (u16*)take((size_t)2 * 1024 * 1024 * 2);
  p.WsT = (u16*)take((size_t)2 * 2048 * 1024 * 2);
  p.Ub = (u16*)take((size_t)2 * 16384 * 1024);
  p.Vb = (u16*)take((size_t)2 * 16384 * 1024);
  p.xq = (signed char*)take((size_t)MT_ROWS * 1024);
  p.sx = (float*)take((size_t)MT_ROWS * 4);
  p.su = (float*)take((size_t)2 * 16384 * 4);
  p.slist = (float*)take((size_t)MT_ROWS * 128 * 4);
  p.elist = (int*)take((size_t)MT_ROWS * 128 * 4);
  p.glist = (float*)take((size_t)MT_ROWS * 128 * 4);
  p.mod = (float*)take((size_t)2 * 9 * 6144 * 4);
  p.xn = (u16*)take((size_t)MT_ROWS * 1024 * 2);
  p.U = (u16*)take((size_t)MT_ROWS * INC * 2);
  p.MQK = (float*)take((size_t)MT_ROWS * 512 * 2);
  p.Y = (u16*)take((size_t)MT_ROWS * 1024 * 2);
  p.S = (float*)p.U;
  p.hp = (float*)take((size_t)MT_ROWS * 8 * 128 * 4);
  p.G = (float*)take((size_t)MT_ROWS * 16 * 4);
  p.mst = (float*)take((size_t)2304 * SLOT * 4);
  p.hc = (float*)take((size_t)MC_ROWS * 1024 * 4);
  p.bar = (unsigned*)take((size_t)XCD_BAR_WORDS * 4);
  p.VTm = (u16*)take((size_t)(8 * 4 * 64) * (2048 + 256) * 2);
  p.VT = (u16*)take((size_t)(8 * 8 * 64) * (2048 + 256) * 2);
  if (off > ws_size) { fprintf(stderr, "workspace too small: need %zu have %zu\n", off, ws_size); return; }
  (void)hipMemsetAsync(p.bar, 0, (size_t)XCD_BAR_WORDS * 4, stream);
#if MEGA
  p.ph_lo = 0; p.ph_hi = NPHASES;
  void* args[] = {&p};
  hipError_t e = hipLaunchCooperativeKernel((void*)fwd_kernel, dim3(grid_blocks), dim3(256), args, 0, stream);
  if (e != hipSuccess) fprintf(stderr, "cooperative launch failed: %s (grid %d)\n", hipGetErrorString(e), grid_blocks);
#else
  for (int ph = 0; ph < NPHASES; ph++) {
    p.ph_lo = ph; p.ph_hi = ph + 1;
    void* args[] = {&p};
    hipError_t e = hipLaunchCooperativeKernel((void*)fwd_kernel, dim3(grid_blocks), dim3(256), args, 0, stream);
    if (e != hipSuccess) fprintf(stderr, "cooperative launch failed: %s (grid %d)\n", hipGetErrorString(e), grid_blocks);
  }
#endif
}
```

```cpp
#include <hip/hip_runtime.h>
#include <hip/hip_cooperative_groups.h>
#include <cstdio>
namespace cg = cooperative_groups;

#ifndef MEGA
#define MEGA 1
#endif

typedef unsigned short u16;
typedef __attribute__((ext_vector_type(8))) short bf16x8;
typedef __attribute__((ext_vector_type(4))) float f32x4;

#define ML_ROWS 16384
#define MC_ROWS 2048
#define MT_ROWS 18432
#define INC 2832
#define INC_PAD 2944
#define SLOT 4480
#define SMEM_BYTES 49152
#define NPHASES 27

struct P {
  const float *x, *c, *ctx, *c_ctx, *w_ada, *b_ada, *norm1_g, *w_in, *ml_gate_b, *na_q_g, *na_k_g, *na_rpb,
      *pool_w, *pool_scale, *ml_conv, *ml_norm_g, *w_out, *norm2_g, *peer_wq, *peer_keys, *peer_u, *peer_v;
  float* out;
  u16 *WinT, *WoutT, *WsT, *Ub, *Vb;
  float* mod;
  u16* xn;
  u16* U;
  float* MQK;
  u16* Y;
  float* S;
  float* G;
  float* mst;
  float* hc;
  u16* VT;
  u16* VTm;
  signed char* xq;
  float* sx;
  float* su;
  float* slist;
  int* elist;
  float* glist;
  float* hp;
  unsigned* bar;
  long long ph_lo, ph_hi;
};

__device__ __forceinline__ u16 f2bf(float f) {
  unsigned u = __float_as_uint(f);
  u += 0x7fffu + ((u >> 16) & 1u);
  return (u16)(u >> 16);
}
__device__ __forceinline__ float bf2f(u16 h) { return __uint_as_float(((unsigned)h) << 16); }
__device__ __forceinline__ float bflo(unsigned u) { return __uint_as_float(u << 16); }
__device__ __forceinline__ float bfhi(unsigned u) { return __uint_as_float(u & 0xffff0000u); }
__device__ __forceinline__ unsigned pack2(float a, float b) { return (unsigned)f2bf(a) | ((unsigned)f2bf(b) << 16); }
__device__ __forceinline__ unsigned q8pack(float a, float b, float c, float d) {
  int qa = __float2int_rn(a), qb = __float2int_rn(b), qc = __float2int_rn(c), qd = __float2int_rn(d);
  return (unsigned)(qa & 0xff) | ((unsigned)(qb & 0xff) << 8) | ((unsigned)(qc & 0xff) << 16) | ((unsigned)(qd & 0xff) << 24);
}
__device__ __forceinline__ int opaque_tid() { int t = threadIdx.x; asm volatile("" : "+v"(t)); return t; }
__device__ __forceinline__ float wave_sum(float v) {
#pragma unroll
  for (int o = 32; o; o >>= 1) v += __shfl_xor(v, o);
  return v;
}
__device__ __forceinline__ void wave_argmax(float& v, int& i) {
#pragma unroll
  for (int o = 32; o; o >>= 1) {
    float ov = __shfl_xor(v, o);
    int oi = __shfl_xor(i, o);
    if (ov > v || (ov == v && oi < i)) { v = ov; i = oi; }
  }
}
__device__ __forceinline__ float sigmoidf_(float x) { return 1.f / (1.f + __expf(-x)); }
__device__ __forceinline__ float siluf_(float x) { return x / (1.f + __expf(-x)); }

#define XB_TMO      128
#define XB_XCNT(j)  (256  + 64 * (j))
#define XB_XSUB(j)  (1280 + 64 * (j))
#define XB_XGEN(j)  (2304 + 64 * (j))
#define XB_TOP      3328
#define XB_TOPGEN   3392
#define XCD_BAR_WORDS 3456
#define XB_SPIN_CAP (1u << 18)
#define LAS __attribute__((address_space(3)))
__device__ __forceinline__ unsigned xb_ld(unsigned* p)              { return __hip_atomic_load(p, __ATOMIC_RELAXED, __HIP_MEMORY_SCOPE_AGENT); }
__device__ __forceinline__ unsigned xb_add(unsigned* p, unsigned v) { return __hip_atomic_fetch_add(p, v, __ATOMIC_RELAXED, __HIP_MEMORY_SCOPE_AGENT); }
__device__ __forceinline__ unsigned xb_xcc_id() { return (unsigned)__builtin_amdgcn_s_getreg((3 << 11) | 20) & 0xFu; }
#define XB_SPIN(cond, bar) do { unsigned _sp = 0; while (cond) { __builtin_amdgcn_s_sleep(1); \
    if ((++_sp & 255u) == 0u) { if (xb_ld(&(bar)[XB_TMO])) break; if (_sp > XB_SPIN_CAP) { atomicAdd(&(bar)[XB_TMO], 1u); break; } } } } while (0)
struct XcdBarrier { unsigned* bar; unsigned x; volatile LAS unsigned* st; };
__device__ __forceinline__ XcdBarrier xcd_barrier_post(unsigned* bar, volatile LAS unsigned* st) {
    XcdBarrier b; b.bar = bar; b.x = xb_xcc_id(); b.st = st;
    if (threadIdx.x == 0) (void)xb_add(&bar[XB_XCNT(b.x)], 1u);
    return b;
}
__device__ __forceinline__ void xcd_barrier_complete(unsigned* bar, unsigned x, unsigned& nloc, unsigned& nx) {
    const unsigned G = gridDim.x * gridDim.y * gridDim.z;
    unsigned sum, cnt, mine, sp = 0u;
    for (;;) {
        sum = 0u; cnt = 0u; mine = 0u;
#pragma unroll
        for (unsigned j = 0; j < 16; ++j) { const unsigned c = xb_ld(&bar[XB_XCNT(j)]); sum += c; cnt += (c > 0u) ? 1u : 0u; mine = (j == x) ? c : mine; }
        if (sum == G) break;
        __builtin_amdgcn_s_sleep(1);
        if ((++sp & 255u) == 0u) { if (xb_ld(&bar[XB_TMO])) break; if (sp > XB_SPIN_CAP) { atomicAdd(&bar[XB_TMO], 1u); break; } }
    }
    nloc = mine > 0u ? mine : 1u; nx = cnt > 0u ? cnt : 1u;
}
__device__ __forceinline__ void xcd_barrier(const XcdBarrier& b) {
    asm volatile("s_waitcnt vmcnt(0)" ::: "memory");
    __syncthreads();
    if (threadIdx.x == 0) {
        unsigned* bar = b.bar;
        __builtin_amdgcn_s_waitcnt(0);
        unsigned nloc = b.st[0], nx = b.st[1];
        if (nloc == 0u) { xcd_barrier_complete(bar, b.x, nloc, nx); b.st[0] = nloc; b.st[1] = nx; }
        const unsigned old = xb_add(&bar[XB_XSUB(b.x)], 1u);
        const unsigned gen = old / nloc;
        if (old + 1u == (gen + 1u) * nloc) {
            __builtin_amdgcn_fence(__ATOMIC_RELEASE, "agent");
            asm volatile("s_waitcnt vmcnt(0)" ::: "memory");
            const unsigned og = xb_add(&bar[XB_TOP], 1u);
            const unsigned tg = og / nx;
            if (og + 1u == (tg + 1u) * nx) xb_add(&bar[XB_TOPGEN], 1u);
            else XB_SPIN(xb_ld(&bar[XB_TOPGEN]) == tg, bar);
            __builtin_amdgcn_fence(__ATOMIC_ACQUIRE, "agent");
            xb_add(&bar[XB_XGEN(b.x)], 1u);
            asm volatile("s_waitcnt vmcnt(0)" ::: "memory");
        } else {
            XB_SPIN(xb_ld(&bar[XB_XGEN(b.x)]) == gen, bar);
            __builtin_amdgcn_fence(__ATOMIC_ACQUIRE, "agent");
            asm volatile("s_waitcnt vmcnt(0)" ::: "memory");
        }
    }
    __syncthreads();
}

__device__ __forceinline__ void transpose_item(const float* __restrict__ src, int N, u16* __restrict__ dst, int kt, int nt, float* tl) {
  const int tid = opaque_tid();
#pragma unroll 4
  for (int i = 0; i < 16; i++) {
    int idx = tid + 256 * i;
    int kk = idx >> 6, nn = idx & 63;
    int n = nt * 64 + nn;
    float v = (n < N) ? src[(size_t)(kt * 64 + kk) * N + n] : 0.f;
    tl[kk * 65 + nn] = v;
  }
  __syncthreads();
#pragma unroll 4
  for (int i = 0; i < 16; i++) {
    int idx = tid + 256 * i;
    int nn = idx >> 6, kk = idx & 63;
    dst[(size_t)(nt * 64 + nn) * 1024 + kt * 64 + kk] = f2bf(tl[kk * 65 + nn]);
  }
  __syncthreads();
}

__device__ __forceinline__ void wst_item(const P& p, int it, float* sm) {
  (void)sm;
  const int tid = opaque_tid(), lane = tid & 63, w = tid >> 6, r = lane & 15, quad = lane >> 4;
  const int l = it >> 9, rem = it & 511, hp = rem >> 5, kt = (rem >> 2) & 7, dchunk = rem & 3;
  const float* wq = p.peer_wq + (size_t)l * 1024 * 2048 + hp * 128 + quad * 4;
  const float* keys = p.peer_keys + ((size_t)(l * 16 + hp) * 128 + kt * 16 + r) * 128 + quad * 4;
  const int dbase = dchunk * 256 + w * 64;
  f32x4 acc[4];
#pragma unroll
  for (int dt = 0; dt < 4; dt++) acc[dt] = (f32x4){0.f, 0.f, 0.f, 0.f};
#pragma unroll 2
  for (int jj = 0; jj < 8; jj++) {
    const float4 b4 = *(const float4*)(keys + jj * 16);
#pragma unroll
    for (int dt = 0; dt < 4; dt++) {
      const float4 a4 = *(const float4*)(wq + (size_t)(dbase + dt * 16 + r) * 2048 + jj * 16);
      acc[dt] = __builtin_amdgcn_mfma_f32_16x16x4f32(a4.x, b4.x, acc[dt], 0, 0, 0);
      acc[dt] = __builtin_amdgcn_mfma_f32_16x16x4f32(a4.y, b4.y, acc[dt], 0, 0, 0);
      acc[dt] = __builtin_amdgcn_mfma_f32_16x16x4f32(a4.z, b4.z, acc[dt], 0, 0, 0);
      acc[dt] = __builtin_amdgcn_mfma_f32_16x16x4f32(a4.w, b4.w, acc[dt], 0, 0, 0);
    }
  }
  u16* dst = p.WsT + (size_t)l * 2048 * 1024 + (size_t)(hp * 128 + kt * 16 + r) * 1024 + dbase + quad * 4;
#pragma unroll
  for (int dt = 0; dt < 4; dt++) {
    uint2 o;
    o.x = pack2(acc[dt][0], acc[dt][1]);
    o.y = pack2(acc[dt][2], acc[dt][3]);
    *(uint2*)(dst + dt * 16) = o;
  }
}

__device__ __forceinline__ void mod_item(const P& p, int it, float* sm) {
  const int tid = opaque_tid();
  int l = it / 96, cc = it % 96;
  float* sc = sm;
  float* red = sm + 9216;
  for (int idx = tid; idx < 9216; idx += 256) {
    int r = idx >> 10, k = idx & 1023;
    float v = (r < 8) ? p.c[r * 1024 + k] : p.c_ctx[k];
    sc[idx] = siluf_(v);
  }
  __syncthreads();
  int cl = tid & 63, kg = tid >> 6;
  int col = cc * 64 + cl;
  float acc[9];
#pragma unroll
  for (int r = 0; r < 9; r++) acc[r] = 0.f;
  const float* wa = p.w_ada + (size_t)l * 1024 * 6144;
#pragma unroll 16
  for (int k = kg * 256; k < kg * 256 + 256; k++) {
    float w = wa[(size_t)k * 6144 + col];
#pragma unroll
    for (int r = 0; r < 9; r++) acc[r] += sc[r * 1024 + k] * w;
  }
#pragma unroll
  for (int r = 0; r < 9; r++) red[(kg * 9 + r) * 64 + cl] = acc[r];
  __syncthreads();
  if (kg == 0) {
    float bb = p.b_ada[l * 6144 + col];
#pragma unroll
    for (int r = 0; r < 9; r++) {
      float s = red[(0 * 9 + r) * 64 + cl] + red[(1 * 9 + r) * 64 + cl] + red[(2 * 9 + r) * 64 + cl] + red[(3 * 9 + r) * 64 + cl];
      p.mod[(size_t)(l * 9 + r) * 6144 + col] = s + bb;
    }
  }
  __syncthreads();
}

__device__ __forceinline__ void phase_prologue(const P& p, char* smem) {
  float* sm = (float*)smem;
  const int tid = opaque_tid();
  const int N_A = 2 * 16 * 46, N_B = 2 * 16 * 16, N_C = 1024, N_D = 192, N_E = 4096;
  const int total = N_A + N_B + N_C + N_D + N_E;
  for (int item = blockIdx.x; item < total; item += gridDim.x) {
    int it = item;
    if (it < N_D) { mod_item(p, it, sm); continue; }
    it -= N_D;
    if (it < N_C) { wst_item(p, it, sm); continue; }
    it -= N_C;
    if (it < N_A) {
      int l = it / (16 * 46), r = it % (16 * 46);
      transpose_item(p.w_in + (size_t)l * 1024 * INC, INC, p.WinT + (size_t)l * INC_PAD * 1024, r / 46, r % 46, sm);
      continue;
    }
    it -= N_A;
    if (it < N_B) {
      int l = it >> 8, r = it & 255;
      transpose_item(p.w_out + (size_t)l * 1024 * 1024, 1024, p.WoutT + (size_t)l * 1024 * 1024, r >> 4, r & 15, sm);
      continue;
    }
    it -= N_B;
    {
      if ((it >> 11) == 0) {
        const int lane_ = tid & 63, w_ = tid >> 6;
        const int chunk_ = it & 2047;
#pragma unroll
        for (int rr = 0; rr < 4; rr++) {
          const int R = chunk_ * 16 + w_ * 4 + rr;
          const float4* src = (const float4*)(p.peer_u + (size_t)R * 1024 + lane_ * 16);
          typedef __attribute__((ext_vector_type(4))) float f4v;
          const f4v* s4 = (const f4v*)src;
          f4v t0 = __builtin_nontemporal_load(s4), t1 = __builtin_nontemporal_load(s4 + 1), t2 = __builtin_nontemporal_load(s4 + 2), t3 = __builtin_nontemporal_load(s4 + 3);
          float4 v0 = make_float4(t0[0], t0[1], t0[2], t0[3]), v1 = make_float4(t1[0], t1[1], t1[2], t1[3]), v2 = make_float4(t2[0], t2[1], t2[2], t2[3]), v3 = make_float4(t3[0], t3[1], t3[2], t3[3]);
          float mx = fmaxf(fmaxf(fmaxf(fabsf(v0.x), fabsf(v0.y)), fmaxf(fabsf(v0.z), fabsf(v0.w))), fmaxf(fmaxf(fabsf(v1.x), fabsf(v1.y)), fmaxf(fabsf(v1.z), fabsf(v1.w))));
          mx = fmaxf(mx, fmaxf(fmaxf(fmaxf(fabsf(v2.x), fabsf(v2.y)), fmaxf(fabsf(v2.z), fabsf(v2.w))), fmaxf(fmaxf(fabsf(v3.x), fabsf(v3.y)), fmaxf(fabsf(v3.z), fabsf(v3.w)))));
#pragma unroll
          for (int o = 32; o; o >>= 1) mx = fmaxf(mx, __shfl_xor(mx, o));
          const float inv = mx > 0.f ? 127.f / mx : 0.f;
          uint4 o;
          o.x = q8pack(v0.x * inv, v0.y * inv, v0.z * inv, v0.w * inv);
          o.y = q8pack(v1.x * inv, v1.y * inv, v1.z * inv, v1.w * inv);
          o.z = q8pack(v2.x * inv, v2.y * inv, v2.z * inv, v2.w * inv);
          o.w = q8pack(v3.x * inv, v3.y * inv, v3.z * inv, v3.w * inv);
          const unsigned ll = (unsigned)R >> 14, ee = (unsigned)R & 16383u;
          size_t off = ((size_t)((ll * 8u + (unsigned)(lane_ >> 3)) * 16384u + ee)) * 128 + (lane_ & 7) * 16;
          *(uint4*)((unsigned char*)p.Ub + off) = o;
          if (lane_ == 0) p.su[R] = mx * (1.f / 127.f);
        }
        continue;
      }
      int tab = it >> 11;
      int chunk = it & 2047;
      const float scl = tab ? 8.f : 64.f;
      const float4* src = (const float4*)(tab ? p.peer_v : p.peer_u) + (size_t)chunk * 4096;
      unsigned char* dstb = (unsigned char*)(tab ? p.Vb : p.Ub);
#pragma unroll
      for (int i = 0; i < 4; i++) {
        int q = i * 256 + tid;
        typedef __attribute__((ext_vector_type(4))) float f4v;
        const f4v* s4 = (const f4v*)src + q * 4;
        f4v t0 = __builtin_nontemporal_load(s4), t1 = __builtin_nontemporal_load(s4 + 1), t2 = __builtin_nontemporal_load(s4 + 2), t3 = __builtin_nontemporal_load(s4 + 3);
        float4 v0 = make_float4(t0[0], t0[1], t0[2], t0[3]), v1 = make_float4(t1[0], t1[1], t1[2], t1[3]), v2 = make_float4(t2[0], t2[1], t2[2], t2[3]), v3 = make_float4(t3[0], t3[1], t3[2], t3[3]);
        uint4 o;
        int w_;
        w_ = __builtin_amdgcn_cvt_pk_fp8_f32(v0.x * scl, v0.y * scl, 0, false);
        w_ = __builtin_amdgcn_cvt_pk_fp8_f32(v0.z * scl, v0.w * scl, w_, true);
        o.x = (unsigned)w_;
        w_ = __builtin_amdgcn_cvt_pk_fp8_f32(v1.x * scl, v1.y * scl, 0, false);
        w_ = __builtin_amdgcn_cvt_pk_fp8_f32(v1.z * scl, v1.w * scl, w_, true);
        o.y = (unsigned)w_;
        w_ = __builtin_amdgcn_cvt_pk_fp8_f32(v2.x * scl, v2.y * scl, 0, false);
        w_ = __builtin_amdgcn_cvt_pk_fp8_f32(v2.z * scl, v2.w * scl, w_, true);
        o.z = (unsigned)w_;
        w_ = __builtin_amdgcn_cvt_pk_fp8_f32(v3.x * scl, v3.y * scl, 0, false);
        w_ = __builtin_amdgcn_cvt_pk_fp8_f32(v3.z * scl, v3.w * scl, w_, true);
        o.w = (unsigned)w_;
        {
          unsigned G = (unsigned)chunk * 1024u + (unsigned)q;
          unsigned ll = G >> 20, ee = (G >> 6) & 16383u, cgp = G & 63u;
          size_t off = ((size_t)((ll * 8u + (cgp >> 3)) * 16384u + ee)) * 128 + (cgp & 7u) * 16;
          *(uint4*)(dstb + off) = o;
        }
      }
    }
  }
}

__device__ __forceinline__ void phase_norm(const P& p, int l, int which) {
  const int tid = opaque_tid(), lane = tid & 63, w = tid >> 6;
  const int nrows = (which == 2 && l == 1) ? ML_ROWS : MT_ROWS;
  const float* g = (which == 1 ? p.norm1_g : p.norm2_g) + l * 1024;
  for (int item = blockIdx.x; item * 4 < nrows; item += gridDim.x) {
    int row = item * 4 + w;
    const float* src;
    if (l == 0 && which == 1) src = row < ML_ROWS ? p.x + (size_t)row * 1024 : p.ctx + (size_t)(row - ML_ROWS) * 1024;
    else src = row < ML_ROWS ? p.out + (size_t)row * 1024 : p.hc + (size_t)(row - ML_ROWS) * 1024;
    int mr = row < ML_ROWS ? (row >> 11) : 8;
    const float* modp = p.mod + (size_t)(l * 9 + mr) * 6144;
    const float* sh = modp + (which == 1 ? 0 : 3072);
    const float* sc = modp + (which == 1 ? 1024 : 4096);
    float4 v[4];
    float ss = 0.f;
#pragma unroll
    for (int i = 0; i < 4; i++) {
      v[i] = ((const float4*)src)[i * 64 + lane];
      ss += v[i].x * v[i].x + v[i].y * v[i].y + v[i].z * v[i].z + v[i].w * v[i].w;
    }
    ss = wave_sum(ss);
    float rs = rsqrtf(ss * (1.f / 1024.f) + 1e-6f);
    float ov[16];
    float omax = 0.f;
#pragma unroll
    for (int i = 0; i < 4; i++) {
      int d = (i * 64 + lane) * 4;
      float4 gg = *(const float4*)(g + d);
      float4 s4 = *(const float4*)(sc + d);
      float4 h4 = *(const float4*)(sh + d);
      float o0 = v[i].x * rs * gg.x * (1.f + s4.x) + h4.x;
      float o1 = v[i].y * rs * gg.y * (1.f + s4.y) + h4.y;
      float o2 = v[i].z * rs * gg.z * (1.f + s4.z) + h4.z;
      float o3 = v[i].w * rs * gg.w * (1.f + s4.w) + h4.w;
      uint2 o;
      o.x = pack2(o0, o1);
      o.y = pack2(o2, o3);
      ((uint2*)(p.xn + (size_t)row * 1024))[i * 64 + lane] = o;
      ov[i * 4 + 0] = o0; ov[i * 4 + 1] = o1; ov[i * 4 + 2] = o2; ov[i * 4 + 3] = o3;
      omax = fmaxf(omax, fmaxf(fmaxf(fabsf(o0), fabsf(o1)), fmaxf(fabsf(o2), fabsf(o3))));
    }
    if (which == 2) {
#pragma unroll
      for (int o = 32; o; o >>= 1) omax = fmaxf(omax, __shfl_xor(omax, o));
      const float inv = omax > 0.f ? 127.f / omax : 0.f;
#pragma unroll
      for (int i = 0; i < 4; i++)
        ((unsigned*)(p.xq + (size_t)row * 1024))[i * 64 + lane] = q8pack(ov[i * 4] * inv, ov[i * 4 + 1] * inv, ov[i * 4 + 2] * inv, ov[i * 4 + 3] * inv);
      if (lane == 0) p.sx[row] = omax * (1.f / 127.f);
    }
  }
}

template <int EPI>
__device__ __forceinline__ void phase_gemm(const P& p, int l, const u16* __restrict__ A, const u16* __restrict__ Bt, int mtiles, int ntiles,
                           char* smem) {
  u16* As = (u16*)smem;
  u16* Bs = As + 128 * 72;
  const int tid = opaque_tid(), lane = tid & 63, w = tid >> 6, wm = w >> 1, wn = w & 1;
  const int lr = lane & 15, quad = lane >> 4;
  const int xk = blockIdx.x & 7, lb = blockIdx.x >> 3, nb = gridDim.x >> 3;
  const int mg = xk >> 1;
  const int nh0 = (ntiles + 1) >> 1;
  const int nbase = (xk & 1) ? nh0 : 0, nloc = (xk & 1) ? (ntiles - nh0) : nh0;
  const int mcount = (mtiles - mg + 3) >> 2;
  const int nlocal = mcount * nloc;
  for (int li = lb; li < nlocal; li += nb) {
    int mi = li / nloc;
    int mt = mg + 4 * mi, nt = nbase + (li - mi * nloc);
    int m0 = mt * 128, n0 = nt * 128;
    f32x4 acc[4][4];
#pragma unroll
    for (int i = 0; i < 4; i++)
#pragma unroll
      for (int j = 0; j < 4; j++) acc[i][j] = (f32x4){0.f, 0.f, 0.f, 0.f};
    const int r0_ = tid >> 3, ch_ = tid & 7;
    const u16* Ap0 = A + (size_t)(m0 + r0_) * 1024 + ch_ * 8;
    const u16* Bp0 = Bt + (size_t)(n0 + r0_) * 1024 + ch_ * 8;
    uint4 ra0 = *(const uint4*)Ap0, ra1 = *(const uint4*)(Ap0 + 32 * 1024), ra2 = *(const uint4*)(Ap0 + 64 * 1024), ra3 = *(const uint4*)(Ap0 + 96 * 1024);
    uint4 rb0 = *(const uint4*)Bp0, rb1 = *(const uint4*)(Bp0 + 32 * 1024), rb2 = *(const uint4*)(Bp0 + 64 * 1024), rb3 = *(const uint4*)(Bp0 + 96 * 1024);
    for (int kt = 0; kt < 16; kt++) {
      __syncthreads();
      *(uint4*)(As + r0_ * 72 + ch_ * 8) = ra0;
      *(uint4*)(As + (r0_ + 32) * 72 + ch_ * 8) = ra1;
      *(uint4*)(As + (r0_ + 64) * 72 + ch_ * 8) = ra2;
      *(uint4*)(As + (r0_ + 96) * 72 + ch_ * 8) = ra3;
      *(uint4*)(Bs + r0_ * 72 + ch_ * 8) = rb0;
      *(uint4*)(Bs + (r0_ + 32) * 72 + ch_ * 8) = rb1;
      *(uint4*)(Bs + (r0_ + 64) * 72 + ch_ * 8) = rb2;
      *(uint4*)(Bs + (r0_ + 96) * 72 + ch_ * 8) = rb3;
      __syncthreads();
      if (kt < 15) {
        const int ko = (kt + 1) * 64;
        ra0 = *(const uint4*)(Ap0 + ko); ra1 = *(const uint4*)(Ap0 + 32 * 1024 + ko); ra2 = *(const uint4*)(Ap0 + 64 * 1024 + ko); ra3 = *(const uint4*)(Ap0 + 96 * 1024 + ko);
        rb0 = *(const uint4*)(Bp0 + ko); rb1 = *(const uint4*)(Bp0 + 32 * 1024 + ko); rb2 = *(const uint4*)(Bp0 + 64 * 1024 + ko); rb3 = *(const uint4*)(Bp0 + 96 * 1024 + ko);
      }
#pragma unroll
      for (int ks = 0; ks < 2; ks++) {
        bf16x8 a[4], b[4];
#pragma unroll
        for (int i = 0; i < 4; i++) {
          a[i] = *(const bf16x8*)(As + (wm * 64 + i * 16 + lr) * 72 + ks * 32 + quad * 8);
          b[i] = *(const bf16x8*)(Bs + (wn * 64 + i * 16 + lr) * 72 + ks * 32 + quad * 8);
        }
#pragma unroll
        for (int i = 0; i < 4; i++)
#pragma unroll
          for (int j = 0; j < 4; j++) acc[i][j] = __builtin_amdgcn_mfma_f32_16x16x32_bf16(b[j], a[i], acc[i][j], 0, 0, 0);
      }
    }
#pragma unroll
    for (int i = 0; i < 4; i++)
#pragma unroll
      for (int j = 0; j < 4; j++) {
        const int row = m0 + wm * 64 + i * 16 + lr;
        const int col = n0 + wn * 64 + j * 16 + quad * 4;
        const f32x4 v = acc[i][j];
        if (EPI == 0) {
          if (col < INC) {
            uint2 o;
            o.x = pack2(v[0], v[1]);
            o.y = pack2(v[2], v[3]);
            *(uint2*)(p.U + (size_t)row * INC + col) = o;
            if (col >= 2816) *(float4*)(p.G + row * 16 + (col - 2816)) = make_float4(v[0], v[1], v[2], v[3]);
          }
        } else if (EPI == 1) {
          const int mr = row < ML_ROWS ? (row >> 11) : 8;
          const float4 g1 = *(const float4*)(p.mod + (size_t)(l * 9 + mr) * 6144 + 2048 + col);
          float4 sv;
          if (l == 0) sv = row < ML_ROWS ? *(const float4*)(p.x + (size_t)row * 1024 + col) : *(const float4*)(p.ctx + (size_t)(row - ML_ROWS) * 1024 + col);
          else sv = *(const float4*)(p.out + (size_t)row * 1024 + col);
          float* dst = row < ML_ROWS ? p.out + (size_t)row * 1024 + col : p.hc + (size_t)(row - ML_ROWS) * 1024 + col;
          *(float4*)dst = make_float4(sv.x + g1.x * v[0], sv.y + g1.y * v[1], sv.z + g1.z * v[2], sv.w + g1.w * v[3]);
        } else {
          *(float4*)(p.S + (size_t)row * 2048 + col) = make_float4(v[0], v[1], v[2], v[3]);
        }
      }
  }
}

__device__ __forceinline__ void vt_item(const P& p, int it, u16* tl);
__device__ __forceinline__ void phase_mixprep(const P& p, int l, char* smem) {
  float* pl = (float*)smem;
  const int N_QK = MT_ROWS * 16 / 256;
  const int N_POOL = (l == 0 ? MT_ROWS : ML_ROWS) / 16;
  const int N_PREP = MT_ROWS / 4;
  const int N_VT = 2304 + 1152;
  const int total = N_QK + N_POOL + N_PREP + N_VT;
  for (int item = blockIdx.x; item < total; item += gridDim.x) {
    const int tid = opaque_tid();
    int it = item;
    if (it >= N_QK + N_POOL + N_PREP) { vt_item(p, it - (N_QK + N_POOL + N_PREP), (u16*)smem); continue; }
    if (it < N_QK) {
      int gi = it * 256 + tid;
      int row = gi >> 4, sub = gi & 15;
      int qk = sub >> 3, h = sub & 7;
      u16* ptr = p.U + (size_t)row * INC + qk * 512 + h * 64;
      const float* g = (qk ? p.na_k_g : p.na_q_g) + l * 64;
      uint4 v[8];
      float ss = 0.f;
#pragma unroll
      for (int c = 0; c < 8; c++) {
        v[c] = ((const uint4*)ptr)[c];
        float a;
        a = bflo(v[c].x); ss += a * a; a = bfhi(v[c].x); ss += a * a;
        a = bflo(v[c].y); ss += a * a; a = bfhi(v[c].y); ss += a * a;
        a = bflo(v[c].z); ss += a * a; a = bfhi(v[c].z); ss += a * a;
        a = bflo(v[c].w); ss += a * a; a = bfhi(v[c].w); ss += a * a;
      }
      float rs = rsqrtf(ss * (1.f / 64.f) + 1e-6f);
#pragma unroll
      for (int c = 0; c < 8; c++) {
        uint4 o;
        o.x = pack2(bflo(v[c].x) * rs * g[c * 8 + 0], bfhi(v[c].x) * rs * g[c * 8 + 1]);
        o.y = pack2(bflo(v[c].y) * rs * g[c * 8 + 2], bfhi(v[c].y) * rs * g[c * 8 + 3]);
        o.z = pack2(bflo(v[c].z) * rs * g[c * 8 + 4], bfhi(v[c].z) * rs * g[c * 8 + 5]);
        o.w = pack2(bflo(v[c].w) * rs * g[c * 8 + 6], bfhi(v[c].w) * rs * g[c * 8 + 7]);
        ((uint4*)ptr)[c] = o;
      }
      continue;
    }
    it -= N_QK;
    if (it < N_POOL) {
      int row0 = it * 16;
      int base, T;
      if (row0 < ML_ROWS) { base = (row0 >> 11) << 11; T = 2048; }
      else { base = ML_ROWS + (((row0 - ML_ROWS) >> 8) << 8); T = 256; }
      int t0 = row0 - base;
      int ch = tid, g = ch >> 6;
      int wdw = 2 << g;
      __syncthreads();
      {
        float vals[31];
#pragma unroll
        for (int j = 0; j < 31; j++) {
          int tau = t0 - 8 + j;
          bool ok = (tau >= 0) && (tau < T);
          vals[j] = ok ? bf2f(p.U[(size_t)(base + (ok ? tau : t0)) * INC + 1536 + ch]) : 0.f;
        }
        const int hl = wdw / 2, hr = wdw - wdw / 2 - 1;
#pragma unroll
        for (int tt = 0; tt < 16; tt++) {
          int t = t0 + tt;
          int lo = max(t - hl, 0), hi = min(t + hr, T - 1);
          float s = 0.f;
#pragma unroll
          for (int j = 0; j < 31; j++) {
            int rel = j - 8 - tt;
            if (rel >= -8 && rel <= 7) s += (rel >= -hl && rel <= hr) ? vals[j] : 0.f;
          }
          pl[tt * 256 + ch] = s / (float)(hi - lo + 1) - vals[8 + tt];
        }
      }
      __syncthreads();
      float acc[16];
#pragma unroll
      for (int tt = 0; tt < 16; tt++) acc[tt] = 0.f;
      int d = ch & 63;
      const float* pw = p.pool_w + ((size_t)(l * 4 + g) * 64) * 64 + d;
      for (int c = 0; c < 64; c++) {
        float wv = pw[c * 64];
#pragma unroll
        for (int tt = 0; tt < 16; tt++) acc[tt] += pl[tt * 256 + g * 64 + c] * wv;
      }
      float ps = p.pool_scale[l * 256 + ch];
#pragma unroll
      for (int tt = 0; tt < 16; tt++) p.Y[(size_t)(row0 + tt) * 1024 + 512 + ch] = f2bf(acc[tt] * ps);
      continue;
    }
    it -= N_POOL;
    {
      const int row0 = it * 4;
      int base, T;
      if (row0 < ML_ROWS) { base = (row0 >> 11) << 11; T = 2048; }
      else { base = ML_ROWS + (((row0 - ML_ROWS) >> 8) << 8); T = 256; }
      const int t0 = row0 - base;
      const int qk = tid >> 7, hh = (tid >> 5) & 3, ax = (tid >> 4) & 1, f = tid & 15;
      const int ca = qk * 256 + hh * 64 + ax * 32 + f, cb = ca + 16;
      float ua[8], ub[8];
#pragma unroll
      for (int j = 0; j < 8; j++) {
        int tt = t0 + j - 2;
        bool ok = (tt >= 0) && (tt < T);
        const u16* ur = p.U + (size_t)(base + (ok ? tt : t0)) * INC + 1792;
        ua[j] = ok ? bf2f(ur[ca]) : 0.f;
        ub[j] = ok ? bf2f(ur[cb]) : 0.f;
      }
      float wa[5], wb[5];
#pragma unroll
      for (int j = 0; j < 5; j++) { wa[j] = p.ml_conv[(l * 5 + j) * 512 + ca]; wb[j] = p.ml_conv[(l * 5 + j) * 512 + cb]; }
      const float inv = __expf(-(float)f * (9.210340371976184f / 16.f));
#pragma unroll
      for (int i = 0; i < 4; i++) {
        float a = 0.f, b = 0.f;
#pragma unroll
        for (int j = 0; j < 5; j++) { a += wa[j] * ua[i + j]; b += wb[j] * ub[i + j]; }
        a = siluf_(a);
        b = siluf_(b);
        if (row0 < ML_ROWS) {
          int t = t0 + i;
          float pos = (float)(ax == 0 ? (t >> 6) : (t & 63));
          float ang = pos * inv;
          float cs = __cosf(ang), sn = __sinf(ang);
          float oa = a * cs - b * sn, ob = a * sn + b * cs;
          a = oa; b = ob;
        }
        if (qk) { a *= 0.125f; b *= 0.125f; }
        ((u16*)p.MQK)[(size_t)(row0 + i) * 512 + ca] = f2bf(a);
        ((u16*)p.MQK)[(size_t)(row0 + i) * 512 + cb] = f2bf(b);
      }
      if (tid < 64) {
        int gi = tid & 15;
        float gv = p.G[row0 * 16 + tid] + p.ml_gate_b[l * 16 + gi];
        if ((gi >> 2) & 1) gv = fminf(gv, 0.f) - log1pf(__expf(-fabsf(gv)));
        p.G[row0 * 16 + tid] = gv;
      }
    }
  }
}

#define VT_CTX_OFF ((size_t)8 * 8 * 64 * 2048)
#define VTM_CTX_OFF ((size_t)8 * 4 * 64 * 2048)
__device__ __forceinline__ void vt_item(const P& p, int it, u16* tl) {
  const int tid = opaque_tid();
  int b, h, tt, row0, TK, col0;
  u16* dst;
  if (it < 2048) { b = it >> 8; h = (it >> 5) & 7; tt = it & 31; row0 = b * 2048 + tt * 64; TK = 2048; col0 = 1024 + h * 64; dst = p.VT + (size_t)((b * 8 + h) * 64) * 2048 + tt * 64; }
  else if (it < 2304) { int ci = it - 2048; b = ci >> 5; h = (ci >> 2) & 7; tt = ci & 3; row0 = ML_ROWS + b * 256 + tt * 64; TK = 256; col0 = 1024 + h * 64; dst = p.VT + VT_CTX_OFF + (size_t)((b * 8 + h) * 64) * 256 + tt * 64; }
  else if (it < 2304 + 1024) { int mi = it - 2304; b = mi >> 7; h = (mi >> 5) & 3; tt = mi & 31; row0 = b * 2048 + tt * 64; TK = 2048; col0 = 2304 + h * 64; dst = p.VTm + (size_t)((b * 4 + h) * 64) * 2048 + tt * 64; }
  else { int mi = it - 3328; b = mi >> 4; h = (mi >> 2) & 3; tt = mi & 3; row0 = ML_ROWS + b * 256 + tt * 64; TK = 256; col0 = 2304 + h * 64; dst = p.VTm + VTM_CTX_OFF + (size_t)((b * 4 + h) * 64) * 256 + tt * 64; }
  __syncthreads();
  {
    int i = tid >> 2, part = tid & 3;
    const uint4* src = (const uint4*)(p.U + (size_t)(row0 + i) * INC + col0 + part * 16);
    uint4 v0 = src[0], v1 = src[1];
    unsigned* t32 = (unsigned*)(tl + i * 66 + part * 16);
    t32[0] = v0.x; t32[1] = v0.y; t32[2] = v0.z; t32[3] = v0.w;
    t32[4] = v1.x; t32[5] = v1.y; t32[6] = v1.z; t32[7] = v1.w;
  }
  __syncthreads();
  {
    int d = tid >> 2, part = tid & 3;
    unsigned o[8];
#pragma unroll
    for (int k = 0; k < 8; k++) {
      unsigned lo = tl[(part * 16 + 2 * k) * 66 + d], hi = tl[(part * 16 + 2 * k + 1) * 66 + d];
      o[k] = lo | (hi << 16);
    }
    uint4* dp = (uint4*)(dst + (size_t)d * TK + part * 16);
    dp[0] = make_uint4(o[0], o[1], o[2], o[3]);
    dp[1] = make_uint4(o[4], o[5], o[6], o[7]);
  }
}

__device__ __forceinline__ void attn_item(const P& p, int l, int item, float* sb) {
  const int tid = opaque_tid(), lane = tid & 63, w = tid >> 6, q = lane & 15, quad = lane >> 4;
  const bool latent = item < 2048;
  int b, r = 0, h, qb = 0;
  if (latent) { b = item >> 8; r = (item >> 3) & 31; h = item & 7; }
  else { int ci = item - 2048; b = ci >> 5; qb = (ci >> 3) & 3; h = ci & 7; }
  const int r0 = min(max(r - 4, 0), 24);
  __syncthreads();
  if (latent) {
    int kr = tid >> 5, j = tid & 31;
    if (j < 31) sb[tid] = p.na_rpb[(size_t)((l * 8 + h) * 15 + (r0 + kr - r + 7)) * 31 + j];
  }
  __syncthreads();
  const int qc = w * 16 + q;
  const int qrow = latent ? (b * 2048 + r * 64 + qc) : (ML_ROWS + b * 256 + qb * 64 + qc);
  const int cs = (w == 0) ? 0 : (w == 1) ? 8 : (w == 2) ? 24 : 32;
  const int c0 = min(max(qc - 8, 0), 48);
  const bf16x8 bq0 = *(const bf16x8*)(p.U + (size_t)qrow * INC + h * 64 + quad * 8);
  const bf16x8 bq1 = *(const bf16x8*)(p.U + (size_t)qrow * INC + h * 64 + 32 + quad * 8);
  const int mrow = (q >> 2) * 8 + (q & 3);
  const u16* vt_lat = p.VT + (size_t)((b * 8 + h) * 64 + q) * 2048 + quad * 8;
  const u16* vt_ctx = p.VT + VT_CTX_OFF + (size_t)((b * 8 + h) * 64 + q) * 256 + quad * 8;
  float m = -INFINITY, lsum = 0.f;
  f32x4 o[4];
#pragma unroll
  for (int dt = 0; dt < 4; dt++) o[dt] = (f32x4){0.f, 0.f, 0.f, 0.f};
#pragma unroll 1
  for (int chunk = (latent ? 0 : 2); chunk < 4; chunk++) {
    f32x4 s[4][2];
#pragma unroll
    for (int blk = 0; blk < 4; blk++) {
      int rowbase = (chunk < 2) ? (b * 2048 + (r0 + chunk * 4 + blk) * 64 + cs) : (ML_ROWS + b * 256 + (chunk - 2) * 128 + blk * 32);
#pragma unroll
      for (int T = 0; T < 2; T++) {
        const u16* kp = p.U + (size_t)(rowbase + mrow + T * 4) * INC + 512 + h * 64 + quad * 8;
        bf16x8 a0 = *(const bf16x8*)kp;
        bf16x8 a1 = *(const bf16x8*)(kp + 32);
        f32x4 acc = (f32x4){0.f, 0.f, 0.f, 0.f};
        acc = __builtin_amdgcn_mfma_f32_16x16x32_bf16(a0, bq0, acc, 0, 0, 0);
        acc = __builtin_amdgcn_mfma_f32_16x16x32_bf16(a1, bq1, acc, 0, 0, 0);
        s[blk][T] = acc;
      }
    }
    float mx = -INFINITY;
    if (chunk < 2) {
#pragma unroll
      for (int blk = 0; blk < 4; blk++)
#pragma unroll
        for (int T = 0; T < 2; T++)
#pragma unroll
          for (int rr = 0; rr < 4; rr++) {
            int kc = cs + quad * 8 + T * 4 + rr;
            bool valid = (kc >= c0) && (kc < c0 + 16);
            int bi = (chunk * 4 + blk) * 32 + min(max(kc - qc + 15, 0), 30);
            float v = valid ? (s[blk][T][rr] * 0.125f + sb[bi]) : -INFINITY;
            s[blk][T][rr] = v;
            mx = fmaxf(mx, v);
          }
    } else {
#pragma unroll
      for (int blk = 0; blk < 4; blk++)
#pragma unroll
        for (int T = 0; T < 2; T++)
#pragma unroll
          for (int rr = 0; rr < 4; rr++) {
            float v = s[blk][T][rr] * 0.125f;
            s[blk][T][rr] = v;
            mx = fmaxf(mx, v);
          }
    }
    mx = fmaxf(mx, __shfl_xor(mx, 16));
    mx = fmaxf(mx, __shfl_xor(mx, 32));
    float mn = fmaxf(m, mx);
    float sc = __expf(m - mn);
    lsum *= sc;
#pragma unroll
    for (int dt = 0; dt < 4; dt++) o[dt] *= sc;
    m = mn;
#pragma unroll
    for (int blk = 0; blk < 4; blk++) {
      float pv[8];
#pragma unroll
      for (int T = 0; T < 2; T++)
#pragma unroll
        for (int rr = 0; rr < 4; rr++) {
          float e = __expf(s[blk][T][rr] - mn);
          pv[T * 4 + rr] = e;
          lsum += e;
        }
      union { bf16x8 v; unsigned u[4]; } pk;
      pk.u[0] = pack2(pv[0], pv[1]); pk.u[1] = pack2(pv[2], pv[3]); pk.u[2] = pack2(pv[4], pv[5]); pk.u[3] = pack2(pv[6], pv[7]);
      const u16* vb = (chunk < 2) ? (vt_lat + (r0 + chunk * 4 + blk) * 64 + cs) : (vt_ctx + (chunk - 2) * 128 + blk * 32);
      const size_t dstr = (chunk < 2) ? (size_t)16 * 2048 : (size_t)16 * 256;
#pragma unroll
      for (int dt = 0; dt < 4; dt++) {
        bf16x8 av = *(const bf16x8*)(vb + dt * dstr);
        o[dt] = __builtin_amdgcn_mfma_f32_16x16x32_bf16(av, pk.v, o[dt], 0, 0, 0);
      }
    }
  }
  lsum += __shfl_xor(lsum, 16);
  lsum += __shfl_xor(lsum, 32);
  float il = 1.f / lsum;
#pragma unroll
  for (int dt = 0; dt < 4; dt++) {
    uint2 ov;
    ov.x = pack2(o[dt][0] * il, o[dt][1] * il);
    ov.y = pack2(o[dt][2] * il, o[dt][3] * il);
    *(uint2*)(p.Y + (size_t)qrow * 1024 + h * 64 + dt * 16 + quad * 4) = ov;
  }
}

__device__ __forceinline__ int ml_row(int b, int dir, int j, int pp) {
  if (j < 4) {
    int pos = j * 64 + pp;
    int t = dir ? 255 - pos : pos;
    return ML_ROWS + b * 256 + t;
  } else {
    int pos = (j - 4) * 64 + pp;
    int t = dir ? 2047 - pos : pos;
    return b * 2048 + t;
  }
}

__device__ __forceinline__ void mlstmA_item(const P& p, int it, float* sm) {
  const int tid = opaque_tid(), lane = tid & 63;
  int seq = it / 36, j = it % 36;
  int b = seq >> 3, h = (seq >> 1) & 3, dir = seq & 1;
  float* ks = sm;
  float* vs = sm + 64 * 68;
  float* wsm = vs + 64 * 65;
  float* slot = p.mst + (size_t)it * SLOT;
  const u16* mqk = (const u16*)p.MQK;
  __syncthreads();
#pragma unroll
  for (int q = 0; q < 2; q++) {
    int idx = tid + 256 * q;
    int pp = idx >> 3, d8 = (idx & 7) * 8;
    int row = ml_row(b, dir, j, pp);
    uint4 kv = *(const uint4*)(mqk + (size_t)row * 512 + 256 + h * 64 + d8);
    uint4 vv = *(const uint4*)(p.U + (size_t)row * INC + 2304 + h * 64 + d8);
    *(float4*)(ks + pp * 68 + d8) = make_float4(bflo(kv.x), bfhi(kv.x), bflo(kv.y), bfhi(kv.y));
    *(float4*)(ks + pp * 68 + d8 + 4) = make_float4(bflo(kv.z), bfhi(kv.z), bflo(kv.w), bfhi(kv.w));
    float* vp = vs + pp * 65 + d8;
    vp[0] = bflo(vv.x); vp[1] = bfhi(vv.x); vp[2] = bflo(vv.y); vp[3] = bfhi(vv.y);
    vp[4] = bflo(vv.z); vp[5] = bfhi(vv.z); vp[6] = bflo(vv.w); vp[7] = bfhi(vv.w);
  }
  if (tid < 64) {
    int row = ml_row(b, dir, j, lane);
    float ic = p.G[row * 16 + (dir * 2) * 4 + h];
    float fc = p.G[row * 16 + (dir * 2 + 1) * 4 + h];
    float bbv = fc;
#pragma unroll
    for (int o = 1; o < 64; o <<= 1) { float u = __shfl_up(bbv, o); if (lane >= o) bbv += u; }
    float cs = ic - bbv;
    float pm = cs;
#pragma unroll
    for (int o = 1; o < 64; o <<= 1) { float u = __shfl_up(pm, o); if (lane >= o) pm = fmaxf(pm, u); }
    float bl = __shfl(bbv, 63);
    float ml = __shfl(pm, 63) + bl;
    wsm[lane] = __expf(bl + cs - ml);
    slot[4224 + lane] = bbv;
    slot[4288 + lane] = cs;
    slot[4352 + lane] = pm;
    if (lane == 0) { slot[4160] = bl; slot[4161] = ml; }
  }
  __syncthreads();
  {
    int e = tid & 63, dg = tid >> 6;
    float acc[16];
#pragma unroll
    for (int dd = 0; dd < 16; dd++) acc[dd] = 0.f;
    for (int pp = 0; pp < 64; pp++) {
      float wv = wsm[pp] * vs[pp * 65 + e];
      const float4* kp = (const float4*)(ks + pp * 68 + dg * 16);
#pragma unroll
      for (int q4 = 0; q4 < 4; q4++) {
        float4 k4 = kp[q4];
        acc[q4 * 4 + 0] += k4.x * wv; acc[q4 * 4 + 1] += k4.y * wv; acc[q4 * 4 + 2] += k4.z * wv; acc[q4 * 4 + 3] += k4.w * wv;
      }
    }
#pragma unroll
    for (int q4 = 0; q4 < 4; q4++)
      *(float4*)(slot + e * 64 + dg * 16 + q4 * 4) = make_float4(acc[q4 * 4], acc[q4 * 4 + 1], acc[q4 * 4 + 2], acc[q4 * 4 + 3]);
  }
  if (tid < 64) {
    float a = 0.f;
    for (int pp = 0; pp < 64; pp++) a += wsm[pp] * ks[pp * 68 + tid];
    slot[4096 + tid] = a;
  }
}

#define ATT_SPLIT 768
__device__ __forceinline__ void phase_attn_mlA(const P& p, int l, char* smem) {
  const int N_MLA = 64 * 36;
  const int total = ATT_SPLIT + N_MLA;
  for (int item = blockIdx.x; item < total; item += gridDim.x) {
    if (item < N_MLA) mlstmA_item(p, item, (float*)smem);
    else attn_item(p, l, item - N_MLA, (float*)smem);
  }
}
__device__ __forceinline__ void mlB_item(const P& p, int item);
__device__ __forceinline__ void phase_attn_mlB(const P& p, int l, char* smem) {
  const int N_ATT = (l == 0 ? 2304 : 2048) - ATT_SPLIT;
  const int N_MLB = 64 * 17;
  const int total = N_ATT + N_MLB;
  for (int item = blockIdx.x; item < total; item += gridDim.x) {
    if (item < N_MLB) mlB_item(p, item);
    else attn_item(p, l, ATT_SPLIT + item - N_MLB, (float*)smem);
  }
}

__device__ __forceinline__ void mlB_item(const P& p, int item) {
  const int tid = opaque_tid();
  int seq = item / 17, ech = item - seq * 17;
  int el = ech * 256 + tid;
  if (el >= 4160) return;
  float* base = p.mst + (size_t)(seq * 36) * SLOT;
  float loc[36], bl[36], ml[36];
#pragma unroll
  for (int j = 0; j < 36; j++) {
    loc[j] = base[(size_t)j * SLOT + el];
    bl[j] = base[(size_t)j * SLOT + 4160];
    ml[j] = base[(size_t)j * SLOT + 4161];
  }
  float m = 0.f, val = 0.f;
#pragma unroll
  for (int j = 0; j < 36; j++) {
    base[(size_t)j * SLOT + el] = val;
    if (el == 0) base[(size_t)j * SLOT + 4162] = m;
    float mn = fmaxf(bl[j] + m, ml[j]);
    val = __expf(bl[j] + m - mn) * val + __expf(ml[j] - mn) * loc[j];
    m = mn;
  }
}

__device__ __forceinline__ bf16x8 pack8(float4 a, float4 b) {
  union { bf16x8 v; unsigned u[4]; } r;
  r.u[0] = pack2(a.x, a.y); r.u[1] = pack2(a.z, a.w); r.u[2] = pack2(b.x, b.y); r.u[3] = pack2(b.z, b.w);
  return r.v;
}
__device__ __forceinline__ void phase_mlC(const P& p, int l, char* smem) {
  const int tid = opaque_tid(), lane = tid & 63, w = tid >> 6, q = lane & 15, quad = lane >> 4;
  const u16* mqk = (const u16*)p.MQK;
  const int nch = (l == 0) ? 36 : 32;
  const int total = 32 * nch;
  const int mrow = (q >> 2) * 8 + (q & 3);
  for (int item = blockIdx.x; item < total; item += gridDim.x) {
    int bh = item / nch, c = item % nch + (l == 0 ? 0 : 4);
    int b = bh >> 2, h = bh & 3;
    const int rowbase = (c < 4) ? (ML_ROWS + b * 256 + c * 64) : (b * 2048 + (c - 4) * 64);
    const int tau_t = w * 16 + q;
    const int trow = rowbase + tau_t;
    const bf16x8 bq0 = *(const bf16x8*)(mqk + (size_t)trow * 512 + h * 64 + quad * 8);
    const bf16x8 bq1 = *(const bf16x8*)(mqk + (size_t)trow * 512 + h * 64 + 32 + quad * 8);
    const u16* vt = (c < 4) ? (p.VTm + VTM_CTX_OFF + (size_t)((b * 4 + h) * 64 + q) * 256 + c * 64 + quad * 8)
                            : (p.VTm + (size_t)((b * 4 + h) * 64 + q) * 2048 + (c - 4) * 64 + quad * 8);
    const size_t vstr = (c < 4) ? (size_t)16 * 256 : (size_t)16 * 2048;
    f32x4 hs[4];
#pragma unroll
    for (int et = 0; et < 4; et++) hs[et] = (f32x4){0.f, 0.f, 0.f, 0.f};
#pragma unroll 1
    for (int dir = 0; dir < 2; dir++) {
      int j = dir ? (c < 4 ? 3 - c : 4 + 31 - (c - 4)) : c;
      const float* slot = p.mst + (size_t)(((b * 4 + h) * 2 + dir) * 36 + j) * SLOT;
      const int pt = dir ? 63 - tau_t : tau_t;
      const float m0 = slot[4162];
      const float bt = slot[4224 + pt];
      const float mt = bt + fmaxf(m0, slot[4352 + pt]);
      const float winter = __expf(bt + m0 - mt);
      f32x4 aw[4], ac[4];
#pragma unroll
      for (int et = 0; et < 4; et++) { aw[et] = (f32x4){0.f, 0.f, 0.f, 0.f}; ac[et] = (f32x4){0.f, 0.f, 0.f, 0.f}; }
      float dsum = 0.f;
#pragma unroll 1
      for (int kb = 0; kb < 2; kb++) {
        float wv[8];
#pragma unroll
        for (int T = 0; T < 2; T++) {
          const u16* kp = mqk + (size_t)(rowbase + kb * 32 + mrow + T * 4) * 512 + 256 + h * 64 + quad * 8;
          bf16x8 a0 = *(const bf16x8*)kp;
          bf16x8 a1 = *(const bf16x8*)(kp + 32);
          f32x4 sacc = (f32x4){0.f, 0.f, 0.f, 0.f};
          sacc = __builtin_amdgcn_mfma_f32_16x16x32_bf16(a0, bq0, sacc, 0, 0, 0);
          sacc = __builtin_amdgcn_mfma_f32_16x16x32_bf16(a1, bq1, sacc, 0, 0, 0);
#pragma unroll
          for (int rr = 0; rr < 4; rr++) {
            int tau_s = kb * 32 + quad * 8 + T * 4 + rr;
            int ps = dir ? 63 - tau_s : tau_s;
            bool valid = dir ? (tau_s >= tau_t) : (tau_s <= tau_t);
            float cs = slot[4288 + ps];
            float v = valid ? sacc[rr] * __expf(bt - mt + cs) : 0.f;
            wv[T * 4 + rr] = v;
            dsum += v;
          }
        }
        union { bf16x8 v; unsigned u[4]; } pk;
        pk.u[0] = pack2(wv[0], wv[1]); pk.u[1] = pack2(wv[2], wv[3]); pk.u[2] = pack2(wv[4], wv[5]); pk.u[3] = pack2(wv[6], wv[7]);
#pragma unroll
        for (int et = 0; et < 4; et++) {
          bf16x8 av = *(const bf16x8*)(vt + et * vstr + kb * 32);
          aw[et] = __builtin_amdgcn_mfma_f32_16x16x32_bf16(av, pk.v, aw[et], 0, 0, 0);
        }
      }
#pragma unroll 2
      for (int et = 0; et < 4; et++) {
        const float* cp = slot + (et * 16 + q) * 64 + quad * 8;
        bf16x8 c0 = pack8(*(const float4*)cp, *(const float4*)(cp + 4));
        bf16x8 c1 = pack8(*(const float4*)(cp + 32), *(const float4*)(cp + 36));
        ac[et] = __builtin_amdgcn_mfma_f32_16x16x32_bf16(c0, bq0, ac[et], 0, 0, 0);
        ac[et] = __builtin_amdgcn_mfma_f32_16x16x32_bf16(c1, bq1, ac[et], 0, 0, 0);
      }
      float qn = 0.f;
      {
        const float* np_ = slot + 4096 + quad * 8;
        float4 n0 = *(const float4*)np_, n1 = *(const float4*)(np_ + 4), n2 = *(const float4*)(np_ + 32), n3 = *(const float4*)(np_ + 36);
        union { bf16x8 v; unsigned u[4]; } q0, q1;
        q0.v = bq0; q1.v = bq1;
        qn += bflo(q0.u[0]) * n0.x + bfhi(q0.u[0]) * n0.y + bflo(q0.u[1]) * n0.z + bfhi(q0.u[1]) * n0.w;
        qn += bflo(q0.u[2]) * n1.x + bfhi(q0.u[2]) * n1.y + bflo(q0.u[3]) * n1.z + bfhi(q0.u[3]) * n1.w;
        qn += bflo(q1.u[0]) * n2.x + bfhi(q1.u[0]) * n2.y + bflo(q1.u[1]) * n2.z + bfhi(q1.u[1]) * n2.w;
        qn += bflo(q1.u[2]) * n3.x + bfhi(q1.u[2]) * n3.y + bflo(q1.u[3]) * n3.z + bfhi(q1.u[3]) * n3.w;
      }
      qn += __shfl_xor(qn, 16);
      qn += __shfl_xor(qn, 32);
      dsum += __shfl_xor(dsum, 16);
      dsum += __shfl_xor(dsum, 32);
      float den = dsum + winter * qn;
      float ih = 1.f / fmaxf(fabsf(den), __expf(-mt));
#pragma unroll
      for (int et = 0; et < 4; et++)
#pragma unroll
        for (int rr = 0; rr < 4; rr++) hs[et][rr] += (aw[et][rr] + winter * ac[et][rr]) * ih;
    }
    float ss = 0.f;
#pragma unroll
    for (int et = 0; et < 4; et++)
#pragma unroll
      for (int rr = 0; rr < 4; rr++) ss += hs[et][rr] * hs[et][rr];
    ss += __shfl_xor(ss, 16);
    ss += __shfl_xor(ss, 32);
    float rs = rsqrtf(ss * (1.f / 64.f) + 1e-6f);
#pragma unroll
    for (int et = 0; et < 4; et++) {
      int e0 = h * 64 + et * 16 + quad * 4;
      uint2 uo = *(const uint2*)(p.U + (size_t)trow * INC + 2560 + e0);
      float4 ng = *(const float4*)(p.ml_norm_g + l * 256 + e0);
      float o0 = hs[et][0] * rs * ng.x * sigmoidf_(bflo(uo.x));
      float o1 = hs[et][1] * rs * ng.y * sigmoidf_(bfhi(uo.x));
      float o2 = hs[et][2] * rs * ng.z * sigmoidf_(bflo(uo.y));
      float o3 = hs[et][3] * rs * ng.w * sigmoidf_(bfhi(uo.y));
      uint2 ov;
      ov.x = pack2(o0, o1);
      ov.y = pack2(o2, o3);
      *(uint2*)(p.Y + (size_t)trow * 1024 + 768 + e0) = ov;
    }
  }
}

typedef __attribute__((ext_vector_type(2))) float f32x2;
__device__ __forceinline__ float gelu_tanh(float x) {
  float u = 0.7978845608028654f * (x + 0.044715f * x * x * x);
  float th = 1.f - 2.f / (1.f + __expf(2.f * u));
  return 0.5f * x * (1.f + th);
}
__device__ __forceinline__ float dot16_fp8(const f32x2* xr, uint4 v) {
  f32x2 s = __builtin_amdgcn_cvt_pk_f32_fp8((int)v.x, false) * xr[0];
  s += __builtin_amdgcn_cvt_pk_f32_fp8((int)v.x, true) * xr[1];
  s += __builtin_amdgcn_cvt_pk_f32_fp8((int)v.y, false) * xr[2];
  s += __builtin_amdgcn_cvt_pk_f32_fp8((int)v.y, true) * xr[3];
  s += __builtin_amdgcn_cvt_pk_f32_fp8((int)v.z, false) * xr[4];
  s += __builtin_amdgcn_cvt_pk_f32_fp8((int)v.z, true) * xr[5];
  s += __builtin_amdgcn_cvt_pk_f32_fp8((int)v.w, false) * xr[6];
  s += __builtin_amdgcn_cvt_pk_f32_fp8((int)v.w, true) * xr[7];
  return s.x + s.y;
}
__device__ __forceinline__ void axpy16_fp8(f32x2* acc, float a, uint4 v) {
  f32x2 av = (f32x2){a, a};
  acc[0] += av * __builtin_amdgcn_cvt_pk_f32_fp8((int)v.x, false);
  acc[1] += av * __builtin_amdgcn_cvt_pk_f32_fp8((int)v.x, true);
  acc[2] += av * __builtin_amdgcn_cvt_pk_f32_fp8((int)v.y, false);
  acc[3] += av * __builtin_amdgcn_cvt_pk_f32_fp8((int)v.y, true);
  acc[4] += av * __builtin_amdgcn_cvt_pk_f32_fp8((int)v.z, false);
  acc[5] += av * __builtin_amdgcn_cvt_pk_f32_fp8((int)v.z, true);
  acc[6] += av * __builtin_amdgcn_cvt_pk_f32_fp8((int)v.w, false);
  acc[7] += av * __builtin_amdgcn_cvt_pk_f32_fp8((int)v.w, true);
}

__device__ __forceinline__ unsigned fkey(float f) {
  unsigned u = __float_as_uint(f);
  return (u & 0x80000000u) ? ~u : (u | 0x80000000u);
}
__device__ __forceinline__ int mbcnt64(unsigned long long m) {
  return __builtin_amdgcn_mbcnt_hi((unsigned)(m >> 32), __builtin_amdgcn_mbcnt_lo((unsigned)m, 0));
}
#define WAVE_LDS_FENCE() do { __builtin_amdgcn_fence(__ATOMIC_RELEASE, "wavefront"); __builtin_amdgcn_wave_barrier(); __builtin_amdgcn_fence(__ATOMIC_ACQUIRE, "wavefront"); } while (0)

#define RADIX_BODY(COUNT)                                                                  \
  unsigned pf = 0;                                                                         \
  int bit = 31;                                                                            \
  bool done = false;                                                                       \
  {                                                                                        \
    unsigned c = 0xC1000000u;                                                \
    int n = COUNT;                                                                         \
    n = __builtin_amdgcn_readfirstlane(n);                                                 \
    if (n < 16) {                                                                          \
      _Pragma("unroll 1") for (c = 0xC0800000u; c >= 0xBE800000u; c -= 0x00800000u) {      \
        n = COUNT;                                                                         \
        n = __builtin_amdgcn_readfirstlane(n);                                             \
        if (n >= 16) { pf = c; bit = 22; done = (n == 16); break; }                        \
      }                                                                                    \
    }                                                                                      \
  }                                                                                        \
  if (!done) {                                                                             \
    _Pragma("unroll 1") for (; bit >= 0; --bit) {                                          \
      const unsigned c = pf | (1u << bit);                                                 \
      int n = COUNT;                                                                       \
      n = __builtin_amdgcn_readfirstlane(n);                                               \
      if (n >= 16) { pf = c; if (n == 16) break; }                                         \
    }                                                                                      \
  }                                                                                        \
  return (unsigned)__builtin_amdgcn_readfirstlane((int)pf);
__device__ __forceinline__ unsigned radix_thr2(unsigned k0, unsigned k1) {
  RADIX_BODY((__popcll(__ballot(k0 >= c)) + __popcll(__ballot(k1 >= c))))
}
__device__ __forceinline__ unsigned radix_thr4(unsigned k0, unsigned k1, unsigned k2, unsigned k3) {
  RADIX_BODY((__popcll(__ballot(k0 >= c)) + __popcll(__ballot(k1 >= c)) + __popcll(__ballot(k2 >= c)) + __popcll(__ballot(k3 >= c))))
}
__device__ __forceinline__ void phase_peer_topk(const P& p, int l, char* smem) {
  const int tid = opaque_tid(), lane = tid & 63, w = tid >> 6;
  float* wl = (float*)smem + w * 512;
  float* cs = wl;
  int* ci = (int*)(wl + 32);
  int* el = (int*)(wl + 64);
  float* sl = wl + 192;
  const int nrows = (l == 1) ? ML_ROWS : MT_ROWS;
  const int nw = gridDim.x * 4;
  for (int row = blockIdx.x * 4 + w; row < nrows; row += nw) {
    float na0, na1, nb0, nb1;
    {
      const float* sp0 = p.S + (size_t)row * 2048;
      na0 = sp0[lane]; na1 = sp0[64 + lane]; nb0 = sp0[128 + lane]; nb1 = sp0[192 + lane];
    }
#pragma unroll 1
    for (int h = 0; h < 8; h++) {
      float a0 = na0, a1 = na1, b0 = nb0, b1 = nb1;
      {
        const float* spn = p.S + (size_t)row * 2048 + ((h + 1) & 7) * 256;
        na0 = spn[lane]; na1 = spn[64 + lane]; nb0 = spn[128 + lane]; nb1 = spn[192 + lane];
      }
      unsigned kA0 = fkey(a0), kA1 = fkey(a1), kB0 = fkey(b0), kB1 = fkey(b1);
      const unsigned pA = radix_thr2(kA0, kA1), pB = radix_thr2(kB0, kB1);
      {
        unsigned long long m0 = __ballot(kA0 >= pA), m1 = __ballot(kA1 >= pA);
        int p0 = mbcnt64(m0), p1 = __popcll(m0) + mbcnt64(m1);
        if (kA0 >= pA && p0 < 16) { cs[p0] = a0; ci[p0] = lane; }
        if (kA1 >= pA && p1 < 16) { cs[p1] = a1; ci[p1] = lane + 64; }
        m0 = __ballot(kB0 >= pB); m1 = __ballot(kB1 >= pB);
        p0 = mbcnt64(m0); p1 = __popcll(m0) + mbcnt64(m1);
        if (kB0 >= pB && p0 < 16) { cs[16 + p0] = b0; ci[16 + p0] = lane; }
        if (kB1 >= pB && p1 < 16) { cs[16 + p1] = b1; ci[16 + p1] = lane + 64; }
      }
      WAVE_LDS_FENCE();
      const int ii = lane >> 2, jb = (lane & 3) * 4;
      float s1 = cs[ii];
      float c0 = s1 + cs[16 + jb + 0], c1 = s1 + cs[16 + jb + 1], c2 = s1 + cs[16 + jb + 2], c3 = s1 + cs[16 + jb + 3];
      int e1 = ci[ii] * 128;
      int f0 = e1 + ci[16 + jb + 0], f1 = e1 + ci[16 + jb + 1], f2 = e1 + ci[16 + jb + 2], f3 = e1 + ci[16 + jb + 3];
      unsigned k0 = fkey(c0), k1 = fkey(c1), k2 = fkey(c2), k3 = fkey(c3);
      const unsigned pC = radix_thr4(k0, k1, k2, k3);
      {
        unsigned long long m0 = __ballot(k0 >= pC), m1 = __ballot(k1 >= pC), m2 = __ballot(k2 >= pC), m3 = __ballot(k3 >= pC);
        int q0 = mbcnt64(m0);
        int q1 = __popcll(m0) + mbcnt64(m1);
        int q2 = __popcll(m0) + __popcll(m1) + mbcnt64(m2);
        int q3 = __popcll(m0) + __popcll(m1) + __popcll(m2) + mbcnt64(m3);
        if (k0 >= pC && q0 < 16) { el[h * 16 + q0] = f0; sl[h * 16 + q0] = c0; }
        if (k1 >= pC && q1 < 16) { el[h * 16 + q1] = f1; sl[h * 16 + q1] = c1; }
        if (k2 >= pC && q2 < 16) { el[h * 16 + q2] = f2; sl[h * 16 + q2] = c2; }
        if (k3 >= pC && q3 < 16) { el[h * 16 + q3] = f3; sl[h * 16 + q3] = c3; }
      }
      WAVE_LDS_FENCE();
    }
    {
      float v0 = sl[lane], v1 = sl[64 + lane];
      float m0 = v0, m1 = v1;
#pragma unroll
      for (int o = 1; o < 16; o <<= 1) { m0 = fmaxf(m0, __shfl_xor(m0, o)); m1 = fmaxf(m1, __shfl_xor(m1, o)); }
      float e0 = __expf(v0 - m0), e1 = __expf(v1 - m1);
      float s0 = e0, s1 = e1;
#pragma unroll
      for (int o = 1; o < 16; o <<= 1) { s0 += __shfl_xor(s0, o); s1 += __shfl_xor(s1, o); }
      sl[lane] = e0 / s0;
      sl[64 + lane] = e1 / s1;
    }
    WAVE_LDS_FENCE();
    p.elist[(size_t)row * 128 + lane] = el[lane];
    p.elist[(size_t)row * 128 + 64 + lane] = el[64 + lane];
    p.glist[(size_t)row * 128 + lane] = sl[lane];
    p.glist[(size_t)row * 128 + 64 + lane] = sl[64 + lane];
    p.slist[(size_t)row * 128 + lane] = p.su[l * 16384 + el[lane]];
    p.slist[(size_t)row * 128 + 64 + lane] = p.su[l * 16384 + el[64 + lane]];
    WAVE_LDS_FENCE();
  }
}

template <int S>
__device__ __forceinline__ float xor_xchg(float v) {
  if (S == 1) return __int_as_float(__builtin_amdgcn_mov_dpp(__float_as_int(v), 0xB1, 0xF, 0xF, true));
  if (S == 2) return __int_as_float(__builtin_amdgcn_mov_dpp(__float_as_int(v), 0x4E, 0xF, 0xF, true));
  return __shfl_xor(v, S);
}
struct PeerMeta {
  int id0, id1;
  uint4 xq;
  float g0, g1;
  float2 cur, g2;
};
template <int PH>
__device__ __forceinline__ void peer_load_meta(const P& p, int l, int t, int k, int lane, PeerMeta& m) {
  m.id0 = p.elist[(size_t)t * 128 + lane];
  m.id1 = p.elist[(size_t)t * 128 + 64 + lane];
  if (PH == 0) {
    m.xq = *(const uint4*)(p.xq + (size_t)t * 1024 + k * 128 + (lane & 7) * 16);
  } else {
    m.g0 = p.glist[(size_t)t * 128 + lane];
    m.g1 = p.glist[(size_t)t * 128 + 64 + lane];
    {
      const int Bc = ((lane & 8) ? 8 : 0) + ((lane & 16) ? 4 : 0) + ((lane & 32) ? 2 : 0);
      const int col = k * 128 + (lane & 7) * 16 + Bc;
      const int mr = t < ML_ROWS ? (t >> 11) : 8;
      m.g2 = *(const float2*)(p.mod + (size_t)(l * 9 + mr) * 6144 + 5120 + col);
      m.cur = *(const float2*)(t < ML_ROWS ? p.out + (size_t)t * 1024 + col : p.hc + (size_t)(t - ML_ROWS) * 1024 + col);
    }
  }
}
template <int PH>
__device__ __forceinline__ void peer_issue(const PeerMeta& m, int* idb, float* alb, const unsigned char* tab, int lane, uint4* rr, uint4& xq, float2& rmw, float2& gsc) {
  idb[lane] = m.id0;
  idb[64 + lane] = m.id1;
  if (PH == 0) {
    xq = m.xq;
  } else {
    alb[lane] = m.g0;
    alb[64 + lane] = m.g1;
    rmw = m.cur;
    gsc = m.g2;
  }
  WAVE_LDS_FENCE();
  const int es = lane >> 3;
#pragma unroll
  for (int i = 0; i < 16; i++) rr[i] = *(const uint4*)(tab + (size_t)idb[i * 8 + es] * 128);
}
template <int PH>
__device__ __forceinline__ void peer_compute(const P& p, int l, int t, bool valid, int k, int lane, const uint4* rr, const uint4& xq4, const float* alb, float2 rmw, float2 gsc) {
  const int es = lane >> 3;
  const int s0 = (PH == 0) ? 1 : 8, s1 = (PH == 0) ? 2 : 16, s2 = (PH == 0) ? 4 : 32;
  const bool c0 = (lane & s0) != 0, c1 = (lane & s1) != 0, c2 = (lane & s2) != 0;
  const int B = (c0 ? 8 : 0) + (c1 ? 4 : 0) + (c2 ? 2 : 0);
  float v[16];
  if (PH == 0) {
#pragma unroll
    for (int i = 0; i < 16; i++) {
      int a_ = __builtin_amdgcn_sdot4((int)rr[i].x, (int)xq4.x, 0, false);
      a_ = __builtin_amdgcn_sdot4((int)rr[i].y, (int)xq4.y, a_, false);
      a_ = __builtin_amdgcn_sdot4((int)rr[i].z, (int)xq4.z, a_, false);
      a_ = __builtin_amdgcn_sdot4((int)rr[i].w, (int)xq4.w, a_, false);
      v[i] = (float)a_;
    }
  } else {
    f32x2 acc[8];
#pragma unroll
    for (int i = 0; i < 8; i++) acc[i] = (f32x2){0.f, 0.f};
#pragma unroll
    for (int i = 0; i < 16; i++) axpy16_fp8(acc, alb[i * 8 + es], rr[i]);
#pragma unroll
    for (int i = 0; i < 8; i++) { v[2 * i] = acc[i].x; v[2 * i + 1] = acc[i].y; }
  }
  float k8[8], k4[4], k2[2];
#pragma unroll
  for (int i = 0; i < 8; i++) k8[i] = (c0 ? v[i + 8] : v[i]) + xor_xchg<(PH == 0) ? 1 : 8>(c0 ? v[i] : v[i + 8]);
#pragma unroll
  for (int i = 0; i < 4; i++) k4[i] = (c1 ? k8[i + 4] : k8[i]) + xor_xchg<(PH == 0) ? 2 : 16>(c1 ? k8[i] : k8[i + 4]);
#pragma unroll
  for (int i = 0; i < 2; i++) k2[i] = (c2 ? k4[i + 2] : k4[i]) + xor_xchg<(PH == 0) ? 4 : 32>(c2 ? k4[i] : k4[i + 2]);
  if (PH == 0) {
    float* hq = p.hp + ((size_t)t * 8 + k) * 128;
    if (valid) {
      hq[(B + 0) * 8 + es] = k2[0];
      hq[(B + 1) * 8 + es] = k2[1];
    }
  } else {
    const int col = k * 128 + (lane & 7) * 16 + B;
    float2* dst = (float2*)(t < ML_ROWS ? p.out + (size_t)t * 1024 + col : p.hc + (size_t)(t - ML_ROWS) * 1024 + col);
    float2 cur = rmw;
    cur.x += gsc.x * 0.125f * k2[0];
    cur.y += gsc.y * 0.125f * k2[1];
    if (valid) *dst = cur;
  }
}
template <int PH>
__device__ __forceinline__ void phase_peer_uv(const P& p, int l, char* smem) {
  const int tid = opaque_tid(), lane = tid & 63, w = tid >> 6;
  int* idA = (int*)smem + w * 512;
  int* idB = idA + 128;
  float* alA = (float*)(idA + 256);
  float* alB = alA + 128;
  const int nrows = (l == 1) ? ML_ROWS : MT_ROWS;
  const int k = blockIdx.x & 7;
  const int gw = (blockIdx.x >> 3) * 4 + w, ngw = (gridDim.x >> 3) * 4;
  const unsigned char* tab = (const unsigned char*)(PH == 0 ? p.Ub : p.Vb) + (size_t)((l * 8 + k) * 16384) * 128 + (lane & 7) * 16;
  PeerMeta M;
  uint4 rrA[16], rrB[16];
  uint4 xqA = make_uint4(0, 0, 0, 0), xqB = xqA;
  float2 rmA = make_float2(0.f, 0.f), rmB = rmA, gsA = rmA, gsB = rmA;
  if (gw >= nrows) return;
  const int nit = (nrows - gw + ngw - 1) / ngw;
  const int tlast = gw + (nit - 1) * ngw;
  peer_load_meta<PH>(p, l, gw, k, lane, M);
  peer_issue<PH>(M, idA, alA, tab, lane, rrA, xqA, rmA, gsA);
  peer_load_meta<PH>(p, l, min(gw + ngw, tlast), k, lane, M);
#pragma unroll 1
  for (int i = 0; i < nit; i += 2) {
    const int tA = gw + i * ngw, tB = tA + ngw;
    peer_issue<PH>(M, idB, alB, tab, lane, rrB, xqB, rmB, gsB);
    peer_load_meta<PH>(p, l, min(tB + ngw, tlast), k, lane, M);
    peer_compute<PH>(p, l, tA, true, k, lane, rrA, xqA, alA, rmA, gsA);
    peer_issue<PH>(M, idA, alA, tab, lane, rrA, xqA, rmA, gsA);
    peer_load_meta<PH>(p, l, min(tB + 2 * ngw, tlast), k, lane, M);
    peer_compute<PH>(p, l, min(tB, tlast), tB <= tlast, k, lane, rrB, xqB, alB, rmB, gsB);
  }
}

__device__ __forceinline__ void phase_peer_act(const P& p, int l) {
  const int tid = opaque_tid(), lane = tid & 63, w = tid >> 6;
  const int nrows = (l == 1) ? ML_ROWS : MT_ROWS;
  const int nw = gridDim.x * 4;
  for (int t = blockIdx.x * 4 + w; t < nrows; t += nw) {
    float h0 = 0.f, h1 = 0.f;
#pragma unroll
    for (int kk = 0; kk < 8; kk++) {
      h0 += p.hp[((size_t)t * 8 + kk) * 128 + lane];
      h1 += p.hp[((size_t)t * 8 + kk) * 128 + 64 + lane];
    }
    const float sxt = p.sx[t];
    const float s0 = p.slist[(size_t)t * 128 + lane] * sxt, s1 = p.slist[(size_t)t * 128 + 64 + lane] * sxt;
    const float g0 = p.glist[(size_t)t * 128 + lane], g1 = p.glist[(size_t)t * 128 + 64 + lane];
    p.glist[(size_t)t * 128 + lane] = gelu_tanh(h0 * s0) * g0;
    p.glist[(size_t)t * 128 + 64 + lane] = gelu_tanh(h1 * s1) * g1;
  }
}

#define RUN(k, call)                         \
  if (lo <= (k) && (k) < hi) {               \
    call;                                    \
    if ((k) + 1 < hi) xcd_barrier(xb);       \
  }
#define LAYER(l, base)                                                                                                    \
  RUN(base + 0, phase_norm(p, l, 1))                                                                                     \
  RUN(base + 1, phase_gemm<0>(p, l, p.xn, p.WinT + (size_t)l * INC_PAD * 1024, MT_ROWS / 128, INC_PAD / 128, smem))     \
  RUN(base + 2, phase_mixprep(p, l, smem))                                                                               \
  RUN(base + 3, phase_attn_mlA(p, l, smem))                                                                              \
  RUN(base + 4, phase_attn_mlB(p, l, smem))                                                                                            \
  RUN(base + 5, phase_mlC(p, l, smem))                                                                                   \
  RUN(base + 6, phase_gemm<1>(p, l, p.Y, p.WoutT + (size_t)l * 1024 * 1024, (l == 0 ? MT_ROWS : ML_ROWS) / 128, 8, smem)) \
  RUN(base + 7, phase_norm(p, l, 2))                                                                                     \
  RUN(base + 8, phase_gemm<2>(p, l, p.xn, p.WsT + (size_t)l * 2048 * 1024, (l == 0 ? MT_ROWS : ML_ROWS) / 128, 16, smem)) \
  RUN(base + 9, phase_peer_topk(p, l, smem))                                                                             \
  RUN(base + 10, phase_peer_uv<0>(p, l, smem))                                                                            \
  RUN(base + 11, phase_peer_act(p, l))                                                                                   \
  RUN(base + 12, phase_peer_uv<1>(p, l, smem))

__global__ void __launch_bounds__(256, 3) fwd_kernel(P p) {
  __shared__ __attribute__((aligned(16))) char smem[SMEM_BYTES];
  __shared__ uint4 xb_words;
  cg::grid_group grid = cg::this_grid();
  const int lo = (int)p.ph_lo, hi = (int)p.ph_hi;
  if (threadIdx.x == 0) xb_words = make_uint4(0u, 0u, 0u, 0u);
  __syncthreads();
  XcdBarrier xb = xcd_barrier_post(p.bar, (volatile LAS unsigned*)&xb_words);
  if (hi - lo > 1) grid.sync();
  RUN(0, phase_prologue(p, smem))
  LAYER(0, 1)
  LAYER(1, 14)
}

extern "C" void kernel_launch(void* const* d_in, const int* in_sizes, int n_in, void* d_out, int out_size, void* d_ws,
                              size_t ws_size, hipStream_t stream) {
  static int grid_blocks = 0;
  if (!grid_blocks) {
    int dev = 0, cus = 0, per_cu = 0;
    hipGetDevice(&dev);
    hipDeviceGetAttribute(&cus, hipDeviceAttributeMultiprocessorCount, dev);
    hipOccupancyMaxActiveBlocksPerMultiprocessor(&per_cu, fwd_kernel, 256, 0);
    if (per_cu < 1) per_cu = 1;
    if (per_cu > 3) per_cu = 3;
    grid_blocks = (cus * per_cu) & ~7;
  }
  P p{};
  const float** ins = (const float**)&p;
  for (int i = 0; i < 22; i++) ins[i] = (const float*)d_in[i];
  p.out = (float*)d_out;
  char* ws = (char*)d_ws;
  size_t off = 0;
  auto take = [&](size_t bytes) { char* r = ws + off; off += (bytes + 255) & ~(size_t)255; return r; };
  p.WinT = (u16*)take((size_t)2 * INC_PAD * 1024 * 2);
  p.WoutT = (u16*)take((size_t)2 * 1024 * 1024 * 2);
  p.WsT = (u16*)take((size_t)2 * 2048 * 1024 * 2);
  p.Ub = (u16*)take((size_t)2 * 16384 * 1024);
  p.Vb = (u16*)take((size_t)2 * 16384 * 1024);
  p.xq = (signed char*)take((size_t)MT_ROWS * 1024);
  p.sx = (float*)take((size_t)MT_ROWS * 4);
  p.su = (float*)take((size_t)2 * 16384 * 4);
  p.slist = (float*)take((size_t)MT_ROWS * 128 * 4);
  p.elist = (int*)take((size_t)MT_ROWS * 128 * 4);
  p.glist = (float*)take((size_t)MT_ROWS * 128 * 4);
  p.mod = (float*)take((size_t)2 * 9 * 6144 * 4);
  p.xn = (u16*)take((size_t)MT_ROWS * 1024 * 2);
  p.U = (u16*)take((size_t)MT_ROWS * INC * 2);
  p.MQK = (float*)take((size_t)MT_ROWS * 512 * 2);
  p.Y = (u16*)take((size_t)MT_ROWS * 1024 * 2);
  p.S = (float*)p.U;
  p.hp = (float*)take((size_t)MT_ROWS * 8 * 128 * 4);
  p.G = (float*)take((size_t)MT_ROWS * 16 * 4);
  p.mst = (float*)take((size_t)2304 * SLOT * 4);
  p.hc = (float*)take((size_t)MC_ROWS * 1024 * 4);
  p.bar = (unsigned*)take((size_t)XCD_BAR_WORDS * 4);
  p.VTm = (u16*)take((size_t)(8 * 4 * 64) * (2048 + 256) * 2);
  p.VT = (u16*)take((size_t)(8 * 8 * 64) * (2048 + 256) * 2);
  if (off > ws_size) { fprintf(stderr, "workspace too small: need %zu have %zu\n", off, ws_size); return; }
  (void)hipMemsetAsync(p.bar, 0, (size_t)XCD_BAR_WORDS * 4, stream);
#if MEGA
  p.ph_lo = 0; p.ph_hi = NPHASES;
  void* args[] = {&p};
  hipError_t e = hipLaunchCooperativeKernel((void*)fwd_kernel, dim3(grid_blocks), dim3(256), args, 0, stream);
  if (e != hipSuccess) fprintf(stderr, "cooperative launch failed: %s (grid %d)\n", hipGetErrorString(e), grid_blocks);
#else
  for (int ph = 0; ph < NPHASES; ph++) {
    p.ph_lo = ph; p.ph_hi = ph + 1;
    void* args[] = {&p};
    hipError_t e = hipLaunchCooperativeKernel((void*)fwd_kernel, dim3(grid_blocks), dim3(256), args, 0, stream);
    if (e != hipSuccess) fprintf(stderr, "cooperative launch failed: %s (grid %d)\n", hipGetErrorString(e), grid_blocks);
  }
#endif
}
```
